# Optimizing an MI355X kernel written in HIP

```python
import jax, jax.numpy as jnp
from jax import lax
import numpy as np

D_MODEL = 2048
BATCH = 8
SEQ = 2048
DEPTH = 1

CHUNK = 64
Q_BLOCK = 128
D_PLE = 256
EPS = 1e-6

POOL_WIDTH = D_MODEL // 2
POOL_WINDOWS = (2, 4, 8, 16)
POOL_GROUPS = len(POOL_WINDOWS)
POOL_GROUP_WIDTH = POOL_WIDTH // POOL_GROUPS

V_HEAD = 128
MLA_HEADS = (D_MODEL // 2) // V_HEAD
MLA_WIDTH = MLA_HEADS * V_HEAD
QK_NOPE = 128
QK_ROPE = 64
QK_HEAD = QK_NOPE + QK_ROPE
Q_LORA = 512
KV_LORA = 512
ROPE_THETA = 10000.0

MIX_WIDTH = POOL_WIDTH + MLA_WIDTH
IN_COLS = POOL_WIDTH + Q_LORA + KV_LORA + QK_ROPE

PEER_HEADS = 8
PEER_NKEYS = 128
PEER_EXPERTS = PEER_NKEYS * PEER_NKEYS
PEER_DKEY = 256
PEER_HALF = PEER_DKEY // 2
PEER_TOPK = 16
PEER_TOK_BLOCK = 128

kernel_name = "hybrid_pool_mla_peer_ple"


def rms_norm(x, g):
    xf = x.astype(jnp.float32)
    y = xf * lax.rsqrt(jnp.mean(xf * xf, axis=-1, keepdims=True) + EPS)
    return (y * g.astype(jnp.float32)).astype(x.dtype)


def apply_rope(x, cos, sin):
    half = QK_ROPE // 2
    xf = x.astype(jnp.float32)
    x1, x2 = xf[..., :half], xf[..., half:]
    return jnp.concatenate([x1 * cos - x2 * sin, x2 * cos + x1 * sin], axis=-1).astype(x.dtype)


def pool_mixer(xp, w_pool, pool_scale):
    B, S, _ = xp.shape
    xf = xp.reshape(B, S, POOL_GROUPS, POOL_GROUP_WIDTH).astype(jnp.float32)
    cs = jnp.cumsum(xf, axis=1)
    t = jnp.arange(S)
    outs = []
    for g, w in enumerate(POOL_WINDOWS):
        csg = cs[:, :, g]
        lower = jnp.pad(csg, ((0, 0), (w, 0), (0, 0)))[:, :S]
        cnt = jnp.minimum(t + 1, w).astype(jnp.float32)[None, :, None]
        outs.append((csg - lower) / cnt - xf[:, :, g])
    d = jnp.stack(outs, axis=2).astype(xp.dtype)
    y = jnp.einsum('bsgc,gcd->bsgd', d, w_pool)
    return y.reshape(B, S, POOL_WIDTH) * pool_scale


def mla(c_q, c_kv, k_rope, positions, q_lat_gain, kv_lat_gain, w_uq, w_ukv, q_norm_gain, k_norm_gain):
    B, S, _ = c_q.shape
    q = (rms_norm(c_q, q_lat_gain) @ w_uq).reshape(B, S, MLA_HEADS, QK_HEAD)
    kv = (rms_norm(c_kv, kv_lat_gain) @ w_ukv).reshape(B, S, MLA_HEADS, QK_NOPE + V_HEAD)
    k_nope, v = kv[..., :QK_NOPE], kv[..., QK_NOPE:]
    k = jnp.concatenate([k_nope, jnp.broadcast_to(k_rope[:, :, None, :], (B, S, MLA_HEADS, QK_ROPE))], axis=-1)
    q = rms_norm(q, q_norm_gain)
    k = rms_norm(k, k_norm_gain)
    inv_freq = ROPE_THETA ** (-jnp.arange(0, QK_ROPE, 2, dtype=jnp.float32) / QK_ROPE)
    ang = positions.astype(jnp.float32)[:, :, None] * inv_freq
    cos, sin = jnp.cos(ang)[:, :, None, :], jnp.sin(ang)[:, :, None, :]
    q = jnp.concatenate([q[..., :QK_NOPE], apply_rope(q[..., QK_NOPE:], cos, sin)], axis=-1)
    k = jnp.concatenate([k[..., :QK_NOPE], apply_rope(k[..., QK_NOPE:], cos, sin)], axis=-1)

    nb = S // Q_BLOCK
    qb = q.reshape(B, nb, Q_BLOCK, MLA_HEADS, QK_HEAD).transpose(1, 0, 2, 3, 4)
    k_chunk = jnp.arange(S) // CHUNK
    scale = QK_HEAD ** -0.5

    def attend(args):
        q_blk, blk = args
        q_chunk = (blk * Q_BLOCK + jnp.arange(Q_BLOCK)) // CHUNK
        s = jnp.einsum('bqhd,bkhd->bhqk', q_blk, k, preferred_element_type=jnp.float32) * scale
        s = jnp.where(k_chunk[None, :] <= q_chunk[:, None], s, -jnp.inf)
        pr = jax.nn.softmax(s, axis=-1).astype(v.dtype)
        return jnp.einsum('bhqk,bkhd->bqhd', pr, v)

    o = lax.map(attend, (qb, jnp.arange(nb)))
    return o.transpose(1, 0, 2, 3, 4).reshape(B, S, MLA_WIDTH)


def peer(xn, w_pq, sub_k1, sub_k2, expert_u, expert_v):
    B, S, D = xn.shape
    q = (xn @ w_pq).reshape(B, S, PEER_HEADS, 2, PEER_HALF)
    s1 = jnp.einsum('bshd,hnd->bshn', q[..., 0, :], sub_k1, preferred_element_type=jnp.float32)
    s2 = jnp.einsum('bshd,hnd->bshn', q[..., 1, :], sub_k2, preferred_element_type=jnp.float32)
    v1, i1 = lax.top_k(s1, PEER_TOPK)
    v2, i2 = lax.top_k(s2, PEER_TOPK)
    cand = (v1[..., :, None] + v2[..., None, :]).reshape(B, S, PEER_HEADS, PEER_TOPK * PEER_TOPK)
    vs, ci = lax.top_k(cand, PEER_TOPK)
    e1 = jnp.take_along_axis(i1, ci // PEER_TOPK, axis=-1)
    e2 = jnp.take_along_axis(i2, ci % PEER_TOPK, axis=-1)
    eidx = e1 * PEER_NKEYS + e2
    gates = jax.nn.softmax(vs, axis=-1).astype(xn.dtype)

    T = B * S
    nblk = T // PEER_TOK_BLOCK
    kk = PEER_HEADS * PEER_TOPK
    xt = xn.reshape(nblk, PEER_TOK_BLOCK, D)
    it = eidx.reshape(nblk, PEER_TOK_BLOCK, kk)
    gt = gates.reshape(nblk, PEER_TOK_BLOCK, kk)

    def block(args):
        xb, ib, gb = args
        act = jax.nn.gelu(jnp.einsum('tkd,td->tk', expert_u[ib], xb))
        return jnp.einsum('tk,tkd->td', act * gb, expert_v[ib])

    return lax.map(block, (xt, it, gt)).reshape(B, S, D)


def setup_inputs(seed: int = 0) -> dict:
    key = jax.random.key(seed)
    ks = jax.random.split(key, 24)
    f32 = jnp.float32

    def nrm(k, shape, scale):
        return jax.random.normal(k, shape, f32) * scale

    def gain(k, n):
        return 1.0 + 0.02 * jax.random.normal(k, (DEPTH, n), f32)

    x = jax.random.normal(ks[0], (BATCH, SEQ, D_MODEL), f32)
    p = jax.random.normal(ks[1], (DEPTH, BATCH, SEQ, D_PLE), f32)
    offs = jax.random.randint(ks[2], (BATCH, 1), 0, 4096, dtype=jnp.int32)
    positions = offs + jnp.arange(SEQ, dtype=jnp.int32)[None, :]
    return {
        "x": x,
        "p": p,
        "positions": positions,
        "mix_norm_gain": gain(ks[3], D_MODEL),
        "w_in": nrm(ks[4], (DEPTH, D_MODEL, IN_COLS), D_MODEL ** -0.5),
        "w_pool": nrm(ks[5], (DEPTH, POOL_GROUPS, POOL_GROUP_WIDTH, POOL_GROUP_WIDTH), POOL_GROUP_WIDTH ** -0.5),
        "pool_scale": 1.0 + 0.1 * jax.random.normal(ks[6], (DEPTH, POOL_WIDTH), f32),
        "q_lat_gain": gain(ks[7], Q_LORA),
        "kv_lat_gain": gain(ks[8], KV_LORA),
        "w_uq": nrm(ks[9], (DEPTH, Q_LORA, MLA_HEADS * QK_HEAD), Q_LORA ** -0.5),
        "w_ukv": nrm(ks[10], (DEPTH, KV_LORA, MLA_HEADS * (QK_NOPE + V_HEAD)), KV_LORA ** -0.5),
        "q_norm_gain": gain(ks[11], QK_HEAD),
        "k_norm_gain": gain(ks[12], QK_HEAD),
        "w_out": nrm(ks[13], (DEPTH, MIX_WIDTH, D_MODEL), MIX_WIDTH ** -0.5),
        "ffn_norm_gain": gain(ks[14], D_MODEL),
        "w_pq": nrm(ks[15], (DEPTH, D_MODEL, PEER_HEADS * PEER_DKEY), D_MODEL ** -0.5),
        "sub_k1": nrm(ks[16], (DEPTH, PEER_HEADS, PEER_NKEYS, PEER_HALF), PEER_HALF ** -0.5),
        "sub_k2": nrm(ks[17], (DEPTH, PEER_HEADS, PEER_NKEYS, PEER_HALF), PEER_HALF ** -0.5),
        "expert_u": nrm(ks[18], (DEPTH, PEER_EXPERTS, D_MODEL), D_MODEL ** -0.5),
        "expert_v": nrm(ks[19], (DEPTH, PEER_EXPERTS, D_MODEL), PEER_HEADS ** -0.5),
        "ple_norm_gain": gain(ks[20], D_MODEL),
        "w_ple_gate": nrm(ks[21], (DEPTH, D_MODEL, D_MODEL), D_MODEL ** -0.5),
        "w_ple_proj": nrm(ks[22], (DEPTH, D_PLE, D_MODEL), D_PLE ** -0.5),
    }


def reference(x, p, positions, mix_norm_gain, w_in, w_pool, pool_scale, q_lat_gain, kv_lat_gain,
              w_uq, w_ukv, q_norm_gain, k_norm_gain, w_out, ffn_norm_gain, w_pq, sub_k1, sub_k2,
              expert_u, expert_v, ple_norm_gain, w_ple_gate, w_ple_proj):
    h = x
    c0 = POOL_WIDTH
    c1 = c0 + Q_LORA
    c2 = c1 + KV_LORA
    for i in range(DEPTH):
        z = rms_norm(h, mix_norm_gain[i]) @ w_in[i]
        y_pool = pool_mixer(z[..., :c0], w_pool[i], pool_scale[i])
        y_mla = mla(z[..., c0:c1], z[..., c1:c2], z[..., c2:], positions,
                    q_lat_gain[i], kv_lat_gain[i], w_uq[i], w_ukv[i], q_norm_gain[i], k_norm_gain[i])
        h = h + jnp.concatenate([y_pool, y_mla], axis=-1) @ w_out[i]
        h = h + peer(rms_norm(h, ffn_norm_gain[i]), w_pq[i], sub_k1[i], sub_k2[i], expert_u[i], expert_v[i])
        gate = jax.nn.sigmoid(rms_norm(h, ple_norm_gain[i]) @ w_ple_gate[i])
        h = h + gate * (p[i] @ w_ple_proj[i])
    return h
```

```cpp
#include <hip/hip_runtime.h>
#include <cstdio>
#include <cstdint>

#define LAS __attribute__((address_space(3)))
#define GAS __attribute__((address_space(1)))
typedef unsigned short bf16_t;
typedef short bf16x8 __attribute__((ext_vector_type(8)));
typedef short s16x4 __attribute__((ext_vector_type(4)));
typedef float f32x4 __attribute__((ext_vector_type(4)));
typedef float f32x2 __attribute__((ext_vector_type(2)));
typedef float f32x16 __attribute__((ext_vector_type(16)));
typedef unsigned u32x4 __attribute__((ext_vector_type(4)));
typedef unsigned u32x2 __attribute__((ext_vector_type(2)));
typedef __bf16 bf16x2_t __attribute__((ext_vector_type(2)));

constexpr int M = 16384, DM = 2048, SEQ = 2048, NB = 8, NH = 8;
constexpr float EPS = 1e-6f;
constexpr size_t MiB = 1u << 20;
constexpr size_t WS_CTL = 0, CTL_ZERO_BYTES = 1 * MiB;
constexpr size_t WS_WIN = 1 * MiB;
constexpr size_t WS_WPOOL = 10 * MiB;
constexpr size_t WS_SK = 10 * MiB + 512 * 1024;
constexpr size_t WS_WUQ = 11 * MiB;
constexpr size_t WS_WUKV = 13 * MiB;
constexpr size_t WS_WOUT = 15 * MiB;
constexpr size_t WS_WPQ = 23 * MiB;
constexpr size_t WS_WG = 31 * MiB;
constexpr size_t WS_WP = 39 * MiB;
constexpr size_t WS_PB = 40 * MiB;
constexpr size_t WS_COS = 48 * MiB, WS_SIN = 50 * MiB;
constexpr size_t WS_SSQ_CQ = 52 * MiB, WS_SSQ_CKV = 52 * MiB + 512 * 1024, WS_SSQ_H1 = 53 * MiB, WS_RSTD2 = 55 * MiB, WS_RSTD3 = 55 * MiB + 512 * 1024;
constexpr size_t WS_EU = 56 * MiB, WS_EV = 120 * MiB;
constexpr size_t WS_R1 = 184 * MiB;
constexpr size_t WS_ZP = 248 * MiB, WS_U = 280 * MiB, WS_H2B = 248 * MiB;
constexpr size_t WS_CQ = 312 * MiB, WS_CKV = 328 * MiB, WS_KRP = 344 * MiB, WS_PIDX = 312 * MiB, WS_PGATE = 320 * MiB;
constexpr size_t WS_Q = 360 * MiB, WS_K = 408 * MiB, WS_V = 456 * MiB, WS_H1G = 360 * MiB;
constexpr size_t WS_END = 488 * MiB;
constexpr int RING_BYTES = 131072, EPI_OFF = RING_BYTES, EPI_BYTES = 8192, LDSCTL_OFF = EPI_OFF + EPI_BYTES, MISC_OFF = LDSCTL_OFF + 320, LDS_BYTES = 147456;
constexpr int NWAVES = 8;

__device__ __forceinline__ unsigned cvtpk(float lo, float hi) { f32x2 v = {lo, hi}; bf16x2_t b = __builtin_convertvector(v, bf16x2_t); return __builtin_bit_cast(unsigned, b); }
__device__ __forceinline__ float bf_lo(unsigned w) { return __builtin_bit_cast(float, w << 16); }
__device__ __forceinline__ float bf_hi(unsigned w) { return __builtin_bit_cast(float, w & 0xffff0000u); }
__device__ __forceinline__ float wave_sum(float v) {
#pragma unroll
    for (int o = 1; o < 64; o <<= 1) v += __shfl_xor(v, o);
    return v;
}
#define EPI_BAR() do { asm volatile("s_waitcnt lgkmcnt(0)" ::: "memory"); __builtin_amdgcn_s_barrier(); asm volatile("" ::: "memory"); } while (0)

namespace pg8 {
constexpr int BM = 256, BK = 64, HALF = 128, HTB = HALF * BK * 2, STAGE_BYTES = 8 * HTB, NXCD = 8, WGM = 8;
__host__ __device__ __forceinline__ int lds_byte(int r, int c) { const int st = (r >> 4) * 2 + (c >> 5), rr = r & 15, cc = c & 31, ob = rr * 64 + cc * 2; return st * 1024 + (ob ^ (((ob >> 9) & 1) << 5)); }
__host__ __device__ __forceinline__ void stage_rc(int b, int& R, int& C) { const int st = b / 1024, sb = b % 1024, swz = sb ^ (((sb >> 9) & 1) << 5); R = (st >> 1) * 16 + swz / 64; C = (st & 1) * 32 + (swz % 64) / 2; }
__host__ __device__ __forceinline__ int perm32(int rho) { const int n = rho >> 4, i = rho & 15; return 8 * (i >> 2) + 4 * n + (i & 3); }

struct Unit { int pm, pn, ka, kb; };
struct Gemm { const bf16_t* A; const bf16_t* Bt; int lda, ldb, K; };

struct StaticOrder {
    int nM, nN, nwg, G, c;
    __device__ void init(int Mr, int N, int G_, int c_) { nM = Mr / BM; nN = N / BM; nwg = nM * nN; G = G_; c = c_; }
    __device__ bool next(int i, Unit& u) const {
        const long L = (long)i * G + c; if (L >= nwg) return false;
        int wgid = (int)L; { const int q = nwg / NXCD, r = nwg % NXCD, xcd = wgid % NXCD, off = wgid / NXCD; wgid = (xcd < r ? xcd * (q + 1) : r * (q + 1) + (xcd - r) * q) + off; }
        const int nig = WGM * nN, gid = wgid / nig, fm = gid * WGM, gsz = (nM - fm) < WGM ? (nM - fm) : WGM;
        u.pm = fm + ((wgid % nig) % gsz); u.pn = (wgid % nig) / gsz; u.ka = 0; u.kb = 0; return true;
    }
};
template <int MODE> struct QuadOrder {
    int v;
    __device__ bool next(int i, Unit& u) const {
        if (i > 0) return false;
        u.pm = v >> 2; const int j = v & 3;
        if (MODE == 0) { u.pn = 8; u.ka = 512 * j; u.kb = 512 * j; } else { u.pn = j; u.ka = 256 * j; u.kb = 0; }
        return true;
    }
};

template <class Epi, class Sched, bool ALIGN_EPI>
__device__ __forceinline__ void gemm_phase(LAS unsigned char* lds, LAS unsigned char* eps, const Gemm g, const Sched& S, const Epi& E) {
    int tid = threadIdx.x; asm volatile("" : "+v"(tid));
    const int wid = __builtin_amdgcn_readfirstlane(tid >> 6), lane = tid & 63, wr = wid >> 2, wc = wid & 3, fr = lane & 15, fq = lane >> 4;
    int nt = g.K / BK; asm volatile("" : "+s"(nt));
    unsigned voffA[2], voffB[2];
#pragma unroll
    for (int i = 0; i < 2; ++i) { int R, C; stage_rc(tid * 16 + i * 8192, R, C); const int Rb = Epi::PERM ? ((R & ~31) + perm32(R & 31)) : R;
        voffA[i] = (unsigned)(R * g.lda + C) * 2u; voffB[i] = (unsigned)(Rb * g.ldb + C) * 2u; }
    const size_t kstep = (size_t)(BK * 2);
    const size_t hstepA = (size_t)HALF * g.lda * 2, hstepB = (size_t)HALF * g.ldb * 2;
    const size_t tstepA = 2 * hstepA, tstepB = 2 * hstepB;
    const unsigned ldsw = (unsigned)wid * 1024u;
    const int aoff = lds_byte(wr * 64 + fr, fq * 8), boff = lds_byte(wc * 32 + fr, fq * 8);
#define PG8_SA(b, h) (((b) * 2 + (h)) * HTB)
#define PG8_SB(b, h) ((4 + (b) * 2 + (h)) * HTB)
#define PG8_STAGE(bufoff, gbase, voff) do { _Pragma("unroll") for (int _i = 0; _i < 2; ++_i) \
        __builtin_amdgcn_global_load_lds((const unsigned*)((const char*)(gbase) + (voff)[_i]), (LAS unsigned*)(lds + (bufoff) + ldsw + _i * 8192), 16, 0, 0); } while (0)
#define PG8_LDA(dst, b, h) do { _Pragma("unroll") for (int m = 0; m < 4; ++m) _Pragma("unroll") for (int k = 0; k < 2; ++k) dst[m][k] = *(const LAS bf16x8*)(lds + PG8_SA(b, h) + aoff + m * 2048 + k * 1024); } while (0)
#define PG8_LDB(dst, b, h) do { _Pragma("unroll") for (int n = 0; n < 2; ++n) _Pragma("unroll") for (int k = 0; k < 2; ++k) dst[n][k] = *(const LAS bf16x8*)(lds + PG8_SB(b, h) + boff + n * 2048 + k * 1024); } while (0)
#define PG8_MMA(ai, bj, At, Bt) do { __builtin_amdgcn_s_setprio(1); _Pragma("unroll") for (int m = 0; m < 4; ++m) _Pragma("unroll") for (int n = 0; n < 2; ++n) _Pragma("unroll") for (int k = 0; k < 2; ++k) \
        acc[ai][bj][m][n] = __builtin_amdgcn_mfma_f32_16x16x32_bf16(Bt[n][k], At[m][k], acc[ai][bj][m][n], 0, 0, 0); __builtin_amdgcn_s_setprio(0); } while (0)
#define PG8_WAIT_V(n) asm volatile("s_waitcnt vmcnt(" #n ")" ::: "memory")
#define PG8_WAIT_L(n) asm volatile("s_waitcnt lgkmcnt(" #n ")" ::: "memory")
#define PG8_BAR __builtin_amdgcn_s_barrier()
#define PG8_SCHED __builtin_amdgcn_sched_barrier(0)
    Unit cur, nxt; int ui = 0;
    if (!S.next(0, cur)) return;
    f32x4 acc[2][2][4][2];
#pragma unroll
    for (int a = 0; a < 2; ++a)
#pragma unroll
        for (int b = 0; b < 2; ++b)
#pragma unroll
            for (int m = 0; m < 4; ++m)
#pragma unroll
                for (int n = 0; n < 2; ++n) acc[a][b][m][n] = (f32x4){0.f, 0.f, 0.f, 0.f};
    bf16x8 At[4][2], B0[2][2], B1[2][2];
    const char* cA = (const char*)g.A + (size_t)cur.pm * tstepA + (size_t)cur.ka * 2; const char* cB = (const char*)g.Bt + (size_t)cur.pn * tstepB + (size_t)cur.kb * 2;
    PG8_STAGE(PG8_SB(0, 0), cB, voffB); PG8_STAGE(PG8_SB(0, 1), cB + hstepB, voffB); PG8_STAGE(PG8_SA(0, 0), cA, voffA); PG8_STAGE(PG8_SA(0, 1), cA + hstepA, voffA);
    if (wr == 1) PG8_BAR;
    PG8_WAIT_V(2); PG8_BAR;
    PG8_STAGE(PG8_SB(1, 0), cB + kstep, voffB); PG8_STAGE(PG8_SA(1, 0), cA + kstep, voffA); PG8_STAGE(PG8_SB(1, 1), cB + hstepB + kstep, voffB);
    PG8_WAIT_V(6); PG8_BAR;
    for (;;) {
        const bool has_next = S.next(ui + 1, nxt);
        const char* nA = has_next ? (const char*)g.A + (size_t)nxt.pm * tstepA + (size_t)nxt.ka * 2 : cA; const char* nB = has_next ? (const char*)g.Bt + (size_t)nxt.pn * tstepB + (size_t)nxt.kb * 2 : cB;
#pragma unroll 1
        for (int t = 0; t < nt; t += 2) {
            const bool last = (t == nt - 2);
            const char* a1 = cA + (size_t)(t + 1) * kstep;
            const char* a2 = last ? nA : cA + (size_t)(t + 2) * kstep; const char* b2 = last ? nB : cB + (size_t)(t + 2) * kstep;
            const char* a3 = a2 + kstep; const char* b3 = b2 + kstep;
            PG8_LDB(B0, 0, 0); PG8_LDB(B1, 0, 1); PG8_SCHED; PG8_LDA(At, 0, 0); PG8_STAGE(PG8_SA(1, 1), a1 + hstepA, voffA);
            PG8_WAIT_V(8); PG8_WAIT_L(0); PG8_BAR; PG8_MMA(0, 0, At, B0); PG8_MMA(0, 1, At, B1); PG8_BAR; PG8_SCHED;
            PG8_LDA(At, 0, 1); PG8_STAGE(PG8_SB(0, 0), b2, voffB); PG8_STAGE(PG8_SB(0, 1), b2 + hstepB, voffB); PG8_STAGE(PG8_SA(0, 0), a2, voffA);
            PG8_WAIT_V(8); PG8_WAIT_L(0); PG8_BAR; PG8_MMA(1, 0, At, B0); PG8_MMA(1, 1, At, B1); PG8_BAR; PG8_SCHED;
            PG8_LDB(B0, 1, 0); PG8_LDB(B1, 1, 1); PG8_SCHED; PG8_LDA(At, 1, 0); PG8_STAGE(PG8_SA(0, 1), a2 + hstepA, voffA);
            PG8_WAIT_V(8); PG8_WAIT_L(0); PG8_BAR; PG8_MMA(0, 0, At, B0); PG8_MMA(0, 1, At, B1); PG8_BAR; PG8_SCHED;
            PG8_LDA(At, 1, 1); PG8_STAGE(PG8_SB(1, 0), b3, voffB); PG8_STAGE(PG8_SB(1, 1), b3 + hstepB, voffB); PG8_STAGE(PG8_SA(1, 0), a3, voffA);
            PG8_WAIT_V(8); PG8_WAIT_L(0); PG8_BAR; PG8_MMA(1, 0, At, B0); PG8_MMA(1, 1, At, B1); PG8_BAR; PG8_SCHED;
        }
        if constexpr (ALIGN_EPI) { if (wr == 0) PG8_BAR; }
        E(acc, cur, wr, wc, fr, fq, eps, tid);
        if (!has_next) break;
#pragma unroll
        for (int a = 0; a < 2; ++a)
#pragma unroll
            for (int b = 0; b < 2; ++b)
#pragma unroll
                for (int m = 0; m < 4; ++m)
#pragma unroll
                    for (int n = 0; n < 2; ++n) acc[a][b][m][n] = (f32x4){0.f, 0.f, 0.f, 0.f};
        cur = nxt; cA = nA; cB = nB; ++ui;
        if constexpr (ALIGN_EPI) { if (wr == 1) PG8_BAR; }
    }
    PG8_WAIT_V(0);
    if constexpr (!ALIGN_EPI) { if (wr == 0) PG8_BAR; }
    PG8_BAR;
#undef PG8_SA
#undef PG8_SB
#undef PG8_STAGE
#undef PG8_LDA
#undef PG8_LDB
#undef PG8_MMA
#undef PG8_WAIT_V
#undef PG8_WAIT_L
#undef PG8_BAR
#undef PG8_SCHED
}
}
using pg8::Unit;
typedef const f32x4 (&AccRef)[2][2][4][2];

__device__ __forceinline__ u32x4 pack8(f32x4 a, f32x4 b) { u32x4 w; w.x = cvtpk(a[0], a[1]); w.y = cvtpk(a[2], a[3]); w.z = cvtpk(b[0], b[1]); w.w = cvtpk(b[2], b[3]); return w; }
__device__ __forceinline__ u32x2 pack4(f32x4 a) { u32x2 w; w.x = cvtpk(a[0], a[1]); w.y = cvtpk(a[2], a[3]); return w; }
__device__ __forceinline__ float sq4(f32x4 a) { return (a[0] * a[0] + a[1] * a[1]) + (a[2] * a[2] + a[3] * a[3]); }

struct EpiA {
    static constexpr bool PERM = true;
    bf16_t* ZP; bf16_t* CQ; bf16_t* CKV; float* ssq_cq; float* ssq_ckv;
    __device__ __forceinline__ void operator()(AccRef acc, const Unit& u, int wr, int wc, int fr, int fq, LAS unsigned char*, int) const {
        bf16_t* base; int ldc, colt; float* ssq = nullptr;
        if (u.pn < 4) { base = ZP; ldc = 1024; colt = u.pn * 256; }
        else if (u.pn < 6) { base = CQ; ldc = 512; colt = (u.pn - 4) * 256; ssq = ssq_cq + (u.pn - 4) * 4 + wc; }
        else { base = CKV; ldc = 512; colt = (u.pn - 6) * 256; ssq = ssq_ckv + (u.pn - 6) * 4 + wc; }
        const int row0 = u.pm * 256 + wr * 64 + fr, col0 = colt + wc * 32 + 8 * fq;
#pragma unroll
        for (int ai = 0; ai < 2; ++ai)
#pragma unroll
            for (int m = 0; m < 4; ++m) { const int row = row0 + ai * 128 + m * 16; bf16_t* rowp = base + (size_t)row * ldc + col0; float s = 0.f;
#pragma unroll
                for (int bj = 0; bj < 2; ++bj) { const f32x4 v0 = acc[ai][bj][m][0], v1 = acc[ai][bj][m][1]; *(u32x4*)(rowp + bj * 128) = pack8(v0, v1); s += sq4(v0) + sq4(v1); }
                if (ssq) { s += __shfl_xor(s, 16); s += __shfl_xor(s, 32); if (fq == 0) ssq[(size_t)row * 8] = s; } }
    }
};
struct EpiKR {
    static constexpr bool PERM = false;
    float* KRP;
    __device__ __forceinline__ void operator()(AccRef acc, const Unit& u, int wr, int wc, int fr, int fq, LAS unsigned char*, int) const {
        if (wc < 2) { const int ks = u.ka >> 9; const int row0 = u.pm * 256 + wr * 64 + fr;
#pragma unroll
            for (int ai = 0; ai < 2; ++ai)
#pragma unroll
                for (int m = 0; m < 4; ++m) { const int row = row0 + ai * 128 + m * 16;
#pragma unroll
                    for (int n = 0; n < 2; ++n) *(f32x4*)(KRP + ((size_t)ks * M + row) * 64 + 32 * wc + 16 * n + 4 * fq) = acc[ai][0][m][n]; } }
    }
};
struct EpiStore {
    static constexpr bool PERM = true;
    bf16_t* O; int ldc;
    __device__ __forceinline__ void operator()(AccRef acc, const Unit& u, int wr, int wc, int fr, int fq, LAS unsigned char*, int) const {
        const int row0 = u.pm * 256 + wr * 64 + fr, col0 = u.pn * 256 + wc * 32 + 8 * fq;
#pragma unroll
        for (int ai = 0; ai < 2; ++ai)
#pragma unroll
            for (int m = 0; m < 4; ++m) { bf16_t* rowp = O + (size_t)(row0 + ai * 128 + m * 16) * ldc + col0;
#pragma unroll
                for (int bj = 0; bj < 2; ++bj) *(u32x4*)(rowp + bj * 128) = pack8(acc[ai][bj][m][0], acc[ai][bj][m][1]); }
    }
};
struct EpiQ {
    static constexpr bool PERM = false;
    bf16_t* Q; const float* ssq_cq; const float* qg; const float* COS; const float* SIN;
    __device__ __forceinline__ void operator()(AccRef acc, const Unit& u, int wr, int wc, int fr, int fq, LAS unsigned char* eps, int tid) const {
        LAS float* P = (LAS float*)eps; LAS float* R = (LAS float*)(eps + 4096);
        const int h = u.pn, rowt = u.pm * 256;
        if (tid < 256) { const f32x4* p = (const f32x4*)(ssq_cq + (size_t)(rowt + tid) * 8); const f32x4 a = p[0], b = p[1];
            R[tid] = rsqrtf(((a[0] + a[1]) + (a[2] + a[3]) + (b[0] + b[1]) + (b[2] + b[3])) * (1.f / 512.f) + EPS); }
#pragma unroll
        for (int ai = 0; ai < 2; ++ai)
#pragma unroll
            for (int m = 0; m < 4; ++m) { const int r = ai * 128 + wr * 64 + m * 16 + fr; float s = 0.f;
#pragma unroll
                for (int bj = 0; bj < 2; ++bj)
#pragma unroll
                    for (int n = 0; n < 2; ++n) s += sq4(acc[ai][bj][m][n]);
                s += __shfl_xor(s, 16); s += __shfl_xor(s, 32); if (fq == 0) P[r * 4 + wc] = s; }
        EPI_BAR();
        const int dn = 32 * wc + 4 * fq, j = 16 * wc + 4 * fq;
        const f32x4 g0 = *(const f32x4*)(qg + dn), g1 = *(const f32x4*)(qg + dn + 16);
        f32x4 gr1 = {0.f, 0.f, 0.f, 0.f}, gr2 = gr1; if (wc < 2) { gr1 = *(const f32x4*)(qg + 128 + j); gr2 = *(const f32x4*)(qg + 160 + j); }
#pragma unroll
        for (int ai = 0; ai < 2; ++ai)
#pragma unroll
            for (int m = 0; m < 4; ++m) { const int r = ai * 128 + wr * 64 + m * 16 + fr; const float rc = R[r]; const f32x4 pp = *(LAS f32x4*)(P + r * 4);
                const float ss = ((pp[0] + pp[1]) + (pp[2] + pp[3])) * rc * rc; const float sc = rc * rsqrtf(ss * (1.f / 192.f) + EPS);
                const size_t grow = (size_t)(rowt + r); bf16_t* qrow = Q + grow * 1536 + h * 192;
                *(u32x2*)(qrow + dn) = pack4(acc[ai][0][m][0] * sc * g0); *(u32x2*)(qrow + dn + 16) = pack4(acc[ai][0][m][1] * sc * g1);
                if (wc < 2) { const f32x4 x1 = acc[ai][1][m][0] * sc * gr1, x2 = acc[ai][1][m][1] * sc * gr2;
                    const f32x4 c4 = *(const f32x4*)(COS + grow * 32 + j), s4 = *(const f32x4*)(SIN + grow * 32 + j);
                    *(u32x2*)(qrow + 128 + j) = pack4(x1 * c4 - x2 * s4); *(u32x2*)(qrow + 160 + j) = pack4(x2 * c4 + x1 * s4); } }
    }
};
struct EpiKV {
    static constexpr bool PERM = false;
    bf16_t* K; bf16_t* V; const float* ssq_ckv; const float* KRP; const float* kg; const float* COS; const float* SIN;
    __device__ __forceinline__ void operator()(AccRef acc, const Unit& u, int wr, int wc, int fr, int fq, LAS unsigned char* eps, int tid) const {
        LAS float* P = (LAS float*)eps; LAS float* R = (LAS float*)(eps + 4096); LAS float* R2 = (LAS float*)(eps + 5120);
        const int h = u.pn, rowt = u.pm * 256;
        if (tid < 256) { const f32x4* p = (const f32x4*)(ssq_ckv + (size_t)(rowt + tid) * 8); const f32x4 a = p[0], b = p[1];
            R[tid] = rsqrtf(((a[0] + a[1]) + (a[2] + a[3]) + (b[0] + b[1]) + (b[2] + b[3])) * (1.f / 512.f) + EPS); }
        const int rr = tid >> 1, hf = tid & 1; const size_t grr = (size_t)(rowt + rr);
#define KR_LOAD(i) ((*(const f32x4*)(KRP + grr * 64 + hf * 32 + (i) * 4) + *(const f32x4*)(KRP + grr * 64 + hf * 32 + (i) * 4 + (size_t)M * 64)) + \
                    (*(const f32x4*)(KRP + grr * 64 + hf * 32 + (i) * 4 + (size_t)2 * M * 64) + *(const f32x4*)(KRP + grr * 64 + hf * 32 + (i) * 4 + (size_t)3 * M * 64)))
        { float sr = 0.f;
#pragma unroll
            for (int i = 0; i < 8; ++i) { const f32x4 t = KR_LOAD(i); sr += sq4(t); if (i & 1) asm volatile("" ::: "memory"); }
            sr += __shfl_xor(sr, 1); if (hf == 0) R2[rr] = sr; }
#pragma unroll
        for (int ai = 0; ai < 2; ++ai)
#pragma unroll
            for (int m = 0; m < 4; ++m) { const int r = ai * 128 + wr * 64 + m * 16 + fr; float s = sq4(acc[ai][0][m][0]) + sq4(acc[ai][0][m][1]);
                s += __shfl_xor(s, 16); s += __shfl_xor(s, 32); if (fq == 0) P[r * 4 + wc] = s; }
        EPI_BAR();
        const int dn = 32 * wc + 4 * fq;
        const f32x4 g0 = *(const f32x4*)(kg + dn), g1 = *(const f32x4*)(kg + dn + 16);
#pragma unroll
        for (int ai = 0; ai < 2; ++ai)
#pragma unroll
            for (int m = 0; m < 4; ++m) { const int r = ai * 128 + wr * 64 + m * 16 + fr; const float rc = R[r]; const f32x4 pp = *(LAS f32x4*)(P + r * 4);
                const float ssn = ((pp[0] + pp[1]) + (pp[2] + pp[3])) * rc * rc; const float sk = rc * rsqrtf((ssn + R2[r]) * (1.f / 192.f) + EPS);
                const size_t grow = (size_t)(rowt + r);
                bf16_t* vrow = V + grow * 1024 + h * 128 + dn; *(u32x2*)vrow = pack4(acc[ai][1][m][0] * rc); *(u32x2*)(vrow + 16) = pack4(acc[ai][1][m][1] * rc);
                bf16_t* krow = K + grow * 1536 + h * 192 + dn; *(u32x2*)krow = pack4(acc[ai][0][m][0] * sk * g0); *(u32x2*)(krow + 16) = pack4(acc[ai][0][m][1] * sk * g1); }
        { const float rc = R[rr]; const f32x4 pp = *(LAS f32x4*)(P + rr * 4); const float ssn = ((pp[0] + pp[1]) + (pp[2] + pp[3])) * rc * rc;
          const float rk = rsqrtf((ssn + R2[rr]) * (1.f / 192.f) + EPS);
          bf16_t* kout = K + grr * 1536 + h * 192 + 128 + hf * 32;
#pragma unroll
          for (int i = 0; i < 8; i += 2) { f32x4 o[2];
#pragma unroll
            for (int q = 0; q < 2; ++q) { const f32x4 mine = KR_LOAD(i + q); f32x4 oth; oth[0] = __shfl_xor(mine[0], 1); oth[1] = __shfl_xor(mine[1], 1); oth[2] = __shfl_xor(mine[2], 1); oth[3] = __shfl_xor(mine[3], 1);
                const f32x4 ga = *(const f32x4*)(kg + 128 + (i + q) * 4), gb = *(const f32x4*)(kg + 160 + (i + q) * 4);
                const f32x4 c4 = *(const f32x4*)(COS + grr * 32 + (i + q) * 4), s4 = *(const f32x4*)(SIN + grr * 32 + (i + q) * 4);
                const f32x4 x1 = (hf ? oth : mine) * ga, x2 = (hf ? mine : oth) * gb;
                o[q] = (hf ? (x2 * c4 + x1 * s4) : (x1 * c4 - x2 * s4)) * rk; }
            *(u32x4*)(kout + i * 4) = pack8(o[0], o[1]); asm volatile("" ::: "memory"); } }
#undef KR_LOAD
    }
};
struct EpiH1 {
    static constexpr bool PERM = true;
    const float* X; float* OUT; bf16_t* H1G; const float* fg; float* SSQ;
    __device__ __forceinline__ void operator()(AccRef acc, const Unit& u, int wr, int wc, int fr, int fq, LAS unsigned char*, int) const {
        const int row0 = u.pm * 256 + wr * 64 + fr, col0 = u.pn * 256 + wc * 32 + 8 * fq;
        f32x4 gv[2][2];
#pragma unroll
        for (int bj = 0; bj < 2; ++bj) { gv[bj][0] = *(const f32x4*)(fg + col0 + bj * 128); gv[bj][1] = *(const f32x4*)(fg + col0 + bj * 128 + 4); }
#pragma unroll
        for (int ai = 0; ai < 2; ++ai)
#pragma unroll
            for (int m = 0; m < 4; ++m) { const size_t off = (size_t)(row0 + ai * 128 + m * 16) * DM + col0; float s = 0.f;
#pragma unroll
                for (int bj = 0; bj < 2; ++bj) { const f32x4 h0 = *(const f32x4*)(X + off + bj * 128) + acc[ai][bj][m][0], h1 = *(const f32x4*)(X + off + bj * 128 + 4) + acc[ai][bj][m][1];
                    *(f32x4*)(OUT + off + bj * 128) = h0; *(f32x4*)(OUT + off + bj * 128 + 4) = h1; s += sq4(h0) + sq4(h1);
                    *(u32x4*)(H1G + off + bj * 128) = pack8(h0 * gv[bj][0], h1 * gv[bj][1]); }
                s += __shfl_xor(s, 16); s += __shfl_xor(s, 32); if (fq == 0) SSQ[(size_t)(row0 + ai * 128 + m * 16) * 32 + u.pn * 4 + wc] = s;
                if (m & 1) asm volatile("" ::: "memory"); }
    }
};
struct EpiQP {
    static constexpr bool PERM = true;
    bf16_t* QP; const float* SSQ; float* RSTD2;
    __device__ __forceinline__ void operator()(AccRef acc, const Unit& u, int wr, int wc, int fr, int fq, LAS unsigned char* eps, int tid) const {
        LAS float* R = (LAS float*)(eps + 4096);
        if (tid < 256) { const f32x4* p = (const f32x4*)(SSQ + (size_t)(u.pm * 256 + tid) * 32); f32x4 a = p[0];
#pragma unroll
            for (int i = 1; i < 8; ++i) a += p[i];
            const float rs = rsqrtf(((a[0] + a[1]) + (a[2] + a[3])) * (1.f / 2048.f) + EPS); R[tid] = rs; if (u.pn == 0) RSTD2[u.pm * 256 + tid] = rs; }
        EPI_BAR();
        const int col0 = u.pn * 256 + wc * 32 + 8 * fq;
#pragma unroll
        for (int ai = 0; ai < 2; ++ai)
#pragma unroll
            for (int m = 0; m < 4; ++m) { const int r = ai * 128 + wr * 64 + m * 16 + fr; const float rs = R[r]; bf16_t* rowp = QP + (size_t)(u.pm * 256 + r) * DM + col0;
#pragma unroll
                for (int bj = 0; bj < 2; ++bj) *(u32x4*)(rowp + bj * 128) = pack8(acc[ai][bj][m][0] * rs, acc[ai][bj][m][1] * rs); }
        EPI_BAR();
    }
};
struct EpiGate {
    static constexpr bool PERM = true;
    float* OUT; const bf16_t* PROJ; const float* RSTD3;
    __device__ __forceinline__ void operator()(AccRef acc, const Unit& u, int wr, int wc, int fr, int fq, LAS unsigned char*, int) const {
        const int row0 = u.pm * 256 + wr * 64 + fr, col0 = u.pn * 256 + wc * 32 + 8 * fq;
#pragma unroll
        for (int ai = 0; ai < 2; ++ai)
#pragma unroll
            for (int m = 0; m < 4; ++m) { const int row = row0 + ai * 128 + m * 16; const float rs = RSTD3[row]; const size_t off = (size_t)row * DM + col0;
#pragma unroll
                for (int bj = 0; bj < 2; ++bj) { const u32x4 pw = *(const u32x4*)(PROJ + off + bj * 128);
                    const f32x4 p0 = {bf_lo(pw.x), bf_hi(pw.x), bf_lo(pw.y), bf_hi(pw.y)}, p1 = {bf_lo(pw.z), bf_hi(pw.z), bf_lo(pw.w), bf_hi(pw.w)};
                    f32x4 g0, g1;
#pragma unroll
                    for (int e = 0; e < 4; ++e) { g0[e] = __builtin_amdgcn_rcpf(1.f + __builtin_amdgcn_exp2f(-1.4426950408889634f * rs * acc[ai][bj][m][0][e]));
                                                  g1[e] = __builtin_amdgcn_rcpf(1.f + __builtin_amdgcn_exp2f(-1.4426950408889634f * rs * acc[ai][bj][m][1][e])); }
                    float* o = OUT + off + bj * 128; const f32x4 h0 = *(const f32x4*)o, h1 = *(const f32x4*)(o + 4);
                    *(f32x4*)o = h0 + g0 * p0; *(f32x4*)(o + 4) = h1 + g1 * p1; }
                asm volatile("" ::: "memory"); }
    }
};

typedef GAS unsigned gu32;
#define RLX_AGENT __ATOMIC_RELAXED, __HIP_MEMORY_SCOPE_AGENT
#define XB_TMO      128
#define XB_XCNT(j)  (256  + 64 * (j))
#define XB_XSUB(j)  (1280 + 64 * (j))
#define XB_XGEN(j)  (2304 + 64 * (j))
#define XB_TOP      3328
#define XB_TOPGEN   3392
#define XCD_BAR_WORDS 3456
#define XB_SPIN_CAP (1u << 20)
__device__ __forceinline__ unsigned xb_ld(unsigned* p)              { return __hip_atomic_load(p, __ATOMIC_RELAXED, __HIP_MEMORY_SCOPE_AGENT); }
__device__ __forceinline__ unsigned xb_add(unsigned* p, unsigned v) { return __hip_atomic_fetch_add(p, v, __ATOMIC_RELAXED, __HIP_MEMORY_SCOPE_AGENT); }
__device__ __forceinline__ unsigned xb_xcc_id() { return (unsigned)__builtin_amdgcn_s_getreg((3 << 11) | 20) & 0xFu; }
#define XB_SPIN(cond, bar) do { unsigned _sp = 0; while (cond) { __builtin_amdgcn_s_sleep(1); \
    if ((++_sp & 255u) == 0u) { if (xb_ld(&(bar)[XB_TMO])) break; if (_sp > XB_SPIN_CAP) { atomicAdd(&(bar)[XB_TMO], 1u); break; } } } } while (0)
struct XcdBarrier { unsigned* bar; unsigned x; volatile LAS unsigned* st; };
__device__ __forceinline__ XcdBarrier xcd_barrier_post(unsigned* bar, volatile LAS unsigned* st) {
    XcdBarrier b; b.bar = bar; b.x = xb_xcc_id(); b.st = st;
    if (threadIdx.x == 0) (void)xb_add(&bar[XB_XCNT(b.x)], 1u);
    return b;
}
__device__ __forceinline__ void xcd_barrier_complete(unsigned* bar, unsigned x, unsigned& nloc, unsigned& nx) {
    const unsigned G = gridDim.x * gridDim.y * gridDim.z;
    unsigned sum, cnt, mine, sp = 0u;
    for (;;) {
        sum = 0u; cnt = 0u; mine = 0u;
#pragma unroll
        for (unsigned j = 0; j < 16; ++j) { const unsigned c = xb_ld(&bar[XB_XCNT(j)]); sum += c; cnt += (c > 0u) ? 1u : 0u; mine = (j == x) ? c : mine; }
        if (sum == G) break;
        __builtin_amdgcn_s_sleep(1);
        if ((++sp & 255u) == 0u) { if (xb_ld(&bar[XB_TMO])) break; if (sp > XB_SPIN_CAP) { atomicAdd(&bar[XB_TMO], 1u); break; } }
    }
    nloc = mine > 0u ? mine : 1u; nx = cnt > 0u ? cnt : 1u;
}
__device__ __forceinline__ void xcd_barrier(const XcdBarrier& b) {
    asm volatile("s_waitcnt vmcnt(0)" ::: "memory");
    __syncthreads();
    if (threadIdx.x == 0) {
        unsigned* bar = b.bar;
        __builtin_amdgcn_s_waitcnt(0);
        unsigned nloc = b.st[0], nx = b.st[1];
        if (nloc == 0u) { xcd_barrier_complete(bar, b.x, nloc, nx); b.st[0] = nloc; b.st[1] = nx; }
        const unsigned old = xb_add(&bar[XB_XSUB(b.x)], 1u);
        const unsigned gen = old / nloc;
        if (old + 1u == (gen + 1u) * nloc) {
            __builtin_amdgcn_fence(__ATOMIC_RELEASE, "agent");
            asm volatile("s_waitcnt vmcnt(0)" ::: "memory");
            const unsigned og = xb_add(&bar[XB_TOP], 1u);
            const unsigned tg = og / nx;
            if (og + 1u == (tg + 1u) * nx) xb_add(&bar[XB_TOPGEN], 1u);
            else XB_SPIN(xb_ld(&bar[XB_TOPGEN]) == tg, bar);
            __builtin_amdgcn_fence(__ATOMIC_ACQUIRE, "agent");
            xb_add(&bar[XB_XGEN(b.x)], 1u);
            asm volatile("s_waitcnt vmcnt(0)" ::: "memory");
        } else {
            XB_SPIN(xb_ld(&bar[XB_XGEN(b.x)]) == gen, bar);
            __builtin_amdgcn_fence(__ATOMIC_ACQUIRE, "agent");
            asm volatile("s_waitcnt vmcnt(0)" ::: "memory");
        }
    }
    __syncthreads();
}

__device__ __forceinline__ int uq_row(int n) {
    const int h = n / 192, d = n - h * 192; int slot;
    if (d < 128) slot = d; else { const int j = d - 128; if (j < 32) slot = 128 + 32 * (j >> 4) + (j & 15); else { const int jj = j - 32; slot = 128 + 32 * (jj >> 4) + 16 + (jj & 15); } }
    return h * 256 + slot;
}
template <int MAP>
__device__ __forceinline__ void tr_item(const float* W, int ldw, int col_off, const float* gk, const float* gn, bf16_t* WT, int ldt, int row_off, int nblk, LAS float* scr, int item, int lane) {
    const int kb = item / nblk, nb = item - kb * nblk, k0 = 64 * kb, n0 = 32 * nb;
#pragma unroll 8
    for (int i = 0; i < 32; ++i) { const int kk = 2 * i + (lane >> 5); float v = W[(size_t)(k0 + kk) * ldw + col_off + n0 + (lane & 31)]; if (gk) v *= gk[k0 + kk]; scr[kk * 33 + (lane & 31)] = v; }
    asm volatile("s_waitcnt lgkmcnt(0)" ::: "memory");
    const int c = lane & 7;
#pragma unroll
    for (int j = 0; j < 4; ++j) { const int n = (lane >> 3) + 8 * j; const LAS float* s = scr + (8 * c) * 33 + n; const float g = gn ? gn[n0 + n] : 1.f;
        u32x4 o; o.x = cvtpk(s[0 * 33] * g, s[1 * 33] * g); o.y = cvtpk(s[2 * 33] * g, s[3 * 33] * g); o.z = cvtpk(s[4 * 33] * g, s[5 * 33] * g); o.w = cvtpk(s[6 * 33] * g, s[7 * 33] * g);
        const int drow = (MAP == 1) ? uq_row(n0 + n) : (row_off + n0 + n);
        *(u32x4*)(WT + (size_t)drow * ldt + k0 + 8 * c) = o; }
    asm volatile("s_waitcnt lgkmcnt(0)" ::: "memory");
}

namespace att {
constexpr int DQ = 192, DV = 128, KVBLK = 64, QBLK = 32;
constexpr int LDQ = 1536, LDV = 1024, LDO = 2048;
constexpr int SHM_V = KVBLK * DV * 2, SHM_K = KVBLK * DQ * 2;
constexpr float SCALE = 0.07216878364870322f;
constexpr float THR = 8.f;
#define KSWZ(row, colB) ((row) * 384 + ((colB) ^ ((((row) >> 1) & 7) << 4)))
#define SBAR() __builtin_amdgcn_sched_barrier(0)
__device__ __forceinline__ int crow(int r, int hi) { return (r & 3) + 8 * (r >> 2) + 4 * hi; }
__device__ __forceinline__ void partialSM(f32x16& p0, f32x16& p1, float& m_reg, float& alpha) {
    constexpr float C = SCALE * 1.4426950408889634f;
    float pmax = p0[0];
#pragma unroll
    for (int r = 1; r < 16; ++r) pmax = fmaxf(pmax, p0[r]);
#pragma unroll
    for (int r = 0; r < 16; ++r) pmax = fmaxf(pmax, p1[r]);
    { auto rr = __builtin_amdgcn_permlane32_swap(__float_as_uint(pmax), __float_as_uint(pmax), false, false);
      pmax = fmaxf(__uint_as_float(rr[0]), __uint_as_float(rr[1])); }
    float mn;
    if (__builtin_expect(__all(pmax - m_reg <= THR / SCALE), 1)) { mn = m_reg; alpha = 1.f; }
    else { mn = fmaxf(m_reg, pmax); alpha = __builtin_amdgcn_exp2f((m_reg - mn) * C); m_reg = mn; }
    const float mnC = -mn * C;
#pragma unroll
    for (int r = 0; r < 16; ++r) { p0[r] = __builtin_amdgcn_exp2f(fmaf(p0[r], C, mnC)); p1[r] = __builtin_amdgcn_exp2f(fmaf(p1[r], C, mnC)); }
}
__device__ __forceinline__ void finishSM(const f32x16& p0, const f32x16& p1, float alpha, float& l_reg, bf16x8& pa0, bf16x8& pa1, bf16x8& pa2, bf16x8& pa3) {
    float ps = 0.f;
#pragma unroll
    for (int r = 0; r < 16; ++r) ps += p0[r];
#pragma unroll
    for (int r = 0; r < 16; ++r) ps += p1[r];
    { auto rr = __builtin_amdgcn_permlane32_swap(__float_as_uint(ps), __float_as_uint(ps), false, false);
      ps = __uint_as_float(rr[0]) + __uint_as_float(rr[1]); }
    l_reg = l_reg * alpha + ps;
#define PK4(P, BASE, OUT) do { unsigned a0 = cvtpk(P[BASE + 0], P[BASE + 1]), a1 = cvtpk(P[BASE + 2], P[BASE + 3]);   \
    unsigned b0 = cvtpk(P[BASE + 4], P[BASE + 5]), b1 = cvtpk(P[BASE + 6], P[BASE + 7]);                              \
    auto r0 = __builtin_amdgcn_permlane32_swap(a0, b0, false, false); auto r1 = __builtin_amdgcn_permlane32_swap(a1, b1, false, false); \
    u32x4 w = {r0[0], r1[0], r0[1], r1[1]}; OUT = __builtin_bit_cast(bf16x8, w); } while (0)
    PK4(p0, 0, pa0); PK4(p0, 8, pa1); PK4(p1, 0, pa2); PK4(p1, 8, pa3);
#undef PK4
}
__device__ __forceinline__ void qkt(f32x16& p0, f32x16& p1, const char* Ks, const bf16x8* qr, int r32, int hi) {
    p0 = f32x16{}; p1 = f32x16{};
#pragma unroll
    for (int d0 = 0; d0 < 12; ++d0) { const int cb = (d0 * 16 + hi * 8) * 2;
        const bf16x8 b0 = *reinterpret_cast<const bf16x8*>(Ks + KSWZ(r32, cb));
        const bf16x8 b1 = *reinterpret_cast<const bf16x8*>(Ks + KSWZ(32 + r32, cb));
        p0 = __builtin_amdgcn_mfma_f32_32x32x16_bf16(b0, qr[d0], p0, 0, 0, 0);
        p1 = __builtin_amdgcn_mfma_f32_32x32x16_bf16(b1, qr[d0], p1, 0, 0, 0); }
}
__device__ __forceinline__ int v_st(int k, int c) { const int kk = (k & ~0xC) | ((k & 4) << 1) | ((k & 8) >> 1); return ((kk >> 3) * 4 + (c >> 5)) * 512 + ((kk & 7) * 32 + (c & 31)) * 2; }
__device__ __forceinline__ int v_rd_base(int lane) { return ((lane & 3) << 3) | (((lane >> 2) & 3) << 6) | (((lane >> 4) & 1) << 5) | (((lane >> 5) & 1) << 8); }
constexpr int v_rd_off(int d0, int ks, int half) { return d0 * 512 + ks * 4096 + half * 2048; }
template <int OFF> __device__ __forceinline__ s16x4 tr_read(int vb) {
    s16x4 r; asm volatile("ds_read_b64_tr_b16 %0, %1 offset:%2" : "=&v"(r) : "v"(vb), "i"(OFF) : "memory"); return r;
}
template <int D0> __device__ __forceinline__ void pv_one(f32x16& od, int vb, bf16x8 pa0, bf16x8 pa1, bf16x8 pa2, bf16x8 pa3) {
    const s16x4 l0 = tr_read<v_rd_off(D0, 0, 0)>(vb), h0 = tr_read<v_rd_off(D0, 0, 1)>(vb), l1 = tr_read<v_rd_off(D0, 1, 0)>(vb), h1 = tr_read<v_rd_off(D0, 1, 1)>(vb);
    const s16x4 l2 = tr_read<v_rd_off(D0, 2, 0)>(vb), h2 = tr_read<v_rd_off(D0, 2, 1)>(vb), l3 = tr_read<v_rd_off(D0, 3, 0)>(vb), h3 = tr_read<v_rd_off(D0, 3, 1)>(vb);
    asm volatile("s_waitcnt lgkmcnt(0)" ::: "memory"); SBAR();
#define PK(L, H) (bf16x8){L[0], L[1], L[2], L[3], H[0], H[1], H[2], H[3]}
    od = __builtin_amdgcn_mfma_f32_32x32x16_bf16(pa0, PK(l0, h0), od, 0, 0, 0);
    od = __builtin_amdgcn_mfma_f32_32x32x16_bf16(pa1, PK(l1, h1), od, 0, 0, 0);
    od = __builtin_amdgcn_mfma_f32_32x32x16_bf16(pa2, PK(l2, h2), od, 0, 0, 0);
    od = __builtin_amdgcn_mfma_f32_32x32x16_bf16(pa3, PK(l3, h3), od, 0, 0, 0);
#undef PK
}
__device__ __forceinline__ void attn_unit(int b, int h, int qt, const bf16_t* Q, const bf16_t* K, const bf16_t* V, bf16_t* Y, char* lds, LAS unsigned char* ldsl) {
    int tid = threadIdx.x; asm volatile("" : "+v"(tid)); const int lane = tid & 63, r32 = lane & 31, hi = lane >> 5; const int wid = __builtin_amdgcn_readfirstlane(tid >> 6);
    char* V_lds = lds; char* K_lds = lds + 2 * SHM_V;
    float* ws = (float*)(lds + 2 * SHM_V + 2 * SHM_K) + wid * 64; float* li_l = ws; float* al_l = ws + 32;
    const size_t rowbase = (size_t)b * SEQ;
    const bf16_t* Qw = Q + (rowbase + qt * 256 + wid * QBLK + r32) * LDQ + h * DQ + hi * 8;
    const bf16_t* Kh = K + rowbase * LDQ + h * DQ; const bf16_t* Vh = V + rowbase * LDV + h * DV;
    float m_reg = -1e30f, l_reg = 0.f; f32x16 o[4] = {}; bf16x8 qr[12];
#pragma unroll
    for (int d0 = 0; d0 < 12; ++d0) qr[d0] = *reinterpret_cast<const bf16x8*>(Qw + d0 * 16);
    unsigned koff[3], voff[2];
#pragma unroll
    for (int i = 0; i < 3; ++i) { const int p = (wid * 3 + i) * 64 + lane, row = p / 24, s = p - row * 24; const int sg = (s & ~7) | ((s & 7) ^ ((row >> 1) & 7)); koff[i] = (unsigned)(row * LDQ + sg * 8) * 2u; }
#pragma unroll
    for (int i = 0; i < 2; ++i) { const int p = (wid * 2 + i) * 64 + lane, st = p >> 5, kk = (st >> 2) * 8 + ((p & 31) >> 2), c = (st & 3) * 32 + (p & 3) * 8;
        const int k = (kk & ~0xC) | ((kk & 4) << 1) | ((kk & 8) >> 1); voff[i] = (unsigned)(k * LDV + c) * 2u; }
    const int vb0 = (int)(uintptr_t)V_lds + v_rd_base(lane);
    const int NT = 4 * qt + 4, climit = 4 * qt + (wid >> 1);
#define DMA_TILE(t, bb) do { const char* kg_ = (const char*)Kh + (size_t)(t) * (KVBLK * LDQ * 2); const char* vg_ = (const char*)Vh + (size_t)(t) * (KVBLK * LDV * 2); \
    _Pragma("unroll") for (int i = 0; i < 3; ++i) __builtin_amdgcn_global_load_lds((const unsigned*)(kg_ + koff[i]), (LAS unsigned*)(ldsl + 2 * SHM_V + (bb) * SHM_K + (wid * 3 + i) * 1024), 16, 0, 0); \
    _Pragma("unroll") for (int i = 0; i < 2; ++i) __builtin_amdgcn_global_load_lds((const unsigned*)(vg_ + voff[i]), (LAS unsigned*)(ldsl + (bb) * SHM_V + (wid * 2 + i) * 1024), 16, 0, 0); } while (0)
    DMA_TILE(0, 0); asm volatile("s_waitcnt vmcnt(0)" ::: "memory"); __syncthreads();
    for (int t = 0; t < NT; ++t) {
        const int bb = t & 1;
        if (t + 1 < NT) DMA_TILE(t + 1, bb ^ 1);
        if (t <= climit) {
            f32x16 p0, p1; float alpha; bf16x8 pa0, pa1, pa2, pa3;
            qkt(p0, p1, K_lds + bb * SHM_K, qr, r32, hi);
            partialSM(p0, p1, m_reg, alpha);
            if (__any(alpha < 1.f)) { if (hi == 0) al_l[r32] = alpha; asm volatile("s_waitcnt lgkmcnt(0)" ::: "memory");
#pragma unroll
                for (int d = 0; d < 4; ++d)
#pragma unroll
                    for (int r = 0; r < 16; ++r) o[d][r] *= al_l[crow(r, hi)]; }
            finishSM(p0, p1, alpha, l_reg, pa0, pa1, pa2, pa3); SBAR();
            const int vb = vb0 + bb * SHM_V;
            pv_one<0>(o[0], vb, pa0, pa1, pa2, pa3); pv_one<1>(o[1], vb, pa0, pa1, pa2, pa3); pv_one<2>(o[2], vb, pa0, pa1, pa2, pa3); pv_one<3>(o[3], vb, pa0, pa1, pa2, pa3);
        }
        asm volatile("s_waitcnt vmcnt(0)" ::: "memory");
        __syncthreads();
    }
    if (hi == 0) li_l[r32] = l_reg; asm volatile("s_waitcnt lgkmcnt(0)" ::: "memory");
    bf16_t* Ow = Y + (rowbase + qt * 256 + wid * QBLK) * LDO + 1024 + h * DV;
#pragma unroll
    for (int r = 0; r < 16; ++r) { const int orow = crow(r, hi); const float rl = __builtin_amdgcn_rcpf(li_l[orow]);
#pragma unroll
        for (int d0 = 0; d0 < 4; ++d0) Ow[(size_t)orow * LDO + d0 * 32 + r32] = (bf16_t)(cvtpk(o[d0][r] * rl, 0.f) & 0xffffu); }
    __syncthreads();
#undef DMA_TILE
}
#undef SBAR
}

struct Args { const float* in[23]; float* out; unsigned char* ws; };
static_assert(sizeof(Args) == 25 * 8, "no padding");
typedef const __attribute__((address_space(4))) Args* KArgsP;
__device__ __forceinline__ KArgsP kargs() { KArgsP p = (KArgsP)__builtin_amdgcn_kernarg_segment_ptr(); asm volatile("" : "+s"(p)); return p; }
#define IN_F(i) ((const float*)ka->in[i])
#define WSP(off) (ws + (off))

__device__ __forceinline__ float dot2bf(unsigned a, unsigned b, float c) {
    return __builtin_amdgcn_fdot2_f32_bf16(__builtin_bit_cast(bf16x2_t, a), __builtin_bit_cast(bf16x2_t, b), c, false); }
__device__ __forceinline__ float gelu_tanh(float x) {
    const float y = 0.7978845608028654f * (x + 0.044715f * x * x * x);
    const float t = __builtin_amdgcn_exp2f(2.8853900817779268f * y);
    return 0.5f * x * (2.f - 2.f * __builtin_amdgcn_rcpf(t + 1.f));
}

#ifndef DBG_ONLY
#define DBG_ONLY -1
#endif
#define PH(n) (DBG_ONLY < 0 || DBG_ONLY == (n))
#ifndef DBG_STOP
#define DBG_STOP 99

#endif

__global__ void __launch_bounds__(NWAVES * 64, 2) fwd_kernel(Args args) {
    extern __shared__ __attribute__((aligned(16))) unsigned char lds_raw[];
    LAS unsigned char* lds = (LAS unsigned char*)lds_raw;
    LAS unsigned char* eps = lds + EPI_OFF;
    volatile LAS unsigned* MISC = (volatile LAS unsigned*)(lds + MISC_OFF);
    const int G = gridDim.x, bx = blockIdx.x, vcu = (G % 8 == 0) ? (bx % 8) * (G / 8) + bx / 8 : bx;
    const int NGW = G * NWAVES; const long NGT = (long)G * 512;
#define PHASE_IDS() int tid = threadIdx.x; asm volatile("" : "+v"(tid)); const int lane = tid & 63, wave = __builtin_amdgcn_readfirstlane(tid >> 6); const int gw = vcu * NWAVES + wave; const long gt = (long)vcu * 512 + tid; (void)lane; (void)gw; (void)gt
    for (int u = threadIdx.x; u < (LDS_BYTES - LDSCTL_OFF) / 4; u += NWAVES * 64) ((LAS unsigned*)(lds + LDSCTL_OFF))[u] = 0u;
    __syncthreads();
    XcdBarrier bar;
    { KArgsP ka = kargs(); unsigned char* ws = ka->ws; bar = xcd_barrier_post((unsigned*)(ws + WS_CTL) + 4096, MISC + 8); }

    if (PH(0)) {
        KArgsP ka = kargs(); unsigned char* ws = ka->ws;
        const float* x = IN_F(0); const float* p_in = IN_F(1); const int* positions = (const int*)ka->in[2];
        const float* mix_gain = IN_F(3); const float* w_in = IN_F(4); const float* w_pool = IN_F(5); const float* pool_scale = IN_F(6);
        const float* q_lat_gain = IN_F(7); const float* kv_lat_gain = IN_F(8); const float* w_uq = IN_F(9); const float* w_ukv = IN_F(10);
        const float* w_out = IN_F(13); const float* w_pq = IN_F(15); const float* sub_k1 = IN_F(16); const float* sub_k2 = IN_F(17);
        const float* expert_u = IN_F(18); const float* expert_v = IN_F(19); const float* ple_gain = IN_F(20); const float* w_ple_gate = IN_F(21); const float* w_ple_proj = IN_F(22);
        bf16_t* WIN = (bf16_t*)WSP(WS_WIN); bf16_t* WPOOL = (bf16_t*)WSP(WS_WPOOL); bf16_t* SKB = (bf16_t*)WSP(WS_SK); bf16_t* WUQ = (bf16_t*)WSP(WS_WUQ); bf16_t* WUKV = (bf16_t*)WSP(WS_WUKV);
        bf16_t* WOUT = (bf16_t*)WSP(WS_WOUT); bf16_t* WPQ = (bf16_t*)WSP(WS_WPQ); bf16_t* WG = (bf16_t*)WSP(WS_WG); bf16_t* WP = (bf16_t*)WSP(WS_WP); bf16_t* PB = (bf16_t*)WSP(WS_PB);
        float* COS = (float*)WSP(WS_COS); float* SIN = (float*)WSP(WS_SIN); bf16_t* EU = (bf16_t*)WSP(WS_EU); bf16_t* EV = (bf16_t*)WSP(WS_EV); bf16_t* XN = (bf16_t*)WSP(WS_R1);
        PHASE_IDS();
        LAS float* scr = (LAS float*)(lds + wave * 16384);
        constexpr int I_IN = 32 * 66, I_POOL = 4 * 4 * 8, I_UQ = 8 * 48, I_UKV = 8 * 64, I_SQ = 32 * 64, I_WP = 4 * 64;
        constexpr int NITEMS = I_IN + I_POOL + I_UQ + I_UKV + 3 * I_SQ + I_WP;
        for (int it = gw; it < NITEMS; it += NGW) {
            int r = it;
            if (r < I_IN) { tr_item<0>(w_in, 2112, 0, mix_gain, nullptr, WIN, 2048, 0, 66, scr, r, lane); continue; } r -= I_IN;
            if (r < I_POOL) { const int g = r >> 5; tr_item<0>(w_pool + g * 65536, 256, 0, nullptr, pool_scale + g * 256, WPOOL + g * 65536, 256, 0, 8, scr, r & 31, lane); continue; } r -= I_POOL;
            if (r < I_UQ) { tr_item<1>(w_uq, 1536, 0, q_lat_gain, nullptr, WUQ, 512, 0, 48, scr, r, lane); continue; } r -= I_UQ;
            if (r < I_UKV) { tr_item<0>(w_ukv, 2048, 0, kv_lat_gain, nullptr, WUKV, 512, 0, 64, scr, r, lane); continue; } r -= I_UKV;
            if (r < I_SQ) { tr_item<0>(w_out, 2048, 0, nullptr, nullptr, WOUT, 2048, 0, 64, scr, r, lane); continue; } r -= I_SQ;
            if (r < I_SQ) { tr_item<0>(w_pq, 2048, 0, nullptr, nullptr, WPQ, 2048, 0, 64, scr, r, lane); continue; } r -= I_SQ;
            if (r < I_SQ) { tr_item<0>(w_ple_gate, 2048, 0, ple_gain, nullptr, WG, 2048, 0, 64, scr, r, lane); continue; } r -= I_SQ;
            tr_item<0>(w_ple_proj, 2048, 0, nullptr, nullptr, WP, 256, 0, 64, scr, r, lane);
        }
        for (long i = gt; i < 49152 + 32768; i += NGT) {
            const u32x4 z = {0u, 0u, 0u, 0u};
            if (i < 49152) *(u32x4*)(WIN + (size_t)2112 * 2048 + i * 8) = z;
            else { const long j = i - 49152; const int hh = (int)(j >> 12), rem = (int)(j & 4095); *(u32x4*)(WUQ + ((size_t)hh * 256 + 192) * 512 + (size_t)rem * 8) = z; }
        }
        for (int m = gw; m < M; m += NGW) {
            const f32x4* xr = (const f32x4*)(x + (size_t)m * DM) + lane; f32x4 v[8]; float s = 0.f;
#pragma unroll
            for (int j = 0; j < 8; ++j) { v[j] = xr[64 * j]; s += sq4(v[j]); }
            const float rs = rsqrtf(wave_sum(s) * (1.f / DM) + EPS);
            u32x2* o8 = (u32x2*)(XN + (size_t)m * DM) + lane;
#pragma unroll
            for (int j = 0; j < 8; ++j) o8[64 * j] = pack4(v[j] * rs);
        }
        constexpr long NE8 = 4194304, NP8 = 524288, NS8 = 16384;
        for (long i = gt; i < 2 * NE8 + NP8 + 2 * NS8; i += NGT) {
            const float* src; bf16_t* dst; long j = i;
            if (j < NE8) { src = expert_u; dst = EU; } else if ((j -= NE8) < NE8) { src = expert_v; dst = EV; } else if ((j -= NE8) < NP8) { src = p_in; dst = PB; }
            else if ((j -= NP8) < NS8) { src = sub_k1; dst = SKB; } else { j -= NS8; src = sub_k2; dst = SKB + 131072; }
            const f32x4 a = *(const f32x4*)(src + j * 8), b = *(const f32x4*)(src + j * 8 + 4);
            *(u32x4*)(dst + j * 8) = pack8(a, b);
        }
        for (long i = gt; i < (long)M * 32; i += NGT) {
            const int row = (int)(i >> 5), j = (int)(i & 31);
            const float inv = __builtin_amdgcn_exp2f(-(float)j * (13.287712379549449f / 32.f));
            const float ang = (float)positions[row] * inv;
            const float kq = rintf(ang * 0.15915494309189535f);
            float r = fmaf(-kq, 6.2831854820251465f, ang); r = fmaf(-kq, -1.7484555e-7f, r);
            const float rev = r * 0.15915494309189535f;
            COS[i] = __builtin_amdgcn_cosf(rev); SIN[i] = __builtin_amdgcn_sinf(rev);
        }
    }
    xcd_barrier(bar);
    if (DBG_STOP == 0) return;
#if defined(DIAG) && DIAG == 5
    {
        KArgsP ka = kargs(); unsigned char* ws = ka->ws; float* OUT = ka->out; const float* eu = IN_F(18); const float* ev = IN_F(19); const float* x = IN_F(0);
        bf16_t* EU = (bf16_t*)WSP(WS_EU); bf16_t* EV = (bf16_t*)WSP(WS_EV); float* FL = (float*)(ws + WS_CTL) + 32768;
        PHASE_IDS();
        float num = 0.f, den = 0.f;
        for (int r = 0; r < 8; ++r) { const size_t e = (size_t)((vcu * 8 + r) * 8 + 3);
            for (int q = 0; q < 4; ++q) { const size_t j = e * 2048 + tid * 4 + q;
                const float a = __builtin_bit_cast(float, (unsigned)EU[j] << 16), b = __builtin_bit_cast(float, (unsigned)EV[j] << 16);
                num += (a - eu[j]) * (a - eu[j]) + (b - ev[j]) * (b - ev[j]) * (1.f / 256.f); den += eu[j] * eu[j] + ev[j] * ev[j] * (1.f / 256.f); } }
        num = wave_sum(num); den = wave_sum(den);
        if (lane == 0) { atomicAdd(FL, num); atomicAdd(FL + 1, den); }
        xcd_barrier(bar);
        for (long i = gt; i < (long)M * 2048 / 4; i += NGT) ((f32x4*)OUT)[i] = ((const f32x4*)x)[i];
        xcd_barrier(bar);
        if (blockIdx.x == 0 && tid == 0) { const float n_ = __hip_atomic_load(FL, __ATOMIC_RELAXED, __HIP_MEMORY_SCOPE_AGENT), d_ = __hip_atomic_load(FL + 1, __ATOMIC_RELAXED, __HIP_MEMORY_SCOPE_AGENT);
            OUT[0] += 1e4f * sqrtf(n_ / fmaxf(d_, 1e-30f)); }
        return;
    }
#endif

    if (PH(1)) {
        KArgsP ka = kargs(); unsigned char* ws = ka->ws;
        bf16_t* XN = (bf16_t*)WSP(WS_R1); bf16_t* WIN = (bf16_t*)WSP(WS_WIN); bf16_t* ZP = (bf16_t*)WSP(WS_ZP); bf16_t* CQ = (bf16_t*)WSP(WS_CQ); bf16_t* CKV = (bf16_t*)WSP(WS_CKV);
        float* SSQ_CQ = (float*)WSP(WS_SSQ_CQ); float* SSQ_CKV = (float*)WSP(WS_SSQ_CKV); float* KRP = (float*)WSP(WS_KRP);
        pg8::Gemm g{XN, WIN, 2048, 2048, 2048}; pg8::StaticOrder S; S.init(M, 2048, G, bx);
        EpiA E{ZP, CQ, CKV, SSQ_CQ, SSQ_CKV};
        pg8::gemm_phase<EpiA, pg8::StaticOrder, true>(lds, eps, g, S, E);
        pg8::Gemm g2{XN, WIN, 2048, 2048, 512}; pg8::QuadOrder<0> S2{vcu};
        EpiKR E2{KRP};
        pg8::gemm_phase<EpiKR, pg8::QuadOrder<0>, true>(lds, eps, g2, S2, E2);
    }
    xcd_barrier(bar);
    if (DBG_STOP == 1) return;

    if (PH(2)) {
        { KArgsP ka = kargs(); unsigned char* ws = ka->ws;
          bf16_t* ZP = (bf16_t*)WSP(WS_ZP); bf16_t* WPOOL = (bf16_t*)WSP(WS_WPOOL); bf16_t* UB = (bf16_t*)WSP(WS_U);
          pg8::Gemm gp{ZP, WPOOL, 1024, 256, 256}; pg8::QuadOrder<1> Sp{vcu};
          EpiStore Ep{UB, 1024};
          pg8::gemm_phase<EpiStore, pg8::QuadOrder<1>, true>(lds, eps, gp, Sp, Ep); }
        { KArgsP ka = kargs(); unsigned char* ws = ka->ws; const float* q_norm_gain = IN_F(11);
          bf16_t* CQ = (bf16_t*)WSP(WS_CQ); bf16_t* WUQ = (bf16_t*)WSP(WS_WUQ); bf16_t* QB = (bf16_t*)WSP(WS_Q);
          float* SSQ_CQ = (float*)WSP(WS_SSQ_CQ); float* COS = (float*)WSP(WS_COS); float* SIN = (float*)WSP(WS_SIN);
          pg8::Gemm gq{CQ, WUQ, 512, 512, 512}; pg8::StaticOrder Sq; Sq.init(M, 2048, G, bx);
          EpiQ Eq{QB, SSQ_CQ, q_norm_gain, COS, SIN};
          pg8::gemm_phase<EpiQ, pg8::StaticOrder, true>(lds, eps, gq, Sq, Eq); }
        { KArgsP ka = kargs(); unsigned char* ws = ka->ws; const float* k_norm_gain = IN_F(12);
          bf16_t* CKV = (bf16_t*)WSP(WS_CKV); bf16_t* WUKV = (bf16_t*)WSP(WS_WUKV); bf16_t* KB = (bf16_t*)WSP(WS_K); bf16_t* VB = (bf16_t*)WSP(WS_V);
          float* SSQ_CKV = (float*)WSP(WS_SSQ_CKV); float* KRP = (float*)WSP(WS_KRP); float* COS = (float*)WSP(WS_COS); float* SIN = (float*)WSP(WS_SIN);
          pg8::Gemm gk{CKV, WUKV, 512, 512, 512}; pg8::StaticOrder Sk; Sk.init(M, 2048, G, bx);
          EpiKV Ek{KB, VB, SSQ_CKV, KRP, k_norm_gain, COS, SIN};
          pg8::gemm_phase<EpiKV, pg8::StaticOrder, true>(lds, eps, gk, Sk, Ek); }
    }
    xcd_barrier(bar);
    if (DBG_STOP == 2) return;

    if (PH(3)) {
        KArgsP ka = kargs(); unsigned char* ws = ka->ws;
        bf16_t* UB = (bf16_t*)WSP(WS_U); bf16_t* YMIX = (bf16_t*)WSP(WS_R1); bf16_t* QB = (bf16_t*)WSP(WS_Q); bf16_t* KB = (bf16_t*)WSP(WS_K); bf16_t* VB = (bf16_t*)WSP(WS_V);
        PHASE_IDS();
        {
            const int ch = tid & 127, rg = tid >> 7; const int c0 = ch * 8; const int w = 2 << (c0 >> 8);
            const int row0 = vcu * 64 + rg * 16;
            for (int rI = 0; rI < 16; ++rI) {
                const int row = row0 + rI, tl = row & (SEQ - 1); const int cnt = (tl + 1 < w) ? tl + 1 : w;
                float a[8];
#pragma unroll
                for (int e = 0; e < 8; ++e) a[e] = 0.f;
                u32x4 cur = {0u, 0u, 0u, 0u};
                for (int i = 0; i < cnt; ++i) { const u32x4 v = *(const u32x4*)(UB + (size_t)(row - i) * 1024 + c0); if (i == 0) cur = v;
                    a[0] += bf_lo(v.x); a[1] += bf_hi(v.x); a[2] += bf_lo(v.y); a[3] += bf_hi(v.y); a[4] += bf_lo(v.z); a[5] += bf_hi(v.z); a[6] += bf_lo(v.w); a[7] += bf_hi(v.w); }
                const float ic = 1.f / (float)cnt;
                u32x4 o; o.x = cvtpk(a[0] * ic - bf_lo(cur.x), a[1] * ic - bf_hi(cur.x)); o.y = cvtpk(a[2] * ic - bf_lo(cur.y), a[3] * ic - bf_hi(cur.y));
                o.z = cvtpk(a[4] * ic - bf_lo(cur.z), a[5] * ic - bf_hi(cur.z)); o.w = cvtpk(a[6] * ic - bf_lo(cur.w), a[7] * ic - bf_hi(cur.w));
                *(u32x4*)(YMIX + (size_t)row * DM + c0) = o;
            }
        }
        if (G == 256) {
            const int bh = vcu >> 2, s = vcu & 3;
            att::attn_unit(bh >> 3, bh & 7, s, QB, KB, VB, YMIX, (char*)lds_raw, lds);
            att::attn_unit(bh >> 3, bh & 7, 7 - s, QB, KB, VB, YMIX, (char*)lds_raw, lds);
        }
    }
    xcd_barrier(bar);
    if (DBG_STOP == 3) return;

    if (PH(4)) {
        KArgsP ka = kargs(); unsigned char* ws = ka->ws; const float* x = IN_F(0); const float* ffn_gain = IN_F(14); float* OUT = ka->out;
        bf16_t* YMIX = (bf16_t*)WSP(WS_R1); bf16_t* WOUT = (bf16_t*)WSP(WS_WOUT); bf16_t* H1G = (bf16_t*)WSP(WS_H1G); float* SSQ_H1 = (float*)WSP(WS_SSQ_H1);
        pg8::Gemm g{YMIX, WOUT, 2048, 2048, 2048}; pg8::StaticOrder S; S.init(M, 2048, G, bx);
        EpiH1 E{x, OUT, H1G, ffn_gain, SSQ_H1};
        pg8::gemm_phase<EpiH1, pg8::StaticOrder, true>(lds, eps, g, S, E);
    }
    xcd_barrier(bar);
    if (DBG_STOP == 4) return;

    if (PH(5)) {
        KArgsP ka = kargs(); unsigned char* ws = ka->ws;
        bf16_t* H1G = (bf16_t*)WSP(WS_H1G); bf16_t* WPQ = (bf16_t*)WSP(WS_WPQ); bf16_t* QP = (bf16_t*)WSP(WS_R1); float* SSQ_H1 = (float*)WSP(WS_SSQ_H1); float* RSTD2 = (float*)WSP(WS_RSTD2);
        pg8::Gemm g{H1G, WPQ, 2048, 2048, 2048}; pg8::StaticOrder S; S.init(M, 2048, G, bx);
        EpiQP E{QP, SSQ_H1, RSTD2};
        pg8::gemm_phase<EpiQP, pg8::StaticOrder, true>(lds, eps, g, S, E);
    }
    xcd_barrier(bar);
    if (DBG_STOP == 5) return;

    if (PH(6)) {
        KArgsP ka = kargs(); unsigned char* ws = ka->ws;
        bf16_t* QP = (bf16_t*)WSP(WS_R1); bf16_t* SKB = (bf16_t*)WSP(WS_SK); int* PIDX = (int*)WSP(WS_PIDX); float* PGATE = (float*)WSP(WS_PGATE);
        PHASE_IDS();
        LAS float* SC = (LAS float*)(lds + wave * 12544);
        LAS float* TKV = (LAS float*)(lds + wave * 12544 + 8256);
        LAS int* TKI = (LAS int*)(lds + wave * 12544 + 8256 + 2048);
        const int fr = lane & 15, fq = lane >> 4;
        for (int bt = gw; bt < (M / 16) * NH; bt += NGW) {
            const int tb = bt >> 3, h = bt & 7, t0 = tb * 16;
#pragma unroll 1
            for (int side = 0; side < 2; ++side) {
                bf16x8 qf[4];
#pragma unroll
                for (int kk = 0; kk < 4; ++kk) qf[kk] = *(const bf16x8*)(QP + (size_t)(t0 + fr) * DM + h * 256 + side * 128 + kk * 32 + 8 * fq);
                const bf16_t* skb = SKB + (size_t)side * 131072 + (size_t)h * 16384;
#pragma unroll
                for (int nt = 0; nt < 8; ++nt) { f32x4 a = {0.f, 0.f, 0.f, 0.f};
#pragma unroll
                    for (int kk = 0; kk < 4; ++kk) { const bf16x8 kf = *(const bf16x8*)(skb + (size_t)(nt * 16 + fr) * 128 + kk * 32 + 8 * fq);
                        a = __builtin_amdgcn_mfma_f32_16x16x32_bf16(kf, qf[kk], a, 0, 0, 0); }
#pragma unroll
                    for (int i = 0; i < 4; ++i) SC[fr * 129 + nt * 16 + 4 * fq + i] = a[i]; }
                asm volatile("s_waitcnt lgkmcnt(0)" ::: "memory");
                const int tok = lane >> 2, q4 = lane & 3; float v[32];
#pragma unroll
                for (int i = 0; i < 32; ++i) v[i] = SC[tok * 129 + 4 * i + q4];
#pragma unroll 1
                for (int rnd = 0; rnd < 16; ++rnd) {
                    float best = v[0]; int bi = 0;
#pragma unroll
                    for (int i = 1; i < 32; ++i) { if (v[i] > best) { best = v[i]; bi = i; } }
                    int bk = 4 * bi + q4;
#pragma unroll
                    for (int o = 1; o < 4; o <<= 1) { const float ov = __shfl_xor(best, o); const int ok = __shfl_xor(bk, o); if (ov > best || (ov == best && ok < bk)) { best = ov; bk = ok; } }
                    if ((bk & 3) == q4) { const int wi = bk >> 2;
#pragma unroll
                        for (int i = 0; i < 32; ++i) v[i] = (i == wi) ? -INFINITY : v[i]; }
                    if (q4 == 0) { TKV[(side * 16 + tok) * 16 + rnd] = best; TKI[(side * 16 + tok) * 16 + rnd] = bk; }
                }
                asm volatile("s_waitcnt lgkmcnt(0)" ::: "memory");
            }
            {
                const int tok = lane >> 2, q4 = lane & 3; float c[64]; float v2[16];
#pragma unroll
                for (int b = 0; b < 16; ++b) v2[b] = TKV[(16 + tok) * 16 + b];
#pragma unroll
                for (int ai = 0; ai < 4; ++ai) { const float v1 = TKV[tok * 16 + q4 + 4 * ai];
#pragma unroll
                    for (int b = 0; b < 16; ++b) c[ai * 16 + b] = v1 + v2[b]; }
                float vmax = 0.f, esum = 0.f; float eo[4]; int co[4];
#pragma unroll
                for (int ri = 0; ri < 4; ++ri) {
#pragma unroll 1
                    for (int rq = 0; rq < 4; ++rq) {
                        float best = c[0]; int bi = 0;
#pragma unroll
                        for (int i = 1; i < 64; ++i) { if (c[i] > best) { best = c[i]; bi = i; } }
                        int bci = (q4 + 4 * (bi >> 4)) * 16 + (bi & 15);
#pragma unroll
                        for (int o = 1; o < 4; o <<= 1) { const float ov = __shfl_xor(best, o); const int oc = __shfl_xor(bci, o); if (ov > best || (ov == best && oc < bci)) { best = ov; bci = oc; } }
                        if (((bci >> 4) & 3) == q4) { const int wi = (bci >> 6) * 16 + (bci & 15);
#pragma unroll
                            for (int i = 0; i < 64; ++i) c[i] = (i == wi) ? -INFINITY : c[i]; }
                        if (ri == 0 && rq == 0) vmax = best;
                        const float e = __builtin_amdgcn_exp2f((best - vmax) * 1.4426950408889634f); esum += e;
                        if (rq == q4) { eo[ri] = e; co[ri] = bci; }
                    }
                }
                const float inv = 1.f / esum;
#pragma unroll
                for (int ri = 0; ri < 4; ++ri) { const int e1 = TKI[tok * 16 + (co[ri] >> 4)], e2 = TKI[(16 + tok) * 16 + (co[ri] & 15)];
                    const size_t oi = (size_t)(t0 + tok) * 128 + h * 16 + 4 * ri + q4;
                    PIDX[oi] = e1 * 128 + e2; PGATE[oi] = eo[ri] * inv; }
            }
            asm volatile("s_waitcnt lgkmcnt(0)" ::: "memory");
        }
    }
    xcd_barrier(bar);
    if (DBG_STOP == 6) return;

#if defined(DIAG) && DIAG <= 3
    {
        KArgsP ka = kargs(); unsigned char* ws = ka->ws; float* OUT = ka->out;
        bf16_t* H1G = (bf16_t*)WSP(WS_H1G); bf16_t* WPQ = (bf16_t*)WSP(WS_WPQ); bf16_t* QP = (bf16_t*)WSP(WS_R1); bf16_t* SKB = (bf16_t*)WSP(WS_SK);
        int* PIDX = (int*)WSP(WS_PIDX); float* PGATE = (float*)WSP(WS_PGATE); float* RSTD2 = (float*)WSP(WS_RSTD2);
        float* FL = (float*)(ws + WS_CTL) + 32768;
        PHASE_IDS();
        const int tk = vcu * 64 + 17;
        float num = 0.f, den = 0.f;
#if DIAG == 1
        {
            const float rs = RSTD2[tk];
            for (int q = 0; q < 4; ++q) { const int n = tid * 4 + q; float s = 0.f;
                for (int k = 0; k < 2048; k += 2) { const unsigned a = *(const unsigned*)(H1G + (size_t)tk * 2048 + k), b = *(const unsigned*)(WPQ + (size_t)n * 2048 + k);
                    s += bf_lo(a) * bf_lo(b) + bf_hi(a) * bf_hi(b); }
                s *= rs; const unsigned short qv = QP[(size_t)tk * 2048 + n]; const float got = __builtin_bit_cast(float, (unsigned)qv << 16);
                num += (got - s) * (got - s); den += s * s; }
        }
#elif DIAG == 2 || DIAG == 3
        {
            LAS float* S1 = (LAS float*)(lds + wave * 2048); LAS float* S2 = S1 + 128; LAS float* VC = S1 + 256;
            const int h = wave;
            for (int side = 0; side < 2; ++side) for (int rep = 0; rep < 2; ++rep) { const int n = rep * 64 + lane; float s = 0.f;
                for (int d = 0; d < 128; ++d) { const unsigned short a = QP[(size_t)tk * 2048 + h * 256 + side * 128 + d], b = SKB[(size_t)side * 131072 + (size_t)h * 16384 + n * 128 + d];
                    s += __builtin_bit_cast(float, (unsigned)a << 16) * __builtin_bit_cast(float, (unsigned)b << 16); }
                (side ? S2 : S1)[n] = s; }
            asm volatile("s_waitcnt lgkmcnt(0)" ::: "memory");
            float myv = 1e30f; int myid = -1; float myg = 0.f;
            if (lane < 16) { myid = PIDX[(size_t)tk * 128 + h * 16 + lane]; myg = PGATE[(size_t)tk * 128 + h * 16 + lane];
                const int e1 = myid >> 7, e2 = myid & 127; myv = (e1 >= 0 && e1 < 128) ? S1[e1] + S2[e2] : -1e30f; VC[lane] = myv; }
            asm volatile("s_waitcnt lgkmcnt(0)" ::: "memory");
            float vmin = 1e30f, vmx = -1e30f; for (int i = 0; i < 16; ++i) { vmin = fminf(vmin, VC[i]); vmx = fmaxf(vmx, VC[i]); }
#if DIAG == 2
            int cnt = 0; for (int a = lane; a < 128; a += 64) for (int b = 0; b < 128; ++b) cnt += (S1[a] + S2[b] > vmin) ? 1 : 0;
            for (int o = 1; o < 64; o <<= 1) cnt += __shfl_xor(cnt, o);
            int dup = 0; if (lane < 16) for (int i = 0; i < 16; ++i) if (i != lane && PIDX[(size_t)tk * 128 + h * 16 + i] == myid) dup = 1;
            for (int o = 1; o < 64; o <<= 1) dup += __shfl_xor(dup, o);
            if (lane == 0) { num = (cnt != 15 || dup != 0) ? 1.f : 0.f; den = 1.f; }
#else
            float es = 0.f; for (int i = 0; i < 16; ++i) es += __expf(VC[i] - vmx);
            if (lane < 16) { const float gref = __expf(myv - vmx) / es; num = (gref - myg) * (gref - myg); den = gref * gref; }
#endif
        }
#endif
        num = wave_sum(num); den = wave_sum(den);
        if (lane == 0) { atomicAdd(FL, num); atomicAdd(FL + 1, den); }
        xcd_barrier(bar);
        if (blockIdx.x == 0 && tid == 0) { const float n_ = __hip_atomic_load(FL, __ATOMIC_RELAXED, __HIP_MEMORY_SCOPE_AGENT), d_ = __hip_atomic_load(FL + 1, __ATOMIC_RELAXED, __HIP_MEMORY_SCOPE_AGENT);
            OUT[0] += 1e4f * sqrtf(n_ / fmaxf(d_, 1e-30f)); }
        return;
    }
#endif

#if defined(DIAG) && DIAG == 4
    { KArgsP ka = kargs(); unsigned char* ws = ka->ws; float* OUT = ka->out; float* SAVE = (float*)WSP(WS_KRP);
      const int tk = vcu * 64 + 17; for (int j = threadIdx.x; j < 2048; j += 512) SAVE[(size_t)vcu * 2048 + j] = OUT[(size_t)tk * 2048 + j]; }
    xcd_barrier(bar);
#endif
    if (PH(7)) {
        KArgsP ka = kargs(); unsigned char* ws = ka->ws; float* OUT = ka->out;
        bf16_t* H1G = (bf16_t*)WSP(WS_H1G); bf16_t* EU = (bf16_t*)WSP(WS_EU); bf16_t* EV = (bf16_t*)WSP(WS_EV); bf16_t* H2B = (bf16_t*)WSP(WS_H2B);
        int* PIDX = (int*)WSP(WS_PIDX); float* PGATE = (float*)WSP(WS_PGATE); float* RSTD2 = (float*)WSP(WS_RSTD2); float* RSTD3 = (float*)WSP(WS_RSTD3);
        PHASE_IDS();
        for (int tok = gw; tok < M; tok += NGW) {
            u32x4 xr[4];
#pragma unroll
            for (int c = 0; c < 4; ++c) xr[c] = *(const u32x4*)(H1G + (size_t)tok * DM + 8 * lane + 512 * c);
            const float rs = RSTD2[tok];
            const int id0 = PIDX[(size_t)tok * 128 + lane], id1 = PIDX[(size_t)tok * 128 + 64 + lane];
            const float gt0 = PGATE[(size_t)tok * 128 + lane], gt1 = PGATE[(size_t)tok * 128 + 64 + lane];
            float acc[32];
#pragma unroll
            for (int i = 0; i < 32; ++i) acc[i] = 0.f;
#pragma unroll 4
            for (int k = 0; k < 128; ++k) {
                const int e = __builtin_amdgcn_readlane(k < 64 ? id0 : id1, k & 63);
                const float gk = __builtin_bit_cast(float, __builtin_amdgcn_readlane(__builtin_bit_cast(int, k < 64 ? gt0 : gt1), k & 63));
                const bf16_t* up = EU + (size_t)e * DM + 8 * lane; const bf16_t* vp = EV + (size_t)e * DM + 8 * lane;
                u32x4 uu[4], vv[4];
#pragma unroll
                for (int c = 0; c < 4; ++c) { uu[c] = *(const u32x4*)(up + 512 * c); vv[c] = *(const u32x4*)(vp + 512 * c); }
                float d = 0.f;
#pragma unroll
                for (int c = 0; c < 4; ++c) {
                    d = dot2bf(uu[c].x, xr[c].x, d); d = dot2bf(uu[c].y, xr[c].y, d); d = dot2bf(uu[c].z, xr[c].z, d); d = dot2bf(uu[c].w, xr[c].w, d); }
                d = wave_sum(d);
                const float a = gelu_tanh(rs * d) * gk;
#pragma unroll
                for (int c = 0; c < 4; ++c) {
                    acc[8 * c + 0] += a * bf_lo(vv[c].x); acc[8 * c + 1] += a * bf_hi(vv[c].x); acc[8 * c + 2] += a * bf_lo(vv[c].y); acc[8 * c + 3] += a * bf_hi(vv[c].y);
                    acc[8 * c + 4] += a * bf_lo(vv[c].z); acc[8 * c + 5] += a * bf_hi(vv[c].z); acc[8 * c + 6] += a * bf_lo(vv[c].w); acc[8 * c + 7] += a * bf_hi(vv[c].w); }
            }
            float s = 0.f;
#pragma unroll
            for (int c = 0; c < 4; ++c) { float* o = OUT + (size_t)tok * DM + 8 * lane + 512 * c;
                f32x4 h0 = *(const f32x4*)o, h1 = *(const f32x4*)(o + 4);
                h0 += (f32x4){acc[8 * c + 0], acc[8 * c + 1], acc[8 * c + 2], acc[8 * c + 3]}; h1 += (f32x4){acc[8 * c + 4], acc[8 * c + 5], acc[8 * c + 6], acc[8 * c + 7]};
                *(f32x4*)o = h0; *(f32x4*)(o + 4) = h1; s += sq4(h0) + sq4(h1);
                *(u32x4*)(H2B + (size_t)tok * DM + 8 * lane + 512 * c) = pack8(h0, h1); }
            s = wave_sum(s);
            if (lane == 0) RSTD3[tok] = rsqrtf(s * (1.f / DM) + EPS);
        }
    }
    xcd_barrier(bar);
    if (DBG_STOP == 7) return;
#if defined(DIAG) && DIAG == 4
    {
        KArgsP ka = kargs(); unsigned char* ws = ka->ws; float* OUT = ka->out; float* SAVE = (float*)WSP(WS_KRP);
        const float* eu = IN_F(18); const float* ev = IN_F(19);
        bf16_t* H1G = (bf16_t*)WSP(WS_H1G); int* PIDX = (int*)WSP(WS_PIDX); float* PGATE = (float*)WSP(WS_PGATE); float* RSTD2 = (float*)WSP(WS_RSTD2);
        float* FL = (float*)(ws + WS_CTL) + 32768;
        PHASE_IDS();
        LAS float* RED = (LAS float*)lds;
        const int tk = vcu * 64 + 17; const float rs = RSTD2[tk];
        float xn[4], ref[4] = {0.f, 0.f, 0.f, 0.f};
        for (int q = 0; q < 4; ++q) xn[q] = __builtin_bit_cast(float, (unsigned)H1G[(size_t)tk * 2048 + tid * 4 + q] << 16) * rs;
        for (int k = 0; k < 128; ++k) {
            const int e = PIDX[(size_t)tk * 128 + k]; const float g = PGATE[(size_t)tk * 128 + k];
            float d = 0.f; for (int q = 0; q < 4; ++q) d += eu[(size_t)e * 2048 + tid * 4 + q] * xn[q];
            d = wave_sum(d); if (lane == 0) RED[wave] = d; __syncthreads();
            float dt = 0.f; for (int w = 0; w < 8; ++w) dt += RED[w]; __syncthreads();
            const float a = 0.5f * dt * (1.f + tanhf(0.7978845608f * (dt + 0.044715f * dt * dt * dt))) * g;
            for (int q = 0; q < 4; ++q) ref[q] += a * ev[(size_t)e * 2048 + tid * 4 + q];
        }
        float num = 0.f, den = 0.f;
        for (int q = 0; q < 4; ++q) { const float got = OUT[(size_t)tk * 2048 + tid * 4 + q] - SAVE[(size_t)vcu * 2048 + tid * 4 + q]; num += (got - ref[q]) * (got - ref[q]); den += ref[q] * ref[q]; }
        num = wave_sum(num); den = wave_sum(den);
        if (lane == 0) { atomicAdd(FL, num); atomicAdd(FL + 1, den); }
        xcd_barrier(bar);
        if (blockIdx.x == 0 && tid == 0) { const float n_ = __hip_atomic_load(FL, __ATOMIC_RELAXED, __HIP_MEMORY_SCOPE_AGENT), d_ = __hip_atomic_load(FL + 1, __ATOMIC_RELAXED, __HIP_MEMORY_SCOPE_AGENT);
            OUT[0] += 1e4f * sqrtf(n_ / fmaxf(d_, 1e-30f)); }
        return;
    }
#endif

    if (PH(8)) {
        KArgsP ka = kargs(); unsigned char* ws = ka->ws; float* OUT = ka->out;
        bf16_t* PB = (bf16_t*)WSP(WS_PB); bf16_t* WP = (bf16_t*)WSP(WS_WP); bf16_t* PROJ = (bf16_t*)WSP(WS_R1); bf16_t* H2B = (bf16_t*)WSP(WS_H2B); bf16_t* WG = (bf16_t*)WSP(WS_WG); float* RSTD3 = (float*)WSP(WS_RSTD3);
        pg8::StaticOrder S; S.init(M, 2048, G, bx);
        pg8::Gemm gp{PB, WP, 256, 256, 256};
        EpiStore Ep{PROJ, 2048};
        pg8::gemm_phase<EpiStore, pg8::StaticOrder, true>(lds, eps, gp, S, Ep);
        pg8::Gemm gg{H2B, WG, 2048, 2048, 2048};
        EpiGate Eg{OUT, PROJ, RSTD3};
        pg8::gemm_phase<EpiGate, pg8::StaticOrder, true>(lds, eps, gg, S, Eg);
    }
}

extern "C" void kernel_launch(void* const* d_in, const int* in_sizes, int n_in, void* d_out, int out_size, void* d_ws, size_t ws_size, hipStream_t stream) {
    static int ready = 0;
    if (ready == 0) {
        if (n_in != 23 || out_size != M * DM || ws_size < WS_END) { fprintf(stderr, "kernel_launch: unexpected shapes (n_in %d, out %d, ws %zu)\n", n_in, out_size, ws_size); ready = -1; return; }
        if (hipFuncSetAttribute((const void*)fwd_kernel, hipFuncAttributeMaxDynamicSharedMemorySize, LDS_BYTES) != hipSuccess) { fprintf(stderr, "kernel_launch: hipFuncSetAttribute failed\n"); ready = -1; return; }
        ready = 1;
    }
    if (ready < 0) return;
    (void)hipMemsetAsync((char*)d_ws + WS_CTL, 0, CTL_ZERO_BYTES, stream);
    Args a{};
    for (int i = 0; i < 23; ++i) a.in[i] = (const float*)d_in[i];
    a.out = (float*)d_out; a.ws = (unsigned char*)d_ws;
    hipLaunchKernelGGL(fwd_kernel, dim3(256), dim3(NWAVES * 64), LDS_BYTES, stream, a);
}
```

```cpp
#include <hip/hip_runtime.h>
#include <cstdio>
#include <cstdint>
#include <type_traits>

#define LAS __attribute__((address_space(3)))
#define GAS __attribute__((address_space(1)))
typedef unsigned short bf16_t;
typedef short bf16x8 __attribute__((ext_vector_type(8)));
typedef short s16x4 __attribute__((ext_vector_type(4)));
typedef float f32x4 __attribute__((ext_vector_type(4)));
typedef float f32x2 __attribute__((ext_vector_type(2)));
typedef float f32x16 __attribute__((ext_vector_type(16)));
typedef unsigned u32x4 __attribute__((ext_vector_type(4)));
typedef int i32x4 __attribute__((ext_vector_type(4)));
typedef unsigned u32x2 __attribute__((ext_vector_type(2)));
typedef __bf16 bf16x2_t __attribute__((ext_vector_type(2)));

constexpr int M = 16384, DM = 2048, SEQ = 2048, NB = 8, NH = 8;
constexpr float EPS = 1e-6f;
constexpr size_t MiB = 1u << 20;
constexpr size_t WS_CTL = 0, CTL_ZERO_BYTES = 1 * MiB;
constexpr size_t WS_WIN = 1 * MiB;
constexpr size_t WS_WPOOL = 10 * MiB;
constexpr size_t WS_SK = 10 * MiB + 512 * 1024;
constexpr size_t WS_WUQ = 11 * MiB;
constexpr size_t WS_WUKV = 13 * MiB;
constexpr size_t WS_WOUT = 15 * MiB;
constexpr size_t WS_WPQ = 23 * MiB;
constexpr size_t WS_WG = 31 * MiB;
constexpr size_t WS_WP = 39 * MiB;
constexpr size_t WS_PB = 40 * MiB;
constexpr size_t WS_COS = 48 * MiB, WS_SIN = 50 * MiB;
constexpr size_t WS_SSQ_CQ = 52 * MiB, WS_SSQ_CKV = 52 * MiB + 512 * 1024, WS_SSQ_H1 = 53 * MiB, WS_RSTD2 = 55 * MiB, WS_RSTDX = 55 * MiB + 512 * 1024;
constexpr size_t WS_EU = 56 * MiB, WS_EV = 88 * MiB;
constexpr size_t WS_SU = 55 * MiB + 128 * 1024, WS_SV = 55 * MiB + 256 * 1024;
constexpr size_t WS_AQ = 346 * MiB, WS_AS = 349 * MiB;
constexpr size_t WS_SSQ2 = 344 * MiB;
constexpr size_t WS_XQ = 184 * MiB;
constexpr size_t WS_SBW = 55 * MiB + 640 * 1024;
constexpr size_t WS_XB = 120 * MiB;
constexpr size_t WS_PART0 = 184 * MiB, WS_PART1 = 424 * MiB;
constexpr size_t WS_R1 = 184 * MiB;
constexpr size_t WS_ZP = 248 * MiB, WS_U = 280 * MiB, WS_H2B = 248 * MiB;
constexpr size_t WS_CQ = 312 * MiB, WS_CKV = 328 * MiB, WS_KRP = 344 * MiB, WS_PIDX = 312 * MiB, WS_PGATE = 320 * MiB;
constexpr size_t WS_Q = 360 * MiB, WS_K = 408 * MiB, WS_V = 456 * MiB;
constexpr size_t WS_END = 488 * MiB;
constexpr int RING_BYTES = 131072, EPI_OFF = RING_BYTES, EPI_BYTES = 8192, LDS_BYTES = 163840, LDSCTL_OFF = LDS_BYTES - 1024, MISC_OFF = LDSCTL_OFF + 320;
constexpr int NWAVES = 8;

__device__ __forceinline__ unsigned cvtpk(float lo, float hi) { f32x2 v = {lo, hi}; bf16x2_t b = __builtin_convertvector(v, bf16x2_t); return __builtin_bit_cast(unsigned, b); }
__device__ __forceinline__ float bf_lo(unsigned w) { return __builtin_bit_cast(float, w << 16); }
__device__ __forceinline__ float bf_hi(unsigned w) { return __builtin_bit_cast(float, w & 0xffff0000u); }
__device__ __forceinline__ float ub0(unsigned w) { return (float)(w & 0xffu); }
__device__ __forceinline__ float ub1(unsigned w) { float r; asm("v_cvt_f32_ubyte1 %0, %1" : "=v"(r) : "v"(w)); return r; }
__device__ __forceinline__ float ub2(unsigned w) { float r; asm("v_cvt_f32_ubyte2 %0, %1" : "=v"(r) : "v"(w)); return r; }
__device__ __forceinline__ float ub3(unsigned w) { float r; asm("v_cvt_f32_ubyte3 %0, %1" : "=v"(r) : "v"(w)); return r; }
__device__ __forceinline__ float dpp_xor1(float x) { return __builtin_bit_cast(float, __builtin_amdgcn_mov_dpp(__builtin_bit_cast(int, x), 0xB1, 0xF, 0xF, true)); }
__device__ __forceinline__ float dpp_xor2(float x) { return __builtin_bit_cast(float, __builtin_amdgcn_mov_dpp(__builtin_bit_cast(int, x), 0x4E, 0xF, 0xF, true)); }
#define DPP_I(x, ctrl) __builtin_amdgcn_mov_dpp((x), (ctrl), 0xF, 0xF, true)
#define DPP_F(x, ctrl) __builtin_bit_cast(float, __builtin_amdgcn_mov_dpp(__builtin_bit_cast(int, (float)(x)), (ctrl), 0xF, 0xF, true))
__device__ __forceinline__ int oct_sum_i(int v) { v += DPP_I(v, 0xB1); v += DPP_I(v, 0x4E); return v + DPP_I(v, 0x141); }
__device__ __forceinline__ float oct_sum(float v) { v += DPP_F(v, 0xB1); v += DPP_F(v, 0x4E); return v + DPP_F(v, 0x141); }
__device__ __forceinline__ float oct_max(float v) { v = fmaxf(v, DPP_F(v, 0xB1)); v = fmaxf(v, DPP_F(v, 0x4E)); return fmaxf(v, DPP_F(v, 0x141)); }
template <int N> __device__ __forceinline__ void bitonic_sort_desc(float (&v)[N]) {
#pragma unroll
    for (int k = 2; k <= N; k <<= 1)
#pragma unroll
        for (int j = k >> 1; j > 0; j >>= 1)
#pragma unroll
            for (int i = 0; i < N; ++i) { const int l = i ^ j; if (l > i) { const bool desc = (i & k) == 0; const float a = v[i], b = v[l]; const float hi = fmaxf(a, b), lo = fminf(a, b); v[i] = desc ? hi : lo; v[l] = desc ? lo : hi; } }
}
#define QUAD_MERGE16(v, CTRL) do { float p_[16]; _Pragma("unroll") for (int i = 0; i < 16; ++i) p_[i] = DPP_F(v[15 - i], CTRL); \
    _Pragma("unroll") for (int i = 0; i < 16; ++i) v[i] = fmaxf(v[i], p_[i]); \
    _Pragma("unroll") for (int j = 8; j > 0; j >>= 1) _Pragma("unroll") for (int i = 0; i < 16; ++i) { const int l = i ^ j; if (l > i) { const float a = v[i], b = v[l]; v[i] = fmaxf(a, b); v[l] = fminf(a, b); } } } while (0)
template <int N> __device__ __forceinline__ float tree_max(const float* v) {
    if constexpr (N == 1) return v[0]; else return fmaxf(tree_max<N / 2>(v), tree_max<N - N / 2>(v + N / 2));
}
__device__ __forceinline__ float quad_max(float m) { m = fmaxf(m, dpp_xor1(m)); return fmaxf(m, dpp_xor2(m)); }
__device__ __forceinline__ float quad_sum(float m) { m += dpp_xor1(m); return m + dpp_xor2(m); }
__device__ __forceinline__ float wave_max(float v) {
#pragma unroll
    for (int o = 1; o < 64; o <<= 1) v = fmaxf(v, __shfl_xor(v, o));
    return v;
}
__device__ __forceinline__ int wave_sum_i(int v) {
#pragma unroll
    for (int o = 1; o < 64; o <<= 1) v += __shfl_xor(v, o);
    return v;
}
__device__ __forceinline__ float wave_sum(float v) {
#pragma unroll
    for (int o = 1; o < 64; o <<= 1) v += __shfl_xor(v, o);
    return v;
}
__device__ __forceinline__ int tid_of(int wave0) { int l; asm volatile("v_mbcnt_lo_u32_b32 %0, -1, 0\n\tv_mbcnt_hi_u32_b32 %0, -1, %0" : "=v"(l)); return wave0 * 64 + l; }
#define EPI_BAR() do { asm volatile("s_waitcnt lgkmcnt(0)" ::: "memory"); __builtin_amdgcn_s_barrier(); asm volatile("" ::: "memory"); } while (0)

namespace pg8 {
constexpr int BM = 256, BK = 64, HALF = 128, HTB = HALF * BK * 2, STAGE_BYTES = 8 * HTB, NXCD = 8, WGM = 1;
__host__ __device__ __forceinline__ int lds_byte(int r, int c) { const int st = (r >> 4) * 2 + (c >> 5), rr = r & 15, cc = c & 31, ob = rr * 64 + cc * 2; return st * 1024 + (ob ^ (((ob >> 9) & 1) << 5)); }
__host__ __device__ __forceinline__ void stage_rc(int b, int& R, int& C) { const int st = b / 1024, sb = b % 1024, swz = sb ^ (((sb >> 9) & 1) << 5); R = (st >> 1) * 16 + swz / 64; C = (st & 1) * 32 + (swz % 64) / 2; }
__host__ __device__ __forceinline__ int perm32(int rho) { const int n = rho >> 4, i = rho & 15; return 8 * (i >> 2) + 4 * n + (i & 3); }

struct Unit { int pm, pn, ka, kb; };
struct Gemm { const bf16_t* A; const bf16_t* Bt; int lda, ldb, K; };

struct StaticOrder {
    int nM, nN, nwg, G, c;
    __device__ void init(int Mr, int N, int G_, int c_) { nM = Mr / BM; nN = N / BM; nwg = nM * nN; G = G_; c = c_; }
    __device__ bool next(int i, Unit& u) const {
        const long L = (long)i * G + c; if (L >= nwg) return false;
        int wgid = (int)L; { const int q = nwg / NXCD, r = nwg % NXCD, xcd = wgid % NXCD, off = wgid / NXCD; wgid = (xcd < r ? xcd * (q + 1) : r * (q + 1) + (xcd - r) * q) + off; }
        const int nig = WGM * nN, gid = wgid / nig, fm = gid * WGM, gsz = (nM - fm) < WGM ? (nM - fm) : WGM;
        u.pm = fm + ((wgid % nig) % gsz); u.pn = (wgid % nig) / gsz; u.ka = 0; u.kb = 0; return true;
    }
};
template <int MODE> struct QuadOrder {
    int v;
    __device__ bool next(int i, Unit& u) const {
        if (i > 0) return false;
        u.pm = v >> 2; const int j = v & 3;
        if (MODE == 0) { u.pn = 8; u.ka = 512 * j; u.kb = 512 * j; } else { u.pn = j; u.ka = 256 * j; u.kb = 0; }
        return true;
    }
};

struct PairOrder {
    int v;
    __device__ bool next(int i, Unit& u) const { if (i > 1) return false; u.pm = 2 * (v >> 3) + i; u.pn = v & 7; u.ka = 0; u.kb = 0; return true; }
};
template <class Epi, class Sched, bool ALIGN_EPI, bool PRE = false, bool I8 = false>
__device__ __forceinline__ void gemm_phase(LAS unsigned char* lds, LAS unsigned char* eps, const Gemm g, const Sched& S, const Epi& E, int wave0) {
    int tid = tid_of(wave0); asm volatile("" : "+v"(tid));
    const int wid = __builtin_amdgcn_readfirstlane(tid >> 6), lane = tid & 63, wr = wid >> 2, wc = wid & 3, fr = lane & 15, fq = lane >> 4;
    constexpr int ES = I8 ? 1 : 2;
    int nt = g.K * ES / (BK * 2); asm volatile("" : "+s"(nt));
    unsigned voffA[2], voffB[2];
#pragma unroll
    for (int i = 0; i < 2; ++i) { int R, C; stage_rc(tid * 16 + i * 8192, R, C); const int Rb = Epi::PERM ? ((R & ~31) + perm32(R & 31)) : R;
        voffA[i] = (unsigned)(R * g.lda * ES + C * 2); voffB[i] = (unsigned)(Rb * g.ldb * ES + C * 2); }
    const size_t kstep = (size_t)(BK * 2);
    const size_t hstepA = (size_t)HALF * g.lda * ES, hstepB = (size_t)HALF * g.ldb * ES;
    const size_t tstepA = 2 * hstepA, tstepB = 2 * hstepB;
    const unsigned ldsw = (unsigned)wid * 1024u;
    const int aoff = lds_byte(wr * 64 + fr, fq * 8), boff = lds_byte(wc * 32 + fr, fq * 8);
#define PG8_SA(b, h) (((b) * 2 + (h)) * HTB)
#define PG8_SB(b, h) ((4 + (b) * 2 + (h)) * HTB)
#define PG8_STAGE(bufoff, gbase, voff) do { _Pragma("unroll") for (int _i = 0; _i < 2; ++_i) \
        __builtin_amdgcn_global_load_lds((const unsigned*)((const char*)(gbase) + (voff)[_i]), (LAS unsigned*)(lds + (bufoff) + ldsw + _i * 8192), 16, 0, 0); } while (0)
#define PG8_LDA(dst, b, h) do { _Pragma("unroll") for (int m = 0; m < 4; ++m) _Pragma("unroll") for (int k = 0; k < 2; ++k) dst[m][k] = *(const LAS bf16x8*)(lds + PG8_SA(b, h) + aoff + m * 2048 + k * 1024); } while (0)
#define PG8_LDB(dst, b, h) do { _Pragma("unroll") for (int n = 0; n < 2; ++n) _Pragma("unroll") for (int k = 0; k < 2; ++k) dst[n][k] = *(const LAS bf16x8*)(lds + PG8_SB(b, h) + boff + n * 2048 + k * 1024); } while (0)
#define PG8_MMA(ai, bj, At, Bt) do { __builtin_amdgcn_s_setprio(1); _Pragma("unroll") for (int m = 0; m < 4; ++m) _Pragma("unroll") for (int n = 0; n < 2; ++n) _Pragma("unroll") for (int k = 0; k < 2; ++k) \
        { if constexpr (I8) acc[ai][bj][m][n] = __builtin_bit_cast(AccT, __builtin_amdgcn_mfma_i32_16x16x64_i8(__builtin_bit_cast(i32x4, Bt[n][k]), __builtin_bit_cast(i32x4, At[m][k]), __builtin_bit_cast(i32x4, acc[ai][bj][m][n]), 0, 0, 0)); \
          else acc[ai][bj][m][n] = __builtin_bit_cast(AccT, __builtin_amdgcn_mfma_f32_16x16x32_bf16(Bt[n][k], At[m][k], __builtin_bit_cast(f32x4, acc[ai][bj][m][n]), 0, 0, 0)); } __builtin_amdgcn_s_setprio(0); } while (0)
#define PG8_WAIT_V(n) asm volatile("s_waitcnt vmcnt(" #n ")" ::: "memory")
#define PG8_WAIT_L(n) asm volatile("s_waitcnt lgkmcnt(" #n ")" ::: "memory")
#define PG8_BAR __builtin_amdgcn_s_barrier()
#define PG8_SCHED __builtin_amdgcn_sched_barrier(0)
    Unit cur, nxt; int ui = 0;
    if (!S.next(0, cur)) return;
    using AccT = typename std::conditional<I8, i32x4, f32x4>::type;
    AccT acc[2][2][4][2];
#pragma unroll
    for (int a = 0; a < 2; ++a)
#pragma unroll
        for (int b = 0; b < 2; ++b)
#pragma unroll
            for (int m = 0; m < 4; ++m)
#pragma unroll
                for (int n = 0; n < 2; ++n) acc[a][b][m][n] = (AccT){0, 0, 0, 0};
    bf16x8 At[4][2], B0[2][2], B1[2][2];
    const char* cA = (const char*)g.A + (size_t)cur.pm * tstepA + (size_t)cur.ka * ES; const char* cB = (const char*)g.Bt + (size_t)cur.pn * tstepB + (size_t)cur.kb * ES;
    PG8_STAGE(PG8_SB(0, 0), cB, voffB); PG8_STAGE(PG8_SB(0, 1), cB + hstepB, voffB); PG8_STAGE(PG8_SA(0, 0), cA, voffA); PG8_STAGE(PG8_SA(0, 1), cA + hstepA, voffA);
    if (wr == 1) PG8_BAR;
    PG8_WAIT_V(2); PG8_BAR;
    PG8_STAGE(PG8_SB(1, 0), cB + kstep, voffB); PG8_STAGE(PG8_SA(1, 0), cA + kstep, voffA); PG8_STAGE(PG8_SB(1, 1), cB + hstepB + kstep, voffB);
    PG8_WAIT_V(6); PG8_BAR;
    unsigned pre2 = 0; unsigned pre = 0;
    for (;;) {
        const bool has_next = S.next(ui + 1, nxt);
        const char* nA = has_next ? (const char*)g.A + (size_t)nxt.pm * tstepA + (size_t)nxt.ka * ES : cA; const char* nB = has_next ? (const char*)g.Bt + (size_t)nxt.pn * tstepB + (size_t)nxt.kb * ES : cB;
#pragma unroll 1
        for (int t = 0; t < nt; t += 2) {
            const bool last = (t == nt - 2);
            if constexpr (PRE) { if (last) { const unsigned* pp = E.pre_ptr(cur, tid); asm volatile("global_load_dword %0, %1, off" : "=v"(pre) : "v"(pp) : "memory");
                                           const unsigned* pq = E.pre_ptr2(cur, tid); asm volatile("global_load_dword %0, %1, off" : "=v"(pre2) : "v"(pq) : "memory"); } }
            const char* a1 = cA + (size_t)(t + 1) * kstep;
            const char* a2 = last ? nA : cA + (size_t)(t + 2) * kstep; const char* b2 = last ? nB : cB + (size_t)(t + 2) * kstep;
            const char* a3 = a2 + kstep; const char* b3 = b2 + kstep;
            PG8_LDB(B0, 0, 0); PG8_LDB(B1, 0, 1); PG8_SCHED; PG8_LDA(At, 0, 0); PG8_STAGE(PG8_SA(1, 1), a1 + hstepA, voffA);
            PG8_WAIT_V(8); PG8_WAIT_L(0); PG8_BAR; PG8_MMA(0, 0, At, B0); PG8_MMA(0, 1, At, B1); PG8_BAR; PG8_SCHED;
            PG8_LDA(At, 0, 1); PG8_STAGE(PG8_SB(0, 0), b2, voffB); PG8_STAGE(PG8_SB(0, 1), b2 + hstepB, voffB); PG8_STAGE(PG8_SA(0, 0), a2, voffA);
            PG8_WAIT_V(8); PG8_WAIT_L(0); PG8_BAR; PG8_MMA(1, 0, At, B0); PG8_MMA(1, 1, At, B1); PG8_BAR; PG8_SCHED;
            PG8_LDB(B0, 1, 0); PG8_LDB(B1, 1, 1); PG8_SCHED; PG8_LDA(At, 1, 0); PG8_STAGE(PG8_SA(0, 1), a2 + hstepA, voffA);
            PG8_WAIT_V(8); PG8_WAIT_L(0); PG8_BAR; PG8_MMA(0, 0, At, B0); PG8_MMA(0, 1, At, B1); PG8_BAR; PG8_SCHED;
            PG8_LDA(At, 1, 1); PG8_STAGE(PG8_SB(1, 0), b3, voffB); PG8_STAGE(PG8_SB(1, 1), b3 + hstepB, voffB); PG8_STAGE(PG8_SA(1, 0), a3, voffA);
            PG8_WAIT_V(8); PG8_WAIT_L(0); PG8_BAR; PG8_MMA(1, 0, At, B0); PG8_MMA(1, 1, At, B1); PG8_BAR; PG8_SCHED;
        }
        if constexpr (ALIGN_EPI) { if (wr == 0) PG8_BAR; }
        if constexpr (PRE) { asm volatile("" : "+v"(pre), "+v"(pre2)); E(acc, cur, wr, wc, fr, fq, eps, tid, pre, pre2); } else E(acc, cur, wr, wc, fr, fq, eps, tid);
        if (!has_next) break;
#pragma unroll
        for (int a = 0; a < 2; ++a)
#pragma unroll
            for (int b = 0; b < 2; ++b)
#pragma unroll
                for (int m = 0; m < 4; ++m)
#pragma unroll
                    for (int n = 0; n < 2; ++n) acc[a][b][m][n] = (AccT){0, 0, 0, 0};
        cur = nxt; cA = nA; cB = nB; ++ui;
        if constexpr (ALIGN_EPI) { if (wr == 1) PG8_BAR; }
    }
    PG8_WAIT_V(0);
    if constexpr (!ALIGN_EPI) { if (wr == 0) PG8_BAR; }
    PG8_BAR;
#undef PG8_SA
#undef PG8_SB
#undef PG8_STAGE
#undef PG8_LDA
#undef PG8_LDB
#undef PG8_MMA
#undef PG8_WAIT_V
#undef PG8_WAIT_L
#undef PG8_BAR
#undef PG8_SCHED
}
}
using pg8::Unit;
typedef const f32x4 (&AccRef)[2][2][4][2];
typedef const i32x4 (&AccRefI)[2][2][4][2];

struct Args { const float* in[23]; float* out; unsigned char* ws; };
static_assert(sizeof(Args) == 25 * 8, "no padding");
typedef const __attribute__((address_space(4))) Args* KArgsP;
__device__ __forceinline__ KArgsP kargs() { KArgsP p = (KArgsP)__builtin_amdgcn_kernarg_segment_ptr(); asm volatile("" : "+s"(p)); return p; }
#define IN_F(i) ((const float*)ka->in[i])
#define WSP(off) (ws + (off))

template <int NR>
__device__ __forceinline__ void quant_rows(const float* eu, const float* ev, unsigned* EU8, unsigned* EV8, float* SU, float* SV, int r0, int lane) {
    f32x4 v[NR][8]; float mx[NR];
#pragma unroll
    for (int a = 0; a < NR; ++a) { const int r = r0 + a; const float* srow = (r >= 16384 ? ev : eu) + (size_t)(r & 16383) * 2048 + 4 * lane; mx[a] = 0.f;
#pragma unroll
        for (int j = 0; j < 8; ++j) v[a][j] = __builtin_nontemporal_load((const f32x4*)(srow + 256 * j)); }
#pragma unroll
    for (int a = 0; a < NR; ++a) {
#pragma unroll
        for (int j = 0; j < 8; ++j) mx[a] = fmaxf(fmaxf(mx[a], fmaxf(fabsf(v[a][j][0]), fabsf(v[a][j][1]))), fmaxf(fabsf(v[a][j][2]), fabsf(v[a][j][3])));
        mx[a] = wave_max(mx[a]); }
#pragma unroll
    for (int a = 0; a < NR; ++a) { const int r = r0 + a, e = r & 16383; const bool isv = r >= 16384;
        const float sc = mx[a] > 0.f ? mx[a] * (1.f / 127.f) : 1.f; const float inv = 1.f / sc;
        unsigned* drow = (isv ? EV8 : EU8) + (size_t)(lane >> 5) * (16384 * 32) + (size_t)e * 32 + (lane & 31);
#pragma unroll
        for (int j = 0; j < 8; ++j) { const int q0 = (int)rintf(v[a][j][0] * inv), q1 = (int)rintf(v[a][j][1] * inv), q2 = (int)rintf(v[a][j][2] * inv), q3 = (int)rintf(v[a][j][3] * inv);
            drow[(size_t)(2 * j) * (16384 * 32)] = (unsigned)(q0 & 0xff) | ((unsigned)(q1 & 0xff) << 8) | ((unsigned)(q2 & 0xff) << 16) | ((unsigned)(q3 & 0xff) << 24); }
        if (lane == 0) (isv ? SV : SU)[e] = sc; }
}

#define ALOAD16(dst, ptr) asm volatile("global_load_dwordx4 %0, %1, off" : "=&v"(dst) : "v"(ptr) : "memory")
#define ALOAD16O(dst, ptr, off) asm volatile("global_load_dwordx4 %0, %1, off offset:%c2" : "=&v"(dst) : "v"(ptr), "i"(off) : "memory")
#define AWAIT8(a, b, c, d, e, f, g, h) asm volatile("s_waitcnt vmcnt(0)" : "+v"(a), "+v"(b), "+v"(c), "+v"(d), "+v"(e), "+v"(f), "+v"(g), "+v"(h) :: "memory")
#define AWAIT16(a, b, c, d, e, f, g, h, i, j, k, l, m, n, o, p) asm volatile("s_waitcnt vmcnt(0)" : "+v"(a), "+v"(b), "+v"(c), "+v"(d), "+v"(e), "+v"(f), "+v"(g), "+v"(h), "+v"(i), "+v"(j), "+v"(k), "+v"(l), "+v"(m), "+v"(n), "+v"(o), "+v"(p) :: "memory")

__device__ __forceinline__ u32x4 pack8(f32x4 a, f32x4 b) { u32x4 w; w.x = cvtpk(a[0], a[1]); w.y = cvtpk(a[2], a[3]); w.z = cvtpk(b[0], b[1]); w.w = cvtpk(b[2], b[3]); return w; }
__device__ __forceinline__ u32x2 pack4(f32x4 a) { u32x2 w; w.x = cvtpk(a[0], a[1]); w.y = cvtpk(a[2], a[3]); return w; }
__device__ __forceinline__ float sq4(f32x4 a) { return (a[0] * a[0] + a[1] * a[1]) + (a[2] * a[2] + a[3] * a[3]); }

struct EpiA {
    static constexpr bool PERM = true;
    bf16_t* ZP; bf16_t* CQ; bf16_t* CKV; float* ssq_cq; float* ssq_ckv; const float* RSX; const float* SBW;
    __device__ __forceinline__ const unsigned* pre_ptr(const Unit& u, int tid) const { return (const unsigned*)(RSX + u.pm * 256 + (tid & 255)); }
    __device__ __forceinline__ const unsigned* pre_ptr2(const Unit& u, int tid) const { return (const unsigned*)(SBW + u.pn * 256 + (tid & 255)); }
    __device__ __forceinline__ void operator()(AccRefI acc, const Unit& u, int wr, int wc, int fr, int fq, LAS unsigned char* eps, int tid, unsigned pre, unsigned pre2) const {
        LAS float* R = (LAS float*)(eps + 4096); LAS float* CS = (LAS float*)(eps + 5120);
        if (tid < 256) { R[tid] = __builtin_bit_cast(float, pre); CS[tid] = __builtin_bit_cast(float, pre2); }
        EPI_BAR();
        bf16_t* base; int ldc, colt; float* ssq = nullptr;
        if (u.pn < 4) { base = ZP; ldc = 1024; colt = u.pn * 256; }
        else if (u.pn < 6) { base = CQ; ldc = 512; colt = (u.pn - 4) * 256; ssq = ssq_cq + (u.pn - 4) * 4 + wc; }
        else { base = CKV; ldc = 512; colt = (u.pn - 6) * 256; ssq = ssq_ckv + (u.pn - 6) * 4 + wc; }
        const int row0 = u.pm * 256 + wr * 64 + fr, col0 = colt + wc * 32 + 8 * fq;
        f32x4 cs[2][2];
#pragma unroll
        for (int bj = 0; bj < 2; ++bj)
#pragma unroll
            for (int n = 0; n < 2; ++n) cs[bj][n] = *(const LAS f32x4*)(CS + bj * 128 + wc * 32 + 8 * fq + 4 * n);
#pragma unroll
        for (int ai = 0; ai < 2; ++ai)
#pragma unroll
            for (int m = 0; m < 4; ++m) { const int row = row0 + ai * 128 + m * 16; bf16_t* rowp = base + (size_t)row * ldc + col0; float s = 0.f; const float rs = R[ai * 128 + wr * 64 + m * 16 + fr];
#pragma unroll
                for (int bj = 0; bj < 2; ++bj) { const f32x4 v0 = __builtin_convertvector(acc[ai][bj][m][0], f32x4) * cs[bj][0] * rs, v1 = __builtin_convertvector(acc[ai][bj][m][1], f32x4) * cs[bj][1] * rs;
                    *(u32x4*)(rowp + bj * 128) = pack8(v0, v1); s += sq4(v0) + sq4(v1); }
                if (ssq) { s += __shfl_xor(s, 16); s += __shfl_xor(s, 32); if (fq == 0) ssq[(size_t)row * 8] = s; } }
        EPI_BAR();
    }
};
struct EpiKR {
    static constexpr bool PERM = false;
    float* KRP; const float* RSX; const float* SBW;
    __device__ __forceinline__ const unsigned* pre_ptr(const Unit& u, int tid) const { return (const unsigned*)(RSX + u.pm * 256 + (tid & 255)); }
    __device__ __forceinline__ const unsigned* pre_ptr2(const Unit& u, int tid) const { return (const unsigned*)(SBW + u.pn * 256 + (tid & 255)); }
    __device__ __forceinline__ void operator()(AccRefI acc, const Unit& u, int wr, int wc, int fr, int fq, LAS unsigned char* eps, int tid, unsigned pre, unsigned pre2) const {
        LAS float* R = (LAS float*)(eps + 4096); LAS float* CS = (LAS float*)(eps + 5120);
        if (tid < 256) { R[tid] = __builtin_bit_cast(float, pre); CS[tid] = __builtin_bit_cast(float, pre2); }
        EPI_BAR();
        if (wc < 2) { const int ks = u.ka >> 9; const int row0 = u.pm * 256 + wr * 64 + fr;
#pragma unroll
            for (int ai = 0; ai < 2; ++ai)
#pragma unroll
                for (int m = 0; m < 4; ++m) { const int row = row0 + ai * 128 + m * 16; const float rs = R[ai * 128 + wr * 64 + m * 16 + fr];
#pragma unroll
                    for (int n = 0; n < 2; ++n) *(f32x4*)(KRP + ((size_t)ks * M + row) * 64 + 32 * wc + 16 * n + 4 * fq) = __builtin_convertvector(acc[ai][0][m][n], f32x4) * *(const LAS f32x4*)(CS + 32 * wc + 16 * n + 4 * fq) * rs; } }
        { const int uid = u.pm * 4 + (u.ka >> 9); KArgsP ka = kargs(); unsigned char* ws = ka->ws; const float* p_in = IN_F(1); const float* sk1 = IN_F(16); const float* sk2 = IN_F(17);
          bf16_t* PB = (bf16_t*)WSP(WS_PB); bf16_t* SKB = (bf16_t*)WSP(WS_SK);
          for (int i = tid; i < 2176; i += 512) { long j = (long)uid * 2176 + i; const float* src; bf16_t* dst;
              if (j < 524288) { src = p_in; dst = PB; } else if ((j -= 524288) < 16384) { src = sk1; dst = SKB; } else { j -= 16384; src = sk2; dst = SKB + 131072; }
              const f32x4 a = *(const f32x4*)(src + j * 8), b = *(const f32x4*)(src + j * 8 + 4); *(u32x4*)(dst + j * 8) = pack8(a, b); } }
        EPI_BAR();
    }
};
struct EpiStore {
    static constexpr bool PERM = true;
    bf16_t* O; int ldc;
    __device__ __forceinline__ void operator()(AccRef acc, const Unit& u, int wr, int wc, int fr, int fq, LAS unsigned char*, int) const {
        const int row0 = u.pm * 256 + wr * 64 + fr, col0 = u.pn * 256 + wc * 32 + 8 * fq;
#pragma unroll
        for (int ai = 0; ai < 2; ++ai)
#pragma unroll
            for (int m = 0; m < 4; ++m) { bf16_t* rowp = O + (size_t)(row0 + ai * 128 + m * 16) * ldc + col0;
#pragma unroll
                for (int bj = 0; bj < 2; ++bj) *(u32x4*)(rowp + bj * 128) = pack8(acc[ai][bj][m][0], acc[ai][bj][m][1]); }
    }
};
struct EpiQ {
    static constexpr bool PERM = false;
    bf16_t* Q; const float* ssq_cq; const float* qg; const float* COS; const float* SIN;
    __device__ __forceinline__ void operator()(AccRef acc, const Unit& u, int wr, int wc, int fr, int fq, LAS unsigned char* eps, int tid) const {
        LAS float* P = (LAS float*)eps; LAS float* R = (LAS float*)(eps + 4096);
        const int h = u.pn, rowt = u.pm * 256;
        { const f32x4 a = *(const f32x4*)(ssq_cq + (size_t)(rowt + (tid >> 1)) * 8 + 4 * (tid & 1)); float s = (a[0] + a[1]) + (a[2] + a[3]); s += DPP_F(s, 0xB1);
          if ((tid & 1) == 0) R[tid >> 1] = rsqrtf(s * (1.f / 512.f) + EPS); }
#pragma unroll
        for (int ai = 0; ai < 2; ++ai)
#pragma unroll
            for (int m = 0; m < 4; ++m) { const int r = ai * 128 + wr * 64 + m * 16 + fr; float s = 0.f;
#pragma unroll
                for (int bj = 0; bj < 2; ++bj)
#pragma unroll
                    for (int n = 0; n < 2; ++n) s += sq4(acc[ai][bj][m][n]);
                s += __shfl_xor(s, 16); s += __shfl_xor(s, 32); if (fq == 0) P[r * 4 + wc] = s; }
        EPI_BAR();
        const int dn = 32 * wc + 4 * fq, j = 16 * wc + 4 * fq;
        const f32x4 g0 = *(const f32x4*)(qg + dn), g1 = *(const f32x4*)(qg + dn + 16);
        f32x4 gr1 = {0.f, 0.f, 0.f, 0.f}, gr2 = gr1; if (wc < 2) { gr1 = *(const f32x4*)(qg + 128 + j); gr2 = *(const f32x4*)(qg + 160 + j); }
#pragma unroll
        for (int ai = 0; ai < 2; ++ai)
#pragma unroll
            for (int m = 0; m < 4; ++m) { const int r = ai * 128 + wr * 64 + m * 16 + fr; const float rc = R[r]; const f32x4 pp = *(LAS f32x4*)(P + r * 4);
                const float ss = ((pp[0] + pp[1]) + (pp[2] + pp[3])) * rc * rc; const float sc = rc * rsqrtf(ss * (1.f / 192.f) + EPS);
                const size_t grow = (size_t)(rowt + r); bf16_t* qrow = Q + grow * 1536 + h * 192;
                *(u32x2*)(qrow + dn) = pack4(acc[ai][0][m][0] * sc * g0); *(u32x2*)(qrow + dn + 16) = pack4(acc[ai][0][m][1] * sc * g1);
                if (wc < 2) { const f32x4 x1 = acc[ai][1][m][0] * sc * gr1, x2 = acc[ai][1][m][1] * sc * gr2;
                    const f32x4 c4 = *(const f32x4*)(COS + grow * 32 + j), s4 = *(const f32x4*)(SIN + grow * 32 + j);
                    *(u32x2*)(qrow + 128 + j) = pack4(x1 * c4 - x2 * s4); *(u32x2*)(qrow + 160 + j) = pack4(x2 * c4 + x1 * s4); } }
    }
};
struct EpiKV {
    static constexpr bool PERM = false;
    bf16_t* K; bf16_t* V; const float* ssq_ckv; const float* KRP; const float* kg; const float* COS; const float* SIN;
    __device__ __forceinline__ void operator()(AccRef acc, const Unit& u, int wr, int wc, int fr, int fq, LAS unsigned char* eps, int tid) const {
        LAS float* P = (LAS float*)eps; LAS float* R = (LAS float*)(eps + 4096); LAS float* R2 = (LAS float*)(eps + 5120);
        const int h = u.pn, rowt = u.pm * 256;
        { const f32x4 a = *(const f32x4*)(ssq_ckv + (size_t)(rowt + (tid >> 1)) * 8 + 4 * (tid & 1)); float s = (a[0] + a[1]) + (a[2] + a[3]); s += DPP_F(s, 0xB1);
          if ((tid & 1) == 0) R[tid >> 1] = rsqrtf(s * (1.f / 512.f) + EPS); }
        int tq = tid; asm volatile("" : "+v"(tq));
        const int rc = tq & 15, rb = tq >> 4;
#pragma unroll
        for (int kb = 0; kb < 8; kb += 4) { f32x4 pv[4][4];
#pragma unroll
            for (int k = 0; k < 4; ++k) { const float* p = KRP + (size_t)(rowt + rb + 32 * (kb + k)) * 64 + 4 * rc;
#pragma unroll
                for (int q = 0; q < 4; ++q) { const float* pq = p + (size_t)q * M * 64; ALOAD16(pv[k][q], pq); } }
            AWAIT16(pv[0][0], pv[0][1], pv[0][2], pv[0][3], pv[1][0], pv[1][1], pv[1][2], pv[1][3], pv[2][0], pv[2][1], pv[2][2], pv[2][3], pv[3][0], pv[3][1], pv[3][2], pv[3][3]);
#pragma unroll
            for (int k = 0; k < 4; ++k) { const f32x4 t = (pv[k][0] + pv[k][1]) + (pv[k][2] + pv[k][3]); float s = sq4(t);
                s += DPP_F(s, 0xB1); s += DPP_F(s, 0x4E); s += DPP_F(s, 0x141); s += DPP_F(s, 0x128);
                if (rc == 0) R2[rb + 32 * (kb + k)] = s; } }
#pragma unroll
        for (int ai = 0; ai < 2; ++ai)
#pragma unroll
            for (int m = 0; m < 4; ++m) { const int r = ai * 128 + wr * 64 + m * 16 + fr; float s = sq4(acc[ai][0][m][0]) + sq4(acc[ai][0][m][1]);
                s += __shfl_xor(s, 16); s += __shfl_xor(s, 32); if (fq == 0) P[r * 4 + wc] = s; }
        EPI_BAR();
        const int dn = 32 * wc + 4 * fq;
        const f32x4 g0 = *(const f32x4*)(kg + dn), g1 = *(const f32x4*)(kg + dn + 16);
#pragma unroll
        for (int ai = 0; ai < 2; ++ai)
#pragma unroll
            for (int m = 0; m < 4; ++m) { const int r = ai * 128 + wr * 64 + m * 16 + fr; const float rc = R[r]; const f32x4 pp = *(LAS f32x4*)(P + r * 4);
                const float ssn = ((pp[0] + pp[1]) + (pp[2] + pp[3])) * rc * rc; const float sk = rc * rsqrtf((ssn + R2[r]) * (1.f / 192.f) + EPS);
                const size_t grow = (size_t)(rowt + r);
                bf16_t* vrow = V + grow * 1024 + h * 128 + dn; *(u32x2*)vrow = pack4(acc[ai][1][m][0] * rc); *(u32x2*)(vrow + 16) = pack4(acc[ai][1][m][1] * rc);
                bf16_t* krow = K + grow * 1536 + h * 192 + dn; *(u32x2*)krow = pack4(acc[ai][0][m][0] * sk * g0); *(u32x2*)(krow + 16) = pack4(acc[ai][0][m][1] * sk * g1); }
        { int tq2 = tid; asm volatile("" : "+v"(tq2) :: "memory");
          const int rc = tq2 & 15, rb = tq2 >> 4; const int jj = 4 * (rc & 7); const bool hi8 = rc >= 8;
          const f32x4 ga = *(const f32x4*)(kg + 128 + jj), gb = *(const f32x4*)(kg + 160 + jj);
#pragma unroll
          for (int k2 = 0; k2 < 8; k2 += 4) { f32x4 pv[4][4], c4[4], s4[4];
#pragma unroll
            for (int kk = 0; kk < 4; ++kk) { const size_t grw = (size_t)(rowt + rb + 32 * (k2 + kk)); const float* p = KRP + grw * 64 + 4 * rc;
#pragma unroll
                for (int q = 0; q < 4; ++q) { const float* pq = p + (size_t)q * M * 64; ALOAD16(pv[kk][q], pq); }
                const float* pc = COS + grw * 32 + jj; const float* ps = SIN + grw * 32 + jj; ALOAD16(c4[kk], pc); ALOAD16(s4[kk], ps); }
            asm volatile("s_waitcnt vmcnt(0)" : "+v"(pv[0][0]), "+v"(pv[0][1]), "+v"(pv[0][2]), "+v"(pv[0][3]), "+v"(c4[0]), "+v"(s4[0]), "+v"(pv[1][0]), "+v"(pv[1][1]), "+v"(pv[1][2]), "+v"(pv[1][3]), "+v"(c4[1]), "+v"(s4[1]),
                         "+v"(pv[2][0]), "+v"(pv[2][1]), "+v"(pv[2][2]), "+v"(pv[2][3]), "+v"(c4[2]), "+v"(s4[2]), "+v"(pv[3][0]), "+v"(pv[3][1]), "+v"(pv[3][2]), "+v"(pv[3][3]), "+v"(c4[3]), "+v"(s4[3]) :: "memory");
#pragma unroll
            for (int kk = 0; kk < 4; ++kk) { const int row = rb + 32 * (k2 + kk); const size_t grw = (size_t)(rowt + row);
            const f32x4 mine = (pv[kk][0] + pv[kk][1]) + (pv[kk][2] + pv[kk][3]); f32x4 oth; oth[0] = DPP_F(mine[0], 0x128); oth[1] = DPP_F(mine[1], 0x128); oth[2] = DPP_F(mine[2], 0x128); oth[3] = DPP_F(mine[3], 0x128);
            const float rc_ = R[row]; const f32x4 pp = *(LAS f32x4*)(P + row * 4); const float ssn = ((pp[0] + pp[1]) + (pp[2] + pp[3])) * rc_ * rc_;
            const float rk = rsqrtf((ssn + R2[row]) * (1.f / 192.f) + EPS);
            const f32x4 x1 = (hi8 ? oth : mine) * ga, x2 = (hi8 ? mine : oth) * gb;
            const f32x4 o = (hi8 ? (x2 * c4[kk] + x1 * s4[kk]) : (x1 * c4[kk] - x2 * s4[kk])) * rk;
            *(u32x2*)(K + grw * 1536 + h * 192 + 128 + 4 * rc) = pack4(o); } } }
    }
};
struct EpiH1 {
    static constexpr bool PERM = true;
    const float* X; bf16_t* H1B; float* SSQ;
    __device__ __forceinline__ void operator()(AccRef acc, const Unit& u, int wr, int wc, int fr, int fq, LAS unsigned char*, int) const {
        const int row0 = u.pm * 256 + wr * 64 + fr, col0 = u.pn * 256 + wc * 32 + 8 * fq;
#pragma unroll
        for (int ai = 0; ai < 2; ++ai) {
            f32x4 xa[4][2], xb[4][2];
#pragma unroll
            for (int m = 0; m < 4; ++m)
#pragma unroll
                for (int bj = 0; bj < 2; ++bj) { const float* p = X + (size_t)(row0 + ai * 128 + m * 16) * DM + col0 + bj * 128; ALOAD16(xa[m][bj], p); ALOAD16O(xb[m][bj], p, 16); }
            AWAIT16(xa[0][0], xa[0][1], xa[1][0], xa[1][1], xa[2][0], xa[2][1], xa[3][0], xa[3][1], xb[0][0], xb[0][1], xb[1][0], xb[1][1], xb[2][0], xb[2][1], xb[3][0], xb[3][1]);
#pragma unroll
            for (int m = 0; m < 4; ++m) { const size_t off = (size_t)(row0 + ai * 128 + m * 16) * DM + col0; float s = 0.f;
#pragma unroll
                for (int bj = 0; bj < 2; ++bj) { const f32x4 h0 = xa[m][bj] + acc[ai][bj][m][0], h1 = xb[m][bj] + acc[ai][bj][m][1];
                    *(u32x4*)(H1B + off + bj * 128) = pack8(h0, h1); s += sq4(h0) + sq4(h1); }
                s += __shfl_xor(s, 16); s += __shfl_xor(s, 32); if (fq == 0) SSQ[(size_t)(row0 + ai * 128 + m * 16) * 32 + u.pn * 4 + wc] = s; }
        }
    }
};
struct EpiQP {
    static constexpr bool PERM = true;
    bf16_t* QP; const float* SSQ; float* RSTD2;
    __device__ __forceinline__ void operator()(AccRef acc, const Unit& u, int wr, int wc, int fr, int fq, LAS unsigned char* eps, int tid) const {
        LAS float* R = (LAS float*)(eps + 4096);
#pragma unroll
        for (int k = 0; k < 4; ++k) { const int row = (tid >> 3) + 64 * k; const f32x4 a = *(const f32x4*)(SSQ + (size_t)(u.pm * 256 + row) * 32 + 4 * (tid & 7));
            const float s = oct_sum((a[0] + a[1]) + (a[2] + a[3])); const float rs = rsqrtf(s * (1.f / 2048.f) + EPS);
            if ((tid & 7) == 0) { R[row] = rs; if (u.pn == 0) RSTD2[u.pm * 256 + row] = rs; } }
        EPI_BAR();
        const int col0 = u.pn * 256 + wc * 32 + 8 * fq;
#pragma unroll
        for (int ai = 0; ai < 2; ++ai)
#pragma unroll
            for (int m = 0; m < 4; ++m) { const int r = ai * 128 + wr * 64 + m * 16 + fr; const float rs = R[r]; bf16_t* rowp = QP + (size_t)(u.pm * 256 + r) * DM + col0;
#pragma unroll
                for (int bj = 0; bj < 2; ++bj) *(u32x4*)(rowp + bj * 128) = pack8(acc[ai][bj][m][0] * rs, acc[ai][bj][m][1] * rs); }
        EPI_BAR();
    }
};
struct EpiGate {
    static constexpr bool PERM = true;
    float* OUT; const bf16_t* PROJ; const float* SSQ2; const bf16_t* H2B;
    __device__ __forceinline__ void operator()(AccRef acc, const Unit& u, int wr, int wc, int fr, int fq, LAS unsigned char* eps, int tid) const {
        LAS float* R = (LAS float*)(eps + 4096);
#pragma unroll
        for (int k = 0; k < 2; ++k) { const int row = (tid >> 2) + 128 * k; const f32x4 a = *(const f32x4*)(SSQ2 + (size_t)(u.pm * 256 + row) * 16 + 4 * (tid & 3));
            const float s = quad_sum((a[0] + a[1]) + (a[2] + a[3])); if ((tid & 3) == 0) R[row] = rsqrtf(s * (1.f / 2048.f) + EPS); }
        EPI_BAR();
        const int row0 = u.pm * 256 + wr * 64 + fr, col0 = u.pn * 256 + wc * 32 + 8 * fq;
#pragma unroll
        for (int ai = 0; ai < 2; ++ai) {
            u32x4 pj[4][2], hv[4][2];
#pragma unroll
            for (int m = 0; m < 4; ++m)
#pragma unroll
                for (int bj = 0; bj < 2; ++bj) { const size_t off = (size_t)(row0 + ai * 128 + m * 16) * DM + col0 + bj * 128; const bf16_t* pp = PROJ + off; const bf16_t* ph = H2B + off; ALOAD16(pj[m][bj], pp); ALOAD16(hv[m][bj], ph); }
            AWAIT16(pj[0][0], pj[0][1], pj[1][0], pj[1][1], pj[2][0], pj[2][1], pj[3][0], pj[3][1], hv[0][0], hv[0][1], hv[1][0], hv[1][1], hv[2][0], hv[2][1], hv[3][0], hv[3][1]);
#pragma unroll
            for (int m = 0; m < 4; ++m) { const int row = row0 + ai * 128 + m * 16; const float rs = R[ai * 128 + wr * 64 + m * 16 + fr]; const size_t off = (size_t)row * DM + col0;
#pragma unroll
                for (int bj = 0; bj < 2; ++bj) { const u32x4 pw = pj[m][bj], hw = hv[m][bj];
                    const f32x4 p0 = {bf_lo(pw.x), bf_hi(pw.x), bf_lo(pw.y), bf_hi(pw.y)}, p1 = {bf_lo(pw.z), bf_hi(pw.z), bf_lo(pw.w), bf_hi(pw.w)};
                    f32x4 g0, g1;
#pragma unroll
                    for (int e = 0; e < 4; ++e) { g0[e] = __builtin_amdgcn_rcpf(1.f + __builtin_amdgcn_exp2f(-1.4426950408889634f * rs * acc[ai][bj][m][0][e]));
                                                  g1[e] = __builtin_amdgcn_rcpf(1.f + __builtin_amdgcn_exp2f(-1.4426950408889634f * rs * acc[ai][bj][m][1][e])); }
                    float* o = OUT + off + bj * 128;
                    const f32x4 h0 = {bf_lo(hw.x), bf_hi(hw.x), bf_lo(hw.y), bf_hi(hw.y)}, h1 = {bf_lo(hw.z), bf_hi(hw.z), bf_lo(hw.w), bf_hi(hw.w)};
                    *(f32x4*)o = h0 + g0 * p0; *(f32x4*)(o + 4) = h1 + g1 * p1; } }
        }
        EPI_BAR();
    }
};

typedef GAS unsigned gu32;
#define RLX_AGENT __ATOMIC_RELAXED, __HIP_MEMORY_SCOPE_AGENT
#define XB_TMO      128
#define XB_XCNT(j)  (256  + 64 * (j))
#define XB_XSUB(j)  (1280 + 64 * (j))
#define XB_XGEN(j)  (2304 + 64 * (j))
#define XB_TOP      3328
#define XB_TOPGEN   3392
#define XCD_BAR_WORDS 3456
#define XB_SPIN_CAP (1u << 20)
__device__ __forceinline__ unsigned xb_ld(unsigned* p)              { return __hip_atomic_load(p, __ATOMIC_RELAXED, __HIP_MEMORY_SCOPE_AGENT); }
__device__ __forceinline__ unsigned xb_add(unsigned* p, unsigned v) { return __hip_atomic_fetch_add(p, v, __ATOMIC_RELAXED, __HIP_MEMORY_SCOPE_AGENT); }
__device__ __forceinline__ unsigned xb_xcc_id() { return (unsigned)__builtin_amdgcn_s_getreg((3 << 11) | 20) & 0xFu; }
#define XB_SPIN(cond, bar) do { unsigned _sp = 0; while (cond) { __builtin_amdgcn_s_sleep(1); \
    if ((++_sp & 255u) == 0u) { if (xb_ld(&(bar)[XB_TMO])) break; if (_sp > XB_SPIN_CAP) { atomicAdd(&(bar)[XB_TMO], 1u); break; } } } } while (0)
struct XcdBarrier { unsigned* bar; unsigned x; volatile LAS unsigned* st; int w0; };
__device__ __forceinline__ XcdBarrier xcd_barrier_post(unsigned* bar, volatile LAS unsigned* st, int w0) {
    XcdBarrier b; b.bar = bar; b.x = xb_xcc_id(); b.st = st; b.w0 = w0;
    if (tid_of(w0) == 0) (void)xb_add(&bar[XB_XCNT(b.x)], 1u);
    return b;
}
__device__ __forceinline__ void xcd_barrier_complete(unsigned* bar, unsigned x, unsigned& nloc, unsigned& nx) {
    const unsigned G = gridDim.x * gridDim.y * gridDim.z;
    unsigned sum, cnt, mine, sp = 0u;
    for (;;) {
        sum = 0u; cnt = 0u; mine = 0u;
#pragma unroll
        for (unsigned j = 0; j < 16; ++j) { const unsigned c = xb_ld(&bar[XB_XCNT(j)]); sum += c; cnt += (c > 0u) ? 1u : 0u; mine = (j == x) ? c : mine; }
        if (sum == G) break;
        __builtin_amdgcn_s_sleep(1);
        if ((++sp & 255u) == 0u) { if (xb_ld(&bar[XB_TMO])) break; if (sp > XB_SPIN_CAP) { atomicAdd(&bar[XB_TMO], 1u); break; } }
    }
    nloc = mine > 0u ? mine : 1u; nx = cnt > 0u ? cnt : 1u;
}
__device__ __forceinline__ void xcd_barrier(const XcdBarrier& b) {
    asm volatile("s_waitcnt vmcnt(0)" ::: "memory");
    __syncthreads();
    if (tid_of(b.w0) == 0) {
        unsigned* bar = b.bar;
        __builtin_amdgcn_s_waitcnt(0);
        unsigned nloc = b.st[0], nx = b.st[1];
        if (nloc == 0u) { xcd_barrier_complete(bar, b.x, nloc, nx); b.st[0] = nloc; b.st[1] = nx; }
        const unsigned old = xb_add(&bar[XB_XSUB(b.x)], 1u);
        const unsigned gen = old / nloc;
        if (old + 1u == (gen + 1u) * nloc) {
            __builtin_amdgcn_fence(__ATOMIC_RELEASE, "agent");
            asm volatile("s_waitcnt vmcnt(0)" ::: "memory");
            const unsigned og = xb_add(&bar[XB_TOP], 1u);
            const unsigned tg = og / nx;
            if (og + 1u == (tg + 1u) * nx) xb_add(&bar[XB_TOPGEN], 1u);
            else XB_SPIN(xb_ld(&bar[XB_TOPGEN]) == tg, bar);
            __builtin_amdgcn_fence(__ATOMIC_ACQUIRE, "agent");
            xb_add(&bar[XB_XGEN(b.x)], 1u);
            asm volatile("s_waitcnt vmcnt(0)" ::: "memory");
        } else {
            XB_SPIN(xb_ld(&bar[XB_XGEN(b.x)]) == gen, bar);
            __builtin_amdgcn_fence(__ATOMIC_ACQUIRE, "agent");
            asm volatile("s_waitcnt vmcnt(0)" ::: "memory");
        }
    }
    __syncthreads();
}

__device__ __forceinline__ int uq_row(int n) {
    const int h = n / 192, d = n - h * 192; int slot;
    if (d < 128) slot = d; else { const int j = d - 128; if (j < 32) slot = 128 + 32 * (j >> 4) + (j & 15); else { const int jj = j - 32; slot = 128 + 32 * (jj >> 4) + 16 + (jj & 15); } }
    return h * 256 + slot;
}
template <int MAP>
__device__ __forceinline__ void tr_item(const float* W, int ldw, int col_off, const float* gk, const float* gn, bf16_t* WT, int ldt, int row_off, int nblk, LAS float* scr, int item, int lane) {
    const int kb = item / nblk, nb = item - kb * nblk, k0 = 64 * kb, n0 = 32 * nb;
#pragma unroll
    for (int i = 0; i < 32; ++i) { const int kk = 2 * i + (lane >> 5); float v = W[(size_t)(k0 + kk) * ldw + col_off + n0 + (lane & 31)]; if (gk) v *= gk[k0 + kk]; scr[kk * 33 + (lane & 31)] = v; }
    asm volatile("s_waitcnt lgkmcnt(0)" ::: "memory");
    const int c = lane & 7;
#pragma unroll
    for (int j = 0; j < 4; ++j) { const int n = (lane >> 3) + 8 * j; const LAS float* s = scr + (8 * c) * 33 + n; const float g = gn ? gn[n0 + n] : 1.f;
        u32x4 o; o.x = cvtpk(s[0 * 33] * g, s[1 * 33] * g); o.y = cvtpk(s[2 * 33] * g, s[3 * 33] * g); o.z = cvtpk(s[4 * 33] * g, s[5 * 33] * g); o.w = cvtpk(s[6 * 33] * g, s[7 * 33] * g);
        const int drow = (MAP == 1) ? uq_row(n0 + n) : (row_off + n0 + n);
        *(u32x4*)(WT + (size_t)drow * ldt + k0 + 8 * c) = o; }
    asm volatile("s_waitcnt lgkmcnt(0)" ::: "memory");
}

struct TrP { const float* W; const float* gk; const float* gn; bf16_t* WT; int ldw, ldt, nblk, item, map; };
__device__ __forceinline__ void tr_load(const TrP& p, float (&v)[32], int lane) {
    const int kb = p.item / p.nblk, nb = p.item - kb * p.nblk, k0 = 64 * kb, n0 = 32 * nb;
#pragma unroll
    for (int i = 0; i < 32; ++i) { const int kk = 2 * i + (lane >> 5); v[i] = p.W[(size_t)(k0 + kk) * p.ldw + n0 + (lane & 31)]; }
    if (p.gk) {
#pragma unroll
        for (int i = 0; i < 32; ++i) v[i] *= p.gk[k0 + 2 * i + (lane >> 5)]; }
}
__device__ __forceinline__ void tr_store(const TrP& p, const float (&v)[32], LAS float* scr, int lane) {
    const int kb = p.item / p.nblk, nb = p.item - kb * p.nblk, k0 = 64 * kb, n0 = 32 * nb;
#pragma unroll
    for (int i = 0; i < 32; ++i) scr[(2 * i + (lane >> 5)) * 33 + (lane & 31)] = v[i];
    asm volatile("s_waitcnt lgkmcnt(0)" ::: "memory");
    const int c = lane & 7;
#pragma unroll
    for (int j = 0; j < 4; ++j) { const int n = (lane >> 3) + 8 * j; const LAS float* s = scr + (8 * c) * 33 + n; const float g = p.gn ? p.gn[n0 + n] : 1.f;
        u32x4 o; o.x = cvtpk(s[0 * 33] * g, s[1 * 33] * g); o.y = cvtpk(s[2 * 33] * g, s[3 * 33] * g); o.z = cvtpk(s[4 * 33] * g, s[5 * 33] * g); o.w = cvtpk(s[6 * 33] * g, s[7 * 33] * g);
        const int drow = p.map ? uq_row(n0 + n) : (n0 + n);
        *(u32x4*)(p.WT + (size_t)drow * p.ldt + k0 + 8 * c) = o; }
    asm volatile("s_waitcnt lgkmcnt(0)" ::: "memory");
}

namespace att {
constexpr int DQ = 192, DV = 128, KVBLK = 64, QBLK = 32;
constexpr int LDQ = 1536, LDV = 1024, LDO = 2048;
constexpr int SHM_V = KVBLK * DV * 2, SHM_K = KVBLK * DQ * 2;
constexpr float SCALE = 0.07216878364870322f;
constexpr float THR = 8.f;
#define KSWZ(row, colB) ((row) * 384 + ((colB) ^ ((((row) >> 1) & 7) << 4)))
#define SBAR() __builtin_amdgcn_sched_barrier(0)
__device__ __forceinline__ int crow(int r, int hi) { return (r & 3) + 8 * (r >> 2) + 4 * hi; }
__device__ __forceinline__ void partialSM(f32x16& p0, f32x16& p1, float& m_reg, float& alpha) {
    constexpr float C = SCALE * 1.4426950408889634f;
    float pmax = p0[0];
#pragma unroll
    for (int r = 1; r < 16; ++r) pmax = fmaxf(pmax, p0[r]);
#pragma unroll
    for (int r = 0; r < 16; ++r) pmax = fmaxf(pmax, p1[r]);
    { auto rr = __builtin_amdgcn_permlane32_swap(__float_as_uint(pmax), __float_as_uint(pmax), false, false);
      pmax = fmaxf(__uint_as_float(rr[0]), __uint_as_float(rr[1])); }
    float mn;
    if (__builtin_expect(__all(pmax - m_reg <= THR / SCALE), 1)) { mn = m_reg; alpha = 1.f; }
    else { mn = fmaxf(m_reg, pmax); alpha = __builtin_amdgcn_exp2f((m_reg - mn) * C); m_reg = mn; }
    const float mnC = -mn * C;
#pragma unroll
    for (int r = 0; r < 16; ++r) { p0[r] = __builtin_amdgcn_exp2f(fmaf(p0[r], C, mnC)); p1[r] = __builtin_amdgcn_exp2f(fmaf(p1[r], C, mnC)); }
}
__device__ __forceinline__ void finishSM(const f32x16& p0, const f32x16& p1, float alpha, float& l_reg, bf16x8& pa0, bf16x8& pa1, bf16x8& pa2, bf16x8& pa3) {
    float ps = 0.f;
#pragma unroll
    for (int r = 0; r < 16; ++r) ps += p0[r];
#pragma unroll
    for (int r = 0; r < 16; ++r) ps += p1[r];
    { auto rr = __builtin_amdgcn_permlane32_swap(__float_as_uint(ps), __float_as_uint(ps), false, false);
      ps = __uint_as_float(rr[0]) + __uint_as_float(rr[1]); }
    l_reg = l_reg * alpha + ps;
#define PK4(P, BASE, OUT) do { unsigned a0 = cvtpk(P[BASE + 0], P[BASE + 1]), a1 = cvtpk(P[BASE + 2], P[BASE + 3]);   \
    unsigned b0 = cvtpk(P[BASE + 4], P[BASE + 5]), b1 = cvtpk(P[BASE + 6], P[BASE + 7]);                              \
    auto r0 = __builtin_amdgcn_permlane32_swap(a0, b0, false, false); auto r1 = __builtin_amdgcn_permlane32_swap(a1, b1, false, false); \
    u32x4 w = {r0[0], r1[0], r0[1], r1[1]}; OUT = __builtin_bit_cast(bf16x8, w); } while (0)
    PK4(p0, 0, pa0); PK4(p0, 8, pa1); PK4(p1, 0, pa2); PK4(p1, 8, pa3);
#undef PK4
}
__device__ __forceinline__ void qkt(f32x16& p0, f32x16& p1, const char* Ks, const bf16x8* qr, int r32, int hi) {
    p0 = f32x16{}; p1 = f32x16{};
#pragma unroll
    for (int d0 = 0; d0 < 12; ++d0) { const int cb = (d0 * 16 + hi * 8) * 2;
        const bf16x8 b0 = *reinterpret_cast<const bf16x8*>(Ks + KSWZ(r32, cb));
        const bf16x8 b1 = *reinterpret_cast<const bf16x8*>(Ks + KSWZ(32 + r32, cb));
        p0 = __builtin_amdgcn_mfma_f32_32x32x16_bf16(b0, qr[d0], p0, 0, 0, 0);
        p1 = __builtin_amdgcn_mfma_f32_32x32x16_bf16(b1, qr[d0], p1, 0, 0, 0); }
}
__device__ __forceinline__ int v_st(int k, int c) { const int kk = (k & ~0xC) | ((k & 4) << 1) | ((k & 8) >> 1); return ((kk >> 3) * 4 + (c >> 5)) * 512 + ((kk & 7) * 32 + (c & 31)) * 2; }
__device__ __forceinline__ int v_rd_base(int lane) { return ((lane & 3) << 3) | (((lane >> 2) & 3) << 6) | (((lane >> 4) & 1) << 5) | (((lane >> 5) & 1) << 8); }
constexpr int v_rd_off(int d0, int ks, int half) { return d0 * 512 + ks * 4096 + half * 2048; }
template <int OFF> __device__ __forceinline__ s16x4 tr_read(int vb) {
    s16x4 r; asm volatile("ds_read_b64_tr_b16 %0, %1 offset:%2" : "=&v"(r) : "v"(vb), "i"(OFF) : "memory"); return r;
}
template <int D0> __device__ __forceinline__ void pv_one(f32x16& od, int vb, bf16x8 pa0, bf16x8 pa1, bf16x8 pa2, bf16x8 pa3) {
    const s16x4 l0 = tr_read<v_rd_off(D0, 0, 0)>(vb), h0 = tr_read<v_rd_off(D0, 0, 1)>(vb), l1 = tr_read<v_rd_off(D0, 1, 0)>(vb), h1 = tr_read<v_rd_off(D0, 1, 1)>(vb);
    const s16x4 l2 = tr_read<v_rd_off(D0, 2, 0)>(vb), h2 = tr_read<v_rd_off(D0, 2, 1)>(vb), l3 = tr_read<v_rd_off(D0, 3, 0)>(vb), h3 = tr_read<v_rd_off(D0, 3, 1)>(vb);
    asm volatile("s_waitcnt lgkmcnt(0)" ::: "memory"); SBAR();
#define PK(L, H) (bf16x8){L[0], L[1], L[2], L[3], H[0], H[1], H[2], H[3]}
    od = __builtin_amdgcn_mfma_f32_32x32x16_bf16(pa0, PK(l0, h0), od, 0, 0, 0);
    od = __builtin_amdgcn_mfma_f32_32x32x16_bf16(pa1, PK(l1, h1), od, 0, 0, 0);
    od = __builtin_amdgcn_mfma_f32_32x32x16_bf16(pa2, PK(l2, h2), od, 0, 0, 0);
    od = __builtin_amdgcn_mfma_f32_32x32x16_bf16(pa3, PK(l3, h3), od, 0, 0, 0);
#undef PK
}
__device__ __forceinline__ void attn_unit(int b, int h, int qt, const bf16_t* Q, const bf16_t* K, const bf16_t* V, bf16_t* Y, char* lds, LAS unsigned char* ldsl, int wave0) {
    int tid = tid_of(wave0); asm volatile("" : "+v"(tid)); const int lane = tid & 63, r32 = lane & 31, hi = lane >> 5; const int wid = __builtin_amdgcn_readfirstlane(tid >> 6);
    char* V_lds = lds; char* K_lds = lds + 3 * SHM_V;
    float* ws = (float*)(lds + 3 * SHM_V + 3 * SHM_K) + wid * 64; float* li_l = ws; float* al_l = ws + 32;
    const size_t rowbase = (size_t)b * SEQ;
    const bf16_t* Qw = Q + (rowbase + qt * 256 + wid * QBLK + r32) * LDQ + h * DQ + hi * 8;
    const bf16_t* Kh = K + rowbase * LDQ + h * DQ; const bf16_t* Vh = V + rowbase * LDV + h * DV;
    float m_reg = -1e30f, l_reg = 0.f; f32x16 o[4] = {}; bf16x8 qr[12];
#pragma unroll
    for (int d0 = 0; d0 < 12; ++d0) qr[d0] = *reinterpret_cast<const bf16x8*>(Qw + d0 * 16);
    unsigned koff[3], voff[2];
#pragma unroll
    for (int i = 0; i < 3; ++i) { const int p = (wid * 3 + i) * 64 + lane, row = p / 24, s = p - row * 24; const int sg = (s & ~7) | ((s & 7) ^ ((row >> 1) & 7)); koff[i] = (unsigned)(row * LDQ + sg * 8) * 2u; }
#pragma unroll
    for (int i = 0; i < 2; ++i) { const int p = (wid * 2 + i) * 64 + lane, st = p >> 5, kk = (st >> 2) * 8 + ((p & 31) >> 2), c = (st & 3) * 32 + (p & 3) * 8;
        const int k = (kk & ~0xC) | ((kk & 4) << 1) | ((kk & 8) >> 1); voff[i] = (unsigned)(k * LDV + c) * 2u; }
    const int vb0 = (int)(uintptr_t)V_lds + v_rd_base(lane);
    const int NT = 4 * qt + 4, climit = 4 * qt + (wid >> 1);
#define DMA_TILE(t, sl) do { const char* kg_ = (const char*)Kh + (size_t)(t) * (KVBLK * LDQ * 2); const char* vg_ = (const char*)Vh + (size_t)(t) * (KVBLK * LDV * 2); \
    _Pragma("unroll") for (int i = 0; i < 3; ++i) __builtin_amdgcn_global_load_lds((const unsigned*)(kg_ + koff[i]), (LAS unsigned*)(ldsl + 3 * SHM_V + (sl) * SHM_K + (wid * 3 + i) * 1024), 16, 0, 0); \
    _Pragma("unroll") for (int i = 0; i < 2; ++i) __builtin_amdgcn_global_load_lds((const unsigned*)(vg_ + voff[i]), (LAS unsigned*)(ldsl + (sl) * SHM_V + (wid * 2 + i) * 1024), 16, 0, 0); } while (0)
    f32x16 pA0, pA1, pB0, pB1; float alA = 1.f, alB = 1.f; bf16x8 pa0, pa1, pa2, pa3;
    int sl_k = 0, sl_v = 2, sl_n = 1;
#define RESC(a) do { if (__any((a) < 1.f)) { if (hi == 0) al_l[r32] = (a); asm volatile("s_waitcnt lgkmcnt(0)" ::: "memory"); \
    _Pragma("unroll") for (int d = 0; d < 4; ++d) _Pragma("unroll") for (int r = 0; r < 16; ++r) o[d][r] *= al_l[crow(r, hi)]; } } while (0)
#define ROT() do { const int t_ = sl_v; sl_v = sl_k; sl_k = sl_n; sl_n = t_; } while (0)
#define STEP(j, C0, C1, ALC, P0, P1, ALP) do { \
    if ((j) + 1 < NT) DMA_TILE((j) + 1, sl_n); \
    if ((j) <= climit) { SBAR(); qkt(C0, C1, K_lds + sl_k * SHM_K, qr, r32, hi); } \
    if ((j) >= 1 && (j) - 1 <= climit) { finishSM(P0, P1, ALP, l_reg, pa0, pa1, pa2, pa3); SBAR(); const int vb = vb0 + sl_v * SHM_V; \
        pv_one<0>(o[0], vb, pa0, pa1, pa2, pa3); pv_one<1>(o[1], vb, pa0, pa1, pa2, pa3); pv_one<2>(o[2], vb, pa0, pa1, pa2, pa3); pv_one<3>(o[3], vb, pa0, pa1, pa2, pa3); } \
    if ((j) <= climit) { partialSM(C0, C1, m_reg, ALC); RESC(ALC); } \
    asm volatile("s_waitcnt vmcnt(0)" ::: "memory"); __syncthreads(); ROT(); } while (0)
    DMA_TILE(0, 0); asm volatile("s_waitcnt vmcnt(0)" ::: "memory"); __syncthreads();
    for (int j = 0; j < NT; j += 2) {
        STEP(j, pA0, pA1, alA, pB0, pB1, alB);
        STEP(j + 1, pB0, pB1, alB, pA0, pA1, alA);
    }
    if (NT - 1 <= climit) { finishSM(pB0, pB1, alB, l_reg, pa0, pa1, pa2, pa3); SBAR(); const int vb = vb0 + sl_v * SHM_V;
        pv_one<0>(o[0], vb, pa0, pa1, pa2, pa3); pv_one<1>(o[1], vb, pa0, pa1, pa2, pa3); pv_one<2>(o[2], vb, pa0, pa1, pa2, pa3); pv_one<3>(o[3], vb, pa0, pa1, pa2, pa3); }
#undef STEP
#undef ROT
#undef RESC
    if (hi == 0) li_l[r32] = l_reg; asm volatile("s_waitcnt lgkmcnt(0)" ::: "memory");
    bf16_t* Ow = Y + (rowbase + qt * 256 + wid * QBLK) * LDO + 1024 + h * DV;
#pragma unroll
    for (int r = 0; r < 16; ++r) { const int orow = crow(r, hi); const float rl = __builtin_amdgcn_rcpf(li_l[orow]);
#pragma unroll
        for (int d0 = 0; d0 < 4; ++d0) Ow[(size_t)orow * LDO + d0 * 32 + r32] = (bf16_t)(cvtpk(o[d0][r] * rl, 0.f) & 0xffffu); }
    __syncthreads();
#undef DMA_TILE
}
#undef SBAR
}


__device__ __forceinline__ float dot2bf(unsigned a, unsigned b, float c) {
    return __builtin_amdgcn_fdot2_f32_bf16(__builtin_bit_cast(bf16x2_t, a), __builtin_bit_cast(bf16x2_t, b), c, false); }
__device__ __forceinline__ float gelu_tanh(float x) {
    const float y = 0.7978845608028654f * (x + 0.044715f * x * x * x);
    const float t = __builtin_amdgcn_exp2f(2.8853900817779268f * y);
    return 0.5f * x * (2.f - 2.f * __builtin_amdgcn_rcpf(t + 1.f));
}

#ifndef DBG_ONLY
#define DBG_ONLY -1
#endif
#define PH(n) (DBG_ONLY < 0 || DBG_ONLY == (n))
#ifndef DBG_STOP
#define DBG_STOP 99

#endif

__global__ void __launch_bounds__(NWAVES * 64, 2) fwd_kernel(Args args) {
    extern __shared__ __attribute__((aligned(16))) unsigned char lds_raw[];
    LAS unsigned char* lds = (LAS unsigned char*)lds_raw;
    LAS unsigned char* eps = lds + EPI_OFF;
    volatile LAS unsigned* MISC = (volatile LAS unsigned*)(lds + MISC_OFF);
    const int wave0 = __builtin_amdgcn_readfirstlane((int)threadIdx.x >> 6);
    const int G = gridDim.x, bx = blockIdx.x, vcu = (G % 8 == 0) ? (bx % 8) * (G / 8) + bx / 8 : bx;
    const int NGW = G * NWAVES; const long NGT = (long)G * 512;
#define PHASE_IDS() int tid = tid_of(wave0); asm volatile("" : "+v"(tid)); const int lane = tid & 63, wave = __builtin_amdgcn_readfirstlane(tid >> 6); const int gw = vcu * NWAVES + wave; const long gt = (long)vcu * 512 + tid; (void)lane; (void)gw; (void)gt
    for (int u = threadIdx.x; u < (LDS_BYTES - LDSCTL_OFF) / 4; u += NWAVES * 64) ((LAS unsigned*)(lds + LDSCTL_OFF))[u] = 0u;
    __syncthreads();
#ifdef TIMING
    unsigned long long ts_prev = __builtin_amdgcn_s_memrealtime(); float ts_val = 0.f; int ts_idx = 0;
#define STAMP() do { const unsigned long long now_ = __builtin_amdgcn_s_memrealtime(); if (ts_idx == TIMING) ts_val = (float)(now_ - ts_prev) * 0.0001f; ts_prev = now_; ++ts_idx; } while (0)
#else
#define STAMP() do {} while (0)
#endif
    XcdBarrier bar;
    { KArgsP ka = kargs(); unsigned char* ws = ka->ws; bar = xcd_barrier_post((unsigned*)(ws + WS_CTL) + 4096, MISC + 8, wave0); }

    if (PH(0)) {
        KArgsP ka = kargs(); unsigned char* ws = ka->ws;
        const float* x = IN_F(0); const float* p_in = IN_F(1); const int* positions = (const int*)ka->in[2];
        const float* mix_gain = IN_F(3); const float* w_in = IN_F(4); const float* w_pool = IN_F(5); const float* pool_scale = IN_F(6);
        const float* q_lat_gain = IN_F(7); const float* kv_lat_gain = IN_F(8); const float* w_uq = IN_F(9); const float* w_ukv = IN_F(10);
        const float* w_out = IN_F(13); const float* w_pq = IN_F(15); const float* sub_k1 = IN_F(16); const float* sub_k2 = IN_F(17);
        const float* expert_u = IN_F(18); const float* expert_v = IN_F(19); const float* ple_gain = IN_F(20); const float* w_ple_gate = IN_F(21); const float* w_ple_proj = IN_F(22);
        bf16_t* WIN = (bf16_t*)WSP(WS_WIN); bf16_t* WPOOL = (bf16_t*)WSP(WS_WPOOL); bf16_t* SKB = (bf16_t*)WSP(WS_SK); bf16_t* WUQ = (bf16_t*)WSP(WS_WUQ); bf16_t* WUKV = (bf16_t*)WSP(WS_WUKV);
        bf16_t* WOUT = (bf16_t*)WSP(WS_WOUT); bf16_t* WPQ = (bf16_t*)WSP(WS_WPQ); bf16_t* WG = (bf16_t*)WSP(WS_WG); bf16_t* WP = (bf16_t*)WSP(WS_WP); bf16_t* PB = (bf16_t*)WSP(WS_PB);
        float* COS = (float*)WSP(WS_COS); float* SIN = (float*)WSP(WS_SIN); unsigned* EU8 = (unsigned*)WSP(WS_EU); unsigned* EV8 = (unsigned*)WSP(WS_EV); float* SU = (float*)WSP(WS_SU); float* SV = (float*)WSP(WS_SV); float* RSTDX = (float*)WSP(WS_RSTDX); unsigned* XQ = (unsigned*)WSP(WS_XQ);
        PHASE_IDS();
        LAS float* scr = (LAS float*)(lds + wave * 16384);
        (void)p_in; (void)sub_k1; (void)sub_k2; (void)expert_u; (void)expert_v; (void)SKB; (void)PB; (void)EU8; (void)EV8; (void)SU; (void)SV;
        if (bx < 66) {
            unsigned char* WINQ = (unsigned char*)WIN; float* SBW = (float*)WSP(WS_SBW);
            const int n0 = 32 * bx, c4 = lane & 7, kr = lane >> 3;
            const float* wp = w_in + (size_t)(256 * wave + 4 * kr) * 2112 + n0 + 4 * c4; const float* gp = mix_gain + 256 * wave + 4 * kr;
            f32x4 mx = {0.f, 0.f, 0.f, 0.f};
#pragma unroll 2
            for (int i = 0; i < 8; ++i) { f32x4 v[4]; const f32x4 gk = *(const f32x4*)(gp + 32 * i);
#pragma unroll
                for (int j = 0; j < 4; ++j) v[j] = *(const f32x4*)(wp + (size_t)(32 * i + j) * 2112);
#pragma unroll
                for (int j = 0; j < 4; ++j)
#pragma unroll
                    for (int e = 0; e < 4; ++e) mx[e] = fmaxf(mx[e], fabsf(v[j][e] * gk[j])); }
#pragma unroll
            for (int e = 0; e < 4; ++e) { mx[e] = fmaxf(mx[e], __shfl_xor(mx[e], 8)); mx[e] = fmaxf(mx[e], __shfl_xor(mx[e], 16)); mx[e] = fmaxf(mx[e], __shfl_xor(mx[e], 32)); }
            LAS float* cm = (LAS float*)(lds + EPI_OFF);
            if (kr == 0) *(LAS f32x4*)(cm + wave * 32 + 4 * c4) = mx;
            __syncthreads();
            f32x4 cmax = *(const LAS f32x4*)(cm + 4 * c4);
#pragma unroll
            for (int w = 1; w < 8; ++w) { const f32x4 o = *(const LAS f32x4*)(cm + w * 32 + 4 * c4);
#pragma unroll
                for (int e = 0; e < 4; ++e) cmax[e] = fmaxf(cmax[e], o[e]); }
            f32x4 sc, inv;
#pragma unroll
            for (int e = 0; e < 4; ++e) { sc[e] = cmax[e] > 0.f ? cmax[e] * (1.f / 127.f) : 1.f; inv[e] = 1.f / sc[e]; }
            if (wave == 0 && kr == 0) *(f32x4*)(SBW + n0 + 4 * c4) = sc;
            LAS unsigned char* tb = lds + wave * 16384;
#pragma unroll 2
            for (int i = 0; i < 8; ++i) { f32x4 v[4]; const f32x4 gk = *(const f32x4*)(gp + 32 * i);
#pragma unroll
                for (int j = 0; j < 4; ++j) v[j] = *(const f32x4*)(wp + (size_t)(32 * i + j) * 2112);
#pragma unroll
                for (int e = 0; e < 4; ++e) { unsigned wd = 0;
#pragma unroll
                    for (int j = 0; j < 4; ++j) wd |= ((unsigned)((int)rintf(v[j][e] * gk[j] * inv[e]) & 0xff)) << (8 * j);
                    *(LAS unsigned*)(tb + (4 * c4 + e) * 272 + 32 * i + 4 * kr) = wd; } }
            asm volatile("s_waitcnt lgkmcnt(0)" ::: "memory");
#pragma unroll
            for (int r = 0; r < 8; ++r) { const int id = lane + 64 * r, n = id >> 4, ch = id & 15;
                *(u32x4*)(WINQ + (size_t)(n0 + n) * 2048 + 256 * wave + 16 * ch) = *(const LAS u32x4*)(tb + n * 272 + 16 * ch); }
            asm volatile("s_waitcnt lgkmcnt(0)" ::: "memory");
        }
        (void)w_pool; (void)pool_scale; (void)q_lat_gain; (void)kv_lat_gain; (void)w_uq; (void)w_ukv; (void)w_out; (void)w_pq; (void)ple_gain; (void)w_ple_gate; (void)w_ple_proj;
        (void)WPOOL; (void)WUKV; (void)WOUT; (void)WPQ; (void)WG; (void)WP;
        for (long i = gt; i < 24576 + 32768; i += NGT) {
            const u32x4 z = {0u, 0u, 0u, 0u};
            if (i < 24576) { *(u32x4*)((unsigned char*)WIN + (size_t)2112 * 2048 + i * 16) = z; if (i < 192) ((float*)WSP(WS_SBW))[2112 + i] = 1.f; }
            else { const long j = i - 24576; const int hh = (int)(j >> 12), rem = (int)(j & 4095); *(u32x4*)(WUQ + ((size_t)hh * 256 + 192) * 512 + (size_t)rem * 8) = z; }
        }
        for (int m = 2 * gw; m < M; m += 2 * NGW) {
            f32x4 v[2][8]; float s[2] = {0.f, 0.f}; float mxr[2] = {0.f, 0.f};
#pragma unroll
            for (int a = 0; a < 2; ++a) { const f32x4* xr = (const f32x4*)(x + (size_t)(m + a) * DM) + lane;
#pragma unroll
                for (int j = 0; j < 8; ++j) v[a][j] = __builtin_nontemporal_load(xr + 64 * j); }
#pragma unroll
            for (int a = 0; a < 2; ++a) {
#pragma unroll
                for (int j = 0; j < 8; ++j) { s[a] += sq4(v[a][j]); mxr[a] = fmaxf(mxr[a], fmaxf(fmaxf(fabsf(v[a][j][0]), fabsf(v[a][j][1])), fmaxf(fabsf(v[a][j][2]), fabsf(v[a][j][3])))); }
                const float rs = rsqrtf(wave_sum(s[a]) * (1.f / DM) + EPS);
                const float am = wave_max(mxr[a]), sx = am > 0.f ? am * (1.f / 127.f) : 1.f, ix = 1.f / sx;
                unsigned* q8 = XQ + (size_t)(m + a) * 512 + lane;
#pragma unroll
                for (int j = 0; j < 8; ++j) { const f32x4 t = v[a][j] * ix;
                    q8[64 * j] = ((unsigned)((int)rintf(t[0]) & 0xff)) | (((unsigned)((int)rintf(t[1]) & 0xff)) << 8) | (((unsigned)((int)rintf(t[2]) & 0xff)) << 16) | (((unsigned)((int)rintf(t[3]) & 0xff)) << 24); }
                if (lane == 0) RSTDX[m + a] = rs * sx; }
        }
        for (long i = gt; i < (long)M * 32; i += NGT) {
            const int row = (int)(i >> 5), j = (int)(i & 31);
            const float inv = __builtin_amdgcn_exp2f(-(float)j * (13.287712379549449f / 32.f));
            const float ang = (float)positions[row] * inv;
            const float kq = rintf(ang * 0.15915494309189535f);
            float r = fmaf(-kq, 6.2831854820251465f, ang); r = fmaf(-kq, -1.7484555e-7f, r);
            const float rev = r * 0.15915494309189535f;
            COS[i] = __builtin_amdgcn_cosf(rev); SIN[i] = __builtin_amdgcn_sinf(rev);
        }
    }
    xcd_barrier(bar); STAMP();
    if (DBG_STOP == 0) return;

    if (PH(1)) {
        KArgsP ka = kargs(); unsigned char* ws = ka->ws;
        bf16_t* XN = (bf16_t*)WSP(WS_XQ); const float* RSTDX = (const float*)WSP(WS_RSTDX); const float* SBW = (const float*)WSP(WS_SBW); bf16_t* WIN = (bf16_t*)WSP(WS_WIN); bf16_t* ZP = (bf16_t*)WSP(WS_ZP); bf16_t* CQ = (bf16_t*)WSP(WS_CQ); bf16_t* CKV = (bf16_t*)WSP(WS_CKV);
        float* SSQ_CQ = (float*)WSP(WS_SSQ_CQ); float* SSQ_CKV = (float*)WSP(WS_SSQ_CKV); float* KRP = (float*)WSP(WS_KRP);
#define PHASE_A_SIDE() do { KArgsP kb = kargs(); unsigned char* ws = kb->ws; PHASE_IDS(); LAS float* scr = (LAS float*)(lds + wave * 16384); \
        { const float* eu = (const float*)kb->in[18]; const float* ev = (const float*)kb->in[19]; unsigned* EU8 = (unsigned*)WSP(WS_EU); unsigned* EV8 = (unsigned*)WSP(WS_EV); float* SU = (float*)WSP(WS_SU); float* SV = (float*)WSP(WS_SV); \
          for (int r = gw * 16; r < gw * 16 + 16; r += 4) quant_rows<4>(eu, ev, EU8, EV8, SU, SV, r, lane); } \
        { const float* w_pool = (const float*)kb->in[5]; const float* pool_scale = (const float*)kb->in[6]; const float* q_lat_gain = (const float*)kb->in[7]; const float* kv_lat_gain = (const float*)kb->in[8]; \
          const float* w_uq = (const float*)kb->in[9]; const float* w_ukv = (const float*)kb->in[10]; const float* w_out = (const float*)kb->in[13]; const float* w_pq = (const float*)kb->in[15]; const float* ffn_gain = (const float*)kb->in[14]; \
          const float* ple_gain = (const float*)kb->in[20]; const float* w_ple_gate = (const float*)kb->in[21]; const float* w_ple_proj = (const float*)kb->in[22]; \
          bf16_t* WPOOL = (bf16_t*)WSP(WS_WPOOL); bf16_t* WUQ = (bf16_t*)WSP(WS_WUQ); bf16_t* WUKV = (bf16_t*)WSP(WS_WUKV); bf16_t* WOUT = (bf16_t*)WSP(WS_WOUT); bf16_t* WPQ = (bf16_t*)WSP(WS_WPQ); bf16_t* WG = (bf16_t*)WSP(WS_WG); bf16_t* WP = (bf16_t*)WSP(WS_WP); \
          constexpr int I_POOL = 4 * 4 * 8, I_UQ = 8 * 48, I_UKV = 8 * 64, I_SQ = 32 * 64, I_WP = 4 * 64, NITEMS = I_POOL + I_UQ + I_UKV + 3 * I_SQ + I_WP; \
          auto trp = [&](int r) -> TrP { \
            if (r < I_POOL) { const int g_ = r >> 5; return TrP{w_pool + g_ * 65536, nullptr, pool_scale + g_ * 256, WPOOL + g_ * 65536, 256, 256, 8, r & 31, 0}; } r -= I_POOL; \
            if (r < I_UQ) return TrP{w_uq, q_lat_gain, nullptr, WUQ, 1536, 512, 48, r, 1}; r -= I_UQ; \
            if (r < I_UKV) return TrP{w_ukv, kv_lat_gain, nullptr, WUKV, 2048, 512, 64, r, 0}; r -= I_UKV; \
            if (r < I_SQ) return TrP{w_out, nullptr, nullptr, WOUT, 2048, 2048, 64, r, 0}; r -= I_SQ; \
            if (r < I_SQ) return TrP{w_pq, ffn_gain, nullptr, WPQ, 2048, 2048, 64, r, 0}; r -= I_SQ; \
            if (r < I_SQ) return TrP{w_ple_gate, ple_gain, nullptr, WG, 2048, 2048, 64, r, 0}; r -= I_SQ; \
            return TrP{w_ple_proj, nullptr, nullptr, WP, 2048, 256, 64, r, 0}; }; \
          for (int it = gw; it < NITEMS; it += 2 * NGW) { const bool two = it + NGW < NITEMS; const TrP pa = trp(it), pb = trp(two ? it + NGW : it); \
            float va[32], vb[32]; tr_load(pa, va, lane); if (two) tr_load(pb, vb, lane); \
            tr_store(pa, va, scr, lane); if (two) tr_store(pb, vb, scr, lane); } } \
        asm volatile("s_waitcnt vmcnt(0) lgkmcnt(0)" ::: "memory"); __syncthreads(); } while (0)
        if (vcu & 1) PHASE_A_SIDE();
        pg8::Gemm g{XN, WIN, 2048, 2048, 2048}; pg8::StaticOrder S; S.init(M, 2048, G, bx);
        EpiA E{ZP, CQ, CKV, SSQ_CQ, SSQ_CKV, RSTDX, SBW};
        pg8::gemm_phase<EpiA, pg8::StaticOrder, true, true, true>(lds, eps, g, S, E, wave0);
        pg8::Gemm g2{XN, WIN, 2048, 2048, 512}; pg8::QuadOrder<0> S2{vcu};
        EpiKR E2{KRP, RSTDX, SBW};
        pg8::gemm_phase<EpiKR, pg8::QuadOrder<0>, true, true, true>(lds, eps, g2, S2, E2, wave0);
        if (!(vcu & 1)) PHASE_A_SIDE();
#undef PHASE_A_SIDE
    }
    xcd_barrier(bar); STAMP();
    if (DBG_STOP == 1) return;

    if (PH(2)) {
        { KArgsP ka = kargs(); unsigned char* ws = ka->ws;
          bf16_t* ZP = (bf16_t*)WSP(WS_ZP); bf16_t* WPOOL = (bf16_t*)WSP(WS_WPOOL); bf16_t* UB = (bf16_t*)WSP(WS_U);
          pg8::Gemm gp{ZP, WPOOL, 1024, 256, 256}; pg8::QuadOrder<1> Sp{vcu};
          EpiStore Ep{UB, 1024};
          pg8::gemm_phase<EpiStore, pg8::QuadOrder<1>, true>(lds, eps, gp, Sp, Ep, wave0); }
        { KArgsP ka = kargs(); unsigned char* ws = ka->ws; const float* q_norm_gain = IN_F(11);
          bf16_t* CQ = (bf16_t*)WSP(WS_CQ); bf16_t* WUQ = (bf16_t*)WSP(WS_WUQ); bf16_t* QB = (bf16_t*)WSP(WS_Q);
          float* SSQ_CQ = (float*)WSP(WS_SSQ_CQ); float* COS = (float*)WSP(WS_COS); float* SIN = (float*)WSP(WS_SIN);
          pg8::Gemm gq{CQ, WUQ, 512, 512, 512}; pg8::StaticOrder Sq; Sq.init(M, 2048, G, bx);
          EpiQ Eq{QB, SSQ_CQ, q_norm_gain, COS, SIN};
          pg8::gemm_phase<EpiQ, pg8::StaticOrder, true>(lds, eps, gq, Sq, Eq, wave0); }
        { KArgsP ka = kargs(); unsigned char* ws = ka->ws; const float* k_norm_gain = IN_F(12);
          bf16_t* CKV = (bf16_t*)WSP(WS_CKV); bf16_t* WUKV = (bf16_t*)WSP(WS_WUKV); bf16_t* KB = (bf16_t*)WSP(WS_K); bf16_t* VB = (bf16_t*)WSP(WS_V);
          float* SSQ_CKV = (float*)WSP(WS_SSQ_CKV); float* KRP = (float*)WSP(WS_KRP); float* COS = (float*)WSP(WS_COS); float* SIN = (float*)WSP(WS_SIN);
          pg8::Gemm gk{CKV, WUKV, 512, 512, 512}; pg8::StaticOrder Sk; Sk.init(M, 2048, G, bx);
          EpiKV Ek{KB, VB, SSQ_CKV, KRP, k_norm_gain, COS, SIN};
          pg8::gemm_phase<EpiKV, pg8::StaticOrder, true>(lds, eps, gk, Sk, Ek, wave0); }
    }
    xcd_barrier(bar); STAMP();
    if (DBG_STOP == 2) return;

    if (PH(3)) {
        KArgsP ka = kargs(); unsigned char* ws = ka->ws;
        bf16_t* UB = (bf16_t*)WSP(WS_U); bf16_t* YMIX = (bf16_t*)WSP(WS_R1); bf16_t* QB = (bf16_t*)WSP(WS_Q); bf16_t* KB = (bf16_t*)WSP(WS_K); bf16_t* VB = (bf16_t*)WSP(WS_V);
        PHASE_IDS();
        {
            const int g = wave & 3, c0 = (32 * g + (lane & 31)) * 8, row0 = vcu * 64 + 32 * (wave >> 2) + 16 * (lane >> 5);
#define FILT_ACC(OP, V) do { a[0] OP bf_lo((V).x); a[1] OP bf_hi((V).x); a[2] OP bf_lo((V).y); a[3] OP bf_hi((V).y); a[4] OP bf_lo((V).z); a[5] OP bf_hi((V).z); a[6] OP bf_lo((V).w); a[7] OP bf_hi((V).w); } while (0)
#define FILT(W) do { const int tl0 = row0 & (SEQ - 1); const bool hist = tl0 != 0; u32x4 h[(W) + 16]; \
                _Pragma("unroll") for (int j = 0; j < (W) + 16; ++j) { const bool ok = hist || j >= (W); h[j] = *(const u32x4*)(UB + (size_t)(ok ? row0 - (W) + j : row0) * 1024 + c0); if (!ok) h[j] = (u32x4){0u, 0u, 0u, 0u}; } \
                float a[8]; _Pragma("unroll") for (int e = 0; e < 8; ++e) a[e] = 0.f; \
                _Pragma("unroll") for (int j = 0; j < (W); ++j) FILT_ACC(+=, h[j]); \
                _Pragma("unroll") for (int rI = 0; rI < 16; ++rI) { const int row = row0 + rI, tl = tl0 + rI; const int cnt = (tl + 1 < (W)) ? tl + 1 : (W); const u32x4 cur = h[(W) + rI]; \
                    FILT_ACC(+=, cur); FILT_ACC(-=, h[rI]); \
                    const float ic = 1.f / (float)cnt; u32x4 o; \
                    o.x = cvtpk(a[0] * ic - bf_lo(cur.x), a[1] * ic - bf_hi(cur.x)); o.y = cvtpk(a[2] * ic - bf_lo(cur.y), a[3] * ic - bf_hi(cur.y)); \
                    o.z = cvtpk(a[4] * ic - bf_lo(cur.z), a[5] * ic - bf_hi(cur.z)); o.w = cvtpk(a[6] * ic - bf_lo(cur.w), a[7] * ic - bf_hi(cur.w)); \
                    *(u32x4*)(YMIX + (size_t)row * DM + c0) = o; } } while (0)
            if (g == 0) FILT(2); else if (g == 1) FILT(4); else if (g == 2) FILT(8); else FILT(16);
#undef FILT
#undef FILT_ACC
        }
        if (G == 256) {
            const int bh = vcu >> 2, s = vcu & 3;
            att::attn_unit(bh >> 3, bh & 7, s, QB, KB, VB, YMIX, (char*)lds_raw, lds, wave0);
            att::attn_unit(bh >> 3, bh & 7, 7 - s, QB, KB, VB, YMIX, (char*)lds_raw, lds, wave0);
        }
    }
    xcd_barrier(bar); STAMP();
    if (DBG_STOP == 3) return;

    if (PH(4)) {
        KArgsP ka = kargs(); unsigned char* ws = ka->ws; const float* x = IN_F(0); bf16_t* H1B = (bf16_t*)WSP(WS_H2B);
        bf16_t* YMIX = (bf16_t*)WSP(WS_R1); bf16_t* WOUT = (bf16_t*)WSP(WS_WOUT); float* SSQ_H1 = (float*)WSP(WS_SSQ_H1);
        pg8::Gemm g{YMIX, WOUT, 2048, 2048, 2048}; pg8::StaticOrder S; S.init(M, 2048, G, bx);
        EpiH1 E{x, H1B, SSQ_H1};
        pg8::gemm_phase<EpiH1, pg8::StaticOrder, true>(lds, eps, g, S, E, wave0);
    }
    xcd_barrier(bar); STAMP();
    if (DBG_STOP == 4) return;

    if (PH(5)) {
        KArgsP ka = kargs(); unsigned char* ws = ka->ws;
        bf16_t* H1B = (bf16_t*)WSP(WS_H2B); bf16_t* WPQ = (bf16_t*)WSP(WS_WPQ); bf16_t* QP = (bf16_t*)WSP(WS_R1); float* SSQ_H1 = (float*)WSP(WS_SSQ_H1); float* RSTD2 = (float*)WSP(WS_RSTD2);
        pg8::Gemm g{H1B, WPQ, 2048, 2048, 2048}; pg8::PairOrder S{vcu};
        EpiQP E{QP, SSQ_H1, RSTD2};
        pg8::gemm_phase<EpiQP, pg8::PairOrder, true>(lds, eps, g, S, E, wave0);
    }
    asm volatile("s_waitcnt vmcnt(0)" ::: "memory"); __syncthreads();
    if (tid_of(wave0) == 0) { __builtin_amdgcn_fence(__ATOMIC_ACQUIRE, "agent"); asm volatile("s_waitcnt vmcnt(0)" ::: "memory"); }
    __syncthreads(); STAMP();
    if (DBG_STOP == 5) return;

    if (PH(6)) {
        KArgsP ka = kargs(); unsigned char* ws = ka->ws;
        bf16_t* QP = (bf16_t*)WSP(WS_R1); bf16_t* SKB = (bf16_t*)WSP(WS_SK); int* PIDX = (int*)WSP(WS_PIDX); float* PGATE = (float*)WSP(WS_PGATE);
        PHASE_IDS();
        LAS unsigned char* SKL = lds;
        LAS float* SC = (LAS float*)(lds + 65536 + wave * 10816);
        LAS float* TKV = (LAS float*)(lds + 65536 + wave * 10816 + 8256);
        LAS unsigned char* TKI = lds + 65536 + wave * 10816 + 8256 + 2048;
        const int fr = lane & 15, fq = lane >> 4; const int h = vcu & 7;
#pragma unroll
        for (int i = 0; i < 8; ++i) { const int p = tid + 512 * i, side = p >> 11, key = (p >> 4) & 127, c = p & 15;
            const u32x4 v = *(const u32x4*)(SKB + (size_t)side * 131072 + (size_t)h * 16384 + key * 128 + c * 8);
            *(LAS u32x4*)(SKL + side * 32768 + key * 256 + ((c ^ (key & 15)) << 4)) = v; }
        __syncthreads();
        for (int bi = 0; bi < 4; ++bi) {
            const int tb = (vcu >> 3) * 32 + wave * 4 + bi, t0 = tb * 16;
#pragma unroll 1
            for (int side = 0; side < 2; ++side) {
                bf16x8 qf[4];
#pragma unroll
                for (int kk = 0; kk < 4; ++kk) qf[kk] = *(const bf16x8*)(QP + (size_t)(t0 + fr) * DM + h * 256 + side * 128 + kk * 32 + 8 * fq);
                const LAS unsigned char* skl = SKL + side * 32768 + fr * 256;
#pragma unroll
                for (int nt = 0; nt < 8; ++nt) { f32x4 a = {0.f, 0.f, 0.f, 0.f};
#pragma unroll
                    for (int kk = 0; kk < 4; ++kk) { const bf16x8 kf = *(const LAS bf16x8*)(skl + nt * 4096 + (((kk * 4 + fq) ^ fr) << 4));
                        a = __builtin_amdgcn_mfma_f32_16x16x32_bf16(kf, qf[kk], a, 0, 0, 0); }
#pragma unroll
                    for (int i = 0; i < 4; ++i) SC[fr * 129 + nt * 16 + 4 * fq + i] = a[i]; }
                asm volatile("s_waitcnt lgkmcnt(0)" ::: "memory");
                const int tok = lane >> 2, q4 = lane & 3; float v[32];
#pragma unroll
                for (int i = 0; i < 32; ++i) v[i] = __builtin_bit_cast(float, (__builtin_bit_cast(unsigned, SC[tok * 129 + 4 * i + q4]) & ~0x7Fu) | (unsigned)(4 * i + q4));
                bitonic_sort_desc<32>(v); QUAD_MERGE16(v, 0xB1); QUAD_MERGE16(v, 0x4E);
                if (q4 == 0) {
#pragma unroll
                    for (int r = 0; r < 16; ++r) { const int bk = (int)(__builtin_bit_cast(unsigned, v[r]) & 0x7Fu); TKV[(side * 16 + tok) * 16 + r] = SC[tok * 129 + bk]; TKI[(side * 16 + tok) * 16 + r] = (unsigned char)bk; } }
                asm volatile("s_waitcnt lgkmcnt(0)" ::: "memory");
            }
            {
                const int tok = lane >> 2, q4 = lane & 3; float c[32];
                const LAS float* V1 = TKV + tok * 16; const LAS float* V2 = TKV + (16 + tok) * 16;
#define CAND(slot, a, bi) do { const int b_ = q4 + 4 * (bi); const float s_ = V1[a] + V2[b_]; \
    c[slot] = (((a) + 1) * (b_ + 1) <= 16) ? __builtin_bit_cast(float, (__builtin_bit_cast(unsigned, s_) & ~0xFFu) | (unsigned)((a) * 16 + b_)) : -INFINITY; } while (0)
                CAND(0, 0, 0); CAND(1, 0, 1); CAND(2, 0, 2); CAND(3, 0, 3); CAND(4, 1, 0); CAND(5, 1, 1); CAND(6, 2, 0); CAND(7, 2, 1);
                CAND(8, 3, 0); CAND(9, 4, 0); CAND(10, 5, 0); CAND(11, 6, 0); CAND(12, 7, 0); CAND(13, 8, 0); CAND(14, 9, 0); CAND(15, 10, 0);
                CAND(16, 11, 0); CAND(17, 12, 0); CAND(18, 13, 0); CAND(19, 14, 0); CAND(20, 15, 0);
#undef CAND
#pragma unroll
                for (int i = 21; i < 32; ++i) c[i] = -INFINITY;
                bitonic_sort_desc<32>(c); QUAD_MERGE16(c, 0xB1); QUAD_MERGE16(c, 0x4E);
                int co[4];
#pragma unroll
                for (int ri = 0; ri < 4; ++ri) { const float x_ = q4 == 0 ? c[4 * ri] : q4 == 1 ? c[4 * ri + 1] : q4 == 2 ? c[4 * ri + 2] : c[4 * ri + 3]; co[ri] = (int)(__builtin_bit_cast(unsigned, x_) & 0xFFu); }
                float sv[4]; float mx = -INFINITY;
#pragma unroll
                for (int ri = 0; ri < 4; ++ri) { sv[ri] = V1[co[ri] >> 4] + V2[co[ri] & 15]; mx = fmaxf(mx, sv[ri]); }
                mx = quad_max(mx);
                float eo[4]; float esum = 0.f;
#pragma unroll
                for (int ri = 0; ri < 4; ++ri) { eo[ri] = __builtin_amdgcn_exp2f((sv[ri] - mx) * 1.4426950408889634f); esum += eo[ri]; }
                esum = quad_sum(esum);
                const float inv = 1.f / esum;
#pragma unroll
                for (int ri = 0; ri < 4; ++ri) { const int e1 = (int)TKI[tok * 16 + (co[ri] >> 4)], e2 = (int)TKI[(16 + tok) * 16 + (co[ri] & 15)];
                    const size_t oi = (size_t)(t0 + tok) * 128 + h * 16 + 4 * ri + q4;
                    PIDX[oi] = e1 * 128 + e2; PGATE[oi] = eo[ri] * inv; }
            }
            asm volatile("s_waitcnt lgkmcnt(0)" ::: "memory");
        }
    }
    xcd_barrier(bar); STAMP();
    if (DBG_STOP == 6) return;


    if (PH(7)) {
        PHASE_IDS();
        const int xc = bx & 7, wl = (bx >> 3) * NWAVES + wave;
        const int gi = lane >> 3, cj = lane & 7; const unsigned cj16 = 16u * (unsigned)cj;
        const int tpw = M / ((G >> 3) * NWAVES);
        {
            KArgsP ka = kargs(); unsigned char* ws = ka->ws;
            const bf16_t* H1B = (const bf16_t*)WSP(WS_H2B); const unsigned char* TU = WSP(WS_EU); const int* PIDX = (const int*)WSP(WS_PIDX); const float* ffn_gain = IN_F(14);
            LAS unsigned char* xl = lds + wave * 8448; LAS float* xs = (LAS float*)(xl + 8192);
#define F1_LOADIDX(n_, EV) do { const int nn_ = (n_) < tpw ? (n_) : tpw - 1; const size_t t_ = (size_t)(wl * tpw + nn_); \
        _Pragma("unroll") for (int q = 0; q < 4; ++q) EV[q] = *(const u32x4*)(PIDX + t_ * 128 + 16 * gi + 4 * q); } while (0)
#define F1_GATHER(EV, UU) do { _Pragma("unroll") for (int q = 0; q < 4; ++q) { UU[4 * q] = *(const u32x4*)(tus + ((EV[q].x << 7) | cj16)); UU[4 * q + 1] = *(const u32x4*)(tus + ((EV[q].y << 7) | cj16)); \
        UU[4 * q + 2] = *(const u32x4*)(tus + ((EV[q].z << 7) | cj16)); UU[4 * q + 3] = *(const u32x4*)(tus + ((EV[q].w << 7) | cj16)); } } while (0)
#define F1_COMPUTE(n_, UU) do { const u32x4 xq = *(const LAS u32x4*)(xl + (n_) * 128 + cj16); const float sx = xs[(n_)]; f32x4 pr[4]; \
        _Pragma("unroll") for (int g = 0; g < 16; ++g) { int d = __builtin_amdgcn_sdot4((int)UU[g].x, (int)xq.x, 0, false); d = __builtin_amdgcn_sdot4((int)UU[g].y, (int)xq.y, d, false); \
            d = __builtin_amdgcn_sdot4((int)UU[g].z, (int)xq.z, d, false); d = __builtin_amdgcn_sdot4((int)UU[g].w, (int)xq.w, d, false); pr[g >> 2][g & 3] = (float)oct_sum_i(d) * sx; } \
        if (cj == 0) { bf16_t* po = PART + (size_t)(wl * tpw + (n_)) * 128 + 16 * gi; __builtin_nontemporal_store(pack8(pr[0], pr[1]), (u32x4*)po); __builtin_nontemporal_store(pack8(pr[2], pr[3]), (u32x4*)(po + 8)); } } while (0)
#pragma unroll 1
            for (int p = 0; p < 2; ++p) {
                const int s = 2 * xc + p; const unsigned char* tus = TU + (size_t)s * (16384 * 128);
                bf16_t* PART = (bf16_t*)(p == 0 ? WSP(WS_PART0) : WSP(WS_PART1)) + (size_t)xc * M * 128;
                {
                    float gsl[16];
#pragma unroll
                    for (int i = 0; i < 16; ++i) gsl[i] = ffn_gain[128 * s + 16 * cj + i];
#pragma unroll 2
                    for (int o = 0; o < tpw; o += 8) { const size_t t_ = (size_t)(wl * tpw + o + gi);
                        const u32x4 XA = *(const u32x4*)(H1B + t_ * DM + 128 * s + 16 * cj), XB = *(const u32x4*)(H1B + t_ * DM + 128 * s + 16 * cj + 8);
                        const unsigned xw[8] = {XA.x, XA.y, XA.z, XA.w, XB.x, XB.y, XB.z, XB.w}; float xf[16]; float mx = 0.f;
#pragma unroll
                        for (int i = 0; i < 8; ++i) { xf[2 * i] = bf_lo(xw[i]) * gsl[2 * i]; xf[2 * i + 1] = bf_hi(xw[i]) * gsl[2 * i + 1]; mx = fmaxf(mx, fmaxf(fabsf(xf[2 * i]), fabsf(xf[2 * i + 1]))); }
                        mx = oct_max(mx); const float sx = mx > 0.f ? mx * (1.f / 127.f) : 1.f; const float inv = 1.f / sx; u32x4 xq;
#pragma unroll
                        for (int i = 0; i < 4; ++i) { const int q0 = (int)rintf(xf[4 * i] * inv), q1 = (int)rintf(xf[4 * i + 1] * inv), q2 = (int)rintf(xf[4 * i + 2] * inv), q3 = (int)rintf(xf[4 * i + 3] * inv);
                            xq[i] = (unsigned)(q0 & 0xff) | ((unsigned)(q1 & 0xff) << 8) | ((unsigned)(q2 & 0xff) << 16) | ((unsigned)(q3 & 0xff) << 24); }
                        *(LAS u32x4*)(xl + (o + gi) * 128 + 16 * cj) = xq; if (cj == 0) xs[o + gi] = sx; }
                    asm volatile("s_waitcnt lgkmcnt(0)" ::: "memory");
                }
                u32x4 evA[4], evB[4], uuA[16], uuB[16];
                F1_LOADIDX(0, evA); F1_LOADIDX(1, evB); F1_GATHER(evA, uuA);
#pragma unroll 1
                for (int n = 0; n < tpw; n += 2) {
                    F1_GATHER(evB, uuB); F1_LOADIDX(n + 2, evA); F1_COMPUTE(n, uuA);
                    F1_GATHER(evA, uuA); F1_LOADIDX(n + 3, evB); F1_COMPUTE(n + 1, uuB);
                }
                asm volatile("s_waitcnt lgkmcnt(0)" ::: "memory");
            }
#undef F1_LOADIDX
#undef F1_GATHER
#undef F1_COMPUTE
        }
        xcd_barrier(bar);
        {
            KArgsP ka = kargs(); unsigned char* ws = ka->ws;
            const bf16_t* P0 = (const bf16_t*)WSP(WS_PART0); const bf16_t* P1 = (const bf16_t*)WSP(WS_PART1); const int* PIDX = (const int*)WSP(WS_PIDX); const float* PGATE = (const float*)WSP(WS_PGATE);
            const float* SU = (const float*)WSP(WS_SU); const float* SV = (const float*)WSP(WS_SV); const float* RSTD2 = (const float*)WSP(WS_RSTD2); unsigned* AQ = (unsigned*)WSP(WS_AQ); float* AS = (float*)WSP(WS_AS);
            for (int tp = gw; tp < M / 2; tp += NGW) {
                const int t = 2 * tp + (lane >> 5), li = lane & 31; const size_t i = (size_t)t * 128 + 4 * li;
                f32x4 sum = {0.f, 0.f, 0.f, 0.f};
#pragma unroll
                for (int x8 = 0; x8 < 8; ++x8) { const u32x2 a = __builtin_nontemporal_load((const u32x2*)(P0 + (size_t)x8 * M * 128 + i)), b = __builtin_nontemporal_load((const u32x2*)(P1 + (size_t)x8 * M * 128 + i));
                    sum += (f32x4){bf_lo(a.x), bf_hi(a.x), bf_lo(a.y), bf_hi(a.y)} + (f32x4){bf_lo(b.x), bf_hi(b.x), bf_lo(b.y), bf_hi(b.y)}; }
                const u32x4 e4 = *(const u32x4*)(PIDX + i); const f32x4 g4 = *(const f32x4*)(PGATE + i); const float rs = RSTD2[t];
                const unsigned ee[4] = {e4.x, e4.y, e4.z, e4.w}; float a[4]; float mx = 0.f;
#pragma unroll
                for (int c = 0; c < 4; ++c) { a[c] = gelu_tanh(sum[c] * SU[ee[c]] * rs) * g4[c] * SV[ee[c]]; mx = fmaxf(mx, fabsf(a[c])); }
                mx = oct_max(mx); mx = fmaxf(mx, DPP_F(mx, 0x128)); mx = fmaxf(mx, __shfl_xor(mx, 16));
                const float sc = mx > 0.f ? mx * (1.f / 127.f) : 1.f; const float inv = 1.f / sc;
                const int q0 = (int)rintf(a[0] * inv), q1 = (int)rintf(a[1] * inv), q2 = (int)rintf(a[2] * inv), q3 = (int)rintf(a[3] * inv);
                AQ[(size_t)t * 32 + li] = (unsigned)(q0 & 0xff) | ((unsigned)(q1 & 0xff) << 8) | ((unsigned)(q2 & 0xff) << 16) | ((unsigned)(q3 & 0xff) << 24);
                if (li == 0) AS[t] = sc;
            }
        }
        xcd_barrier(bar);
        {
            KArgsP ka = kargs(); unsigned char* ws = ka->ws;
            const unsigned char* TV = WSP(WS_EV); const int* PIDX = (const int*)WSP(WS_PIDX); const unsigned* AQ = (const unsigned*)WSP(WS_AQ); const float* AS = (const float*)WSP(WS_AS);
            bf16_t* H2B = (bf16_t*)WSP(WS_H2B); float* SSQ2 = (float*)WSP(WS_SSQ2);
            const int nit = tpw;
#define F3_LOADIDX(it_, EV, AQV) do { const int ii_ = (it_) < nit ? (it_) : nit - 1; const size_t t_ = (size_t)(wl * tpw + (ii_ >> 3) * 8 + gi); const int kb_ = ii_ & 7; \
        _Pragma("unroll") for (int q = 0; q < 4; ++q) EV[q] = *(const u32x4*)(PIDX + t_ * 128 + 16 * kb_ + 4 * q); \
        AQV = *(const u32x4*)(AQ + t_ * 32 + 4 * kb_); } while (0)
#define F3_GATHER(EV, VV) do { _Pragma("unroll") for (int q = 0; q < 4; ++q) { VV[4 * q] = *(const u32x4*)(tvs + ((EV[q].x << 7) | cj16)); VV[4 * q + 1] = *(const u32x4*)(tvs + ((EV[q].y << 7) | cj16)); \
        VV[4 * q + 2] = *(const u32x4*)(tvs + ((EV[q].z << 7) | cj16)); VV[4 * q + 3] = *(const u32x4*)(tvs + ((EV[q].w << 7) | cj16)); } } while (0)
#define F3_T4(W, Q, R0, R1, R2, R3, AW) do { const unsigned a_ = __builtin_amdgcn_perm(R1, R0, 0x05010400u), b_ = __builtin_amdgcn_perm(R1, R0, 0x07030602u), c_ = __builtin_amdgcn_perm(R3, R2, 0x05010400u), d_ = __builtin_amdgcn_perm(R3, R2, 0x07030602u); \
        acc[4 * (W) + 0] = __builtin_amdgcn_sdot4((int)__builtin_amdgcn_perm(c_, a_, 0x05040100u), (int)(AW), acc[4 * (W) + 0], false); acc[4 * (W) + 1] = __builtin_amdgcn_sdot4((int)__builtin_amdgcn_perm(c_, a_, 0x07060302u), (int)(AW), acc[4 * (W) + 1], false); \
        acc[4 * (W) + 2] = __builtin_amdgcn_sdot4((int)__builtin_amdgcn_perm(d_, b_, 0x05040100u), (int)(AW), acc[4 * (W) + 2], false); acc[4 * (W) + 3] = __builtin_amdgcn_sdot4((int)__builtin_amdgcn_perm(d_, b_, 0x07060302u), (int)(AW), acc[4 * (W) + 3], false); } while (0)
#define F3_Q(Q, VV, AW) do { F3_T4(0, Q, VV[4 * (Q)].x, VV[4 * (Q) + 1].x, VV[4 * (Q) + 2].x, VV[4 * (Q) + 3].x, AW); F3_T4(1, Q, VV[4 * (Q)].y, VV[4 * (Q) + 1].y, VV[4 * (Q) + 2].y, VV[4 * (Q) + 3].y, AW); \
        F3_T4(2, Q, VV[4 * (Q)].z, VV[4 * (Q) + 1].z, VV[4 * (Q) + 2].z, VV[4 * (Q) + 3].z, AW); F3_T4(3, Q, VV[4 * (Q)].w, VV[4 * (Q) + 1].w, VV[4 * (Q) + 2].w, VV[4 * (Q) + 3].w, AW); } while (0)
#define F3_COMPUTE(it_, VV, AQV) do { F3_Q(0, VV, AQV.x); F3_Q(1, VV, AQV.y); F3_Q(2, VV, AQV.z); F3_Q(3, VV, AQV.w); \
        if (((it_) & 7) == 7) { const size_t t_ = (size_t)(wl * tpw + ((it_) >> 3) * 8 + gi); const float as_ = AS[t_]; bf16_t* o = H2B + t_ * DM + 128 * s + 16 * cj; f32x4 hh[4]; float s2 = 0.f; \
            const u32x4 ha_ = *(const u32x4*)o, hb_ = *(const u32x4*)(o + 8); const unsigned hw_[8] = {ha_.x, ha_.y, ha_.z, ha_.w, hb_.x, hb_.y, hb_.z, hb_.w}; \
            _Pragma("unroll") for (int i = 0; i < 4; ++i) { hh[i] = (f32x4){bf_lo(hw_[2 * i]), bf_hi(hw_[2 * i]), bf_lo(hw_[2 * i + 1]), bf_hi(hw_[2 * i + 1])} + (f32x4){(float)acc[4 * i], (float)acc[4 * i + 1], (float)acc[4 * i + 2], (float)acc[4 * i + 3]} * as_; s2 += sq4(hh[i]); } \
            *(u32x4*)o = pack8(hh[0], hh[1]); *(u32x4*)(o + 8) = pack8(hh[2], hh[3]); \
            s2 = oct_sum(s2); if (cj == 0) SSQ2[t_ * 16 + s] = s2; \
            _Pragma("unroll") for (int i = 0; i < 16; ++i) acc[i] = 0; } } while (0)
#pragma unroll 1
            for (int p = 0; p < 2; ++p) {
                const int s = 2 * xc + p; const unsigned char* tvs = TV + (size_t)s * (16384 * 128);
                u32x4 evA[4], evB[4], vvA[16], vvB[16], aqA, aqB, aqC; int acc[16];
#pragma unroll
                for (int i = 0; i < 16; ++i) acc[i] = 0;
                F3_LOADIDX(0, evA, aqA); F3_LOADIDX(1, evB, aqB); F3_GATHER(evA, vvA);
#pragma unroll 1
                for (int it = 0; it < nit; it += 2) {
                    F3_GATHER(evB, vvB); F3_LOADIDX(it + 2, evA, aqC); F3_COMPUTE(it, vvA, aqA); aqA = aqC;
                    F3_GATHER(evA, vvA); F3_LOADIDX(it + 3, evB, aqC); F3_COMPUTE(it + 1, vvB, aqB); aqB = aqC;
                }
            }
#undef F3_LOADIDX
#undef F3_GATHER
#undef F3_T4
#undef F3_Q
#undef F3_COMPUTE
        }
    }
    xcd_barrier(bar); STAMP();
    if (DBG_STOP == 7) return;

    if (PH(8)) {
        KArgsP ka = kargs(); unsigned char* ws = ka->ws; float* OUT = ka->out;
        bf16_t* PB = (bf16_t*)WSP(WS_PB); bf16_t* WP = (bf16_t*)WSP(WS_WP); bf16_t* PROJ = (bf16_t*)WSP(WS_R1); bf16_t* H2B = (bf16_t*)WSP(WS_H2B); bf16_t* WG = (bf16_t*)WSP(WS_WG); float* SSQ2 = (float*)WSP(WS_SSQ2);
        pg8::StaticOrder S; S.init(M, 2048, G, bx);
        pg8::Gemm gp{PB, WP, 256, 256, 256};
        EpiStore Ep{PROJ, 2048};
        pg8::gemm_phase<EpiStore, pg8::StaticOrder, true>(lds, eps, gp, S, Ep, wave0);
        pg8::Gemm gg{H2B, WG, 2048, 2048, 2048};
        EpiGate Eg{OUT, PROJ, SSQ2, H2B};
        pg8::gemm_phase<EpiGate, pg8::StaticOrder, true>(lds, eps, gg, S, Eg, wave0);
    }
#ifdef TIMING
    xcd_barrier(bar); STAMP();
    if (blockIdx.x == 0 && threadIdx.x == 0) { KArgsP ka = kargs(); float* OUT = ka->out; OUT[0] += ts_val; }
#endif
}

extern "C" void kernel_launch(void* const* d_in, const int* in_sizes, int n_in, void* d_out, int out_size, void* d_ws, size_t ws_size, hipStream_t stream) {
    static int ready = 0;
    if (ready == 0) {
        if (n_in != 23 || out_size != M * DM || ws_size < WS_END) { fprintf(stderr, "kernel_launch: unexpected shapes (n_in %d, out %d, ws %zu)\n", n_in, out_size, ws_size); ready = -1; return; }
        if (hipFuncSetAttribute((const void*)fwd_kernel, hipFuncAttributeMaxDynamicSharedMemorySize, LDS_BYTES) != hipSuccess) { fprintf(stderr, "kernel_launch: hipFuncSetAttribute failed\n"); ready = -1; return; }
        ready = 1;
    }
    if (ready < 0) return;
    (void)hipMemsetAsync((char*)d_ws + WS_CTL, 0, CTL_ZERO_BYTES, stream);
    Args a{};
    for (int i = 0; i < 23; ++i) a.in[i] = (const float*)d_in[i];
    a.out = (float*)d_out; a.ws = (unsigned char*)d_ws;
    hipLaunchKernelGGL(fwd_kernel, dim3(256), dim3(NWAVES * 64), LDS_BYTES, stream, a);
}
```

```cpp
#include <hip/hip_runtime.h>
#include <cstdio>
#include <cstdint>
#include <type_traits>

#define LAS __attribute__((address_space(3)))
#define GAS __attribute__((address_space(1)))
typedef unsigned short bf16_t;
typedef short bf16x8 __attribute__((ext_vector_type(8)));
typedef short s16x4 __attribute__((ext_vector_type(4)));
typedef float f32x4 __attribute__((ext_vector_type(4)));
typedef float f32x2 __attribute__((ext_vector_type(2)));
typedef float f32x16 __attribute__((ext_vector_type(16)));
typedef unsigned u32x4 __attribute__((ext_vector_type(4)));
typedef int i32x4 __attribute__((ext_vector_type(4)));
typedef unsigned u32x2 __attribute__((ext_vector_type(2)));
typedef __bf16 bf16x2_t __attribute__((ext_vector_type(2)));

constexpr int M = 16384, DM = 2048, SEQ = 2048, NB = 8, NH = 8;
constexpr float EPS = 1e-6f;
constexpr size_t MiB = 1u << 20;
constexpr size_t WS_CTL = 0, CTL_ZERO_BYTES = 1 * MiB;
constexpr size_t WS_WIN = 1 * MiB;
constexpr size_t WS_WPOOL = 10 * MiB;
constexpr size_t WS_SK = 10 * MiB + 512 * 1024;
constexpr size_t WS_WUQ = 11 * MiB;
constexpr size_t WS_WUKV = 13 * MiB;
constexpr size_t WS_WOUT = 15 * MiB;
constexpr size_t WS_WPQ = 23 * MiB;
constexpr size_t WS_WG = 31 * MiB;
constexpr size_t WS_WP = 39 * MiB;
constexpr size_t WS_PB = 40 * MiB;
constexpr size_t WS_COS = 48 * MiB, WS_SIN = 50 * MiB;
constexpr size_t WS_SSQ_CQ = 52 * MiB, WS_SSQ_CKV = 52 * MiB + 512 * 1024, WS_SSQ_H1 = 53 * MiB, WS_RSTD2 = 55 * MiB, WS_RSTDX = 55 * MiB + 512 * 1024;
constexpr size_t WS_EU = 56 * MiB, WS_EV = 88 * MiB;
constexpr size_t WS_SU = 55 * MiB + 128 * 1024, WS_SV = 55 * MiB + 256 * 1024;
constexpr size_t WS_AQ = 346 * MiB, WS_AS = 349 * MiB;
constexpr size_t WS_SSQ2 = 344 * MiB;
constexpr size_t WS_XQ = 184 * MiB;
constexpr size_t WS_SBW = 55 * MiB + 640 * 1024;
constexpr size_t WS_XB = 120 * MiB;
constexpr size_t WS_PART0 = 184 * MiB, WS_PART1 = 424 * MiB;
constexpr size_t WS_R1 = 184 * MiB;
constexpr size_t WS_ZP = 248 * MiB, WS_U = 280 * MiB, WS_H2B = 248 * MiB;
constexpr size_t WS_CQ = 312 * MiB, WS_CKV = 328 * MiB, WS_KRP = 344 * MiB, WS_PIDX = 312 * MiB, WS_PGATE = 320 * MiB;
constexpr size_t WS_Q = 360 * MiB, WS_K = 408 * MiB, WS_V = 456 * MiB;
constexpr size_t WS_END = 488 * MiB;
constexpr int RING_BYTES = 131072, EPI_OFF = RING_BYTES, EPI_BYTES = 8192, LDS_BYTES = 163840, LDSCTL_OFF = LDS_BYTES - 1024, MISC_OFF = LDSCTL_OFF + 320;
constexpr int NWAVES = 8;

__device__ __forceinline__ unsigned cvtpk(float lo, float hi) { f32x2 v = {lo, hi}; bf16x2_t b = __builtin_convertvector(v, bf16x2_t); return __builtin_bit_cast(unsigned, b); }
__device__ __forceinline__ float bf_lo(unsigned w) { return __builtin_bit_cast(float, w << 16); }
__device__ __forceinline__ float bf_hi(unsigned w) { return __builtin_bit_cast(float, w & 0xffff0000u); }
__device__ __forceinline__ float ub0(unsigned w) { return (float)(w & 0xffu); }
__device__ __forceinline__ float ub1(unsigned w) { float r; asm("v_cvt_f32_ubyte1 %0, %1" : "=v"(r) : "v"(w)); return r; }
__device__ __forceinline__ float ub2(unsigned w) { float r; asm("v_cvt_f32_ubyte2 %0, %1" : "=v"(r) : "v"(w)); return r; }
__device__ __forceinline__ float ub3(unsigned w) { float r; asm("v_cvt_f32_ubyte3 %0, %1" : "=v"(r) : "v"(w)); return r; }
__device__ __forceinline__ float dpp_xor1(float x) { return __builtin_bit_cast(float, __builtin_amdgcn_mov_dpp(__builtin_bit_cast(int, x), 0xB1, 0xF, 0xF, true)); }
__device__ __forceinline__ float dpp_xor2(float x) { return __builtin_bit_cast(float, __builtin_amdgcn_mov_dpp(__builtin_bit_cast(int, x), 0x4E, 0xF, 0xF, true)); }
#define DPP_I(x, ctrl) __builtin_amdgcn_mov_dpp((x), (ctrl), 0xF, 0xF, true)
#define DPP_F(x, ctrl) __builtin_bit_cast(float, __builtin_amdgcn_mov_dpp(__builtin_bit_cast(int, (float)(x)), (ctrl), 0xF, 0xF, true))
__device__ __forceinline__ int oct_sum_i(int v) { v += DPP_I(v, 0xB1); v += DPP_I(v, 0x4E); return v + DPP_I(v, 0x141); }
__device__ __forceinline__ float oct_sum(float v) { v += DPP_F(v, 0xB1); v += DPP_F(v, 0x4E); return v + DPP_F(v, 0x141); }
__device__ __forceinline__ float oct_max(float v) { v = fmaxf(v, DPP_F(v, 0xB1)); v = fmaxf(v, DPP_F(v, 0x4E)); return fmaxf(v, DPP_F(v, 0x141)); }
template <int N> __device__ __forceinline__ void bitonic_sort_desc(float (&v)[N]) {
#pragma unroll
    for (int k = 2; k <= N; k <<= 1)
#pragma unroll
        for (int j = k >> 1; j > 0; j >>= 1)
#pragma unroll
            for (int i = 0; i < N; ++i) { const int l = i ^ j; if (l > i) { const bool desc = (i & k) == 0; const float a = v[i], b = v[l]; const float hi = fmaxf(a, b), lo = fminf(a, b); v[i] = desc ? hi : lo; v[l] = desc ? lo : hi; } }
}
#define QUAD_MERGE16(v, CTRL) do { float p_[16]; _Pragma("unroll") for (int i = 0; i < 16; ++i) p_[i] = DPP_F(v[15 - i], CTRL); \
    _Pragma("unroll") for (int i = 0; i < 16; ++i) v[i] = fmaxf(v[i], p_[i]); \
    _Pragma("unroll") for (int j = 8; j > 0; j >>= 1) _Pragma("unroll") for (int i = 0; i < 16; ++i) { const int l = i ^ j; if (l > i) { const float a = v[i], b = v[l]; v[i] = fmaxf(a, b); v[l] = fminf(a, b); } } } while (0)
template <int N> __device__ __forceinline__ float tree_max(const float* v) {
    if constexpr (N == 1) return v[0]; else return fmaxf(tree_max<N / 2>(v), tree_max<N - N / 2>(v + N / 2));
}
__device__ __forceinline__ float quad_max(float m) { m = fmaxf(m, dpp_xor1(m)); return fmaxf(m, dpp_xor2(m)); }
__device__ __forceinline__ float quad_sum(float m) { m += dpp_xor1(m); return m + dpp_xor2(m); }
__device__ __forceinline__ float wave_max(float v) {
#pragma unroll
    for (int o = 1; o < 64; o <<= 1) v = fmaxf(v, __shfl_xor(v, o));
    return v;
}
__device__ __forceinline__ int wave_sum_i(int v) {
#pragma unroll
    for (int o = 1; o < 64; o <<= 1) v += __shfl_xor(v, o);
    return v;
}
__device__ __forceinline__ float wave_sum(float v) {
#pragma unroll
    for (int o = 1; o < 64; o <<= 1) v += __shfl_xor(v, o);
    return v;
}
__device__ __forceinline__ int tid_of(int wave0) { int l; asm volatile("v_mbcnt_lo_u32_b32 %0, -1, 0\n\tv_mbcnt_hi_u32_b32 %0, -1, %0" : "=v"(l)); return wave0 * 64 + l; }
#define EPI_BAR() do { asm volatile("s_waitcnt lgkmcnt(0)" ::: "memory"); __builtin_amdgcn_s_barrier(); asm volatile("" ::: "memory"); } while (0)

namespace pg8 {
constexpr int BM = 256, BK = 64, HALF = 128, HTB = HALF * BK * 2, STAGE_BYTES = 8 * HTB, NXCD = 8, WGM = 1;
__host__ __device__ __forceinline__ int lds_byte(int r, int c) { const int st = (r >> 4) * 2 + (c >> 5), rr = r & 15, cc = c & 31, ob = rr * 64 + cc * 2; return st * 1024 + (ob ^ (((ob >> 9) & 1) << 5)); }
__host__ __device__ __forceinline__ void stage_rc(int b, int& R, int& C) { const int st = b / 1024, sb = b % 1024, swz = sb ^ (((sb >> 9) & 1) << 5); R = (st >> 1) * 16 + swz / 64; C = (st & 1) * 32 + (swz % 64) / 2; }
__host__ __device__ __forceinline__ int perm32(int rho) { const int n = rho >> 4, i = rho & 15; return 8 * (i >> 2) + 4 * n + (i & 3); }

struct Unit { int pm, pn, ka, kb; };
struct Gemm { const bf16_t* A; const bf16_t* Bt; int lda, ldb, K; };

struct StaticOrder {
    int nM, nN, nwg, G, c;
    __device__ void init(int Mr, int N, int G_, int c_) { nM = Mr / BM; nN = N / BM; nwg = nM * nN; G = G_; c = c_; }
    __device__ bool next(int i, Unit& u) const {
        const long L = (long)i * G + c; if (L >= nwg) return false;
        int wgid = (int)L; { const int q = nwg / NXCD, r = nwg % NXCD, xcd = wgid % NXCD, off = wgid / NXCD; wgid = (xcd < r ? xcd * (q + 1) : r * (q + 1) + (xcd - r) * q) + off; }
        const int nig = WGM * nN, gid = wgid / nig, fm = gid * WGM, gsz = (nM - fm) < WGM ? (nM - fm) : WGM;
        u.pm = fm + ((wgid % nig) % gsz); u.pn = (wgid % nig) / gsz; u.ka = 0; u.kb = 0; return true;
    }
};
template <int MODE> struct QuadOrder {
    int v;
    __device__ bool next(int i, Unit& u) const {
        if (i > 0) return false;
        u.pm = v >> 2; const int j = v & 3;
        if (MODE == 0) { u.pn = 8; u.ka = 512 * j; u.kb = 512 * j; } else { u.pn = j; u.ka = 256 * j; u.kb = 0; }
        return true;
    }
};

struct PairOrder {
    int v;
    __device__ bool next(int i, Unit& u) const { if (i > 1) return false; u.pm = 2 * (v >> 3) + i; u.pn = v & 7; u.ka = 0; u.kb = 0; return true; }
};
template <class Epi, class Sched, bool ALIGN_EPI, bool PRE = false, bool I8 = false>
__device__ __forceinline__ void gemm_phase(LAS unsigned char* lds, LAS unsigned char* eps, const Gemm g, const Sched& S, const Epi& E, int wave0) {
    int tid = tid_of(wave0); asm volatile("" : "+v"(tid));
    const int wid = __builtin_amdgcn_readfirstlane(tid >> 6), lane = tid & 63, wr = wid >> 2, wc = wid & 3, fr = lane & 15, fq = lane >> 4;
    constexpr int ES = I8 ? 1 : 2;
    int nt = g.K * ES / (BK * 2); asm volatile("" : "+s"(nt));
    unsigned voffA[2], voffB[2];
#pragma unroll
    for (int i = 0; i < 2; ++i) { int R, C; stage_rc(tid * 16 + i * 8192, R, C); const int Rb = Epi::PERM ? ((R & ~31) + perm32(R & 31)) : R;
        voffA[i] = (unsigned)(R * g.lda * ES + C * 2); voffB[i] = (unsigned)(Rb * g.ldb * ES + C * 2); }
    const size_t kstep = (size_t)(BK * 2);
    const size_t hstepA = (size_t)HALF * g.lda * ES, hstepB = (size_t)HALF * g.ldb * ES;
    const size_t tstepA = 2 * hstepA, tstepB = 2 * hstepB;
    const unsigned ldsw = (unsigned)wid * 1024u;
    const int aoff = lds_byte(wr * 64 + fr, fq * 8), boff = lds_byte(wc * 32 + fr, fq * 8);
#define PG8_SA(b, h) (((b) * 2 + (h)) * HTB)
#define PG8_SB(b, h) ((4 + (b) * 2 + (h)) * HTB)
#define PG8_STAGE(bufoff, gbase, voff) do { _Pragma("unroll") for (int _i = 0; _i < 2; ++_i) \
        __builtin_amdgcn_global_load_lds((const unsigned*)((const char*)(gbase) + (voff)[_i]), (LAS unsigned*)(lds + (bufoff) + ldsw + _i * 8192), 16, 0, 0); } while (0)
#define PG8_LDA(dst, b, h) do { _Pragma("unroll") for (int m = 0; m < 4; ++m) _Pragma("unroll") for (int k = 0; k < 2; ++k) dst[m][k] = *(const LAS bf16x8*)(lds + PG8_SA(b, h) + aoff + m * 2048 + k * 1024); } while (0)
#define PG8_LDB(dst, b, h) do { _Pragma("unroll") for (int n = 0; n < 2; ++n) _Pragma("unroll") for (int k = 0; k < 2; ++k) dst[n][k] = *(const LAS bf16x8*)(lds + PG8_SB(b, h) + boff + n * 2048 + k * 1024); } while (0)
#define PG8_MMA(ai, bj, At, Bt) do { __builtin_amdgcn_s_setprio(1); _Pragma("unroll") for (int m = 0; m < 4; ++m) _Pragma("unroll") for (int n = 0; n < 2; ++n) _Pragma("unroll") for (int k = 0; k < 2; ++k) \
        { if constexpr (I8) acc[ai][bj][m][n] = __builtin_bit_cast(AccT, __builtin_amdgcn_mfma_i32_16x16x64_i8(__builtin_bit_cast(i32x4, Bt[n][k]), __builtin_bit_cast(i32x4, At[m][k]), __builtin_bit_cast(i32x4, acc[ai][bj][m][n]), 0, 0, 0)); \
          else acc[ai][bj][m][n] = __builtin_bit_cast(AccT, __builtin_amdgcn_mfma_f32_16x16x32_bf16(Bt[n][k], At[m][k], __builtin_bit_cast(f32x4, acc[ai][bj][m][n]), 0, 0, 0)); } __builtin_amdgcn_s_setprio(0); } while (0)
#define PG8_WAIT_V(n) asm volatile("s_waitcnt vmcnt(" #n ")" ::: "memory")
#define PG8_WAIT_L(n) asm volatile("s_waitcnt lgkmcnt(" #n ")" ::: "memory")
#define PG8_BAR __builtin_amdgcn_s_barrier()
#define PG8_SCHED __builtin_amdgcn_sched_barrier(0)
    Unit cur, nxt; int ui = 0;
    if (!S.next(0, cur)) return;
    using AccT = typename std::conditional<I8, i32x4, f32x4>::type;
    AccT acc[2][2][4][2];
#pragma unroll
    for (int a = 0; a < 2; ++a)
#pragma unroll
        for (int b = 0; b < 2; ++b)
#pragma unroll
            for (int m = 0; m < 4; ++m)
#pragma unroll
                for (int n = 0; n < 2; ++n) acc[a][b][m][n] = (AccT){0, 0, 0, 0};
    bf16x8 At[4][2], B0[2][2], B1[2][2];
    const char* cA = (const char*)g.A + (size_t)cur.pm * tstepA + (size_t)cur.ka * ES; const char* cB = (const char*)g.Bt + (size_t)cur.pn * tstepB + (size_t)cur.kb * ES;
    PG8_STAGE(PG8_SB(0, 0), cB, voffB); PG8_STAGE(PG8_SB(0, 1), cB + hstepB, voffB); PG8_STAGE(PG8_SA(0, 0), cA, voffA); PG8_STAGE(PG8_SA(0, 1), cA + hstepA, voffA);
    if (wr == 1) PG8_BAR;
    PG8_WAIT_V(2); PG8_BAR;
    PG8_STAGE(PG8_SB(1, 0), cB + kstep, voffB); PG8_STAGE(PG8_SA(1, 0), cA + kstep, voffA); PG8_STAGE(PG8_SB(1, 1), cB + hstepB + kstep, voffB);
    PG8_WAIT_V(6); PG8_BAR;
    unsigned pre2 = 0; unsigned pre = 0;
    for (;;) {
        const bool has_next = S.next(ui + 1, nxt);
        const char* nA = has_next ? (const char*)g.A + (size_t)nxt.pm * tstepA + (size_t)nxt.ka * ES : cA; const char* nB = has_next ? (const char*)g.Bt + (size_t)nxt.pn * tstepB + (size_t)nxt.kb * ES : cB;
#pragma unroll 1
        for (int t = 0; t < nt; t += 2) {
            const bool last = (t == nt - 2);
            if constexpr (PRE) { if (last) { const unsigned* pp = E.pre_ptr(cur, tid); asm volatile("global_load_dword %0, %1, off" : "=v"(pre) : "v"(pp) : "memory");
                                           const unsigned* pq = E.pre_ptr2(cur, tid); asm volatile("global_load_dword %0, %1, off" : "=v"(pre2) : "v"(pq) : "memory"); } }
            const char* a1 = cA + (size_t)(t + 1) * kstep;
            const char* a2 = last ? nA : cA + (size_t)(t + 2) * kstep; const char* b2 = last ? nB : cB + (size_t)(t + 2) * kstep;
            const char* a3 = a2 + kstep; const char* b3 = b2 + kstep;
            PG8_LDB(B0, 0, 0); PG8_LDB(B1, 0, 1); PG8_SCHED; PG8_LDA(At, 0, 0); PG8_STAGE(PG8_SA(1, 1), a1 + hstepA, voffA);
            PG8_WAIT_V(8); PG8_WAIT_L(0); PG8_BAR; PG8_MMA(0, 0, At, B0); PG8_MMA(0, 1, At, B1); PG8_BAR; PG8_SCHED;
            PG8_LDA(At, 0, 1); PG8_STAGE(PG8_SB(0, 0), b2, voffB); PG8_STAGE(PG8_SB(0, 1), b2 + hstepB, voffB); PG8_STAGE(PG8_SA(0, 0), a2, voffA);
            PG8_WAIT_V(8); PG8_WAIT_L(0); PG8_BAR; PG8_MMA(1, 0, At, B0); PG8_MMA(1, 1, At, B1); PG8_BAR; PG8_SCHED;
            PG8_LDB(B0, 1, 0); PG8_LDB(B1, 1, 1); PG8_SCHED; PG8_LDA(At, 1, 0); PG8_STAGE(PG8_SA(0, 1), a2 + hstepA, voffA);
            PG8_WAIT_V(8); PG8_WAIT_L(0); PG8_BAR; PG8_MMA(0, 0, At, B0); PG8_MMA(0, 1, At, B1); PG8_BAR; PG8_SCHED;
            PG8_LDA(At, 1, 1); PG8_STAGE(PG8_SB(1, 0), b3, voffB); PG8_STAGE(PG8_SB(1, 1), b3 + hstepB, voffB); PG8_STAGE(PG8_SA(1, 0), a3, voffA);
            PG8_WAIT_V(8); PG8_WAIT_L(0); PG8_BAR; PG8_MMA(1, 0, At, B0); PG8_MMA(1, 1, At, B1); PG8_BAR; PG8_SCHED;
        }
        if constexpr (ALIGN_EPI) { if (wr == 0) PG8_BAR; }
        if constexpr (PRE) { asm volatile("" : "+v"(pre), "+v"(pre2)); E(acc, cur, wr, wc, fr, fq, eps, tid, pre, pre2); } else E(acc, cur, wr, wc, fr, fq, eps, tid);
        if (!has_next) break;
#pragma unroll
        for (int a = 0; a < 2; ++a)
#pragma unroll
            for (int b = 0; b < 2; ++b)
#pragma unroll
                for (int m = 0; m < 4; ++m)
#pragma unroll
                    for (int n = 0; n < 2; ++n) acc[a][b][m][n] = (AccT){0, 0, 0, 0};
        cur = nxt; cA = nA; cB = nB; ++ui;
        if constexpr (ALIGN_EPI) { if (wr == 1) PG8_BAR; }
    }
    PG8_WAIT_V(0);
    if constexpr (!ALIGN_EPI) { if (wr == 0) PG8_BAR; }
    PG8_BAR;
#undef PG8_SA
#undef PG8_SB
#undef PG8_STAGE
#undef PG8_LDA
#undef PG8_LDB
#undef PG8_MMA
#undef PG8_WAIT_V
#undef PG8_WAIT_L
#undef PG8_BAR
#undef PG8_SCHED
}
}
using pg8::Unit;
typedef const f32x4 (&AccRef)[2][2][4][2];
typedef const i32x4 (&AccRefI)[2][2][4][2];

struct Args { const float* in[23]; float* out; unsigned char* ws; };
static_assert(sizeof(Args) == 25 * 8, "no padding");
typedef const __attribute__((address_space(4))) Args* KArgsP;
__device__ __forceinline__ KArgsP kargs() { KArgsP p = (KArgsP)__builtin_amdgcn_kernarg_segment_ptr(); asm volatile("" : "+s"(p)); return p; }
#define IN_F(i) ((const float*)ka->in[i])
#define WSP(off) (ws + (off))

template <int NR>
__device__ __forceinline__ void quant_rows(const float* eu, const float* ev, unsigned* EU8, unsigned* EV8, float* SU, float* SV, int r0, int lane) {
    f32x4 v[NR][8]; float mx[NR];
#pragma unroll
    for (int a = 0; a < NR; ++a) { const int r = r0 + a; const float* srow = (r >= 16384 ? ev : eu) + (size_t)(r & 16383) * 2048 + 4 * lane; mx[a] = 0.f;
#pragma unroll
        for (int j = 0; j < 8; ++j) v[a][j] = __builtin_nontemporal_load((const f32x4*)(srow + 256 * j)); }
#pragma unroll
    for (int a = 0; a < NR; ++a) {
#pragma unroll
        for (int j = 0; j < 8; ++j) mx[a] = fmaxf(fmaxf(mx[a], fmaxf(fabsf(v[a][j][0]), fabsf(v[a][j][1]))), fmaxf(fabsf(v[a][j][2]), fabsf(v[a][j][3])));
        mx[a] = wave_max(mx[a]); }
#pragma unroll
    for (int a = 0; a < NR; ++a) { const int r = r0 + a, e = r & 16383; const bool isv = r >= 16384;
        const float sc = mx[a] > 0.f ? mx[a] * (1.f / 127.f) : 1.f; const float inv = 1.f / sc;
        unsigned* drow = (isv ? EV8 : EU8) + (size_t)(lane >> 5) * (16384 * 32) + (size_t)e * 32 + (lane & 31);
#pragma unroll
        for (int j = 0; j < 8; ++j) { const int q0 = (int)rintf(v[a][j][0] * inv), q1 = (int)rintf(v[a][j][1] * inv), q2 = (int)rintf(v[a][j][2] * inv), q3 = (int)rintf(v[a][j][3] * inv);
            drow[(size_t)(2 * j) * (16384 * 32)] = (unsigned)(q0 & 0xff) | ((unsigned)(q1 & 0xff) << 8) | ((unsigned)(q2 & 0xff) << 16) | ((unsigned)(q3 & 0xff) << 24); }
        if (lane == 0) (isv ? SV : SU)[e] = sc; }
}

#define ALOAD16(dst, ptr) asm volatile("global_load_dwordx4 %0, %1, off" : "=&v"(dst) : "v"(ptr) : "memory")
#define ALOAD16O(dst, ptr, off) asm volatile("global_load_dwordx4 %0, %1, off offset:%c2" : "=&v"(dst) : "v"(ptr), "i"(off) : "memory")
#define AWAIT8(a, b, c, d, e, f, g, h) asm volatile("s_waitcnt vmcnt(0)" : "+v"(a), "+v"(b), "+v"(c), "+v"(d), "+v"(e), "+v"(f), "+v"(g), "+v"(h) :: "memory")
#define AWAIT16(a, b, c, d, e, f, g, h, i, j, k, l, m, n, o, p) asm volatile("s_waitcnt vmcnt(0)" : "+v"(a), "+v"(b), "+v"(c), "+v"(d), "+v"(e), "+v"(f), "+v"(g), "+v"(h), "+v"(i), "+v"(j), "+v"(k), "+v"(l), "+v"(m), "+v"(n), "+v"(o), "+v"(p) :: "memory")

__device__ __forceinline__ u32x4 pack8(f32x4 a, f32x4 b) { u32x4 w; w.x = cvtpk(a[0], a[1]); w.y = cvtpk(a[2], a[3]); w.z = cvtpk(b[0], b[1]); w.w = cvtpk(b[2], b[3]); return w; }
__device__ __forceinline__ u32x2 pack4(f32x4 a) { u32x2 w; w.x = cvtpk(a[0], a[1]); w.y = cvtpk(a[2], a[3]); return w; }
__device__ __forceinline__ float sq4(f32x4 a) { return (a[0] * a[0] + a[1] * a[1]) + (a[2] * a[2] + a[3] * a[3]); }

struct EpiA {
    static constexpr bool PERM = true;
    bf16_t* ZP; bf16_t* CQ; bf16_t* CKV; float* ssq_cq; float* ssq_ckv; const float* RSX; const float* SBW;
    __device__ __forceinline__ const unsigned* pre_ptr(const Unit& u, int tid) const { return (const unsigned*)(RSX + u.pm * 256 + (tid & 255)); }
    __device__ __forceinline__ const unsigned* pre_ptr2(const Unit& u, int tid) const { return (const unsigned*)(SBW + u.pn * 256 + (tid & 255)); }
    __device__ __forceinline__ void operator()(AccRefI acc, const Unit& u, int wr, int wc, int fr, int fq, LAS unsigned char* eps, int tid, unsigned pre, unsigned pre2) const {
        LAS float* R = (LAS float*)(eps + 4096); LAS float* CS = (LAS float*)(eps + 5120);
        if (tid < 256) { R[tid] = __builtin_bit_cast(float, pre); CS[tid] = __builtin_bit_cast(float, pre2); }
        EPI_BAR();
        bf16_t* base; int ldc, colt; float* ssq = nullptr;
        if (u.pn < 4) { base = ZP; ldc = 1024; colt = u.pn * 256; }
        else if (u.pn < 6) { base = CQ; ldc = 512; colt = (u.pn - 4) * 256; ssq = ssq_cq + (u.pn - 4) * 4 + wc; }
        else { base = CKV; ldc = 512; colt = (u.pn - 6) * 256; ssq = ssq_ckv + (u.pn - 6) * 4 + wc; }
        const int row0 = u.pm * 256 + wr * 64 + fr, col0 = colt + wc * 32 + 8 * fq;
        f32x4 cs[2][2];
#pragma unroll
        for (int bj = 0; bj < 2; ++bj)
#pragma unroll
            for (int n = 0; n < 2; ++n) cs[bj][n] = *(const LAS f32x4*)(CS + bj * 128 + wc * 32 + 8 * fq + 4 * n);
#pragma unroll
        for (int ai = 0; ai < 2; ++ai)
#pragma unroll
            for (int m = 0; m < 4; ++m) { const int row = row0 + ai * 128 + m * 16; bf16_t* rowp = base + (size_t)row * ldc + col0; float s = 0.f; const float rs = R[ai * 128 + wr * 64 + m * 16 + fr];
#pragma unroll
                for (int bj = 0; bj < 2; ++bj) { const f32x4 v0 = __builtin_convertvector(acc[ai][bj][m][0], f32x4) * cs[bj][0] * rs, v1 = __builtin_convertvector(acc[ai][bj][m][1], f32x4) * cs[bj][1] * rs;
                    *(u32x4*)(rowp + bj * 128) = pack8(v0, v1); s += sq4(v0) + sq4(v1); }
                if (ssq) { s += __shfl_xor(s, 16); s += __shfl_xor(s, 32); if (fq == 0) ssq[(size_t)row * 8] = s; } }
        EPI_BAR();
    }
};
struct EpiKR {
    static constexpr bool PERM = false;
    float* KRP; const float* RSX; const float* SBW;
    __device__ __forceinline__ const unsigned* pre_ptr(const Unit& u, int tid) const { return (const unsigned*)(RSX + u.pm * 256 + (tid & 255)); }
    __device__ __forceinline__ const unsigned* pre_ptr2(const Unit& u, int tid) const { return (const unsigned*)(SBW + u.pn * 256 + (tid & 255)); }
    __device__ __forceinline__ void operator()(AccRefI acc, const Unit& u, int wr, int wc, int fr, int fq, LAS unsigned char* eps, int tid, unsigned pre, unsigned pre2) const {
        LAS float* R = (LAS float*)(eps + 4096); LAS float* CS = (LAS float*)(eps + 5120);
        if (tid < 256) { R[tid] = __builtin_bit_cast(float, pre); CS[tid] = __builtin_bit_cast(float, pre2); }
        EPI_BAR();
        if (wc < 2) { const int ks = u.ka >> 9; const int row0 = u.pm * 256 + wr * 64 + fr;
#pragma unroll
            for (int ai = 0; ai < 2; ++ai)
#pragma unroll
                for (int m = 0; m < 4; ++m) { const int row = row0 + ai * 128 + m * 16; const float rs = R[ai * 128 + wr * 64 + m * 16 + fr];
#pragma unroll
                    for (int n = 0; n < 2; ++n) *(f32x4*)(KRP + ((size_t)ks * M + row) * 64 + 32 * wc + 16 * n + 4 * fq) = __builtin_convertvector(acc[ai][0][m][n], f32x4) * *(const LAS f32x4*)(CS + 32 * wc + 16 * n + 4 * fq) * rs; } }
        { const int uid = u.pm * 4 + (u.ka >> 9); KArgsP ka = kargs(); unsigned char* ws = ka->ws; const float* p_in = IN_F(1); const float* sk1 = IN_F(16); const float* sk2 = IN_F(17);
          bf16_t* PB = (bf16_t*)WSP(WS_PB); bf16_t* SKB = (bf16_t*)WSP(WS_SK);
          for (int i = tid; i < 2176; i += 512) { long j = (long)uid * 2176 + i; const float* src; bf16_t* dst;
              if (j < 524288) { src = p_in; dst = PB; } else if ((j -= 524288) < 16384) { src = sk1; dst = SKB; } else { j -= 16384; src = sk2; dst = SKB + 131072; }
              const f32x4 a = *(const f32x4*)(src + j * 8), b = *(const f32x4*)(src + j * 8 + 4); *(u32x4*)(dst + j * 8) = pack8(a, b); } }
        EPI_BAR();
    }
};
struct EpiStore {
    static constexpr bool PERM = true;
    bf16_t* O; int ldc;
    __device__ __forceinline__ void operator()(AccRef acc, const Unit& u, int wr, int wc, int fr, int fq, LAS unsigned char*, int) const {
        const int row0 = u.pm * 256 + wr * 64 + fr, col0 = u.pn * 256 + wc * 32 + 8 * fq;
#pragma unroll
        for (int ai = 0; ai < 2; ++ai)
#pragma unroll
            for (int m = 0; m < 4; ++m) { bf16_t* rowp = O + (size_t)(row0 + ai * 128 + m * 16) * ldc + col0;
#pragma unroll
                for (int bj = 0; bj < 2; ++bj) *(u32x4*)(rowp + bj * 128) = pack8(acc[ai][bj][m][0], acc[ai][bj][m][1]); }
    }
};
struct EpiQ {
    static constexpr bool PERM = false;
    bf16_t* Q; const float* ssq_cq; const float* qg; const float* COS; const float* SIN;
    __device__ __forceinline__ void operator()(AccRef acc, const Unit& u, int wr, int wc, int fr, int fq, LAS unsigned char* eps, int tid) const {
        LAS float* P = (LAS float*)eps; LAS float* R = (LAS float*)(eps + 4096);
        const int h = u.pn, rowt = u.pm * 256;
        { const f32x4 a = *(const f32x4*)(ssq_cq + (size_t)(rowt + (tid >> 1)) * 8 + 4 * (tid & 1)); float s = (a[0] + a[1]) + (a[2] + a[3]); s += DPP_F(s, 0xB1);
          if ((tid & 1) == 0) R[tid >> 1] = rsqrtf(s * (1.f / 512.f) + EPS); }
#pragma unroll
        for (int ai = 0; ai < 2; ++ai)
#pragma unroll
            for (int m = 0; m < 4; ++m) { const int r = ai * 128 + wr * 64 + m * 16 + fr; float s = 0.f;
#pragma unroll
                for (int bj = 0; bj < 2; ++bj)
#pragma unroll
                    for (int n = 0; n < 2; ++n) s += sq4(acc[ai][bj][m][n]);
                s += __shfl_xor(s, 16); s += __shfl_xor(s, 32); if (fq == 0) P[r * 4 + wc] = s; }
        EPI_BAR();
        const int dn = 32 * wc + 4 * fq, j = 16 * wc + 4 * fq;
        const f32x4 g0 = *(const f32x4*)(qg + dn), g1 = *(const f32x4*)(qg + dn + 16);
        f32x4 gr1 = {0.f, 0.f, 0.f, 0.f}, gr2 = gr1; if (wc < 2) { gr1 = *(const f32x4*)(qg + 128 + j); gr2 = *(const f32x4*)(qg + 160 + j); }
#pragma unroll
        for (int ai = 0; ai < 2; ++ai)
#pragma unroll
            for (int m = 0; m < 4; ++m) { const int r = ai * 128 + wr * 64 + m * 16 + fr; const float rc = R[r]; const f32x4 pp = *(LAS f32x4*)(P + r * 4);
                const float ss = ((pp[0] + pp[1]) + (pp[2] + pp[3])) * rc * rc; const float sc = rc * rsqrtf(ss * (1.f / 192.f) + EPS);
                const size_t grow = (size_t)(rowt + r); bf16_t* qrow = Q + grow * 1536 + h * 192;
                *(u32x2*)(qrow + dn) = pack4(acc[ai][0][m][0] * sc * g0); *(u32x2*)(qrow + dn + 16) = pack4(acc[ai][0][m][1] * sc * g1);
                if (wc < 2) { const f32x4 x1 = acc[ai][1][m][0] * sc * gr1, x2 = acc[ai][1][m][1] * sc * gr2;
                    const f32x4 c4 = *(const f32x4*)(COS + grow * 32 + j), s4 = *(const f32x4*)(SIN + grow * 32 + j);
                    *(u32x2*)(qrow + 128 + j) = pack4(x1 * c4 - x2 * s4); *(u32x2*)(qrow + 160 + j) = pack4(x2 * c4 + x1 * s4); } }
    }
};
struct EpiKV {
    static constexpr bool PERM = false;
    bf16_t* K; bf16_t* V; const float* ssq_ckv; const float* KRP; const float* kg; const float* COS; const float* SIN;
    __device__ __forceinline__ void operator()(AccRef acc, const Unit& u, int wr, int wc, int fr, int fq, LAS unsigned char* eps, int tid) const {
        LAS float* P = (LAS float*)eps; LAS float* R = (LAS float*)(eps + 4096); LAS float* R2 = (LAS float*)(eps + 5120);
        const int h = u.pn, rowt = u.pm * 256;
        { const f32x4 a = *(const f32x4*)(ssq_ckv + (size_t)(rowt + (tid >> 1)) * 8 + 4 * (tid & 1)); float s = (a[0] + a[1]) + (a[2] + a[3]); s += DPP_F(s, 0xB1);
          if ((tid & 1) == 0) R[tid >> 1] = rsqrtf(s * (1.f / 512.f) + EPS); }
        int tq = tid; asm volatile("" : "+v"(tq));
        const int rc = tq & 15, rb = tq >> 4;
#pragma unroll
        for (int ai = 0; ai < 2; ++ai)
#pragma unroll
            for (int m = 0; m < 4; ++m) { const int r = ai * 128 + wr * 64 + m * 16 + fr; float s = sq4(acc[ai][0][m][0]) + sq4(acc[ai][0][m][1]);
                s += __shfl_xor(s, 16); s += __shfl_xor(s, 32); if (fq == 0) P[r * 4 + wc] = s; }
        EPI_BAR();
        { const int jj = 4 * (rc & 7); const bool hi8 = rc >= 8;
          const f32x4 ga = *(const f32x4*)(kg + 128 + jj), gb = *(const f32x4*)(kg + 160 + jj);
#pragma unroll
          for (int k = 0; k < 8; ++k) { f32x4 pv[4], c4, s4;
            const int row = rb + 32 * k; const size_t grw = (size_t)(rowt + row); const float* p = KRP + grw * 64 + 4 * rc;
#pragma unroll
            for (int q = 0; q < 4; ++q) { const float* pq = p + (size_t)q * M * 64; ALOAD16(pv[q], pq); }
            { const float* pc = COS + grw * 32 + jj; const float* ps = SIN + grw * 32 + jj; ALOAD16(c4, pc); ALOAD16(s4, ps); }
            asm volatile("s_waitcnt vmcnt(0)" : "+v"(pv[0]), "+v"(pv[1]), "+v"(pv[2]), "+v"(pv[3]), "+v"(c4), "+v"(s4) :: "memory");
            const f32x4 mine = (pv[0] + pv[1]) + (pv[2] + pv[3]); f32x4 oth; oth[0] = DPP_F(mine[0], 0x128); oth[1] = DPP_F(mine[1], 0x128); oth[2] = DPP_F(mine[2], 0x128); oth[3] = DPP_F(mine[3], 0x128);
            float s2 = sq4(mine); s2 += DPP_F(s2, 0xB1); s2 += DPP_F(s2, 0x4E); s2 += DPP_F(s2, 0x141); s2 += DPP_F(s2, 0x128);
            if (rc == 0) R2[row] = s2;
            const float rc_ = R[row]; const f32x4 pp = *(LAS f32x4*)(P + row * 4); const float ssn = ((pp[0] + pp[1]) + (pp[2] + pp[3])) * rc_ * rc_;
            const float rk = rsqrtf((ssn + s2) * (1.f / 192.f) + EPS);
            const f32x4 x1 = (hi8 ? oth : mine) * ga, x2 = (hi8 ? mine : oth) * gb;
            const f32x4 o = (hi8 ? (x2 * c4 + x1 * s4) : (x1 * c4 - x2 * s4)) * rk;
            *(u32x2*)(K + grw * 1536 + h * 192 + 128 + 4 * rc) = pack4(o); } }
        EPI_BAR();
        const int dn = 32 * wc + 4 * fq;
        const f32x4 g0 = *(const f32x4*)(kg + dn), g1 = *(const f32x4*)(kg + dn + 16);
#pragma unroll
        for (int ai = 0; ai < 2; ++ai)
#pragma unroll
            for (int m = 0; m < 4; ++m) { const int r = ai * 128 + wr * 64 + m * 16 + fr; const float rc = R[r]; const f32x4 pp = *(LAS f32x4*)(P + r * 4);
                const float ssn = ((pp[0] + pp[1]) + (pp[2] + pp[3])) * rc * rc; const float sk = rc * rsqrtf((ssn + R2[r]) * (1.f / 192.f) + EPS);
                const size_t grow = (size_t)(rowt + r);
                bf16_t* vrow = V + grow * 1024 + h * 128 + dn; *(u32x2*)vrow = pack4(acc[ai][1][m][0] * rc); *(u32x2*)(vrow + 16) = pack4(acc[ai][1][m][1] * rc);
                bf16_t* krow = K + grow * 1536 + h * 192 + dn; *(u32x2*)krow = pack4(acc[ai][0][m][0] * sk * g0); *(u32x2*)(krow + 16) = pack4(acc[ai][0][m][1] * sk * g1); }
    }
};
struct EpiH1 {
    static constexpr bool PERM = true;
    const float* X; bf16_t* H1B; float* SSQ;
    __device__ __forceinline__ void operator()(AccRef acc, const Unit& u, int wr, int wc, int fr, int fq, LAS unsigned char*, int) const {
        const int row0 = u.pm * 256 + wr * 64 + fr, col0 = u.pn * 256 + wc * 32 + 8 * fq;
#pragma unroll
        for (int ai = 0; ai < 2; ++ai) {
            f32x4 xa[4][2], xb[4][2];
#pragma unroll
            for (int m = 0; m < 4; ++m)
#pragma unroll
                for (int bj = 0; bj < 2; ++bj) { const float* p = X + (size_t)(row0 + ai * 128 + m * 16) * DM + col0 + bj * 128; ALOAD16(xa[m][bj], p); ALOAD16O(xb[m][bj], p, 16); }
            AWAIT16(xa[0][0], xa[0][1], xa[1][0], xa[1][1], xa[2][0], xa[2][1], xa[3][0], xa[3][1], xb[0][0], xb[0][1], xb[1][0], xb[1][1], xb[2][0], xb[2][1], xb[3][0], xb[3][1]);
#pragma unroll
            for (int m = 0; m < 4; ++m) { const size_t off = (size_t)(row0 + ai * 128 + m * 16) * DM + col0; float s = 0.f;
#pragma unroll
                for (int bj = 0; bj < 2; ++bj) { const f32x4 h0 = xa[m][bj] + acc[ai][bj][m][0], h1 = xb[m][bj] + acc[ai][bj][m][1];
                    *(u32x4*)(H1B + off + bj * 128) = pack8(h0, h1); s += sq4(h0) + sq4(h1); }
                s += __shfl_xor(s, 16); s += __shfl_xor(s, 32); if (fq == 0) SSQ[(size_t)(row0 + ai * 128 + m * 16) * 32 + u.pn * 4 + wc] = s; }
        }
    }
};
struct EpiQP {
    static constexpr bool PERM = true;
    bf16_t* QP; const float* SSQ; float* RSTD2;
    __device__ __forceinline__ void operator()(AccRef acc, const Unit& u, int wr, int wc, int fr, int fq, LAS unsigned char* eps, int tid) const {
        LAS float* R = (LAS float*)(eps + 4096);
#pragma unroll
        for (int k = 0; k < 4; ++k) { const int row = (tid >> 3) + 64 * k; const f32x4 a = *(const f32x4*)(SSQ + (size_t)(u.pm * 256 + row) * 32 + 4 * (tid & 7));
            const float s = oct_sum((a[0] + a[1]) + (a[2] + a[3])); const float rs = rsqrtf(s * (1.f / 2048.f) + EPS);
            if ((tid & 7) == 0) { R[row] = rs; if (u.pn == 0) RSTD2[u.pm * 256 + row] = rs; } }
        EPI_BAR();
        const int col0 = u.pn * 256 + wc * 32 + 8 * fq;
#pragma unroll
        for (int ai = 0; ai < 2; ++ai)
#pragma unroll
            for (int m = 0; m < 4; ++m) { const int r = ai * 128 + wr * 64 + m * 16 + fr; const float rs = R[r]; bf16_t* rowp = QP + (size_t)(u.pm * 256 + r) * DM + col0;
#pragma unroll
                for (int bj = 0; bj < 2; ++bj) *(u32x4*)(rowp + bj * 128) = pack8(acc[ai][bj][m][0] * rs, acc[ai][bj][m][1] * rs); }
        EPI_BAR();
    }
};
struct EpiGate {
    static constexpr bool PERM = true;
    float* OUT; const bf16_t* PROJ; const float* SSQ2; const bf16_t* H2B;
    __device__ __forceinline__ void operator()(AccRef acc, const Unit& u, int wr, int wc, int fr, int fq, LAS unsigned char* eps, int tid) const {
        LAS float* R = (LAS float*)(eps + 4096);
#pragma unroll
        for (int k = 0; k < 2; ++k) { const int row = (tid >> 2) + 128 * k; const f32x4 a = *(const f32x4*)(SSQ2 + (size_t)(u.pm * 256 + row) * 16 + 4 * (tid & 3));
            const float s = quad_sum((a[0] + a[1]) + (a[2] + a[3])); if ((tid & 3) == 0) R[row] = rsqrtf(s * (1.f / 2048.f) + EPS); }
        EPI_BAR();
        const int row0 = u.pm * 256 + wr * 64 + fr, col0 = u.pn * 256 + wc * 32 + 8 * fq;
#pragma unroll
        for (int ai = 0; ai < 2; ++ai) {
            u32x4 pj[4][2], hv[4][2];
#pragma unroll
            for (int m = 0; m < 4; ++m)
#pragma unroll
                for (int bj = 0; bj < 2; ++bj) { const size_t off = (size_t)(row0 + ai * 128 + m * 16) * DM + col0 + bj * 128; const bf16_t* pp = PROJ + off; const bf16_t* ph = H2B + off; ALOAD16(pj[m][bj], pp); ALOAD16(hv[m][bj], ph); }
            AWAIT16(pj[0][0], pj[0][1], pj[1][0], pj[1][1], pj[2][0], pj[2][1], pj[3][0], pj[3][1], hv[0][0], hv[0][1], hv[1][0], hv[1][1], hv[2][0], hv[2][1], hv[3][0], hv[3][1]);
#pragma unroll
            for (int m = 0; m < 4; ++m) { const int row = row0 + ai * 128 + m * 16; const float rs = R[ai * 128 + wr * 64 + m * 16 + fr]; const size_t off = (size_t)row * DM + col0;
#pragma unroll
                for (int bj = 0; bj < 2; ++bj) { const u32x4 pw = pj[m][bj], hw = hv[m][bj];
                    const f32x4 p0 = {bf_lo(pw.x), bf_hi(pw.x), bf_lo(pw.y), bf_hi(pw.y)}, p1 = {bf_lo(pw.z), bf_hi(pw.z), bf_lo(pw.w), bf_hi(pw.w)};
                    f32x4 g0, g1;
#pragma unroll
                    for (int e = 0; e < 4; ++e) { g0[e] = __builtin_amdgcn_rcpf(1.f + __builtin_amdgcn_exp2f(-1.4426950408889634f * rs * acc[ai][bj][m][0][e]));
                                                  g1[e] = __builtin_amdgcn_rcpf(1.f + __builtin_amdgcn_exp2f(-1.4426950408889634f * rs * acc[ai][bj][m][1][e])); }
                    float* o = OUT + off + bj * 128;
                    const f32x4 h0 = {bf_lo(hw.x), bf_hi(hw.x), bf_lo(hw.y), bf_hi(hw.y)}, h1 = {bf_lo(hw.z), bf_hi(hw.z), bf_lo(hw.w), bf_hi(hw.w)};
                    *(f32x4*)o = h0 + g0 * p0; *(f32x4*)(o + 4) = h1 + g1 * p1; } }
        }
        EPI_BAR();
    }
};

typedef GAS unsigned gu32;
#define RLX_AGENT __ATOMIC_RELAXED, __HIP_MEMORY_SCOPE_AGENT
#define XB_TMO      128
#define XB_XCNT(j)  (256  + 64 * (j))
#define XB_XSUB(j)  (1280 + 64 * (j))
#define XB_XGEN(j)  (2304 + 64 * (j))
#define XB_TOP      3328
#define XB_TOPGEN   3392
#define XCD_BAR_WORDS 3456
#define XB_SPIN_CAP (1u << 20)
__device__ __forceinline__ unsigned xb_ld(unsigned* p)              { return __hip_atomic_load(p, __ATOMIC_RELAXED, __HIP_MEMORY_SCOPE_AGENT); }
__device__ __forceinline__ unsigned xb_add(unsigned* p, unsigned v) { return __hip_atomic_fetch_add(p, v, __ATOMIC_RELAXED, __HIP_MEMORY_SCOPE_AGENT); }
__device__ __forceinline__ unsigned xb_xcc_id() { return (unsigned)__builtin_amdgcn_s_getreg((3 << 11) | 20) & 0xFu; }
#define XB_SPIN(cond, bar) do { unsigned _sp = 0; while (cond) { __builtin_amdgcn_s_sleep(1); \
    if ((++_sp & 255u) == 0u) { if (xb_ld(&(bar)[XB_TMO])) break; if (_sp > XB_SPIN_CAP) { atomicAdd(&(bar)[XB_TMO], 1u); break; } } } } while (0)
struct XcdBarrier { unsigned* bar; unsigned x; volatile LAS unsigned* st; int w0; };
__device__ __forceinline__ XcdBarrier xcd_barrier_post(unsigned* bar, volatile LAS unsigned* st, int w0) {
    XcdBarrier b; b.bar = bar; b.x = xb_xcc_id(); b.st = st; b.w0 = w0;
    if (tid_of(w0) == 0) (void)xb_add(&bar[XB_XCNT(b.x)], 1u);
    return b;
}
__device__ __forceinline__ void xcd_barrier_complete(unsigned* bar, unsigned x, unsigned& nloc, unsigned& nx) {
    const unsigned G = gridDim.x * gridDim.y * gridDim.z;
    unsigned sum, cnt, mine, sp = 0u;
    for (;;) {
        sum = 0u; cnt = 0u; mine = 0u;
#pragma unroll
        for (unsigned j = 0; j < 16; ++j) { const unsigned c = xb_ld(&bar[XB_XCNT(j)]); sum += c; cnt += (c > 0u) ? 1u : 0u; mine = (j == x) ? c : mine; }
        if (sum == G) break;
        __builtin_amdgcn_s_sleep(1);
        if ((++sp & 255u) == 0u) { if (xb_ld(&bar[XB_TMO])) break; if (sp > XB_SPIN_CAP) { atomicAdd(&bar[XB_TMO], 1u); break; } }
    }
    nloc = mine > 0u ? mine : 1u; nx = cnt > 0u ? cnt : 1u;
}
__device__ __forceinline__ void xcd_barrier(const XcdBarrier& b) {
    asm volatile("s_waitcnt vmcnt(0)" ::: "memory");
    __syncthreads();
    if (tid_of(b.w0) == 0) {
        unsigned* bar = b.bar;
        __builtin_amdgcn_s_waitcnt(0);
        unsigned nloc = b.st[0], nx = b.st[1];
        if (nloc == 0u) { xcd_barrier_complete(bar, b.x, nloc, nx); b.st[0] = nloc; b.st[1] = nx; }
        const unsigned old = xb_add(&bar[XB_XSUB(b.x)], 1u);
        const unsigned gen = old / nloc;
        if (old + 1u == (gen + 1u) * nloc) {
            __builtin_amdgcn_fence(__ATOMIC_RELEASE, "agent");
            asm volatile("s_waitcnt vmcnt(0)" ::: "memory");
            const unsigned og = xb_add(&bar[XB_TOP], 1u);
            const unsigned tg = og / nx;
            if (og + 1u == (tg + 1u) * nx) xb_add(&bar[XB_TOPGEN], 1u);
            else XB_SPIN(xb_ld(&bar[XB_TOPGEN]) == tg, bar);
            __builtin_amdgcn_fence(__ATOMIC_ACQUIRE, "agent");
            xb_add(&bar[XB_XGEN(b.x)], 1u);
            asm volatile("s_waitcnt vmcnt(0)" ::: "memory");
        } else {
            XB_SPIN(xb_ld(&bar[XB_XGEN(b.x)]) == gen, bar);
            __builtin_amdgcn_fence(__ATOMIC_ACQUIRE, "agent");
            asm volatile("s_waitcnt vmcnt(0)" ::: "memory");
        }
    }
    __syncthreads();
}

__device__ __forceinline__ int uq_row(int n) {
    const int h = n / 192, d = n - h * 192; int slot;
    if (d < 128) slot = d; else { const int j = d - 128; if (j < 32) slot = 128 + 32 * (j >> 4) + (j & 15); else { const int jj = j - 32; slot = 128 + 32 * (jj >> 4) + 16 + (jj & 15); } }
    return h * 256 + slot;
}
template <int MAP>
__device__ __forceinline__ void tr_item(const float* W, int ldw, int col_off, const float* gk, const float* gn, bf16_t* WT, int ldt, int row_off, int nblk, LAS float* scr, int item, int lane) {
    const int kb = item / nblk, nb = item - kb * nblk, k0 = 64 * kb, n0 = 32 * nb;
#pragma unroll
    for (int i = 0; i < 32; ++i) { const int kk = 2 * i + (lane >> 5); float v = W[(size_t)(k0 + kk) * ldw + col_off + n0 + (lane & 31)]; if (gk) v *= gk[k0 + kk]; scr[kk * 33 + (lane & 31)] = v; }
    asm volatile("s_waitcnt lgkmcnt(0)" ::: "memory");
    const int c = lane & 7;
#pragma unroll
    for (int j = 0; j < 4; ++j) { const int n = (lane >> 3) + 8 * j; const LAS float* s = scr + (8 * c) * 33 + n; const float g = gn ? gn[n0 + n] : 1.f;
        u32x4 o; o.x = cvtpk(s[0 * 33] * g, s[1 * 33] * g); o.y = cvtpk(s[2 * 33] * g, s[3 * 33] * g); o.z = cvtpk(s[4 * 33] * g, s[5 * 33] * g); o.w = cvtpk(s[6 * 33] * g, s[7 * 33] * g);
        const int drow = (MAP == 1) ? uq_row(n0 + n) : (row_off + n0 + n);
        *(u32x4*)(WT + (size_t)drow * ldt + k0 + 8 * c) = o; }
    asm volatile("s_waitcnt lgkmcnt(0)" ::: "memory");
}

struct TrP { const float* W; const float* gk; const float* gn; bf16_t* WT; int ldw, ldt, nblk, item, map; };
__device__ __forceinline__ void tr_load(const TrP& p, float (&v)[32], int lane) {
    const int kb = p.item / p.nblk, nb = p.item - kb * p.nblk, k0 = 64 * kb, n0 = 32 * nb;
#pragma unroll
    for (int i = 0; i < 32; ++i) { const int kk = 2 * i + (lane >> 5); v[i] = p.W[(size_t)(k0 + kk) * p.ldw + n0 + (lane & 31)]; }
    if (p.gk) {
#pragma unroll
        for (int i = 0; i < 32; ++i) v[i] *= p.gk[k0 + 2 * i + (lane >> 5)]; }
}
__device__ __forceinline__ void tr_store(const TrP& p, const float (&v)[32], LAS float* scr, int lane) {
    const int kb = p.item / p.nblk, nb = p.item - kb * p.nblk, k0 = 64 * kb, n0 = 32 * nb;
#pragma unroll
    for (int i = 0; i < 32; ++i) scr[(2 * i + (lane >> 5)) * 33 + (lane & 31)] = v[i];
    asm volatile("s_waitcnt lgkmcnt(0)" ::: "memory");
    const int c = lane & 7;
#pragma unroll
    for (int j = 0; j < 4; ++j) { const int n = (lane >> 3) + 8 * j; const LAS float* s = scr + (8 * c) * 33 + n; const float g = p.gn ? p.gn[n0 + n] : 1.f;
        u32x4 o; o.x = cvtpk(s[0 * 33] * g, s[1 * 33] * g); o.y = cvtpk(s[2 * 33] * g, s[3 * 33] * g); o.z = cvtpk(s[4 * 33] * g, s[5 * 33] * g); o.w = cvtpk(s[6 * 33] * g, s[7 * 33] * g);
        const int drow = p.map ? uq_row(n0 + n) : (n0 + n);
        *(u32x4*)(p.WT + (size_t)drow * p.ldt + k0 + 8 * c) = o; }
    asm volatile("s_waitcnt lgkmcnt(0)" ::: "memory");
}

namespace att {
constexpr int DQ = 192, DV = 128, KVBLK = 64, QBLK = 32;
constexpr int LDQ = 1536, LDV = 1024, LDO = 2048;
constexpr int SHM_V = KVBLK * DV * 2, SHM_K = KVBLK * DQ * 2;
constexpr float SCALE = 0.07216878364870322f;
constexpr float THR = 8.f;
#define KSWZ(row, colB) ((row) * 384 + ((colB) ^ ((((row) >> 1) & 7) << 4)))
#define SBAR() __builtin_amdgcn_sched_barrier(0)
__device__ __forceinline__ int crow(int r, int hi) { return (r & 3) + 8 * (r >> 2) + 4 * hi; }
__device__ __forceinline__ void partialSM(f32x16& p0, f32x16& p1, float& m_reg, float& alpha) {
    constexpr float C = SCALE * 1.4426950408889634f;
    float pmax = p0[0];
#pragma unroll
    for (int r = 1; r < 16; ++r) pmax = fmaxf(pmax, p0[r]);
#pragma unroll
    for (int r = 0; r < 16; ++r) pmax = fmaxf(pmax, p1[r]);
    { auto rr = __builtin_amdgcn_permlane32_swap(__float_as_uint(pmax), __float_as_uint(pmax), false, false);
      pmax = fmaxf(__uint_as_float(rr[0]), __uint_as_float(rr[1])); }
    float mn;
    if (__builtin_expect(__all(pmax - m_reg <= THR / SCALE), 1)) { mn = m_reg; alpha = 1.f; }
    else { mn = fmaxf(m_reg, pmax); alpha = __builtin_amdgcn_exp2f((m_reg - mn) * C); m_reg = mn; }
    const float mnC = -mn * C;
#pragma unroll
    for (int r = 0; r < 16; ++r) { p0[r] = __builtin_amdgcn_exp2f(fmaf(p0[r], C, mnC)); p1[r] = __builtin_amdgcn_exp2f(fmaf(p1[r], C, mnC)); }
}
__device__ __forceinline__ void finishSM(const f32x16& p0, const f32x16& p1, float alpha, float& l_reg, bf16x8& pa0, bf16x8& pa1, bf16x8& pa2, bf16x8& pa3) {
    float ps = 0.f;
#pragma unroll
    for (int r = 0; r < 16; ++r) ps += p0[r];
#pragma unroll
    for (int r = 0; r < 16; ++r) ps += p1[r];
    { auto rr = __builtin_amdgcn_permlane32_swap(__float_as_uint(ps), __float_as_uint(ps), false, false);
      ps = __uint_as_float(rr[0]) + __uint_as_float(rr[1]); }
    l_reg = l_reg * alpha + ps;
#define PK4(P, BASE, OUT) do { unsigned a0 = cvtpk(P[BASE + 0], P[BASE + 1]), a1 = cvtpk(P[BASE + 2], P[BASE + 3]);   \
    unsigned b0 = cvtpk(P[BASE + 4], P[BASE + 5]), b1 = cvtpk(P[BASE + 6], P[BASE + 7]);                              \
    auto r0 = __builtin_amdgcn_permlane32_swap(a0, b0, false, false); auto r1 = __builtin_amdgcn_permlane32_swap(a1, b1, false, false); \
    u32x4 w = {r0[0], r1[0], r0[1], r1[1]}; OUT = __builtin_bit_cast(bf16x8, w); } while (0)
    PK4(p0, 0, pa0); PK4(p0, 8, pa1); PK4(p1, 0, pa2); PK4(p1, 8, pa3);
#undef PK4
}
__device__ __forceinline__ void qkt(f32x16& p0, f32x16& p1, const char* Ks, const bf16x8* qr, int r32, int hi) {
    p0 = f32x16{}; p1 = f32x16{};
#pragma unroll
    for (int d0 = 0; d0 < 12; ++d0) { const int cb = (d0 * 16 + hi * 8) * 2;
        const bf16x8 b0 = *reinterpret_cast<const bf16x8*>(Ks + KSWZ(r32, cb));
        const bf16x8 b1 = *reinterpret_cast<const bf16x8*>(Ks + KSWZ(32 + r32, cb));
        p0 = __builtin_amdgcn_mfma_f32_32x32x16_bf16(b0, qr[d0], p0, 0, 0, 0);
        p1 = __builtin_amdgcn_mfma_f32_32x32x16_bf16(b1, qr[d0], p1, 0, 0, 0); }
}
__device__ __forceinline__ int v_st(int k, int c) { const int kk = (k & ~0xC) | ((k & 4) << 1) | ((k & 8) >> 1); return ((kk >> 3) * 4 + (c >> 5)) * 512 + ((kk & 7) * 32 + (c & 31)) * 2; }
__device__ __forceinline__ int v_rd_base(int lane) { return ((lane & 3) << 3) | (((lane >> 2) & 3) << 6) | (((lane >> 4) & 1) << 5) | (((lane >> 5) & 1) << 8); }
constexpr int v_rd_off(int d0, int ks, int half) { return d0 * 512 + ks * 4096 + half * 2048; }
template <int OFF> __device__ __forceinline__ s16x4 tr_read(int vb) {
    s16x4 r; asm volatile("ds_read_b64_tr_b16 %0, %1 offset:%2" : "=&v"(r) : "v"(vb), "i"(OFF) : "memory"); return r;
}
template <int D0> __device__ __forceinline__ void pv_one(f32x16& od, int vb, bf16x8 pa0, bf16x8 pa1, bf16x8 pa2, bf16x8 pa3) {
    const s16x4 l0 = tr_read<v_rd_off(D0, 0, 0)>(vb), h0 = tr_read<v_rd_off(D0, 0, 1)>(vb), l1 = tr_read<v_rd_off(D0, 1, 0)>(vb), h1 = tr_read<v_rd_off(D0, 1, 1)>(vb);
    const s16x4 l2 = tr_read<v_rd_off(D0, 2, 0)>(vb), h2 = tr_read<v_rd_off(D0, 2, 1)>(vb), l3 = tr_read<v_rd_off(D0, 3, 0)>(vb), h3 = tr_read<v_rd_off(D0, 3, 1)>(vb);
    asm volatile("s_waitcnt lgkmcnt(0)" ::: "memory"); SBAR();
#define PK(L, H) (bf16x8){L[0], L[1], L[2], L[3], H[0], H[1], H[2], H[3]}
    od = __builtin_amdgcn_mfma_f32_32x32x16_bf16(pa0, PK(l0, h0), od, 0, 0, 0);
    od = __builtin_amdgcn_mfma_f32_32x32x16_bf16(pa1, PK(l1, h1), od, 0, 0, 0);
    od = __builtin_amdgcn_mfma_f32_32x32x16_bf16(pa2, PK(l2, h2), od, 0, 0, 0);
    od = __builtin_amdgcn_mfma_f32_32x32x16_bf16(pa3, PK(l3, h3), od, 0, 0, 0);
#undef PK
}
__device__ __forceinline__ void attn_unit(int b, int h, int qt, const bf16_t* Q, const bf16_t* K, const bf16_t* V, bf16_t* Y, char* lds, LAS unsigned char* ldsl, int wave0) {
    int tid = tid_of(wave0); asm volatile("" : "+v"(tid)); const int lane = tid & 63, r32 = lane & 31, hi = lane >> 5; const int wid = __builtin_amdgcn_readfirstlane(tid >> 6);
    char* V_lds = lds; char* K_lds = lds + 3 * SHM_V;
    float* ws = (float*)(lds + 3 * SHM_V + 3 * SHM_K) + wid * 64; float* li_l = ws; float* al_l = ws + 32;
    const size_t rowbase = (size_t)b * SEQ;
    const bf16_t* Qw = Q + (rowbase + qt * 256 + wid * QBLK + r32) * LDQ + h * DQ + hi * 8;
    const bf16_t* Kh = K + rowbase * LDQ + h * DQ; const bf16_t* Vh = V + rowbase * LDV + h * DV;
    float m_reg = -1e30f, l_reg = 0.f; f32x16 o[4] = {}; bf16x8 qr[12];
#pragma unroll
    for (int d0 = 0; d0 < 12; ++d0) qr[d0] = *reinterpret_cast<const bf16x8*>(Qw + d0 * 16);
    unsigned koff[3], voff[2];
#pragma unroll
    for (int i = 0; i < 3; ++i) { const int p = (wid * 3 + i) * 64 + lane, row = p / 24, s = p - row * 24; const int sg = (s & ~7) | ((s & 7) ^ ((row >> 1) & 7)); koff[i] = (unsigned)(row * LDQ + sg * 8) * 2u; }
#pragma unroll
    for (int i = 0; i < 2; ++i) { const int p = (wid * 2 + i) * 64 + lane, st = p >> 5, kk = (st >> 2) * 8 + ((p & 31) >> 2), c = (st & 3) * 32 + (p & 3) * 8;
        const int k = (kk & ~0xC) | ((kk & 4) << 1) | ((kk & 8) >> 1); voff[i] = (unsigned)(k * LDV + c) * 2u; }
    const int vb0 = (int)(uintptr_t)V_lds + v_rd_base(lane);
    const int NT = 4 * qt + 4, climit = 4 * qt + (wid >> 1);
#define DMA_TILE(t, sl) do { const char* kg_ = (const char*)Kh + (size_t)(t) * (KVBLK * LDQ * 2); const char* vg_ = (const char*)Vh + (size_t)(t) * (KVBLK * LDV * 2); \
    _Pragma("unroll") for (int i = 0; i < 3; ++i) __builtin_amdgcn_global_load_lds((const unsigned*)(kg_ + koff[i]), (LAS unsigned*)(ldsl + 3 * SHM_V + (sl) * SHM_K + (wid * 3 + i) * 1024), 16, 0, 0); \
    _Pragma("unroll") for (int i = 0; i < 2; ++i) __builtin_amdgcn_global_load_lds((const unsigned*)(vg_ + voff[i]), (LAS unsigned*)(ldsl + (sl) * SHM_V + (wid * 2 + i) * 1024), 16, 0, 0); } while (0)
    f32x16 pA0, pA1, pB0, pB1; float alA = 1.f, alB = 1.f; bf16x8 pa0, pa1, pa2, pa3;
    int sl_k = 0, sl_v = 2, sl_n = 1;
#define RESC(a) do { if (__any((a) < 1.f)) { if (hi == 0) al_l[r32] = (a); asm volatile("s_waitcnt lgkmcnt(0)" ::: "memory"); \
    _Pragma("unroll") for (int d = 0; d < 4; ++d) _Pragma("unroll") for (int r = 0; r < 16; ++r) o[d][r] *= al_l[crow(r, hi)]; } } while (0)
#define ROT() do { const int t_ = sl_v; sl_v = sl_k; sl_k = sl_n; sl_n = t_; } while (0)
#define STEP(j, C0, C1, ALC, P0, P1, ALP) do { \
    if ((j) + 1 < NT) DMA_TILE((j) + 1, sl_n); \
    if ((j) <= climit) { SBAR(); qkt(C0, C1, K_lds + sl_k * SHM_K, qr, r32, hi); } \
    if ((j) >= 1 && (j) - 1 <= climit) { finishSM(P0, P1, ALP, l_reg, pa0, pa1, pa2, pa3); SBAR(); const int vb = vb0 + sl_v * SHM_V; \
        pv_one<0>(o[0], vb, pa0, pa1, pa2, pa3); pv_one<1>(o[1], vb, pa0, pa1, pa2, pa3); pv_one<2>(o[2], vb, pa0, pa1, pa2, pa3); pv_one<3>(o[3], vb, pa0, pa1, pa2, pa3); } \
    if ((j) <= climit) { partialSM(C0, C1, m_reg, ALC); RESC(ALC); } \
    asm volatile("s_waitcnt vmcnt(0)" ::: "memory"); __syncthreads(); ROT(); } while (0)
    DMA_TILE(0, 0); asm volatile("s_waitcnt vmcnt(0)" ::: "memory"); __syncthreads();
    for (int j = 0; j < NT; j += 2) {
        STEP(j, pA0, pA1, alA, pB0, pB1, alB);
        STEP(j + 1, pB0, pB1, alB, pA0, pA1, alA);
    }
    if (NT - 1 <= climit) { finishSM(pB0, pB1, alB, l_reg, pa0, pa1, pa2, pa3); SBAR(); const int vb = vb0 + sl_v * SHM_V;
        pv_one<0>(o[0], vb, pa0, pa1, pa2, pa3); pv_one<1>(o[1], vb, pa0, pa1, pa2, pa3); pv_one<2>(o[2], vb, pa0, pa1, pa2, pa3); pv_one<3>(o[3], vb, pa0, pa1, pa2, pa3); }
#undef STEP
#undef ROT
#undef RESC
    if (hi == 0) li_l[r32] = l_reg; asm volatile("s_waitcnt lgkmcnt(0)" ::: "memory");
    bf16_t* Ow = Y + (rowbase + qt * 256 + wid * QBLK) * LDO + 1024 + h * DV;
#pragma unroll
    for (int r = 0; r < 16; ++r) { const int orow = crow(r, hi); const float rl = __builtin_amdgcn_rcpf(li_l[orow]);
#pragma unroll
        for (int d0 = 0; d0 < 4; ++d0) Ow[(size_t)orow * LDO + d0 * 32 + r32] = (bf16_t)(cvtpk(o[d0][r] * rl, 0.f) & 0xffffu); }
    __syncthreads();
#undef DMA_TILE
}
#undef SBAR
}


__device__ __forceinline__ float dot2bf(unsigned a, unsigned b, float c) {
    return __builtin_amdgcn_fdot2_f32_bf16(__builtin_bit_cast(bf16x2_t, a), __builtin_bit_cast(bf16x2_t, b), c, false); }
__device__ __forceinline__ float gelu_tanh(float x) {
    const float y = 0.7978845608028654f * (x + 0.044715f * x * x * x);
    const float t = __builtin_amdgcn_exp2f(2.8853900817779268f * y);
    return 0.5f * x * (2.f - 2.f * __builtin_amdgcn_rcpf(t + 1.f));
}

#ifndef DBG_ONLY
#define DBG_ONLY -1
#endif
#define PH(n) (DBG_ONLY < 0 || DBG_ONLY == (n))
#ifndef DBG_STOP
#define DBG_STOP 99

#endif

__global__ void __launch_bounds__(NWAVES * 64, 2) fwd_kernel(Args args) {
    extern __shared__ __attribute__((aligned(16))) unsigned char lds_raw[];
    LAS unsigned char* lds = (LAS unsigned char*)lds_raw;
    LAS unsigned char* eps = lds + EPI_OFF;
    volatile LAS unsigned* MISC = (volatile LAS unsigned*)(lds + MISC_OFF);
    const int wave0 = __builtin_amdgcn_readfirstlane((int)threadIdx.x >> 6);
    const int G = gridDim.x, bx = blockIdx.x, vcu = (G % 8 == 0) ? (bx % 8) * (G / 8) + bx / 8 : bx;
    const int NGW = G * NWAVES; const long NGT = (long)G * 512;
#define PHASE_IDS() int tid = tid_of(wave0); asm volatile("" : "+v"(tid)); const int lane = tid & 63, wave = __builtin_amdgcn_readfirstlane(tid >> 6); const int gw = vcu * NWAVES + wave; const long gt = (long)vcu * 512 + tid; (void)lane; (void)gw; (void)gt
    for (int u = threadIdx.x; u < (LDS_BYTES - LDSCTL_OFF) / 4; u += NWAVES * 64) ((LAS unsigned*)(lds + LDSCTL_OFF))[u] = 0u;
    __syncthreads();
#ifdef TIMING
    unsigned long long ts_prev = __builtin_amdgcn_s_memrealtime(); float ts_val = 0.f; int ts_idx = 0;
#define STAMP() do { const unsigned long long now_ = __builtin_amdgcn_s_memrealtime(); if (ts_idx == TIMING) ts_val = (float)(now_ - ts_prev) * 0.0001f; ts_prev = now_; ++ts_idx; } while (0)
#else
#define STAMP() do {} while (0)
#endif
    XcdBarrier bar;
    { KArgsP ka = kargs(); unsigned char* ws = ka->ws; bar = xcd_barrier_post((unsigned*)(ws + WS_CTL) + 4096, MISC + 8, wave0); }

    if (PH(0)) {
        KArgsP ka = kargs(); unsigned char* ws = ka->ws;
        const float* x = IN_F(0); const float* p_in = IN_F(1); const int* positions = (const int*)ka->in[2];
        const float* mix_gain = IN_F(3); const float* w_in = IN_F(4); const float* w_pool = IN_F(5); const float* pool_scale = IN_F(6);
        const float* q_lat_gain = IN_F(7); const float* kv_lat_gain = IN_F(8); const float* w_uq = IN_F(9); const float* w_ukv = IN_F(10);
        const float* w_out = IN_F(13); const float* w_pq = IN_F(15); const float* sub_k1 = IN_F(16); const float* sub_k2 = IN_F(17);
        const float* expert_u = IN_F(18); const float* expert_v = IN_F(19); const float* ple_gain = IN_F(20); const float* w_ple_gate = IN_F(21); const float* w_ple_proj = IN_F(22);
        bf16_t* WIN = (bf16_t*)WSP(WS_WIN); bf16_t* WPOOL = (bf16_t*)WSP(WS_WPOOL); bf16_t* SKB = (bf16_t*)WSP(WS_SK); bf16_t* WUQ = (bf16_t*)WSP(WS_WUQ); bf16_t* WUKV = (bf16_t*)WSP(WS_WUKV);
        bf16_t* WOUT = (bf16_t*)WSP(WS_WOUT); bf16_t* WPQ = (bf16_t*)WSP(WS_WPQ); bf16_t* WG = (bf16_t*)WSP(WS_WG); bf16_t* WP = (bf16_t*)WSP(WS_WP); bf16_t* PB = (bf16_t*)WSP(WS_PB);
        float* COS = (float*)WSP(WS_COS); float* SIN = (float*)WSP(WS_SIN); unsigned* EU8 = (unsigned*)WSP(WS_EU); unsigned* EV8 = (unsigned*)WSP(WS_EV); float* SU = (float*)WSP(WS_SU); float* SV = (float*)WSP(WS_SV); float* RSTDX = (float*)WSP(WS_RSTDX); unsigned* XQ = (unsigned*)WSP(WS_XQ);
        PHASE_IDS();
        LAS float* scr = (LAS float*)(lds + wave * 16384);
        (void)p_in; (void)sub_k1; (void)sub_k2; (void)expert_u; (void)expert_v; (void)SKB; (void)PB; (void)EU8; (void)EV8; (void)SU; (void)SV;
        if (bx < 66) {
            unsigned char* WINQ = (unsigned char*)WIN; float* SBW = (float*)WSP(WS_SBW);
            const int n0 = 32 * bx, c4 = lane & 7, kr = lane >> 3;
            const float* wp = w_in + (size_t)(256 * wave + 4 * kr) * 2112 + n0 + 4 * c4; const float* gp = mix_gain + 256 * wave + 4 * kr;
            f32x4 mx = {0.f, 0.f, 0.f, 0.f};
#pragma unroll 2
            for (int i = 0; i < 8; ++i) { f32x4 v[4]; const f32x4 gk = *(const f32x4*)(gp + 32 * i);
#pragma unroll
                for (int j = 0; j < 4; ++j) v[j] = *(const f32x4*)(wp + (size_t)(32 * i + j) * 2112);
#pragma unroll
                for (int j = 0; j < 4; ++j)
#pragma unroll
                    for (int e = 0; e < 4; ++e) mx[e] = fmaxf(mx[e], fabsf(v[j][e] * gk[j])); }
#pragma unroll
            for (int e = 0; e < 4; ++e) { mx[e] = fmaxf(mx[e], __shfl_xor(mx[e], 8)); mx[e] = fmaxf(mx[e], __shfl_xor(mx[e], 16)); mx[e] = fmaxf(mx[e], __shfl_xor(mx[e], 32)); }
            LAS float* cm = (LAS float*)(lds + EPI_OFF);
            if (kr == 0) *(LAS f32x4*)(cm + wave * 32 + 4 * c4) = mx;
            __syncthreads();
            f32x4 cmax = *(const LAS f32x4*)(cm + 4 * c4);
#pragma unroll
            for (int w = 1; w < 8; ++w) { const f32x4 o = *(const LAS f32x4*)(cm + w * 32 + 4 * c4);
#pragma unroll
                for (int e = 0; e < 4; ++e) cmax[e] = fmaxf(cmax[e], o[e]); }
            f32x4 sc, inv;
#pragma unroll
            for (int e = 0; e < 4; ++e) { sc[e] = cmax[e] > 0.f ? cmax[e] * (1.f / 127.f) : 1.f; inv[e] = 1.f / sc[e]; }
            if (wave == 0 && kr == 0) *(f32x4*)(SBW + n0 + 4 * c4) = sc;
            LAS unsigned char* tb = lds + wave * 16384;
#pragma unroll 2
            for (int i = 0; i < 8; ++i) { f32x4 v[4]; const f32x4 gk = *(const f32x4*)(gp + 32 * i);
#pragma unroll
                for (int j = 0; j < 4; ++j) v[j] = *(const f32x4*)(wp + (size_t)(32 * i + j) * 2112);
#pragma unroll
                for (int e = 0; e < 4; ++e) { unsigned wd = 0;
#pragma unroll
                    for (int j = 0; j < 4; ++j) wd |= ((unsigned)((int)rintf(v[j][e] * gk[j] * inv[e]) & 0xff)) << (8 * j);
                    *(LAS unsigned*)(tb + (4 * c4 + e) * 272 + 32 * i + 4 * kr) = wd; } }
            asm volatile("s_waitcnt lgkmcnt(0)" ::: "memory");
#pragma unroll
            for (int r = 0; r < 8; ++r) { const int id = lane + 64 * r, n = id >> 4, ch = id & 15;
                *(u32x4*)(WINQ + (size_t)(n0 + n) * 2048 + 256 * wave + 16 * ch) = *(const LAS u32x4*)(tb + n * 272 + 16 * ch); }
            asm volatile("s_waitcnt lgkmcnt(0)" ::: "memory");
        }
        (void)w_pool; (void)pool_scale; (void)q_lat_gain; (void)kv_lat_gain; (void)w_uq; (void)w_ukv; (void)w_out; (void)w_pq; (void)ple_gain; (void)w_ple_gate; (void)w_ple_proj;
        (void)WPOOL; (void)WUKV; (void)WOUT; (void)WPQ; (void)WG; (void)WP;
        for (long i = gt; i < 24576 + 32768; i += NGT) {
            const u32x4 z = {0u, 0u, 0u, 0u};
            if (i < 24576) { *(u32x4*)((unsigned char*)WIN + (size_t)2112 * 2048 + i * 16) = z; if (i < 192) ((float*)WSP(WS_SBW))[2112 + i] = 1.f; }
            else { const long j = i - 24576; const int hh = (int)(j >> 12), rem = (int)(j & 4095); *(u32x4*)(WUQ + ((size_t)hh * 256 + 192) * 512 + (size_t)rem * 8) = z; }
        }
        for (int m = 2 * gw; m < M; m += 2 * NGW) {
            f32x4 v[2][8]; float s[2] = {0.f, 0.f}; float mxr[2] = {0.f, 0.f};
#pragma unroll
            for (int a = 0; a < 2; ++a) { const f32x4* xr = (const f32x4*)(x + (size_t)(m + a) * DM) + lane;
#pragma unroll
                for (int j = 0; j < 8; ++j) v[a][j] = __builtin_nontemporal_load(xr + 64 * j); }
#pragma unroll
            for (int a = 0; a < 2; ++a) {
#pragma unroll
                for (int j = 0; j < 8; ++j) { s[a] += sq4(v[a][j]); mxr[a] = fmaxf(mxr[a], fmaxf(fmaxf(fabsf(v[a][j][0]), fabsf(v[a][j][1])), fmaxf(fabsf(v[a][j][2]), fabsf(v[a][j][3])))); }
                const float rs = rsqrtf(wave_sum(s[a]) * (1.f / DM) + EPS);
                const float am = wave_max(mxr[a]), sx = am > 0.f ? am * (1.f / 127.f) : 1.f, ix = 1.f / sx;
                unsigned* q8 = XQ + (size_t)(m + a) * 512 + lane;
#pragma unroll
                for (int j = 0; j < 8; ++j) { const f32x4 t = v[a][j] * ix;
                    q8[64 * j] = ((unsigned)((int)rintf(t[0]) & 0xff)) | (((unsigned)((int)rintf(t[1]) & 0xff)) << 8) | (((unsigned)((int)rintf(t[2]) & 0xff)) << 16) | (((unsigned)((int)rintf(t[3]) & 0xff)) << 24); }
                if (lane == 0) RSTDX[m + a] = rs * sx; }
        }
        for (long i = gt; i < (long)M * 32; i += NGT) {
            const int row = (int)(i >> 5), j = (int)(i & 31);
            const float inv = __builtin_amdgcn_exp2f(-(float)j * (13.287712379549449f / 32.f));
            const float ang = (float)positions[row] * inv;
            const float kq = rintf(ang * 0.15915494309189535f);
            float r = fmaf(-kq, 6.2831854820251465f, ang); r = fmaf(-kq, -1.7484555e-7f, r);
            const float rev = r * 0.15915494309189535f;
            COS[i] = __builtin_amdgcn_cosf(rev); SIN[i] = __builtin_amdgcn_sinf(rev);
        }
    }
    xcd_barrier(bar); STAMP();
    if (DBG_STOP == 0) return;

    if (PH(1)) {
        KArgsP ka = kargs(); unsigned char* ws = ka->ws;
        bf16_t* XN = (bf16_t*)WSP(WS_XQ); const float* RSTDX = (const float*)WSP(WS_RSTDX); const float* SBW = (const float*)WSP(WS_SBW); bf16_t* WIN = (bf16_t*)WSP(WS_WIN); bf16_t* ZP = (bf16_t*)WSP(WS_ZP); bf16_t* CQ = (bf16_t*)WSP(WS_CQ); bf16_t* CKV = (bf16_t*)WSP(WS_CKV);
        float* SSQ_CQ = (float*)WSP(WS_SSQ_CQ); float* SSQ_CKV = (float*)WSP(WS_SSQ_CKV); float* KRP = (float*)WSP(WS_KRP);
#define PHASE_A_SIDE() do { KArgsP kb = kargs(); unsigned char* ws = kb->ws; PHASE_IDS(); LAS float* scr = (LAS float*)(lds + wave * 16384); \
        { const float* eu = (const float*)kb->in[18]; const float* ev = (const float*)kb->in[19]; unsigned* EU8 = (unsigned*)WSP(WS_EU); unsigned* EV8 = (unsigned*)WSP(WS_EV); float* SU = (float*)WSP(WS_SU); float* SV = (float*)WSP(WS_SV); \
          for (int r = gw * 16; r < gw * 16 + 16; r += 4) quant_rows<4>(eu, ev, EU8, EV8, SU, SV, r, lane); } \
        { const float* w_pool = (const float*)kb->in[5]; const float* pool_scale = (const float*)kb->in[6]; const float* q_lat_gain = (const float*)kb->in[7]; const float* kv_lat_gain = (const float*)kb->in[8]; \
          const float* w_uq = (const float*)kb->in[9]; const float* w_ukv = (const float*)kb->in[10]; const float* w_out = (const float*)kb->in[13]; const float* w_pq = (const float*)kb->in[15]; const float* ffn_gain = (const float*)kb->in[14]; \
          const float* ple_gain = (const float*)kb->in[20]; const float* w_ple_gate = (const float*)kb->in[21]; const float* w_ple_proj = (const float*)kb->in[22]; \
          bf16_t* WPOOL = (bf16_t*)WSP(WS_WPOOL); bf16_t* WUQ = (bf16_t*)WSP(WS_WUQ); bf16_t* WUKV = (bf16_t*)WSP(WS_WUKV); bf16_t* WOUT = (bf16_t*)WSP(WS_WOUT); bf16_t* WPQ = (bf16_t*)WSP(WS_WPQ); bf16_t* WG = (bf16_t*)WSP(WS_WG); bf16_t* WP = (bf16_t*)WSP(WS_WP); \
          constexpr int I_POOL = 4 * 4 * 8, I_UQ = 8 * 48, I_UKV = 8 * 64, I_SQ = 32 * 64, I_WP = 4 * 64, NITEMS = I_POOL + I_UQ + I_UKV + 3 * I_SQ + I_WP; \
          auto trp = [&](int r) -> TrP { \
            if (r < I_POOL) { const int g_ = r >> 5; return TrP{w_pool + g_ * 65536, nullptr, pool_scale + g_ * 256, WPOOL + g_ * 65536, 256, 256, 8, r & 31, 0}; } r -= I_POOL; \
            if (r < I_UQ) return TrP{w_uq, q_lat_gain, nullptr, WUQ, 1536, 512, 48, r, 1}; r -= I_UQ; \
            if (r < I_UKV) return TrP{w_ukv, kv_lat_gain, nullptr, WUKV, 2048, 512, 64, r, 0}; r -= I_UKV; \
            if (r < I_SQ) return TrP{w_out, nullptr, nullptr, WOUT, 2048, 2048, 64, r, 0}; r -= I_SQ; \
            if (r < I_SQ) return TrP{w_pq, ffn_gain, nullptr, WPQ, 2048, 2048, 64, r, 0}; r -= I_SQ; \
            if (r < I_SQ) return TrP{w_ple_gate, ple_gain, nullptr, WG, 2048, 2048, 64, r, 0}; r -= I_SQ; \
            return TrP{w_ple_proj, nullptr, nullptr, WP, 2048, 256, 64, r, 0}; }; \
          for (int it = gw; it < NITEMS; it += 2 * NGW) { const bool two = it + NGW < NITEMS; const TrP pa = trp(it), pb = trp(two ? it + NGW : it); \
            float va[32], vb[32]; tr_load(pa, va, lane); if (two) tr_load(pb, vb, lane); \
            tr_store(pa, va, scr, lane); if (two) tr_store(pb, vb, scr, lane); } } \
        asm volatile("s_waitcnt vmcnt(0) lgkmcnt(0)" ::: "memory"); __syncthreads(); } while (0)
        if (vcu & 1) PHASE_A_SIDE();
        pg8::Gemm g{XN, WIN, 2048, 2048, 2048}; pg8::StaticOrder S; S.init(M, 2048, G, bx);
        EpiA E{ZP, CQ, CKV, SSQ_CQ, SSQ_CKV, RSTDX, SBW};
        pg8::gemm_phase<EpiA, pg8::StaticOrder, true, true, true>(lds, eps, g, S, E, wave0);
        pg8::Gemm g2{XN, WIN, 2048, 2048, 512}; pg8::QuadOrder<0> S2{vcu};
        EpiKR E2{KRP, RSTDX, SBW};
        pg8::gemm_phase<EpiKR, pg8::QuadOrder<0>, true, true, true>(lds, eps, g2, S2, E2, wave0);
        if (!(vcu & 1)) PHASE_A_SIDE();
#undef PHASE_A_SIDE
    }
    xcd_barrier(bar); STAMP();
    if (DBG_STOP == 1) return;

    if (PH(2)) {
        { KArgsP ka = kargs(); unsigned char* ws = ka->ws;
          bf16_t* ZP = (bf16_t*)WSP(WS_ZP); bf16_t* WPOOL = (bf16_t*)WSP(WS_WPOOL); bf16_t* UB = (bf16_t*)WSP(WS_U);
          pg8::Gemm gp{ZP, WPOOL, 1024, 256, 256}; pg8::QuadOrder<1> Sp{vcu};
          EpiStore Ep{UB, 1024};
          pg8::gemm_phase<EpiStore, pg8::QuadOrder<1>, true>(lds, eps, gp, Sp, Ep, wave0); }
        { KArgsP ka = kargs(); unsigned char* ws = ka->ws; const float* q_norm_gain = IN_F(11);
          bf16_t* CQ = (bf16_t*)WSP(WS_CQ); bf16_t* WUQ = (bf16_t*)WSP(WS_WUQ); bf16_t* QB = (bf16_t*)WSP(WS_Q);
          float* SSQ_CQ = (float*)WSP(WS_SSQ_CQ); float* COS = (float*)WSP(WS_COS); float* SIN = (float*)WSP(WS_SIN);
          pg8::Gemm gq{CQ, WUQ, 512, 512, 512}; pg8::StaticOrder Sq; Sq.init(M, 2048, G, bx);
          EpiQ Eq{QB, SSQ_CQ, q_norm_gain, COS, SIN};
          pg8::gemm_phase<EpiQ, pg8::StaticOrder, true>(lds, eps, gq, Sq, Eq, wave0); }
        { KArgsP ka = kargs(); unsigned char* ws = ka->ws; const float* k_norm_gain = IN_F(12);
          bf16_t* CKV = (bf16_t*)WSP(WS_CKV); bf16_t* WUKV = (bf16_t*)WSP(WS_WUKV); bf16_t* KB = (bf16_t*)WSP(WS_K); bf16_t* VB = (bf16_t*)WSP(WS_V);
          float* SSQ_CKV = (float*)WSP(WS_SSQ_CKV); float* KRP = (float*)WSP(WS_KRP); float* COS = (float*)WSP(WS_COS); float* SIN = (float*)WSP(WS_SIN);
          pg8::Gemm gk{CKV, WUKV, 512, 512, 512}; pg8::StaticOrder Sk; Sk.init(M, 2048, G, bx);
          EpiKV Ek{KB, VB, SSQ_CKV, KRP, k_norm_gain, COS, SIN};
          pg8::gemm_phase<EpiKV, pg8::StaticOrder, true>(lds, eps, gk, Sk, Ek, wave0); }
    }
    xcd_barrier(bar); STAMP();
    if (DBG_STOP == 2) return;

    if (PH(3)) {
        KArgsP ka = kargs(); unsigned char* ws = ka->ws;
        bf16_t* UB = (bf16_t*)WSP(WS_U); bf16_t* YMIX = (bf16_t*)WSP(WS_R1); bf16_t* QB = (bf16_t*)WSP(WS_Q); bf16_t* KB = (bf16_t*)WSP(WS_K); bf16_t* VB = (bf16_t*)WSP(WS_V);
        PHASE_IDS();
        {
            const int g = wave & 3, c0 = (32 * g + (lane & 31)) * 8, row0 = vcu * 64 + 32 * (wave >> 2) + 16 * (lane >> 5);
#define FILT_ACC(OP, V) do { a[0] OP bf_lo((V).x); a[1] OP bf_hi((V).x); a[2] OP bf_lo((V).y); a[3] OP bf_hi((V).y); a[4] OP bf_lo((V).z); a[5] OP bf_hi((V).z); a[6] OP bf_lo((V).w); a[7] OP bf_hi((V).w); } while (0)
#define FILT(W) do { const int tl0 = row0 & (SEQ - 1); const bool hist = tl0 != 0; u32x4 h[(W) + 16]; \
                _Pragma("unroll") for (int j = 0; j < (W) + 16; ++j) { const bool ok = hist || j >= (W); h[j] = *(const u32x4*)(UB + (size_t)(ok ? row0 - (W) + j : row0) * 1024 + c0); if (!ok) h[j] = (u32x4){0u, 0u, 0u, 0u}; } \
                float a[8]; _Pragma("unroll") for (int e = 0; e < 8; ++e) a[e] = 0.f; \
                _Pragma("unroll") for (int j = 0; j < (W); ++j) FILT_ACC(+=, h[j]); \
                _Pragma("unroll") for (int rI = 0; rI < 16; ++rI) { const int row = row0 + rI, tl = tl0 + rI; const int cnt = (tl + 1 < (W)) ? tl + 1 : (W); const u32x4 cur = h[(W) + rI]; \
                    FILT_ACC(+=, cur); FILT_ACC(-=, h[rI]); \
                    const float ic = 1.f / (float)cnt; u32x4 o; \
                    o.x = cvtpk(a[0] * ic - bf_lo(cur.x), a[1] * ic - bf_hi(cur.x)); o.y = cvtpk(a[2] * ic - bf_lo(cur.y), a[3] * ic - bf_hi(cur.y)); \
                    o.z = cvtpk(a[4] * ic - bf_lo(cur.z), a[5] * ic - bf_hi(cur.z)); o.w = cvtpk(a[6] * ic - bf_lo(cur.w), a[7] * ic - bf_hi(cur.w)); \
                    *(u32x4*)(YMIX + (size_t)row * DM + c0) = o; } } while (0)
            if (g == 0) FILT(2); else if (g == 1) FILT(4); else if (g == 2) FILT(8); else FILT(16);
#undef FILT
#undef FILT_ACC
        }
        if (G == 256) {
            const int bh = vcu >> 2, s = vcu & 3;
            att::attn_unit(bh >> 3, bh & 7, s, QB, KB, VB, YMIX, (char*)lds_raw, lds, wave0);
            att::attn_unit(bh >> 3, bh & 7, 7 - s, QB, KB, VB, YMIX, (char*)lds_raw, lds, wave0);
        }
    }
    xcd_barrier(bar); STAMP();
    if (DBG_STOP == 3) return;

    if (PH(4)) {
        KArgsP ka = kargs(); unsigned char* ws = ka->ws; const float* x = IN_F(0); bf16_t* H1B = (bf16_t*)WSP(WS_H2B);
        bf16_t* YMIX = (bf16_t*)WSP(WS_R1); bf16_t* WOUT = (bf16_t*)WSP(WS_WOUT); float* SSQ_H1 = (float*)WSP(WS_SSQ_H1);
        pg8::Gemm g{YMIX, WOUT, 2048, 2048, 2048}; pg8::StaticOrder S; S.init(M, 2048, G, bx);
        EpiH1 E{x, H1B, SSQ_H1};
        pg8::gemm_phase<EpiH1, pg8::StaticOrder, true>(lds, eps, g, S, E, wave0);
    }
    xcd_barrier(bar); STAMP();
    if (DBG_STOP == 4) return;

    if (PH(5)) {
        KArgsP ka = kargs(); unsigned char* ws = ka->ws;
        bf16_t* H1B = (bf16_t*)WSP(WS_H2B); bf16_t* WPQ = (bf16_t*)WSP(WS_WPQ); bf16_t* QP = (bf16_t*)WSP(WS_R1); float* SSQ_H1 = (float*)WSP(WS_SSQ_H1); float* RSTD2 = (float*)WSP(WS_RSTD2);
        pg8::Gemm g{H1B, WPQ, 2048, 2048, 2048}; pg8::PairOrder S{vcu};
        EpiQP E{QP, SSQ_H1, RSTD2};
        pg8::gemm_phase<EpiQP, pg8::PairOrder, true>(lds, eps, g, S, E, wave0);
    }
    asm volatile("s_waitcnt vmcnt(0)" ::: "memory"); __syncthreads();
    if (tid_of(wave0) == 0) { __builtin_amdgcn_fence(__ATOMIC_ACQUIRE, "agent"); asm volatile("s_waitcnt vmcnt(0)" ::: "memory"); }
    __syncthreads(); STAMP();
    if (DBG_STOP == 5) return;

    if (PH(6)) {
        KArgsP ka = kargs(); unsigned char* ws = ka->ws;
        bf16_t* QP = (bf16_t*)WSP(WS_R1); bf16_t* SKB = (bf16_t*)WSP(WS_SK); int* PIDX = (int*)WSP(WS_PIDX); float* PGATE = (float*)WSP(WS_PGATE);
        PHASE_IDS();
        LAS unsigned char* SKL = lds;
        LAS float* SC = (LAS float*)(lds + 65536 + wave * 10816);
        LAS float* TKV = (LAS float*)(lds + 65536 + wave * 10816 + 8256);
        LAS unsigned char* TKI = lds + 65536 + wave * 10816 + 8256 + 2048;
        const int fr = lane & 15, fq = lane >> 4; const int h = vcu & 7;
#pragma unroll
        for (int i = 0; i < 8; ++i) { const int p = tid + 512 * i, side = p >> 11, key = (p >> 4) & 127, c = p & 15;
            const u32x4 v = *(const u32x4*)(SKB + (size_t)side * 131072 + (size_t)h * 16384 + key * 128 + c * 8);
            *(LAS u32x4*)(SKL + side * 32768 + key * 256 + ((c ^ (key & 15)) << 4)) = v; }
        __syncthreads();
        for (int bi = 0; bi < 4; ++bi) {
            const int tb = (vcu >> 3) * 32 + wave * 4 + bi, t0 = tb * 16;
#pragma unroll 1
            for (int side = 0; side < 2; ++side) {
                bf16x8 qf[4];
#pragma unroll
                for (int kk = 0; kk < 4; ++kk) qf[kk] = *(const bf16x8*)(QP + (size_t)(t0 + fr) * DM + h * 256 + side * 128 + kk * 32 + 8 * fq);
                const LAS unsigned char* skl = SKL + side * 32768 + fr * 256;
#pragma unroll
                for (int nt = 0; nt < 8; ++nt) { f32x4 a = {0.f, 0.f, 0.f, 0.f};
#pragma unroll
                    for (int kk = 0; kk < 4; ++kk) { const bf16x8 kf = *(const LAS bf16x8*)(skl + nt * 4096 + (((kk * 4 + fq) ^ fr) << 4));
                        a = __builtin_amdgcn_mfma_f32_16x16x32_bf16(kf, qf[kk], a, 0, 0, 0); }
#pragma unroll
                    for (int i = 0; i < 4; ++i) SC[fr * 129 + nt * 16 + 4 * fq + i] = a[i]; }
                asm volatile("s_waitcnt lgkmcnt(0)" ::: "memory");
                const int tok = lane >> 2, q4 = lane & 3; float v[32];
#pragma unroll
                for (int i = 0; i < 32; ++i) v[i] = __builtin_bit_cast(float, (__builtin_bit_cast(unsigned, SC[tok * 129 + 4 * i + q4]) & ~0x7Fu) | (unsigned)(4 * i + q4));
                bitonic_sort_desc<32>(v); QUAD_MERGE16(v, 0xB1); QUAD_MERGE16(v, 0x4E);
                if (q4 == 0) {
#pragma unroll
                    for (int r = 0; r < 16; ++r) { const int bk = (int)(__builtin_bit_cast(unsigned, v[r]) & 0x7Fu); TKV[(side * 16 + tok) * 16 + r] = SC[tok * 129 + bk]; TKI[(side * 16 + tok) * 16 + r] = (unsigned char)bk; } }
                asm volatile("s_waitcnt lgkmcnt(0)" ::: "memory");
            }
            {
                const int tok = lane >> 2, q4 = lane & 3; float c[32];
                const LAS float* V1 = TKV + tok * 16; const LAS float* V2 = TKV + (16 + tok) * 16;
#define CAND(slot, a, bi) do { const int b_ = q4 + 4 * (bi); const float s_ = V1[a] + V2[b_]; \
    c[slot] = (((a) + 1) * (b_ + 1) <= 16) ? __builtin_bit_cast(float, (__builtin_bit_cast(unsigned, s_) & ~0xFFu) | (unsigned)((a) * 16 + b_)) : -INFINITY; } while (0)
                CAND(0, 0, 0); CAND(1, 0, 1); CAND(2, 0, 2); CAND(3, 0, 3); CAND(4, 1, 0); CAND(5, 1, 1); CAND(6, 2, 0); CAND(7, 2, 1);
                CAND(8, 3, 0); CAND(9, 4, 0); CAND(10, 5, 0); CAND(11, 6, 0); CAND(12, 7, 0); CAND(13, 8, 0); CAND(14, 9, 0); CAND(15, 10, 0);
                CAND(16, 11, 0); CAND(17, 12, 0); CAND(18, 13, 0); CAND(19, 14, 0); CAND(20, 15, 0);
#undef CAND
#pragma unroll
                for (int i = 21; i < 32; ++i) c[i] = -INFINITY;
                bitonic_sort_desc<32>(c); QUAD_MERGE16(c, 0xB1); QUAD_MERGE16(c, 0x4E);
                int co[4];
#pragma unroll
                for (int ri = 0; ri < 4; ++ri) { const float x_ = q4 == 0 ? c[4 * ri] : q4 == 1 ? c[4 * ri + 1] : q4 == 2 ? c[4 * ri + 2] : c[4 * ri + 3]; co[ri] = (int)(__builtin_bit_cast(unsigned, x_) & 0xFFu); }
                float sv[4]; float mx = -INFINITY;
#pragma unroll
                for (int ri = 0; ri < 4; ++ri) { sv[ri] = V1[co[ri] >> 4] + V2[co[ri] & 15]; mx = fmaxf(mx, sv[ri]); }
                mx = quad_max(mx);
                float eo[4]; float esum = 0.f;
#pragma unroll
                for (int ri = 0; ri < 4; ++ri) { eo[ri] = __builtin_amdgcn_exp2f((sv[ri] - mx) * 1.4426950408889634f); esum += eo[ri]; }
                esum = quad_sum(esum);
                const float inv = 1.f / esum;
#pragma unroll
                for (int ri = 0; ri < 4; ++ri) { const int e1 = (int)TKI[tok * 16 + (co[ri] >> 4)], e2 = (int)TKI[(16 + tok) * 16 + (co[ri] & 15)];
                    const size_t oi = (size_t)(t0 + tok) * 128 + h * 16 + 4 * ri + q4;
                    PIDX[oi] = e1 * 128 + e2; PGATE[oi] = eo[ri] * inv; }
            }
            asm volatile("s_waitcnt lgkmcnt(0)" ::: "memory");
        }
    }
    xcd_barrier(bar); STAMP();
    if (DBG_STOP == 6) return;


    if (PH(7)) {
        PHASE_IDS();
        const int xc = bx & 7, wl = (bx >> 3) * NWAVES + wave;
        const int gi = lane >> 3, cj = lane & 7; const unsigned cj16 = 16u * (unsigned)cj;
        const int tpw = M / ((G >> 3) * NWAVES);
        {
            KArgsP ka = kargs(); unsigned char* ws = ka->ws;
            const bf16_t* H1B = (const bf16_t*)WSP(WS_H2B); const unsigned char* TU = WSP(WS_EU); const int* PIDX = (const int*)WSP(WS_PIDX); const float* ffn_gain = IN_F(14);
            LAS unsigned char* xl = lds + wave * 8448; LAS float* xs = (LAS float*)(xl + 8192);
#define F1_LOADIDX(n_, EV) do { const int nn_ = (n_) < tpw ? (n_) : tpw - 1; const size_t t_ = (size_t)(wl * tpw + nn_); \
        _Pragma("unroll") for (int q = 0; q < 4; ++q) EV[q] = *(const u32x4*)(PIDX + t_ * 128 + 16 * gi + 4 * q); } while (0)
#define F1_GATHER(EV, UU) do { _Pragma("unroll") for (int q = 0; q < 4; ++q) { UU[4 * q] = *(const u32x4*)(tus + ((EV[q].x << 7) | cj16)); UU[4 * q + 1] = *(const u32x4*)(tus + ((EV[q].y << 7) | cj16)); \
        UU[4 * q + 2] = *(const u32x4*)(tus + ((EV[q].z << 7) | cj16)); UU[4 * q + 3] = *(const u32x4*)(tus + ((EV[q].w << 7) | cj16)); } } while (0)
#define F1_COMPUTE(n_, UU) do { const u32x4 xq = *(const LAS u32x4*)(xl + (n_) * 128 + cj16); const float sx = xs[(n_)]; f32x4 pr[4]; \
        _Pragma("unroll") for (int g = 0; g < 16; ++g) { int d = __builtin_amdgcn_sdot4((int)UU[g].x, (int)xq.x, 0, false); d = __builtin_amdgcn_sdot4((int)UU[g].y, (int)xq.y, d, false); \
            d = __builtin_amdgcn_sdot4((int)UU[g].z, (int)xq.z, d, false); d = __builtin_amdgcn_sdot4((int)UU[g].w, (int)xq.w, d, false); pr[g >> 2][g & 3] = (float)oct_sum_i(d) * sx; } \
        if (cj == 0) { bf16_t* po = PART + (size_t)(wl * tpw + (n_)) * 128 + 16 * gi; __builtin_nontemporal_store(pack8(pr[0], pr[1]), (u32x4*)po); __builtin_nontemporal_store(pack8(pr[2], pr[3]), (u32x4*)(po + 8)); } } while (0)
#pragma unroll 1
            for (int p = 0; p < 2; ++p) {
                const int s = 2 * xc + p; const unsigned char* tus = TU + (size_t)s * (16384 * 128);
                bf16_t* PART = (bf16_t*)(p == 0 ? WSP(WS_PART0) : WSP(WS_PART1)) + (size_t)xc * M * 128;
                {
                    float gsl[16];
#pragma unroll
                    for (int i = 0; i < 16; ++i) gsl[i] = ffn_gain[128 * s + 16 * cj + i];
#pragma unroll 2
                    for (int o = 0; o < tpw; o += 8) { const size_t t_ = (size_t)(wl * tpw + o + gi);
                        const u32x4 XA = *(const u32x4*)(H1B + t_ * DM + 128 * s + 16 * cj), XB = *(const u32x4*)(H1B + t_ * DM + 128 * s + 16 * cj + 8);
                        const unsigned xw[8] = {XA.x, XA.y, XA.z, XA.w, XB.x, XB.y, XB.z, XB.w}; float xf[16]; float mx = 0.f;
#pragma unroll
                        for (int i = 0; i < 8; ++i) { xf[2 * i] = bf_lo(xw[i]) * gsl[2 * i]; xf[2 * i + 1] = bf_hi(xw[i]) * gsl[2 * i + 1]; mx = fmaxf(mx, fmaxf(fabsf(xf[2 * i]), fabsf(xf[2 * i + 1]))); }
                        mx = oct_max(mx); const float sx = mx > 0.f ? mx * (1.f / 127.f) : 1.f; const float inv = 1.f / sx; u32x4 xq;
#pragma unroll
                        for (int i = 0; i < 4; ++i) { const int q0 = (int)rintf(xf[4 * i] * inv), q1 = (int)rintf(xf[4 * i + 1] * inv), q2 = (int)rintf(xf[4 * i + 2] * inv), q3 = (int)rintf(xf[4 * i + 3] * inv);
                            xq[i] = (unsigned)(q0 & 0xff) | ((unsigned)(q1 & 0xff) << 8) | ((unsigned)(q2 & 0xff) << 16) | ((unsigned)(q3 & 0xff) << 24); }
                        *(LAS u32x4*)(xl + (o + gi) * 128 + 16 * cj) = xq; if (cj == 0) xs[o + gi] = sx; }
                    asm volatile("s_waitcnt lgkmcnt(0)" ::: "memory");
                }
                u32x4 evA[4], evB[4], uuA[16], uuB[16];
                F1_LOADIDX(0, evA); F1_LOADIDX(1, evB); F1_GATHER(evA, uuA);
#pragma unroll 1
                for (int n = 0; n < tpw; n += 2) {
                    F1_GATHER(evB, uuB); F1_LOADIDX(n + 2, evA); F1_COMPUTE(n, uuA);
                    F1_GATHER(evA, uuA); F1_LOADIDX(n + 3, evB); F1_COMPUTE(n + 1, uuB);
                }
                asm volatile("s_waitcnt lgkmcnt(0)" ::: "memory");
            }
#undef F1_LOADIDX
#undef F1_GATHER
#undef F1_COMPUTE
        }
        xcd_barrier(bar);
        {
            KArgsP ka = kargs(); unsigned char* ws = ka->ws;
            const bf16_t* P0 = (const bf16_t*)WSP(WS_PART0); const bf16_t* P1 = (const bf16_t*)WSP(WS_PART1); const int* PIDX = (const int*)WSP(WS_PIDX); const float* PGATE = (const float*)WSP(WS_PGATE);
            const float* SU = (const float*)WSP(WS_SU); const float* SV = (const float*)WSP(WS_SV); const float* RSTD2 = (const float*)WSP(WS_RSTD2); unsigned* AQ = (unsigned*)WSP(WS_AQ); float* AS = (float*)WSP(WS_AS);
            for (int tp = gw; tp < M / 2; tp += NGW) {
                const int t = 2 * tp + (lane >> 5), li = lane & 31; const size_t i = (size_t)t * 128 + 4 * li;
                f32x4 sum = {0.f, 0.f, 0.f, 0.f};
#pragma unroll
                for (int x8 = 0; x8 < 8; ++x8) { const u32x2 a = __builtin_nontemporal_load((const u32x2*)(P0 + (size_t)x8 * M * 128 + i)), b = __builtin_nontemporal_load((const u32x2*)(P1 + (size_t)x8 * M * 128 + i));
                    sum += (f32x4){bf_lo(a.x), bf_hi(a.x), bf_lo(a.y), bf_hi(a.y)} + (f32x4){bf_lo(b.x), bf_hi(b.x), bf_lo(b.y), bf_hi(b.y)}; }
                const u32x4 e4 = *(const u32x4*)(PIDX + i); const f32x4 g4 = *(const f32x4*)(PGATE + i); const float rs = RSTD2[t];
                const unsigned ee[4] = {e4.x, e4.y, e4.z, e4.w}; float a[4]; float mx = 0.f;
#pragma unroll
                for (int c = 0; c < 4; ++c) { a[c] = gelu_tanh(sum[c] * SU[ee[c]] * rs) * g4[c] * SV[ee[c]]; mx = fmaxf(mx, fabsf(a[c])); }
                mx = oct_max(mx); mx = fmaxf(mx, DPP_F(mx, 0x128)); mx = fmaxf(mx, __shfl_xor(mx, 16));
                const float sc = mx > 0.f ? mx * (1.f / 127.f) : 1.f; const float inv = 1.f / sc;
                const int q0 = (int)rintf(a[0] * inv), q1 = (int)rintf(a[1] * inv), q2 = (int)rintf(a[2] * inv), q3 = (int)rintf(a[3] * inv);
                AQ[(size_t)t * 32 + li] = (unsigned)(q0 & 0xff) | ((unsigned)(q1 & 0xff) << 8) | ((unsigned)(q2 & 0xff) << 16) | ((unsigned)(q3 & 0xff) << 24);
                if (li == 0) AS[t] = sc;
            }
        }
        xcd_barrier(bar);
        {
            KArgsP ka = kargs(); unsigned char* ws = ka->ws;
            const unsigned char* TV = WSP(WS_EV); const int* PIDX = (const int*)WSP(WS_PIDX); const unsigned* AQ = (const unsigned*)WSP(WS_AQ); const float* AS = (const float*)WSP(WS_AS);
            bf16_t* H2B = (bf16_t*)WSP(WS_H2B); float* SSQ2 = (float*)WSP(WS_SSQ2);
            const int nit = tpw;
#define F3_LOADIDX(it_, EV, AQV) do { const int ii_ = (it_) < nit ? (it_) : nit - 1; const size_t t_ = (size_t)(wl * tpw + (ii_ >> 3) * 8 + gi); const int kb_ = ii_ & 7; \
        _Pragma("unroll") for (int q = 0; q < 4; ++q) EV[q] = *(const u32x4*)(PIDX + t_ * 128 + 16 * kb_ + 4 * q); \
        AQV = *(const u32x4*)(AQ + t_ * 32 + 4 * kb_); } while (0)
#define F3_GATHER(EV, VV) do { _Pragma("unroll") for (int q = 0; q < 4; ++q) { VV[4 * q] = *(const u32x4*)(tvs + ((EV[q].x << 7) | cj16)); VV[4 * q + 1] = *(const u32x4*)(tvs + ((EV[q].y << 7) | cj16)); \
        VV[4 * q + 2] = *(const u32x4*)(tvs + ((EV[q].z << 7) | cj16)); VV[4 * q + 3] = *(const u32x4*)(tvs + ((EV[q].w << 7) | cj16)); } } while (0)
#define F3_T4(W, Q, R0, R1, R2, R3, AW) do { const unsigned a_ = __builtin_amdgcn_perm(R1, R0, 0x05010400u), b_ = __builtin_amdgcn_perm(R1, R0, 0x07030602u), c_ = __builtin_amdgcn_perm(R3, R2, 0x05010400u), d_ = __builtin_amdgcn_perm(R3, R2, 0x07030602u); \
        acc[4 * (W) + 0] = __builtin_amdgcn_sdot4((int)__builtin_amdgcn_perm(c_, a_, 0x05040100u), (int)(AW), acc[4 * (W) + 0], false); acc[4 * (W) + 1] = __builtin_amdgcn_sdot4((int)__builtin_amdgcn_perm(c_, a_, 0x07060302u), (int)(AW), acc[4 * (W) + 1], false); \
        acc[4 * (W) + 2] = __builtin_amdgcn_sdot4((int)__builtin_amdgcn_perm(d_, b_, 0x05040100u), (int)(AW), acc[4 * (W) + 2], false); acc[4 * (W) + 3] = __builtin_amdgcn_sdot4((int)__builtin_amdgcn_perm(d_, b_, 0x07060302u), (int)(AW), acc[4 * (W) + 3], false); } while (0)
#define F3_Q(Q, VV, AW) do { F3_T4(0, Q, VV[4 * (Q)].x, VV[4 * (Q) + 1].x, VV[4 * (Q) + 2].x, VV[4 * (Q) + 3].x, AW); F3_T4(1, Q, VV[4 * (Q)].y, VV[4 * (Q) + 1].y, VV[4 * (Q) + 2].y, VV[4 * (Q) + 3].y, AW); \
        F3_T4(2, Q, VV[4 * (Q)].z, VV[4 * (Q) + 1].z, VV[4 * (Q) + 2].z, VV[4 * (Q) + 3].z, AW); F3_T4(3, Q, VV[4 * (Q)].w, VV[4 * (Q) + 1].w, VV[4 * (Q) + 2].w, VV[4 * (Q) + 3].w, AW); } while (0)
#define F3_COMPUTE(it_, VV, AQV) do { F3_Q(0, VV, AQV.x); F3_Q(1, VV, AQV.y); F3_Q(2, VV, AQV.z); F3_Q(3, VV, AQV.w); \
        if (((it_) & 7) == 7) { const size_t t_ = (size_t)(wl * tpw + ((it_) >> 3) * 8 + gi); const float as_ = AS[t_]; bf16_t* o = H2B + t_ * DM + 128 * s + 16 * cj; f32x4 hh[4]; float s2 = 0.f; \
            const u32x4 ha_ = *(const u32x4*)o, hb_ = *(const u32x4*)(o + 8); const unsigned hw_[8] = {ha_.x, ha_.y, ha_.z, ha_.w, hb_.x, hb_.y, hb_.z, hb_.w}; \
            _Pragma("unroll") for (int i = 0; i < 4; ++i) { hh[i] = (f32x4){bf_lo(hw_[2 * i]), bf_hi(hw_[2 * i]), bf_lo(hw_[2 * i + 1]), bf_hi(hw_[2 * i + 1])} + (f32x4){(float)acc[4 * i], (float)acc[4 * i + 1], (float)acc[4 * i + 2], (float)acc[4 * i + 3]} * as_; s2 += sq4(hh[i]); } \
            *(u32x4*)o = pack8(hh[0], hh[1]); *(u32x4*)(o + 8) = pack8(hh[2], hh[3]); \
            s2 = oct_sum(s2); if (cj == 0) SSQ2[t_ * 16 + s] = s2; \
            _Pragma("unroll") for (int i = 0; i < 16; ++i) acc[i] = 0; } } while (0)
#pragma unroll 1
            for (int p = 0; p < 2; ++p) {
                const int s = 2 * xc + p; const unsigned char* tvs = TV + (size_t)s * (16384 * 128);
                u32x4 evA[4], evB[4], vvA[16], vvB[16], aqA, aqB, aqC; int acc[16];
#pragma unroll
                for (int i = 0; i < 16; ++i) acc[i] = 0;
                F3_LOADIDX(0, evA, aqA); F3_LOADIDX(1, evB, aqB); F3_GATHER(evA, vvA);
#pragma unroll 1
                for (int it = 0; it < nit; it += 2) {
                    F3_GATHER(evB, vvB); F3_LOADIDX(it + 2, evA, aqC); F3_COMPUTE(it, vvA, aqA); aqA = aqC;
                    F3_GATHER(evA, vvA); F3_LOADIDX(it + 3, evB, aqC); F3_COMPUTE(it + 1, vvB, aqB); aqB = aqC;
                }
            }
#undef F3_LOADIDX
#undef F3_GATHER
#undef F3_T4
#undef F3_Q
#undef F3_COMPUTE
        }
    }
    xcd_barrier(bar); STAMP();
    if (DBG_STOP == 7) return;

    if (PH(8)) {
        KArgsP ka = kargs(); unsigned char* ws = ka->ws; float* OUT = ka->out;
        bf16_t* PB = (bf16_t*)WSP(WS_PB); bf16_t* WP = (bf16_t*)WSP(WS_WP); bf16_t* PROJ = (bf16_t*)WSP(WS_R1); bf16_t* H2B = (bf16_t*)WSP(WS_H2B); bf16_t* WG = (bf16_t*)WSP(WS_WG); float* SSQ2 = (float*)WSP(WS_SSQ2);
        pg8::StaticOrder S; S.init(M, 2048, G, bx);
        pg8::Gemm gp{PB, WP, 256, 256, 256};
        EpiStore Ep{PROJ, 2048};
        pg8::gemm_phase<EpiStore, pg8::StaticOrder, true>(lds, eps, gp, S, Ep, wave0);
        pg8::Gemm gg{H2B, WG, 2048, 2048, 2048};
        EpiGate Eg{OUT, PROJ, SSQ2, H2B};
        pg8::gemm_phase<EpiGate, pg8::StaticOrder, true>(lds, eps, gg, S, Eg, wave0);
    }
#ifdef TIMING
    xcd_barrier(bar); STAMP();
    if (blockIdx.x == 0 && threadIdx.x == 0) { KArgsP ka = kargs(); float* OUT = ka->out; OUT[0] += ts_val; }
#endif
}

extern "C" void kernel_launch(void* const* d_in, const int* in_sizes, int n_in, void* d_out, int out_size, void* d_ws, size_t ws_size, hipStream_t stream) {
    static int ready = 0;
    if (ready == 0) {
        if (n_in != 23 || out_size != M * DM || ws_size < WS_END) { fprintf(stderr, "kernel_launch: unexpected shapes (n_in %d, out %d, ws %zu)\n", n_in, out_size, ws_size); ready = -1; return; }
        if (hipFuncSetAttribute((const void*)fwd_kernel, hipFuncAttributeMaxDynamicSharedMemorySize, LDS_BYTES) != hipSuccess) { fprintf(stderr, "kernel_launch: hipFuncSetAttribute failed\n"); ready = -1; return; }
        ready = 1;
    }
    if (ready < 0) return;
    (void)hipMemsetAsync((char*)d_ws + WS_CTL, 0, CTL_ZERO_BYTES, stream);
    Args a{};
    for (int i = 0; i < 23; ++i) a.in[i] = (const float*)d_in[i];
    a.out = (float*)d_out; a.ws = (unsigned char*)d_ws;
    hipLaunchKernelGGL(fwd_kernel, dim3(256), dim3(NWAVES * 64), LDS_BYTES, stream, a);
}
```

```cpp
#include <hip/hip_runtime.h>
#include <cstdio>
#include <cstdint>
#include <type_traits>

#define LAS __attribute__((address_space(3)))
#define GAS __attribute__((address_space(1)))
typedef unsigned short bf16_t;
typedef short bf16x8 __attribute__((ext_vector_type(8)));
typedef short s16x4 __attribute__((ext_vector_type(4)));
typedef float f32x4 __attribute__((ext_vector_type(4)));
typedef float f32x2 __attribute__((ext_vector_type(2)));
typedef float f32x16 __attribute__((ext_vector_type(16)));
typedef unsigned u32x4 __attribute__((ext_vector_type(4)));
typedef int i32x4 __attribute__((ext_vector_type(4)));
typedef unsigned u32x2 __attribute__((ext_vector_type(2)));
typedef __bf16 bf16x2_t __attribute__((ext_vector_type(2)));

constexpr int M = 16384, DM = 2048, SEQ = 2048, NB = 8, NH = 8;
constexpr float EPS = 1e-6f;
constexpr size_t MiB = 1u << 20;
constexpr size_t WS_CTL = 0, CTL_ZERO_BYTES = 1 * MiB;
constexpr size_t WS_WIN = 1 * MiB;
constexpr size_t WS_WPOOL = 10 * MiB;
constexpr size_t WS_SK = 10 * MiB + 512 * 1024;
constexpr size_t WS_WUQ = 11 * MiB;
constexpr size_t WS_WUKV = 13 * MiB;
constexpr size_t WS_WOUT = 15 * MiB;
constexpr size_t WS_WPQ = 23 * MiB;
constexpr size_t WS_WG = 31 * MiB;
constexpr size_t WS_WP = 39 * MiB;
constexpr size_t WS_PB = 40 * MiB;
constexpr size_t WS_COS = 48 * MiB, WS_SIN = 50 * MiB;
constexpr size_t WS_SSQ_CQ = 52 * MiB, WS_SSQ_CKV = 52 * MiB + 512 * 1024, WS_SSQ_H1 = 53 * MiB, WS_RSTD2 = 55 * MiB, WS_RSTDX = 55 * MiB + 512 * 1024;
constexpr size_t WS_EU = 56 * MiB, WS_EV = 88 * MiB;
constexpr size_t WS_SU = 55 * MiB + 128 * 1024, WS_SV = 55 * MiB + 256 * 1024;
constexpr size_t WS_AQ = 346 * MiB, WS_AS = 349 * MiB;
constexpr size_t WS_SSQ2 = 344 * MiB;
constexpr size_t WS_XQ = 184 * MiB;
constexpr size_t WS_SBW = 55 * MiB + 640 * 1024;
constexpr size_t WS_XB = 120 * MiB;
constexpr size_t WS_PART0 = 184 * MiB, WS_PART1 = 424 * MiB;
constexpr size_t WS_R1 = 184 * MiB;
constexpr size_t WS_ZP = 248 * MiB, WS_U = 280 * MiB, WS_H2B = 248 * MiB;
constexpr size_t WS_CQ = 312 * MiB, WS_CKV = 328 * MiB, WS_KRP = 344 * MiB, WS_PIDX = 312 * MiB, WS_PGATE = 320 * MiB;
constexpr size_t WS_Q = 360 * MiB, WS_K = 408 * MiB, WS_V = 456 * MiB;
constexpr size_t WS_END = 488 * MiB;
constexpr int RING_BYTES = 131072, EPI_OFF = RING_BYTES, EPI_BYTES = 8192, LDS_BYTES = 163840, LDSCTL_OFF = LDS_BYTES - 1024, MISC_OFF = LDSCTL_OFF + 320;
constexpr int NWAVES = 8;

__device__ __forceinline__ unsigned cvtpk(float lo, float hi) { f32x2 v = {lo, hi}; bf16x2_t b = __builtin_convertvector(v, bf16x2_t); return __builtin_bit_cast(unsigned, b); }
__device__ __forceinline__ float bf_lo(unsigned w) { return __builtin_bit_cast(float, w << 16); }
__device__ __forceinline__ float bf_hi(unsigned w) { return __builtin_bit_cast(float, w & 0xffff0000u); }
__device__ __forceinline__ float ub0(unsigned w) { return (float)(w & 0xffu); }
__device__ __forceinline__ float ub1(unsigned w) { float r; asm("v_cvt_f32_ubyte1 %0, %1" : "=v"(r) : "v"(w)); return r; }
__device__ __forceinline__ float ub2(unsigned w) { float r; asm("v_cvt_f32_ubyte2 %0, %1" : "=v"(r) : "v"(w)); return r; }
__device__ __forceinline__ float ub3(unsigned w) { float r; asm("v_cvt_f32_ubyte3 %0, %1" : "=v"(r) : "v"(w)); return r; }
__device__ __forceinline__ float dpp_xor1(float x) { return __builtin_bit_cast(float, __builtin_amdgcn_mov_dpp(__builtin_bit_cast(int, x), 0xB1, 0xF, 0xF, true)); }
__device__ __forceinline__ float dpp_xor2(float x) { return __builtin_bit_cast(float, __builtin_amdgcn_mov_dpp(__builtin_bit_cast(int, x), 0x4E, 0xF, 0xF, true)); }
#define DPP_I(x, ctrl) __builtin_amdgcn_mov_dpp((x), (ctrl), 0xF, 0xF, true)
#define DPP_F(x, ctrl) __builtin_bit_cast(float, __builtin_amdgcn_mov_dpp(__builtin_bit_cast(int, (float)(x)), (ctrl), 0xF, 0xF, true))
__device__ __forceinline__ int oct_sum_i(int v) { v += DPP_I(v, 0xB1); v += DPP_I(v, 0x4E); return v + DPP_I(v, 0x141); }
__device__ __forceinline__ float oct_sum(float v) { v += DPP_F(v, 0xB1); v += DPP_F(v, 0x4E); return v + DPP_F(v, 0x141); }
__device__ __forceinline__ float oct_max(float v) { v = fmaxf(v, DPP_F(v, 0xB1)); v = fmaxf(v, DPP_F(v, 0x4E)); return fmaxf(v, DPP_F(v, 0x141)); }
template <int N> __device__ __forceinline__ void bitonic_sort_desc(float (&v)[N]) {
#pragma unroll
    for (int k = 2; k <= N; k <<= 1)
#pragma unroll
        for (int j = k >> 1; j > 0; j >>= 1)
#pragma unroll
            for (int i = 0; i < N; ++i) { const int l = i ^ j; if (l > i) { const bool desc = (i & k) == 0; const float a = v[i], b = v[l]; const float hi = fmaxf(a, b), lo = fminf(a, b); v[i] = desc ? hi : lo; v[l] = desc ? lo : hi; } }
}
#define QUAD_MERGE16(v, CTRL) do { float p_[16]; _Pragma("unroll") for (int i = 0; i < 16; ++i) p_[i] = DPP_F(v[15 - i], CTRL); \
    _Pragma("unroll") for (int i = 0; i < 16; ++i) v[i] = fmaxf(v[i], p_[i]); \
    _Pragma("unroll") for (int j = 8; j > 0; j >>= 1) _Pragma("unroll") for (int i = 0; i < 16; ++i) { const int l = i ^ j; if (l > i) { const float a = v[i], b = v[l]; v[i] = fmaxf(a, b); v[l] = fminf(a, b); } } } while (0)
template <int N> __device__ __forceinline__ float tree_max(const float* v) {
    if constexpr (N == 1) return v[0]; else return fmaxf(tree_max<N / 2>(v), tree_max<N - N / 2>(v + N / 2));
}
__device__ __forceinline__ float quad_max(float m) { m = fmaxf(m, dpp_xor1(m)); return fmaxf(m, dpp_xor2(m)); }
__device__ __forceinline__ float quad_sum(float m) { m += dpp_xor1(m); return m + dpp_xor2(m); }
__device__ __forceinline__ float wave_max(float v) {
#pragma unroll
    for (int o = 1; o < 64; o <<= 1) v = fmaxf(v, __shfl_xor(v, o));
    return v;
}
__device__ __forceinline__ int wave_sum_i(int v) {
#pragma unroll
    for (int o = 1; o < 64; o <<= 1) v += __shfl_xor(v, o);
    return v;
}
__device__ __forceinline__ float wave_sum(float v) {
#pragma unroll
    for (int o = 1; o < 64; o <<= 1) v += __shfl_xor(v, o);
    return v;
}
__device__ __forceinline__ int tid_of(int wave0) { int l; asm volatile("v_mbcnt_lo_u32_b32 %0, -1, 0\n\tv_mbcnt_hi_u32_b32 %0, -1, %0" : "=v"(l)); return wave0 * 64 + l; }
#define EPI_BAR() do { asm volatile("s_waitcnt lgkmcnt(0)" ::: "memory"); __builtin_amdgcn_s_barrier(); asm volatile("" ::: "memory"); } while (0)

namespace pg8 {
constexpr int BM = 256, BK = 64, HALF = 128, HTB = HALF * BK * 2, STAGE_BYTES = 8 * HTB, NXCD = 8, WGM = 1;
__host__ __device__ __forceinline__ int lds_byte(int r, int c) { const int st = (r >> 4) * 2 + (c >> 5), rr = r & 15, cc = c & 31, ob = rr * 64 + cc * 2; return st * 1024 + (ob ^ (((ob >> 9) & 1) << 5)); }
__host__ __device__ __forceinline__ void stage_rc(int b, int& R, int& C) { const int st = b / 1024, sb = b % 1024, swz = sb ^ (((sb >> 9) & 1) << 5); R = (st >> 1) * 16 + swz / 64; C = (st & 1) * 32 + (swz % 64) / 2; }
__host__ __device__ __forceinline__ int perm32(int rho) { const int n = rho >> 4, i = rho & 15; return 8 * (i >> 2) + 4 * n + (i & 3); }

struct Unit { int pm, pn, ka, kb; };
struct Gemm { const bf16_t* A; const bf16_t* Bt; int lda, ldb, K; };

struct StaticOrder {
    int nM, nN, nwg, G, c;
    __device__ void init(int Mr, int N, int G_, int c_) { nM = Mr / BM; nN = N / BM; nwg = nM * nN; G = G_; c = c_; }
    __device__ bool next(int i, Unit& u) const {
        const long L = (long)i * G + c; if (L >= nwg) return false;
        int wgid = (int)L; { const int q = nwg / NXCD, r = nwg % NXCD, xcd = wgid % NXCD, off = wgid / NXCD; wgid = (xcd < r ? xcd * (q + 1) : r * (q + 1) + (xcd - r) * q) + off; }
        const int nig = WGM * nN, gid = wgid / nig, fm = gid * WGM, gsz = (nM - fm) < WGM ? (nM - fm) : WGM;
        u.pm = fm + ((wgid % nig) % gsz); u.pn = (wgid % nig) / gsz; u.ka = 0; u.kb = 0; return true;
    }
};
template <int MODE> struct QuadOrder {
    int v;
    __device__ bool next(int i, Unit& u) const {
        if (i > 0) return false;
        u.pm = v >> 2; const int j = v & 3;
        if (MODE == 0) { u.pn = 8; u.ka = 512 * j; u.kb = 512 * j; } else { u.pn = j; u.ka = 256 * j; u.kb = 0; }
        return true;
    }
};

struct PairOrder {
    int v;
    __device__ bool next(int i, Unit& u) const { if (i > 1) return false; u.pm = 2 * (v >> 3) + i; u.pn = v & 7; u.ka = 0; u.kb = 0; return true; }
};
template <class Epi, class Sched, bool ALIGN_EPI, bool PRE = false, bool I8 = false>
__device__ __forceinline__ void gemm_phase(LAS unsigned char* lds, LAS unsigned char* eps, const Gemm g, const Sched& S, const Epi& E, int wave0) {
    int tid = tid_of(wave0); asm volatile("" : "+v"(tid));
    const int wid = __builtin_amdgcn_readfirstlane(tid >> 6), lane = tid & 63, wr = wid >> 2, wc = wid & 3, fr = lane & 15, fq = lane >> 4;
    constexpr int ES = I8 ? 1 : 2;
    int nt = g.K * ES / (BK * 2); asm volatile("" : "+s"(nt));
    unsigned voffA[2], voffB[2];
#pragma unroll
    for (int i = 0; i < 2; ++i) { int R, C; stage_rc(tid * 16 + i * 8192, R, C); const int Rb = Epi::PERM ? ((R & ~31) + perm32(R & 31)) : R;
        voffA[i] = (unsigned)(R * g.lda * ES + C * 2); voffB[i] = (unsigned)(Rb * g.ldb * ES + C * 2); }
    const size_t kstep = (size_t)(BK * 2);
    const size_t hstepA = (size_t)HALF * g.lda * ES, hstepB = (size_t)HALF * g.ldb * ES;
    const size_t tstepA = 2 * hstepA, tstepB = 2 * hstepB;
    const unsigned ldsw = (unsigned)wid * 1024u;
    const int aoff = lds_byte(wr * 64 + fr, fq * 8), boff = lds_byte(wc * 32 + fr, fq * 8);
#define PG8_SA(b, h) (((b) * 2 + (h)) * HTB)
#define PG8_SB(b, h) ((4 + (b) * 2 + (h)) * HTB)
#define PG8_STAGE(bufoff, gbase, voff) do { _Pragma("unroll") for (int _i = 0; _i < 2; ++_i) \
        __builtin_amdgcn_global_load_lds((const unsigned*)((const char*)(gbase) + (voff)[_i]), (LAS unsigned*)(lds + (bufoff) + ldsw + _i * 8192), 16, 0, 0); } while (0)
#define PG8_LDA(dst, b, h) do { _Pragma("unroll") for (int m = 0; m < 4; ++m) _Pragma("unroll") for (int k = 0; k < 2; ++k) dst[m][k] = *(const LAS bf16x8*)(lds + PG8_SA(b, h) + aoff + m * 2048 + k * 1024); } while (0)
#define PG8_LDB(dst, b, h) do { _Pragma("unroll") for (int n = 0; n < 2; ++n) _Pragma("unroll") for (int k = 0; k < 2; ++k) dst[n][k] = *(const LAS bf16x8*)(lds + PG8_SB(b, h) + boff + n * 2048 + k * 1024); } while (0)
#define PG8_MMA(ai, bj, At, Bt) do { __builtin_amdgcn_s_setprio(1); _Pragma("unroll") for (int m = 0; m < 4; ++m) _Pragma("unroll") for (int n = 0; n < 2; ++n) _Pragma("unroll") for (int k = 0; k < 2; ++k) \
        { if constexpr (I8) acc[ai][bj][m][n] = __builtin_bit_cast(AccT, __builtin_amdgcn_mfma_i32_16x16x64_i8(__builtin_bit_cast(i32x4, Bt[n][k]), __builtin_bit_cast(i32x4, At[m][k]), __builtin_bit_cast(i32x4, acc[ai][bj][m][n]), 0, 0, 0)); \
          else acc[ai][bj][m][n] = __builtin_bit_cast(AccT, __builtin_amdgcn_mfma_f32_16x16x32_bf16(Bt[n][k], At[m][k], __builtin_bit_cast(f32x4, acc[ai][bj][m][n]), 0, 0, 0)); } __builtin_amdgcn_s_setprio(0); } while (0)
#define PG8_WAIT_V(n) asm volatile("s_waitcnt vmcnt(" #n ")" ::: "memory")
#define PG8_WAIT_L(n) asm volatile("s_waitcnt lgkmcnt(" #n ")" ::: "memory")
#define PG8_BAR __builtin_amdgcn_s_barrier()
#define PG8_SCHED __builtin_amdgcn_sched_barrier(0)
    Unit cur, nxt; int ui = 0;
    if (!S.next(0, cur)) return;
    using AccT = typename std::conditional<I8, i32x4, f32x4>::type;
    AccT acc[2][2][4][2];
#pragma unroll
    for (int a = 0; a < 2; ++a)
#pragma unroll
        for (int b = 0; b < 2; ++b)
#pragma unroll
            for (int m = 0; m < 4; ++m)
#pragma unroll
                for (int n = 0; n < 2; ++n) acc[a][b][m][n] = (AccT){0, 0, 0, 0};
    bf16x8 At[4][2], B0[2][2], B1[2][2];
    const char* cA = (const char*)g.A + (size_t)cur.pm * tstepA + (size_t)cur.ka * ES; const char* cB = (const char*)g.Bt + (size_t)cur.pn * tstepB + (size_t)cur.kb * ES;
    PG8_STAGE(PG8_SB(0, 0), cB, voffB); PG8_STAGE(PG8_SB(0, 1), cB + hstepB, voffB); PG8_STAGE(PG8_SA(0, 0), cA, voffA); PG8_STAGE(PG8_SA(0, 1), cA + hstepA, voffA);
    if (wr == 1) PG8_BAR;
    PG8_WAIT_V(2); PG8_BAR;
    PG8_STAGE(PG8_SB(1, 0), cB + kstep, voffB); PG8_STAGE(PG8_SA(1, 0), cA + kstep, voffA); PG8_STAGE(PG8_SB(1, 1), cB + hstepB + kstep, voffB);
    PG8_WAIT_V(6); PG8_BAR;
    unsigned pre2 = 0; unsigned pre = 0;
    for (;;) {
        const bool has_next = S.next(ui + 1, nxt);
        const char* nA = has_next ? (const char*)g.A + (size_t)nxt.pm * tstepA + (size_t)nxt.ka * ES : cA; const char* nB = has_next ? (const char*)g.Bt + (size_t)nxt.pn * tstepB + (size_t)nxt.kb * ES : cB;
#pragma unroll 1
        for (int t = 0; t < nt; t += 2) {
            const bool last = (t == nt - 2);
            if constexpr (PRE) { if (last) { const unsigned* pp = E.pre_ptr(cur, tid); asm volatile("global_load_dword %0, %1, off" : "=v"(pre) : "v"(pp) : "memory");
                                           const unsigned* pq = E.pre_ptr2(cur, tid); asm volatile("global_load_dword %0, %1, off" : "=v"(pre2) : "v"(pq) : "memory"); } }
            const char* a1 = cA + (size_t)(t + 1) * kstep;
            const char* a2 = last ? nA : cA + (size_t)(t + 2) * kstep; const char* b2 = last ? nB : cB + (size_t)(t + 2) * kstep;
            const char* a3 = a2 + kstep; const char* b3 = b2 + kstep;
            PG8_LDB(B0, 0, 0); PG8_LDB(B1, 0, 1); PG8_SCHED; PG8_LDA(At, 0, 0); PG8_STAGE(PG8_SA(1, 1), a1 + hstepA, voffA);
            PG8_WAIT_V(8); PG8_WAIT_L(0); PG8_BAR; PG8_MMA(0, 0, At, B0); PG8_MMA(0, 1, At, B1); PG8_BAR; PG8_SCHED;
            PG8_LDA(At, 0, 1); PG8_STAGE(PG8_SB(0, 0), b2, voffB); PG8_STAGE(PG8_SB(0, 1), b2 + hstepB, voffB); PG8_STAGE(PG8_SA(0, 0), a2, voffA);
            PG8_WAIT_V(8); PG8_WAIT_L(0); PG8_BAR; PG8_MMA(1, 0, At, B0); PG8_MMA(1, 1, At, B1); PG8_BAR; PG8_SCHED;
            PG8_LDB(B0, 1, 0); PG8_LDB(B1, 1, 1); PG8_SCHED; PG8_LDA(At, 1, 0); PG8_STAGE(PG8_SA(0, 1), a2 + hstepA, voffA);
            PG8_WAIT_V(8); PG8_WAIT_L(0); PG8_BAR; PG8_MMA(0, 0, At, B0); PG8_MMA(0, 1, At, B1); PG8_BAR; PG8_SCHED;
            PG8_LDA(At, 1, 1); PG8_STAGE(PG8_SB(1, 0), b3, voffB); PG8_STAGE(PG8_SB(1, 1), b3 + hstepB, voffB); PG8_STAGE(PG8_SA(1, 0), a3, voffA);
            PG8_WAIT_V(8); PG8_WAIT_L(0); PG8_BAR; PG8_MMA(1, 0, At, B0); PG8_MMA(1, 1, At, B1); PG8_BAR; PG8_SCHED;
        }
        if constexpr (ALIGN_EPI) { if (wr == 0) PG8_BAR; }
        if constexpr (PRE) { asm volatile("" : "+v"(pre), "+v"(pre2)); E(acc, cur, wr, wc, fr, fq, eps, tid, pre, pre2); } else E(acc, cur, wr, wc, fr, fq, eps, tid);
        if (!has_next) break;
#pragma unroll
        for (int a = 0; a < 2; ++a)
#pragma unroll
            for (int b = 0; b < 2; ++b)
#pragma unroll
                for (int m = 0; m < 4; ++m)
#pragma unroll
                    for (int n = 0; n < 2; ++n) acc[a][b][m][n] = (AccT){0, 0, 0, 0};
        cur = nxt; cA = nA; cB = nB; ++ui;
        if constexpr (ALIGN_EPI) { if (wr == 1) PG8_BAR; }
    }
    PG8_WAIT_V(0);
    if constexpr (!ALIGN_EPI) { if (wr == 0) PG8_BAR; }
    PG8_BAR;
#undef PG8_SA
#undef PG8_SB
#undef PG8_STAGE
#undef PG8_LDA
#undef PG8_LDB
#undef PG8_MMA
#undef PG8_WAIT_V
#undef PG8_WAIT_L
#undef PG8_BAR
#undef PG8_SCHED
}
}
using pg8::Unit;
typedef const f32x4 (&AccRef)[2][2][4][2];
typedef const i32x4 (&AccRefI)[2][2][4][2];

struct Args { const float* in[23]; float* out; unsigned char* ws; };
static_assert(sizeof(Args) == 25 * 8, "no padding");
typedef const __attribute__((address_space(4))) Args* KArgsP;
__device__ __forceinline__ KArgsP kargs() { KArgsP p = (KArgsP)__builtin_amdgcn_kernarg_segment_ptr(); asm volatile("" : "+s"(p)); return p; }
#define IN_F(i) ((const float*)ka->in[i])
#define WSP(off) (ws + (off))

template <int NR>
__device__ __forceinline__ void quant_rows(const float* eu, const float* ev, unsigned* EU8, unsigned* EV8, float* SU, float* SV, int r0, int lane) {
    f32x4 v[NR][8]; float mx[NR];
#pragma unroll
    for (int a = 0; a < NR; ++a) { const int r = r0 + a; const float* srow = (r >= 16384 ? ev : eu) + (size_t)(r & 16383) * 2048 + 4 * lane; mx[a] = 0.f;
#pragma unroll
        for (int j = 0; j < 8; ++j) v[a][j] = __builtin_nontemporal_load((const f32x4*)(srow + 256 * j)); }
#pragma unroll
    for (int a = 0; a < NR; ++a) {
#pragma unroll
        for (int j = 0; j < 8; ++j) mx[a] = fmaxf(fmaxf(mx[a], fmaxf(fabsf(v[a][j][0]), fabsf(v[a][j][1]))), fmaxf(fabsf(v[a][j][2]), fabsf(v[a][j][3])));
        mx[a] = wave_max(mx[a]); }
#pragma unroll
    for (int a = 0; a < NR; ++a) { const int r = r0 + a, e = r & 16383; const bool isv = r >= 16384;
        const float sc = mx[a] > 0.f ? mx[a] * (1.f / 127.f) : 1.f; const float inv = 1.f / sc;
        unsigned* drow = (isv ? EV8 : EU8) + (size_t)(lane >> 5) * (16384 * 32) + (size_t)e * 32 + (lane & 31);
#pragma unroll
        for (int j = 0; j < 8; ++j) { const int q0 = (int)rintf(v[a][j][0] * inv), q1 = (int)rintf(v[a][j][1] * inv), q2 = (int)rintf(v[a][j][2] * inv), q3 = (int)rintf(v[a][j][3] * inv);
            drow[(size_t)(2 * j) * (16384 * 32)] = (unsigned)(q0 & 0xff) | ((unsigned)(q1 & 0xff) << 8) | ((unsigned)(q2 & 0xff) << 16) | ((unsigned)(q3 & 0xff) << 24); }
        if (lane == 0) (isv ? SV : SU)[e] = sc; }
}

#define ALOAD16(dst, ptr) asm volatile("global_load_dwordx4 %0, %1, off" : "=&v"(dst) : "v"(ptr) : "memory")
#define ALOAD16O(dst, ptr, off) asm volatile("global_load_dwordx4 %0, %1, off offset:%c2" : "=&v"(dst) : "v"(ptr), "i"(off) : "memory")
#define AWAIT8(a, b, c, d, e, f, g, h) asm volatile("s_waitcnt vmcnt(0)" : "+v"(a), "+v"(b), "+v"(c), "+v"(d), "+v"(e), "+v"(f), "+v"(g), "+v"(h) :: "memory")
#define AWAIT16(a, b, c, d, e, f, g, h, i, j, k, l, m, n, o, p) asm volatile("s_waitcnt vmcnt(0)" : "+v"(a), "+v"(b), "+v"(c), "+v"(d), "+v"(e), "+v"(f), "+v"(g), "+v"(h), "+v"(i), "+v"(j), "+v"(k), "+v"(l), "+v"(m), "+v"(n), "+v"(o), "+v"(p) :: "memory")

__device__ __forceinline__ u32x4 pack8(f32x4 a, f32x4 b) { u32x4 w; w.x = cvtpk(a[0], a[1]); w.y = cvtpk(a[2], a[3]); w.z = cvtpk(b[0], b[1]); w.w = cvtpk(b[2], b[3]); return w; }
__device__ __forceinline__ u32x2 pack4(f32x4 a) { u32x2 w; w.x = cvtpk(a[0], a[1]); w.y = cvtpk(a[2], a[3]); return w; }
__device__ __forceinline__ float sq4(f32x4 a) { return (a[0] * a[0] + a[1] * a[1]) + (a[2] * a[2] + a[3] * a[3]); }

struct EpiA {
    static constexpr bool PERM = true;
    bf16_t* ZP; bf16_t* CQ; bf16_t* CKV; float* ssq_cq; float* ssq_ckv; const float* RSX; const float* SBW;
    __device__ __forceinline__ const unsigned* pre_ptr(const Unit& u, int tid) const { return (const unsigned*)(RSX + u.pm * 256 + (tid & 255)); }
    __device__ __forceinline__ const unsigned* pre_ptr2(const Unit& u, int tid) const { return (const unsigned*)(SBW + u.pn * 256 + (tid & 255)); }
    __device__ __forceinline__ void operator()(AccRefI acc, const Unit& u, int wr, int wc, int fr, int fq, LAS unsigned char* eps, int tid, unsigned pre, unsigned pre2) const {
        LAS float* R = (LAS float*)(eps + 4096); LAS float* CS = (LAS float*)(eps + 5120);
        if (tid < 256) { R[tid] = __builtin_bit_cast(float, pre); CS[tid] = __builtin_bit_cast(float, pre2); }
        EPI_BAR();
        bf16_t* base; int ldc, colt; float* ssq = nullptr;
        if (u.pn < 4) { base = ZP; ldc = 1024; colt = u.pn * 256; }
        else if (u.pn < 6) { base = CQ; ldc = 512; colt = (u.pn - 4) * 256; ssq = ssq_cq + (u.pn - 4) * 4 + wc; }
        else { base = CKV; ldc = 512; colt = (u.pn - 6) * 256; ssq = ssq_ckv + (u.pn - 6) * 4 + wc; }
        const int row0 = u.pm * 256 + wr * 64 + fr, col0 = colt + wc * 32 + 8 * fq;
        f32x4 cs[2][2];
#pragma unroll
        for (int bj = 0; bj < 2; ++bj)
#pragma unroll
            for (int n = 0; n < 2; ++n) cs[bj][n] = *(const LAS f32x4*)(CS + bj * 128 + wc * 32 + 8 * fq + 4 * n);
#pragma unroll
        for (int ai = 0; ai < 2; ++ai)
#pragma unroll
            for (int m = 0; m < 4; ++m) { const int row = row0 + ai * 128 + m * 16; bf16_t* rowp = base + (size_t)row * ldc + col0; float s = 0.f; const float rs = R[ai * 128 + wr * 64 + m * 16 + fr];
#pragma unroll
                for (int bj = 0; bj < 2; ++bj) { const f32x4 v0 = __builtin_convertvector(acc[ai][bj][m][0], f32x4) * cs[bj][0] * rs, v1 = __builtin_convertvector(acc[ai][bj][m][1], f32x4) * cs[bj][1] * rs;
                    *(u32x4*)(rowp + bj * 128) = pack8(v0, v1); s += sq4(v0) + sq4(v1); }
                if (ssq) { s += __shfl_xor(s, 16); s += __shfl_xor(s, 32); if (fq == 0) ssq[(size_t)row * 8] = s; } }
        EPI_BAR();
    }
};
struct EpiKR {
    static constexpr bool PERM = false;
    float* KRP; const float* RSX; const float* SBW;
    __device__ __forceinline__ const unsigned* pre_ptr(const Unit& u, int tid) const { return (const unsigned*)(RSX + u.pm * 256 + (tid & 255)); }
    __device__ __forceinline__ const unsigned* pre_ptr2(const Unit& u, int tid) const { return (const unsigned*)(SBW + u.pn * 256 + (tid & 255)); }
    __device__ __forceinline__ void operator()(AccRefI acc, const Unit& u, int wr, int wc, int fr, int fq, LAS unsigned char* eps, int tid, unsigned pre, unsigned pre2) const {
        LAS float* R = (LAS float*)(eps + 4096); LAS float* CS = (LAS float*)(eps + 5120);
        if (tid < 256) { R[tid] = __builtin_bit_cast(float, pre); CS[tid] = __builtin_bit_cast(float, pre2); }
        EPI_BAR();
        if (wc < 2) { const int ks = u.ka >> 9; const int row0 = u.pm * 256 + wr * 64 + fr;
#pragma unroll
            for (int ai = 0; ai < 2; ++ai)
#pragma unroll
                for (int m = 0; m < 4; ++m) { const int row = row0 + ai * 128 + m * 16; const float rs = R[ai * 128 + wr * 64 + m * 16 + fr];
#pragma unroll
                    for (int n = 0; n < 2; ++n) *(f32x4*)(KRP + ((size_t)ks * M + row) * 64 + 32 * wc + 16 * n + 4 * fq) = __builtin_convertvector(acc[ai][0][m][n], f32x4) * *(const LAS f32x4*)(CS + 32 * wc + 16 * n + 4 * fq) * rs; } }
        { const int uid = u.pm * 4 + (u.ka >> 9); KArgsP ka = kargs(); unsigned char* ws = ka->ws; const float* p_in = IN_F(1); const float* sk1 = IN_F(16); const float* sk2 = IN_F(17);
          bf16_t* PB = (bf16_t*)WSP(WS_PB); bf16_t* SKB = (bf16_t*)WSP(WS_SK);
          for (int i = tid; i < 2176; i += 512) { long j = (long)uid * 2176 + i; const float* src; bf16_t* dst;
              if (j < 524288) { src = p_in; dst = PB; } else if ((j -= 524288) < 16384) { src = sk1; dst = SKB; } else { j -= 16384; src = sk2; dst = SKB + 131072; }
              const f32x4 a = *(const f32x4*)(src + j * 8), b = *(const f32x4*)(src + j * 8 + 4); *(u32x4*)(dst + j * 8) = pack8(a, b); } }
        EPI_BAR();
    }
};
struct EpiStore {
    static constexpr bool PERM = true;
    bf16_t* O; int ldc;
    __device__ __forceinline__ void operator()(AccRef acc, const Unit& u, int wr, int wc, int fr, int fq, LAS unsigned char*, int) const {
        const int row0 = u.pm * 256 + wr * 64 + fr, col0 = u.pn * 256 + wc * 32 + 8 * fq;
#pragma unroll
        for (int ai = 0; ai < 2; ++ai)
#pragma unroll
            for (int m = 0; m < 4; ++m) { bf16_t* rowp = O + (size_t)(row0 + ai * 128 + m * 16) * ldc + col0;
#pragma unroll
                for (int bj = 0; bj < 2; ++bj) *(u32x4*)(rowp + bj * 128) = pack8(acc[ai][bj][m][0], acc[ai][bj][m][1]); }
    }
};
struct EpiQ {
    static constexpr bool PERM = false;
    bf16_t* Q; const float* ssq_cq; const float* qg; const float* COS; const float* SIN;
    __device__ __forceinline__ void operator()(AccRef acc, const Unit& u, int wr, int wc, int fr, int fq, LAS unsigned char* eps, int tid) const {
        LAS float* P = (LAS float*)eps; LAS float* R = (LAS float*)(eps + 4096);
        const int h = u.pn, rowt = u.pm * 256;
        { const f32x4 a = *(const f32x4*)(ssq_cq + (size_t)(rowt + (tid >> 1)) * 8 + 4 * (tid & 1)); float s = (a[0] + a[1]) + (a[2] + a[3]); s += DPP_F(s, 0xB1);
          if ((tid & 1) == 0) R[tid >> 1] = rsqrtf(s * (1.f / 512.f) + EPS); }
#pragma unroll
        for (int ai = 0; ai < 2; ++ai)
#pragma unroll
            for (int m = 0; m < 4; ++m) { const int r = ai * 128 + wr * 64 + m * 16 + fr; float s = 0.f;
#pragma unroll
                for (int bj = 0; bj < 2; ++bj)
#pragma unroll
                    for (int n = 0; n < 2; ++n) s += sq4(acc[ai][bj][m][n]);
                s += __shfl_xor(s, 16); s += __shfl_xor(s, 32); if (fq == 0) P[r * 4 + wc] = s; }
        EPI_BAR();
        const int dn = 32 * wc + 4 * fq, j = 16 * wc + 4 * fq;
        const f32x4 g0 = *(const f32x4*)(qg + dn), g1 = *(const f32x4*)(qg + dn + 16);
        f32x4 gr1 = {0.f, 0.f, 0.f, 0.f}, gr2 = gr1; if (wc < 2) { gr1 = *(const f32x4*)(qg + 128 + j); gr2 = *(const f32x4*)(qg + 160 + j); }
#pragma unroll
        for (int ai = 0; ai < 2; ++ai)
#pragma unroll
            for (int m = 0; m < 4; ++m) { const int r = ai * 128 + wr * 64 + m * 16 + fr; const float rc = R[r]; const f32x4 pp = *(LAS f32x4*)(P + r * 4);
                const float ss = ((pp[0] + pp[1]) + (pp[2] + pp[3])) * rc * rc; const float sc = rc * rsqrtf(ss * (1.f / 192.f) + EPS);
                const size_t grow = (size_t)(rowt + r); bf16_t* qrow = Q + grow * 1536 + h * 192;
                *(u32x2*)(qrow + dn) = pack4(acc[ai][0][m][0] * sc * g0); *(u32x2*)(qrow + dn + 16) = pack4(acc[ai][0][m][1] * sc * g1);
                if (wc < 2) { const f32x4 x1 = acc[ai][1][m][0] * sc * gr1, x2 = acc[ai][1][m][1] * sc * gr2;
                    const f32x4 c4 = *(const f32x4*)(COS + grow * 32 + j), s4 = *(const f32x4*)(SIN + grow * 32 + j);
                    *(u32x2*)(qrow + 128 + j) = pack4(x1 * c4 - x2 * s4); *(u32x2*)(qrow + 160 + j) = pack4(x2 * c4 + x1 * s4); } }
    }
};
struct EpiKV {
    static constexpr bool PERM = true;
    bf16_t* K; bf16_t* V; const float* ssq_ckv; const float* KRP; const float* kg; const float* COS; const float* SIN;
    __device__ __forceinline__ void operator()(AccRef acc, const Unit& u, int wr, int wc, int fr, int fq, LAS unsigned char* eps, int tid) const {
        LAS float* P = (LAS float*)eps; LAS float* R = (LAS float*)(eps + 4096); LAS float* R2 = (LAS float*)(eps + 5120);
        const int h = u.pn, rowt = u.pm * 256;
        { const f32x4 a = *(const f32x4*)(ssq_ckv + (size_t)(rowt + (tid >> 1)) * 8 + 4 * (tid & 1)); float s = (a[0] + a[1]) + (a[2] + a[3]); s += DPP_F(s, 0xB1);
          if ((tid & 1) == 0) R[tid >> 1] = rsqrtf(s * (1.f / 512.f) + EPS); }
        int tq = tid; asm volatile("" : "+v"(tq));
        const int rc = tq & 15, rb = tq >> 4;
#pragma unroll
        for (int kb = 0; kb < 8; kb += 2) { f32x4 pv[2][4];
#pragma unroll
            for (int k = 0; k < 2; ++k) { const float* p = KRP + (size_t)(rowt + rb + 32 * (kb + k)) * 64 + 4 * rc;
#pragma unroll
                for (int q = 0; q < 4; ++q) { const float* pq = p + (size_t)q * M * 64; ALOAD16(pv[k][q], pq); } }
            AWAIT8(pv[0][0], pv[0][1], pv[0][2], pv[0][3], pv[1][0], pv[1][1], pv[1][2], pv[1][3]);
#pragma unroll
            for (int k = 0; k < 2; ++k) { const f32x4 t = (pv[k][0] + pv[k][1]) + (pv[k][2] + pv[k][3]); float s = sq4(t);
                s += DPP_F(s, 0xB1); s += DPP_F(s, 0x4E); s += DPP_F(s, 0x141); s += DPP_F(s, 0x128);
                if (rc == 0) R2[rb + 32 * (kb + k)] = s; } }
#pragma unroll
        for (int ai = 0; ai < 2; ++ai)
#pragma unroll
            for (int m = 0; m < 4; ++m) { const int r = ai * 128 + wr * 64 + m * 16 + fr; float s = sq4(acc[ai][0][m][0]) + sq4(acc[ai][0][m][1]);
                s += __shfl_xor(s, 16); s += __shfl_xor(s, 32); if (fq == 0) P[r * 4 + wc] = s; }
        EPI_BAR();
        const int dn = 32 * wc + 8 * fq;
        const f32x4 g0 = *(const f32x4*)(kg + dn), g1 = *(const f32x4*)(kg + dn + 4);
#pragma unroll
        for (int ai = 0; ai < 2; ++ai)
#pragma unroll
            for (int m = 0; m < 4; ++m) { const int r = ai * 128 + wr * 64 + m * 16 + fr; const float rc = R[r]; const f32x4 pp = *(LAS f32x4*)(P + r * 4);
                const float ssn = ((pp[0] + pp[1]) + (pp[2] + pp[3])) * rc * rc; const float sk = rc * rsqrtf((ssn + R2[r]) * (1.f / 192.f) + EPS);
                const size_t grow = (size_t)(rowt + r);
                bf16_t* vrow = V + grow * 1024 + h * 128 + dn; *(u32x4*)vrow = pack8(acc[ai][1][m][0] * rc, acc[ai][1][m][1] * rc);
                bf16_t* krow = K + grow * 1536 + h * 192 + dn; *(u32x4*)krow = pack8(acc[ai][0][m][0] * sk * g0, acc[ai][0][m][1] * sk * g1); }
        { const int jj = 4 * (rc & 7); const bool hi8 = rc >= 8;
          const f32x4 ga = *(const f32x4*)(kg + 128 + jj), gb = *(const f32x4*)(kg + 160 + jj);
#pragma unroll
          for (int k = 0; k < 8; ++k) { f32x4 pv[4], c4, s4;
            const int row = rb + 32 * k; const size_t grw = (size_t)(rowt + row); const float* p = KRP + grw * 64 + 4 * rc;
#pragma unroll
            for (int q = 0; q < 4; ++q) { const float* pq = p + (size_t)q * M * 64; ALOAD16(pv[q], pq); }
            { const float* pc = COS + grw * 32 + jj; const float* ps = SIN + grw * 32 + jj; ALOAD16(c4, pc); ALOAD16(s4, ps); }
            asm volatile("s_waitcnt vmcnt(0)" : "+v"(pv[0]), "+v"(pv[1]), "+v"(pv[2]), "+v"(pv[3]), "+v"(c4), "+v"(s4) :: "memory");
            const f32x4 mine = (pv[0] + pv[1]) + (pv[2] + pv[3]); f32x4 oth; oth[0] = DPP_F(mine[0], 0x128); oth[1] = DPP_F(mine[1], 0x128); oth[2] = DPP_F(mine[2], 0x128); oth[3] = DPP_F(mine[3], 0x128);
            const float rc_ = R[row]; const f32x4 pp = *(LAS f32x4*)(P + row * 4); const float ssn = ((pp[0] + pp[1]) + (pp[2] + pp[3])) * rc_ * rc_;
            const float rk = rsqrtf((ssn + R2[row]) * (1.f / 192.f) + EPS);
            const f32x4 x1 = (hi8 ? oth : mine) * ga, x2 = (hi8 ? mine : oth) * gb;
            const f32x4 o = (hi8 ? (x2 * c4 + x1 * s4) : (x1 * c4 - x2 * s4)) * rk;
            *(u32x2*)(K + grw * 1536 + h * 192 + 128 + 4 * rc) = pack4(o); } }
    }
};
struct EpiH1 {
    static constexpr bool PERM = true;
    const float* X; bf16_t* H1B; float* SSQ;
    __device__ __forceinline__ void operator()(AccRef acc, const Unit& u, int wr, int wc, int fr, int fq, LAS unsigned char*, int) const {
        const int row0 = u.pm * 256 + wr * 64 + fr, col0 = u.pn * 256 + wc * 32 + 8 * fq;
#pragma unroll
        for (int ai = 0; ai < 2; ++ai) {
            f32x4 xa[4][2], xb[4][2];
#pragma unroll
            for (int m = 0; m < 4; ++m)
#pragma unroll
                for (int bj = 0; bj < 2; ++bj) { const float* p = X + (size_t)(row0 + ai * 128 + m * 16) * DM + col0 + bj * 128; ALOAD16(xa[m][bj], p); ALOAD16O(xb[m][bj], p, 16); }
            AWAIT16(xa[0][0], xa[0][1], xa[1][0], xa[1][1], xa[2][0], xa[2][1], xa[3][0], xa[3][1], xb[0][0], xb[0][1], xb[1][0], xb[1][1], xb[2][0], xb[2][1], xb[3][0], xb[3][1]);
#pragma unroll
            for (int m = 0; m < 4; ++m) { const size_t off = (size_t)(row0 + ai * 128 + m * 16) * DM + col0; float s = 0.f;
#pragma unroll
                for (int bj = 0; bj < 2; ++bj) { const f32x4 h0 = xa[m][bj] + acc[ai][bj][m][0], h1 = xb[m][bj] + acc[ai][bj][m][1];
                    *(u32x4*)(H1B + off + bj * 128) = pack8(h0, h1); s += sq4(h0) + sq4(h1); }
                s += __shfl_xor(s, 16); s += __shfl_xor(s, 32); if (fq == 0) SSQ[(size_t)(row0 + ai * 128 + m * 16) * 32 + u.pn * 4 + wc] = s; }
        }
    }
};
struct EpiQP {
    static constexpr bool PERM = true;
    bf16_t* QP; const float* SSQ; float* RSTD2;
    __device__ __forceinline__ void operator()(AccRef acc, const Unit& u, int wr, int wc, int fr, int fq, LAS unsigned char* eps, int tid) const {
        LAS float* R = (LAS float*)(eps + 4096);
#pragma unroll
        for (int k = 0; k < 4; ++k) { const int row = (tid >> 3) + 64 * k; const f32x4 a = *(const f32x4*)(SSQ + (size_t)(u.pm * 256 + row) * 32 + 4 * (tid & 7));
            const float s = oct_sum((a[0] + a[1]) + (a[2] + a[3])); const float rs = rsqrtf(s * (1.f / 2048.f) + EPS);
            if ((tid & 7) == 0) { R[row] = rs; if (u.pn == 0) RSTD2[u.pm * 256 + row] = rs; } }
        EPI_BAR();
        const int col0 = u.pn * 256 + wc * 32 + 8 * fq;
#pragma unroll
        for (int ai = 0; ai < 2; ++ai)
#pragma unroll
            for (int m = 0; m < 4; ++m) { const int r = ai * 128 + wr * 64 + m * 16 + fr; const float rs = R[r]; bf16_t* rowp = QP + (size_t)(u.pm * 256 + r) * DM + col0;
#pragma unroll
                for (int bj = 0; bj < 2; ++bj) *(u32x4*)(rowp + bj * 128) = pack8(acc[ai][bj][m][0] * rs, acc[ai][bj][m][1] * rs); }
        EPI_BAR();
    }
};
struct EpiGate {
    static constexpr bool PERM = true;
    float* OUT; const bf16_t* PROJ; const float* SSQ2; const bf16_t* H2B;
    __device__ __forceinline__ void operator()(AccRef acc, const Unit& u, int wr, int wc, int fr, int fq, LAS unsigned char* eps, int tid) const {
        LAS float* R = (LAS float*)(eps + 4096);
#pragma unroll
        for (int k = 0; k < 2; ++k) { const int row = (tid >> 2) + 128 * k; const f32x4 a = *(const f32x4*)(SSQ2 + (size_t)(u.pm * 256 + row) * 16 + 4 * (tid & 3));
            const float s = quad_sum((a[0] + a[1]) + (a[2] + a[3])); if ((tid & 3) == 0) R[row] = rsqrtf(s * (1.f / 2048.f) + EPS); }
        EPI_BAR();
        const int row0 = u.pm * 256 + wr * 64 + fr, col0 = u.pn * 256 + wc * 32 + 8 * fq;
#pragma unroll
        for (int ai = 0; ai < 2; ++ai) {
            u32x4 pj[4][2], hv[4][2];
#pragma unroll
            for (int m = 0; m < 4; ++m)
#pragma unroll
                for (int bj = 0; bj < 2; ++bj) { const size_t off = (size_t)(row0 + ai * 128 + m * 16) * DM + col0 + bj * 128; const bf16_t* pp = PROJ + off; const bf16_t* ph = H2B + off; ALOAD16(pj[m][bj], pp); ALOAD16(hv[m][bj], ph); }
            AWAIT16(pj[0][0], pj[0][1], pj[1][0], pj[1][1], pj[2][0], pj[2][1], pj[3][0], pj[3][1], hv[0][0], hv[0][1], hv[1][0], hv[1][1], hv[2][0], hv[2][1], hv[3][0], hv[3][1]);
#pragma unroll
            for (int m = 0; m < 4; ++m) { const int row = row0 + ai * 128 + m * 16; const float rs = R[ai * 128 + wr * 64 + m * 16 + fr]; const size_t off = (size_t)row * DM + col0;
#pragma unroll
                for (int bj = 0; bj < 2; ++bj) { const u32x4 pw = pj[m][bj], hw = hv[m][bj];
                    const f32x4 p0 = {bf_lo(pw.x), bf_hi(pw.x), bf_lo(pw.y), bf_hi(pw.y)}, p1 = {bf_lo(pw.z), bf_hi(pw.z), bf_lo(pw.w), bf_hi(pw.w)};
                    f32x4 g0, g1;
#pragma unroll
                    for (int e = 0; e < 4; ++e) { g0[e] = __builtin_amdgcn_rcpf(1.f + __builtin_amdgcn_exp2f(-1.4426950408889634f * rs * acc[ai][bj][m][0][e]));
                                                  g1[e] = __builtin_amdgcn_rcpf(1.f + __builtin_amdgcn_exp2f(-1.4426950408889634f * rs * acc[ai][bj][m][1][e])); }
                    float* o = OUT + off + bj * 128;
                    const f32x4 h0 = {bf_lo(hw.x), bf_hi(hw.x), bf_lo(hw.y), bf_hi(hw.y)}, h1 = {bf_lo(hw.z), bf_hi(hw.z), bf_lo(hw.w), bf_hi(hw.w)};
                    *(f32x4*)o = h0 + g0 * p0; *(f32x4*)(o + 4) = h1 + g1 * p1; } }
        }
        EPI_BAR();
    }
};

typedef GAS unsigned gu32;
#define RLX_AGENT __ATOMIC_RELAXED, __HIP_MEMORY_SCOPE_AGENT
#define XB_TMO      128
#define XB_XCNT(j)  (256  + 64 * (j))
#define XB_XSUB(j)  (1280 + 64 * (j))
#define XB_XGEN(j)  (2304 + 64 * (j))
#define XB_TOP      3328
#define XB_TOPGEN   3392
#define XCD_BAR_WORDS 3456
#define XB_SPIN_CAP (1u << 20)
__device__ __forceinline__ unsigned xb_ld(unsigned* p)              { return __hip_atomic_load(p, __ATOMIC_RELAXED, __HIP_MEMORY_SCOPE_AGENT); }
__device__ __forceinline__ unsigned xb_add(unsigned* p, unsigned v) { return __hip_atomic_fetch_add(p, v, __ATOMIC_RELAXED, __HIP_MEMORY_SCOPE_AGENT); }
__device__ __forceinline__ unsigned xb_xcc_id() { return (unsigned)__builtin_amdgcn_s_getreg((3 << 11) | 20) & 0xFu; }
#define XB_SPIN(cond, bar) do { unsigned _sp = 0; while (cond) { __builtin_amdgcn_s_sleep(1); \
    if ((++_sp & 255u) == 0u) { if (xb_ld(&(bar)[XB_TMO])) break; if (_sp > XB_SPIN_CAP) { atomicAdd(&(bar)[XB_TMO], 1u); break; } } } } while (0)
struct XcdBarrier { unsigned* bar; unsigned x; volatile LAS unsigned* st; int w0; };
__device__ __forceinline__ XcdBarrier xcd_barrier_post(unsigned* bar, volatile LAS unsigned* st, int w0) {
    XcdBarrier b; b.bar = bar; b.x = xb_xcc_id(); b.st = st; b.w0 = w0;
    if (tid_of(w0) == 0) (void)xb_add(&bar[XB_XCNT(b.x)], 1u);
    return b;
}
__device__ __forceinline__ void xcd_barrier_complete(unsigned* bar, unsigned x, unsigned& nloc, unsigned& nx) {
    const unsigned G = gridDim.x * gridDim.y * gridDim.z;
    unsigned sum, cnt, mine, sp = 0u;
    for (;;) {
        sum = 0u; cnt = 0u; mine = 0u;
#pragma unroll
        for (unsigned j = 0; j < 16; ++j) { const unsigned c = xb_ld(&bar[XB_XCNT(j)]); sum += c; cnt += (c > 0u) ? 1u : 0u; mine = (j == x) ? c : mine; }
        if (sum == G) break;
        __builtin_amdgcn_s_sleep(1);
        if ((++sp & 255u) == 0u) { if (xb_ld(&bar[XB_TMO])) break; if (sp > XB_SPIN_CAP) { atomicAdd(&bar[XB_TMO], 1u); break; } }
    }
    nloc = mine > 0u ? mine : 1u; nx = cnt > 0u ? cnt : 1u;
}
__device__ __forceinline__ void xcd_barrier(const XcdBarrier& b) {
    asm volatile("s_waitcnt vmcnt(0)" ::: "memory");
    __syncthreads();
    if (tid_of(b.w0) == 0) {
        unsigned* bar = b.bar;
        __builtin_amdgcn_s_waitcnt(0);
        unsigned nloc = b.st[0], nx = b.st[1];
        if (nloc == 0u) { xcd_barrier_complete(bar, b.x, nloc, nx); b.st[0] = nloc; b.st[1] = nx; }
        const unsigned old = xb_add(&bar[XB_XSUB(b.x)], 1u);
        const unsigned gen = old / nloc;
        if (old + 1u == (gen + 1u) * nloc) {
            __builtin_amdgcn_fence(__ATOMIC_RELEASE, "agent");
            asm volatile("s_waitcnt vmcnt(0)" ::: "memory");
            const unsigned og = xb_add(&bar[XB_TOP], 1u);
            const unsigned tg = og / nx;
            if (og + 1u == (tg + 1u) * nx) xb_add(&bar[XB_TOPGEN], 1u);
            else XB_SPIN(xb_ld(&bar[XB_TOPGEN]) == tg, bar);
            __builtin_amdgcn_fence(__ATOMIC_ACQUIRE, "agent");
            xb_add(&bar[XB_XGEN(b.x)], 1u);
            asm volatile("s_waitcnt vmcnt(0)" ::: "memory");
        } else {
            XB_SPIN(xb_ld(&bar[XB_XGEN(b.x)]) == gen, bar);
            __builtin_amdgcn_fence(__ATOMIC_ACQUIRE, "agent");
            asm volatile("s_waitcnt vmcnt(0)" ::: "memory");
        }
    }
    __syncthreads();
}

__device__ __forceinline__ int uq_row(int n) {
    const int h = n / 192, d = n - h * 192; int slot;
    if (d < 128) slot = d; else { const int j = d - 128; if (j < 32) slot = 128 + 32 * (j >> 4) + (j & 15); else { const int jj = j - 32; slot = 128 + 32 * (jj >> 4) + 16 + (jj & 15); } }
    return h * 256 + slot;
}
template <int MAP>
__device__ __forceinline__ void tr_item(const float* W, int ldw, int col_off, const float* gk, const float* gn, bf16_t* WT, int ldt, int row_off, int nblk, LAS float* scr, int item, int lane) {
    const int kb = item / nblk, nb = item - kb * nblk, k0 = 64 * kb, n0 = 32 * nb;
#pragma unroll
    for (int i = 0; i < 32; ++i) { const int kk = 2 * i + (lane >> 5); float v = W[(size_t)(k0 + kk) * ldw + col_off + n0 + (lane & 31)]; if (gk) v *= gk[k0 + kk]; scr[kk * 33 + (lane & 31)] = v; }
    asm volatile("s_waitcnt lgkmcnt(0)" ::: "memory");
    const int c = lane & 7;
#pragma unroll
    for (int j = 0; j < 4; ++j) { const int n = (lane >> 3) + 8 * j; const LAS float* s = scr + (8 * c) * 33 + n; const float g = gn ? gn[n0 + n] : 1.f;
        u32x4 o; o.x = cvtpk(s[0 * 33] * g, s[1 * 33] * g); o.y = cvtpk(s[2 * 33] * g, s[3 * 33] * g); o.z = cvtpk(s[4 * 33] * g, s[5 * 33] * g); o.w = cvtpk(s[6 * 33] * g, s[7 * 33] * g);
        const int drow = (MAP == 1) ? uq_row(n0 + n) : (row_off + n0 + n);
        *(u32x4*)(WT + (size_t)drow * ldt + k0 + 8 * c) = o; }
    asm volatile("s_waitcnt lgkmcnt(0)" ::: "memory");
}

struct TrP { const float* W; const float* gk; const float* gn; bf16_t* WT; int ldw, ldt, nblk, item, map; };
__device__ __forceinline__ void tr_load(const TrP& p, float (&v)[32], int lane) {
    const int kb = p.item / p.nblk, nb = p.item - kb * p.nblk, k0 = 64 * kb, n0 = 32 * nb;
#pragma unroll
    for (int i = 0; i < 32; ++i) { const int kk = 2 * i + (lane >> 5); v[i] = p.W[(size_t)(k0 + kk) * p.ldw + n0 + (lane & 31)]; }
    if (p.gk) {
#pragma unroll
        for (int i = 0; i < 32; ++i) v[i] *= p.gk[k0 + 2 * i + (lane >> 5)]; }
}
__device__ __forceinline__ void tr_store(const TrP& p, const float (&v)[32], LAS float* scr, int lane) {
    const int kb = p.item / p.nblk, nb = p.item - kb * p.nblk, k0 = 64 * kb, n0 = 32 * nb;
#pragma unroll
    for (int i = 0; i < 32; ++i) scr[(2 * i + (lane >> 5)) * 33 + (lane & 31)] = v[i];
    asm volatile("s_waitcnt lgkmcnt(0)" ::: "memory");
    const int c = lane & 7;
#pragma unroll
    for (int j = 0; j < 4; ++j) { const int n = (lane >> 3) + 8 * j; const LAS float* s = scr + (8 * c) * 33 + n; const float g = p.gn ? p.gn[n0 + n] : 1.f;
        u32x4 o; o.x = cvtpk(s[0 * 33] * g, s[1 * 33] * g); o.y = cvtpk(s[2 * 33] * g, s[3 * 33] * g); o.z = cvtpk(s[4 * 33] * g, s[5 * 33] * g); o.w = cvtpk(s[6 * 33] * g, s[7 * 33] * g);
        const int drow = p.map ? uq_row(n0 + n) : (n0 + n);
        *(u32x4*)(p.WT + (size_t)drow * p.ldt + k0 + 8 * c) = o; }
    asm volatile("s_waitcnt lgkmcnt(0)" ::: "memory");
}

namespace att {
constexpr int DQ = 192, DV = 128, KVBLK = 64, QBLK = 32;
constexpr int LDQ = 1536, LDV = 1024, LDO = 2048;
constexpr int SHM_V = KVBLK * DV * 2, SHM_K = KVBLK * DQ * 2;
constexpr float SCALE = 0.07216878364870322f;
constexpr float THR = 8.f;
#define KSWZ(row, colB) ((row) * 384 + ((colB) ^ ((((row) >> 1) & 7) << 4)))
#define SBAR() __builtin_amdgcn_sched_barrier(0)
__device__ __forceinline__ int crow(int r, int hi) { return (r & 3) + 8 * (r >> 2) + 4 * hi; }
__device__ __forceinline__ void partialSM(f32x16& p0, f32x16& p1, float& m_reg, float& alpha) {
    constexpr float C = SCALE * 1.4426950408889634f;
    float pmax = p0[0];
#pragma unroll
    for (int r = 1; r < 16; ++r) pmax = fmaxf(pmax, p0[r]);
#pragma unroll
    for (int r = 0; r < 16; ++r) pmax = fmaxf(pmax, p1[r]);
    { auto rr = __builtin_amdgcn_permlane32_swap(__float_as_uint(pmax), __float_as_uint(pmax), false, false);
      pmax = fmaxf(__uint_as_float(rr[0]), __uint_as_float(rr[1])); }
    float mn;
    if (__builtin_expect(__all(pmax - m_reg <= THR / SCALE), 1)) { mn = m_reg; alpha = 1.f; }
    else { mn = fmaxf(m_reg, pmax); alpha = __builtin_amdgcn_exp2f((m_reg - mn) * C); m_reg = mn; }
    const float mnC = -mn * C;
#pragma unroll
    for (int r = 0; r < 16; ++r) { p0[r] = __builtin_amdgcn_exp2f(fmaf(p0[r], C, mnC)); p1[r] = __builtin_amdgcn_exp2f(fmaf(p1[r], C, mnC)); }
}
__device__ __forceinline__ void finishSM(const f32x16& p0, const f32x16& p1, float alpha, float& l_reg, bf16x8& pa0, bf16x8& pa1, bf16x8& pa2, bf16x8& pa3) {
    float ps = 0.f;
#pragma unroll
    for (int r = 0; r < 16; ++r) ps += p0[r];
#pragma unroll
    for (int r = 0; r < 16; ++r) ps += p1[r];
    { auto rr = __builtin_amdgcn_permlane32_swap(__float_as_uint(ps), __float_as_uint(ps), false, false);
      ps = __uint_as_float(rr[0]) + __uint_as_float(rr[1]); }
    l_reg = l_reg * alpha + ps;
#define PK4(P, BASE, OUT) do { unsigned a0 = cvtpk(P[BASE + 0], P[BASE + 1]), a1 = cvtpk(P[BASE + 2], P[BASE + 3]);   \
    unsigned b0 = cvtpk(P[BASE + 4], P[BASE + 5]), b1 = cvtpk(P[BASE + 6], P[BASE + 7]);                              \
    auto r0 = __builtin_amdgcn_permlane32_swap(a0, b0, false, false); auto r1 = __builtin_amdgcn_permlane32_swap(a1, b1, false, false); \
    u32x4 w = {r0[0], r1[0], r0[1], r1[1]}; OUT = __builtin_bit_cast(bf16x8, w); } while (0)
    PK4(p0, 0, pa0); PK4(p0, 8, pa1); PK4(p1, 0, pa2); PK4(p1, 8, pa3);
#undef PK4
}
__device__ __forceinline__ void qkt(f32x16& p0, f32x16& p1, const char* Ks, const bf16x8* qr, int r32, int hi) {
    p0 = f32x16{}; p1 = f32x16{};
#pragma unroll
    for (int d0 = 0; d0 < 12; ++d0) { const int cb = (d0 * 16 + hi * 8) * 2;
        const bf16x8 b0 = *reinterpret_cast<const bf16x8*>(Ks + KSWZ(r32, cb));
        const bf16x8 b1 = *reinterpret_cast<const bf16x8*>(Ks + KSWZ(32 + r32, cb));
        p0 = __builtin_amdgcn_mfma_f32_32x32x16_bf16(b0, qr[d0], p0, 0, 0, 0);
        p1 = __builtin_amdgcn_mfma_f32_32x32x16_bf16(b1, qr[d0], p1, 0, 0, 0); }
}
__device__ __forceinline__ int v_st(int k, int c) { const int kk = (k & ~0xC) | ((k & 4) << 1) | ((k & 8) >> 1); return ((kk >> 3) * 4 + (c >> 5)) * 512 + ((kk & 7) * 32 + (c & 31)) * 2; }
__device__ __forceinline__ int v_rd_base(int lane) { return ((lane & 3) << 3) | (((lane >> 2) & 3) << 6) | (((lane >> 4) & 1) << 5) | (((lane >> 5) & 1) << 8); }
constexpr int v_rd_off(int d0, int ks, int half) { return d0 * 512 + ks * 4096 + half * 2048; }
template <int OFF> __device__ __forceinline__ s16x4 tr_read(int vb) {
    s16x4 r; asm volatile("ds_read_b64_tr_b16 %0, %1 offset:%2" : "=&v"(r) : "v"(vb), "i"(OFF) : "memory"); return r;
}
template <int D0> __device__ __forceinline__ void pv_one(f32x16& od, int vb, bf16x8 pa0, bf16x8 pa1, bf16x8 pa2, bf16x8 pa3) {
    const s16x4 l0 = tr_read<v_rd_off(D0, 0, 0)>(vb), h0 = tr_read<v_rd_off(D0, 0, 1)>(vb), l1 = tr_read<v_rd_off(D0, 1, 0)>(vb), h1 = tr_read<v_rd_off(D0, 1, 1)>(vb);
    const s16x4 l2 = tr_read<v_rd_off(D0, 2, 0)>(vb), h2 = tr_read<v_rd_off(D0, 2, 1)>(vb), l3 = tr_read<v_rd_off(D0, 3, 0)>(vb), h3 = tr_read<v_rd_off(D0, 3, 1)>(vb);
    asm volatile("s_waitcnt lgkmcnt(0)" ::: "memory"); SBAR();
#define PK(L, H) (bf16x8){L[0], L[1], L[2], L[3], H[0], H[1], H[2], H[3]}
    od = __builtin_amdgcn_mfma_f32_32x32x16_bf16(pa0, PK(l0, h0), od, 0, 0, 0);
    od = __builtin_amdgcn_mfma_f32_32x32x16_bf16(pa1, PK(l1, h1), od, 0, 0, 0);
    od = __builtin_amdgcn_mfma_f32_32x32x16_bf16(pa2, PK(l2, h2), od, 0, 0, 0);
    od = __builtin_amdgcn_mfma_f32_32x32x16_bf16(pa3, PK(l3, h3), od, 0, 0, 0);
#undef PK
}
__device__ __forceinline__ void attn_unit(int b, int h, int qt, const bf16_t* Q, const bf16_t* K, const bf16_t* V, bf16_t* Y, char* lds, LAS unsigned char* ldsl, int wave0) {
    int tid = tid_of(wave0); asm volatile("" : "+v"(tid)); const int lane = tid & 63, r32 = lane & 31, hi = lane >> 5; const int wid = __builtin_amdgcn_readfirstlane(tid >> 6);
    char* V_lds = lds; char* K_lds = lds + 3 * SHM_V;
    float* ws = (float*)(lds + 3 * SHM_V + 3 * SHM_K) + wid * 64; float* li_l = ws; float* al_l = ws + 32;
    const size_t rowbase = (size_t)b * SEQ;
    const bf16_t* Qw = Q + (rowbase + qt * 256 + wid * QBLK + r32) * LDQ + h * DQ + hi * 8;
    const bf16_t* Kh = K + rowbase * LDQ + h * DQ; const bf16_t* Vh = V + rowbase * LDV + h * DV;
    float m_reg = -1e30f, l_reg = 0.f; f32x16 o[4] = {}; bf16x8 qr[12];
#pragma unroll
    for (int d0 = 0; d0 < 12; ++d0) qr[d0] = *reinterpret_cast<const bf16x8*>(Qw + d0 * 16);
    unsigned koff[3], voff[2];
#pragma unroll
    for (int i = 0; i < 3; ++i) { const int p = (wid * 3 + i) * 64 + lane, row = p / 24, s = p - row * 24; const int sg = (s & ~7) | ((s & 7) ^ ((row >> 1) & 7)); koff[i] = (unsigned)(row * LDQ + sg * 8) * 2u; }
#pragma unroll
    for (int i = 0; i < 2; ++i) { const int p = (wid * 2 + i) * 64 + lane, st = p >> 5, kk = (st >> 2) * 8 + ((p & 31) >> 2), c = (st & 3) * 32 + (p & 3) * 8;
        const int k = (kk & ~0xC) | ((kk & 4) << 1) | ((kk & 8) >> 1); voff[i] = (unsigned)(k * LDV + c) * 2u; }
    const int vb0 = (int)(uintptr_t)V_lds + v_rd_base(lane);
    const int NT = 4 * qt + 4, climit = 4 * qt + (wid >> 1);
#define DMA_TILE(t, sl) do { const char* kg_ = (const char*)Kh + (size_t)(t) * (KVBLK * LDQ * 2); const char* vg_ = (const char*)Vh + (size_t)(t) * (KVBLK * LDV * 2); \
    _Pragma("unroll") for (int i = 0; i < 3; ++i) __builtin_amdgcn_global_load_lds((const unsigned*)(kg_ + koff[i]), (LAS unsigned*)(ldsl + 3 * SHM_V + (sl) * SHM_K + (wid * 3 + i) * 1024), 16, 0, 0); \
    _Pragma("unroll") for (int i = 0; i < 2; ++i) __builtin_amdgcn_global_load_lds((const unsigned*)(vg_ + voff[i]), (LAS unsigned*)(ldsl + (sl) * SHM_V + (wid * 2 + i) * 1024), 16, 0, 0); } while (0)
    f32x16 pA0, pA1, pB0, pB1; float alA = 1.f, alB = 1.f; bf16x8 pa0, pa1, pa2, pa3;
    int sl_k = 0, sl_v = 2, sl_n = 1;
#define RESC(a) do { if (__any((a) < 1.f)) { if (hi == 0) al_l[r32] = (a); asm volatile("s_waitcnt lgkmcnt(0)" ::: "memory"); \
    _Pragma("unroll") for (int d = 0; d < 4; ++d) _Pragma("unroll") for (int r = 0; r < 16; ++r) o[d][r] *= al_l[crow(r, hi)]; } } while (0)
#define ROT() do { const int t_ = sl_v; sl_v = sl_k; sl_k = sl_n; sl_n = t_; } while (0)
#define STEP(j, C0, C1, ALC, P0, P1, ALP) do { \
    if ((j) + 1 < NT) DMA_TILE((j) + 1, sl_n); \
    if ((j) <= climit) { SBAR(); qkt(C0, C1, K_lds + sl_k * SHM_K, qr, r32, hi); } \
    if ((j) >= 1 && (j) - 1 <= climit) { finishSM(P0, P1, ALP, l_reg, pa0, pa1, pa2, pa3); SBAR(); const int vb = vb0 + sl_v * SHM_V; \
        pv_one<0>(o[0], vb, pa0, pa1, pa2, pa3); pv_one<1>(o[1], vb, pa0, pa1, pa2, pa3); pv_one<2>(o[2], vb, pa0, pa1, pa2, pa3); pv_one<3>(o[3], vb, pa0, pa1, pa2, pa3); } \
    if ((j) <= climit) { partialSM(C0, C1, m_reg, ALC); RESC(ALC); } \
    asm volatile("s_waitcnt vmcnt(0)" ::: "memory"); __syncthreads(); ROT(); } while (0)
    DMA_TILE(0, 0); asm volatile("s_waitcnt vmcnt(0)" ::: "memory"); __syncthreads();
    for (int j = 0; j < NT; j += 2) {
        STEP(j, pA0, pA1, alA, pB0, pB1, alB);
        STEP(j + 1, pB0, pB1, alB, pA0, pA1, alA);
    }
    if (NT - 1 <= climit) { finishSM(pB0, pB1, alB, l_reg, pa0, pa1, pa2, pa3); SBAR(); const int vb = vb0 + sl_v * SHM_V;
        pv_one<0>(o[0], vb, pa0, pa1, pa2, pa3); pv_one<1>(o[1], vb, pa0, pa1, pa2, pa3); pv_one<2>(o[2], vb, pa0, pa1, pa2, pa3); pv_one<3>(o[3], vb, pa0, pa1, pa2, pa3); }
#undef STEP
#undef ROT
#undef RESC
    if (hi == 0) li_l[r32] = l_reg; asm volatile("s_waitcnt lgkmcnt(0)" ::: "memory");
    bf16_t* Ow = Y + (rowbase + qt * 256 + wid * QBLK) * LDO + 1024 + h * DV;
#pragma unroll
    for (int r = 0; r < 16; ++r) { const int orow = crow(r, hi); const float rl = __builtin_amdgcn_rcpf(li_l[orow]);
#pragma unroll
        for (int d0 = 0; d0 < 4; ++d0) Ow[(size_t)orow * LDO + d0 * 32 + r32] = (bf16_t)(cvtpk(o[d0][r] * rl, 0.f) & 0xffffu); }
    __syncthreads();
#undef DMA_TILE
}
#undef SBAR
}


__device__ __forceinline__ float dot2bf(unsigned a, unsigned b, float c) {
    return __builtin_amdgcn_fdot2_f32_bf16(__builtin_bit_cast(bf16x2_t, a), __builtin_bit_cast(bf16x2_t, b), c, false); }
__device__ __forceinline__ float gelu_tanh(float x) {
    const float y = 0.7978845608028654f * (x + 0.044715f * x * x * x);
    const float t = __builtin_amdgcn_exp2f(2.8853900817779268f * y);
    return 0.5f * x * (2.f - 2.f * __builtin_amdgcn_rcpf(t + 1.f));
}

#ifndef DBG_ONLY
#define DBG_ONLY -1
#endif
#define PH(n) (DBG_ONLY < 0 || DBG_ONLY == (n))
#ifndef DBG_STOP
#define DBG_STOP 99

#endif

__global__ void __launch_bounds__(NWAVES * 64, 2) fwd_kernel(Args args) {
    extern __shared__ __attribute__((aligned(16))) unsigned char lds_raw[];
    LAS unsigned char* lds = (LAS unsigned char*)lds_raw;
    LAS unsigned char* eps = lds + EPI_OFF;
    volatile LAS unsigned* MISC = (volatile LAS unsigned*)(lds + MISC_OFF);
    const int wave0 = __builtin_amdgcn_readfirstlane((int)threadIdx.x >> 6);
    const int G = gridDim.x, bx = blockIdx.x, vcu = (G % 8 == 0) ? (bx % 8) * (G / 8) + bx / 8 : bx;
    const int NGW = G * NWAVES; const long NGT = (long)G * 512;
#define PHASE_IDS() int tid = tid_of(wave0); asm volatile("" : "+v"(tid)); const int lane = tid & 63, wave = __builtin_amdgcn_readfirstlane(tid >> 6); const int gw = vcu * NWAVES + wave; const long gt = (long)vcu * 512 + tid; (void)lane; (void)gw; (void)gt
    for (int u = threadIdx.x; u < (LDS_BYTES - LDSCTL_OFF) / 4; u += NWAVES * 64) ((LAS unsigned*)(lds + LDSCTL_OFF))[u] = 0u;
    __syncthreads();
#ifdef TIMING
    unsigned long long ts_prev = __builtin_amdgcn_s_memrealtime(); float ts_val = 0.f; int ts_idx = 0;
#define STAMP() do { const unsigned long long now_ = __builtin_amdgcn_s_memrealtime(); if (ts_idx == TIMING) ts_val = (float)(now_ - ts_prev) * 0.0001f; ts_prev = now_; ++ts_idx; } while (0)
#else
#define STAMP() do {} while (0)
#endif
    XcdBarrier bar;
    { KArgsP ka = kargs(); unsigned char* ws = ka->ws; bar = xcd_barrier_post((unsigned*)(ws + WS_CTL) + 4096, MISC + 8, wave0); }

    if (PH(0)) {
        KArgsP ka = kargs(); unsigned char* ws = ka->ws;
        const float* x = IN_F(0); const float* p_in = IN_F(1); const int* positions = (const int*)ka->in[2];
        const float* mix_gain = IN_F(3); const float* w_in = IN_F(4); const float* w_pool = IN_F(5); const float* pool_scale = IN_F(6);
        const float* q_lat_gain = IN_F(7); const float* kv_lat_gain = IN_F(8); const float* w_uq = IN_F(9); const float* w_ukv = IN_F(10);
        const float* w_out = IN_F(13); const float* w_pq = IN_F(15); const float* sub_k1 = IN_F(16); const float* sub_k2 = IN_F(17);
        const float* expert_u = IN_F(18); const float* expert_v = IN_F(19); const float* ple_gain = IN_F(20); const float* w_ple_gate = IN_F(21); const float* w_ple_proj = IN_F(22);
        bf16_t* WIN = (bf16_t*)WSP(WS_WIN); bf16_t* WPOOL = (bf16_t*)WSP(WS_WPOOL); bf16_t* SKB = (bf16_t*)WSP(WS_SK); bf16_t* WUQ = (bf16_t*)WSP(WS_WUQ); bf16_t* WUKV = (bf16_t*)WSP(WS_WUKV);
        bf16_t* WOUT = (bf16_t*)WSP(WS_WOUT); bf16_t* WPQ = (bf16_t*)WSP(WS_WPQ); bf16_t* WG = (bf16_t*)WSP(WS_WG); bf16_t* WP = (bf16_t*)WSP(WS_WP); bf16_t* PB = (bf16_t*)WSP(WS_PB);
        float* COS = (float*)WSP(WS_COS); float* SIN = (float*)WSP(WS_SIN); unsigned* EU8 = (unsigned*)WSP(WS_EU); unsigned* EV8 = (unsigned*)WSP(WS_EV); float* SU = (float*)WSP(WS_SU); float* SV = (float*)WSP(WS_SV); float* RSTDX = (float*)WSP(WS_RSTDX); unsigned* XQ = (unsigned*)WSP(WS_XQ);
        PHASE_IDS();
        LAS float* scr = (LAS float*)(lds + wave * 16384);
        (void)p_in; (void)sub_k1; (void)sub_k2; (void)expert_u; (void)expert_v; (void)SKB; (void)PB; (void)EU8; (void)EV8; (void)SU; (void)SV;
        if (bx < 66) {
            unsigned char* WINQ = (unsigned char*)WIN; float* SBW = (float*)WSP(WS_SBW);
            const int n0 = 32 * bx, c4 = lane & 7, kr = lane >> 3;
            const float* wp = w_in + (size_t)(256 * wave + 4 * kr) * 2112 + n0 + 4 * c4; const float* gp = mix_gain + 256 * wave + 4 * kr;
            f32x4 mx = {0.f, 0.f, 0.f, 0.f};
#pragma unroll 2
            for (int i = 0; i < 8; ++i) { f32x4 v[4]; const f32x4 gk = *(const f32x4*)(gp + 32 * i);
#pragma unroll
                for (int j = 0; j < 4; ++j) v[j] = *(const f32x4*)(wp + (size_t)(32 * i + j) * 2112);
#pragma unroll
                for (int j = 0; j < 4; ++j)
#pragma unroll
                    for (int e = 0; e < 4; ++e) mx[e] = fmaxf(mx[e], fabsf(v[j][e] * gk[j])); }
#pragma unroll
            for (int e = 0; e < 4; ++e) { mx[e] = fmaxf(mx[e], __shfl_xor(mx[e], 8)); mx[e] = fmaxf(mx[e], __shfl_xor(mx[e], 16)); mx[e] = fmaxf(mx[e], __shfl_xor(mx[e], 32)); }
            LAS float* cm = (LAS float*)(lds + EPI_OFF);
            if (kr == 0) *(LAS f32x4*)(cm + wave * 32 + 4 * c4) = mx;
            __syncthreads();
            f32x4 cmax = *(const LAS f32x4*)(cm + 4 * c4);
#pragma unroll
            for (int w = 1; w < 8; ++w) { const f32x4 o = *(const LAS f32x4*)(cm + w * 32 + 4 * c4);
#pragma unroll
                for (int e = 0; e < 4; ++e) cmax[e] = fmaxf(cmax[e], o[e]); }
            f32x4 sc, inv;
#pragma unroll
            for (int e = 0; e < 4; ++e) { sc[e] = cmax[e] > 0.f ? cmax[e] * (1.f / 127.f) : 1.f; inv[e] = 1.f / sc[e]; }
            if (wave == 0 && kr == 0) *(f32x4*)(SBW + n0 + 4 * c4) = sc;
            LAS unsigned char* tb = lds + wave * 16384;
#pragma unroll 2
            for (int i = 0; i < 8; ++i) { f32x4 v[4]; const f32x4 gk = *(const f32x4*)(gp + 32 * i);
#pragma unroll
                for (int j = 0; j < 4; ++j) v[j] = *(const f32x4*)(wp + (size_t)(32 * i + j) * 2112);
#pragma unroll
                for (int e = 0; e < 4; ++e) { unsigned wd = 0;
#pragma unroll
                    for (int j = 0; j < 4; ++j) wd |= ((unsigned)((int)rintf(v[j][e] * gk[j] * inv[e]) & 0xff)) << (8 * j);
                    *(LAS unsigned*)(tb + (4 * c4 + e) * 272 + 32 * i + 4 * kr) = wd; } }
            asm volatile("s_waitcnt lgkmcnt(0)" ::: "memory");
#pragma unroll
            for (int r = 0; r < 8; ++r) { const int id = lane + 64 * r, n = id >> 4, ch = id & 15;
                *(u32x4*)(WINQ + (size_t)(n0 + n) * 2048 + 256 * wave + 16 * ch) = *(const LAS u32x4*)(tb + n * 272 + 16 * ch); }
            asm volatile("s_waitcnt lgkmcnt(0)" ::: "memory");
        }
        (void)w_pool; (void)pool_scale; (void)q_lat_gain; (void)kv_lat_gain; (void)w_uq; (void)w_ukv; (void)w_out; (void)w_pq; (void)ple_gain; (void)w_ple_gate; (void)w_ple_proj;
        (void)WPOOL; (void)WUKV; (void)WOUT; (void)WPQ; (void)WG; (void)WP;
        for (long i = gt; i < 24576 + 32768; i += NGT) {
            const u32x4 z = {0u, 0u, 0u, 0u};
            if (i < 24576) { *(u32x4*)((unsigned char*)WIN + (size_t)2112 * 2048 + i * 16) = z; if (i < 192) ((float*)WSP(WS_SBW))[2112 + i] = 1.f; }
            else { const long j = i - 24576; const int hh = (int)(j >> 12), rem = (int)(j & 4095); *(u32x4*)(WUQ + ((size_t)hh * 256 + 192) * 512 + (size_t)rem * 8) = z; }
        }
        for (int m = 2 * gw; m < M; m += 2 * NGW) {
            f32x4 v[2][8]; float s[2] = {0.f, 0.f}; float mxr[2] = {0.f, 0.f};
#pragma unroll
            for (int a = 0; a < 2; ++a) { const f32x4* xr = (const f32x4*)(x + (size_t)(m + a) * DM) + lane;
#pragma unroll
                for (int j = 0; j < 8; ++j) v[a][j] = __builtin_nontemporal_load(xr + 64 * j); }
#pragma unroll
            for (int a = 0; a < 2; ++a) {
#pragma unroll
                for (int j = 0; j < 8; ++j) { s[a] += sq4(v[a][j]); mxr[a] = fmaxf(mxr[a], fmaxf(fmaxf(fabsf(v[a][j][0]), fabsf(v[a][j][1])), fmaxf(fabsf(v[a][j][2]), fabsf(v[a][j][3])))); }
                const float rs = rsqrtf(wave_sum(s[a]) * (1.f / DM) + EPS);
                const float am = wave_max(mxr[a]), sx = am > 0.f ? am * (1.f / 127.f) : 1.f, ix = 1.f / sx;
                unsigned* q8 = XQ + (size_t)(m + a) * 512 + lane;
#pragma unroll
                for (int j = 0; j < 8; ++j) { const f32x4 t = v[a][j] * ix;
                    q8[64 * j] = ((unsigned)((int)rintf(t[0]) & 0xff)) | (((unsigned)((int)rintf(t[1]) & 0xff)) << 8) | (((unsigned)((int)rintf(t[2]) & 0xff)) << 16) | (((unsigned)((int)rintf(t[3]) & 0xff)) << 24); }
                if (lane == 0) RSTDX[m + a] = rs * sx; }
        }
        for (long i = gt; i < (long)M * 32; i += NGT) {
            const int row = (int)(i >> 5), j = (int)(i & 31);
            const float inv = __builtin_amdgcn_exp2f(-(float)j * (13.287712379549449f / 32.f));
            const float ang = (float)positions[row] * inv;
            const float kq = rintf(ang * 0.15915494309189535f);
            float r = fmaf(-kq, 6.2831854820251465f, ang); r = fmaf(-kq, -1.7484555e-7f, r);
            const float rev = r * 0.15915494309189535f;
            COS[i] = __builtin_amdgcn_cosf(rev); SIN[i] = __builtin_amdgcn_sinf(rev);
        }
    }
    xcd_barrier(bar); STAMP();
    if (DBG_STOP == 0) return;

    if (PH(1)) {
        KArgsP ka = kargs(); unsigned char* ws = ka->ws;
        bf16_t* XN = (bf16_t*)WSP(WS_XQ); const float* RSTDX = (const float*)WSP(WS_RSTDX); const float* SBW = (const float*)WSP(WS_SBW); bf16_t* WIN = (bf16_t*)WSP(WS_WIN); bf16_t* ZP = (bf16_t*)WSP(WS_ZP); bf16_t* CQ = (bf16_t*)WSP(WS_CQ); bf16_t* CKV = (bf16_t*)WSP(WS_CKV);
        float* SSQ_CQ = (float*)WSP(WS_SSQ_CQ); float* SSQ_CKV = (float*)WSP(WS_SSQ_CKV); float* KRP = (float*)WSP(WS_KRP);
#define PHASE_A_SIDE() do { KArgsP kb = kargs(); unsigned char* ws = kb->ws; PHASE_IDS(); LAS float* scr = (LAS float*)(lds + wave * 16384); \
        { const float* eu = (const float*)kb->in[18]; const float* ev = (const float*)kb->in[19]; unsigned* EU8 = (unsigned*)WSP(WS_EU); unsigned* EV8 = (unsigned*)WSP(WS_EV); float* SU = (float*)WSP(WS_SU); float* SV = (float*)WSP(WS_SV); \
          for (int r = gw * 16; r < gw * 16 + 16; r += 4) quant_rows<4>(eu, ev, EU8, EV8, SU, SV, r, lane); } \
        { const float* w_pool = (const float*)kb->in[5]; const float* pool_scale = (const float*)kb->in[6]; const float* q_lat_gain = (const float*)kb->in[7]; const float* kv_lat_gain = (const float*)kb->in[8]; \
          const float* w_uq = (const float*)kb->in[9]; const float* w_ukv = (const float*)kb->in[10]; const float* w_out = (const float*)kb->in[13]; const float* w_pq = (const float*)kb->in[15]; const float* ffn_gain = (const float*)kb->in[14]; \
          const float* ple_gain = (const float*)kb->in[20]; const float* w_ple_gate = (const float*)kb->in[21]; const float* w_ple_proj = (const float*)kb->in[22]; \
          bf16_t* WPOOL = (bf16_t*)WSP(WS_WPOOL); bf16_t* WUQ = (bf16_t*)WSP(WS_WUQ); bf16_t* WUKV = (bf16_t*)WSP(WS_WUKV); bf16_t* WOUT = (bf16_t*)WSP(WS_WOUT); bf16_t* WPQ = (bf16_t*)WSP(WS_WPQ); bf16_t* WG = (bf16_t*)WSP(WS_WG); bf16_t* WP = (bf16_t*)WSP(WS_WP); \
          constexpr int I_POOL = 4 * 4 * 8, I_UQ = 8 * 48, I_UKV = 8 * 64, I_SQ = 32 * 64, I_WP = 4 * 64, NITEMS = I_POOL + I_UQ + I_UKV + 3 * I_SQ + I_WP; \
          auto trp = [&](int r) -> TrP { \
            if (r < I_POOL) { const int g_ = r >> 5; return TrP{w_pool + g_ * 65536, nullptr, pool_scale + g_ * 256, WPOOL + g_ * 65536, 256, 256, 8, r & 31, 0}; } r -= I_POOL; \
            if (r < I_UQ) return TrP{w_uq, q_lat_gain, nullptr, WUQ, 1536, 512, 48, r, 1}; r -= I_UQ; \
            if (r < I_UKV) return TrP{w_ukv, kv_lat_gain, nullptr, WUKV, 2048, 512, 64, r, 0}; r -= I_UKV; \
            if (r < I_SQ) return TrP{w_out, nullptr, nullptr, WOUT, 2048, 2048, 64, r, 0}; r -= I_SQ; \
            if (r < I_SQ) return TrP{w_pq, ffn_gain, nullptr, WPQ, 2048, 2048, 64, r, 0}; r -= I_SQ; \
            if (r < I_SQ) return TrP{w_ple_gate, ple_gain, nullptr, WG, 2048, 2048, 64, r, 0}; r -= I_SQ; \
            return TrP{w_ple_proj, nullptr, nullptr, WP, 2048, 256, 64, r, 0}; }; \
          for (int it = gw; it < NITEMS; it += 2 * NGW) { const bool two = it + NGW < NITEMS; const TrP pa = trp(it), pb = trp(two ? it + NGW : it); \
            float va[32], vb[32]; tr_load(pa, va, lane); if (two) tr_load(pb, vb, lane); \
            tr_store(pa, va, scr, lane); if (two) tr_store(pb, vb, scr, lane); } } \
        asm volatile("s_waitcnt vmcnt(0) lgkmcnt(0)" ::: "memory"); __syncthreads(); } while (0)
        if (vcu & 1) PHASE_A_SIDE();
        pg8::Gemm g{XN, WIN, 2048, 2048, 2048}; pg8::StaticOrder S; S.init(M, 2048, G, bx);
        EpiA E{ZP, CQ, CKV, SSQ_CQ, SSQ_CKV, RSTDX, SBW};
        pg8::gemm_phase<EpiA, pg8::StaticOrder, true, true, true>(lds, eps, g, S, E, wave0);
        pg8::Gemm g2{XN, WIN, 2048, 2048, 512}; pg8::QuadOrder<0> S2{vcu};
        EpiKR E2{KRP, RSTDX, SBW};
        pg8::gemm_phase<EpiKR, pg8::QuadOrder<0>, true, true, true>(lds, eps, g2, S2, E2, wave0);
        if (!(vcu & 1)) PHASE_A_SIDE();
#undef PHASE_A_SIDE
    }
    xcd_barrier(bar); STAMP();
    if (DBG_STOP == 1) return;

    if (PH(2)) {
        { KArgsP ka = kargs(); unsigned char* ws = ka->ws;
          bf16_t* ZP = (bf16_t*)WSP(WS_ZP); bf16_t* WPOOL = (bf16_t*)WSP(WS_WPOOL); bf16_t* UB = (bf16_t*)WSP(WS_U);
          pg8::Gemm gp{ZP, WPOOL, 1024, 256, 256}; pg8::QuadOrder<1> Sp{vcu};
          EpiStore Ep{UB, 1024};
          pg8::gemm_phase<EpiStore, pg8::QuadOrder<1>, true>(lds, eps, gp, Sp, Ep, wave0); }
        { KArgsP ka = kargs(); unsigned char* ws = ka->ws; const float* q_norm_gain = IN_F(11);
          bf16_t* CQ = (bf16_t*)WSP(WS_CQ); bf16_t* WUQ = (bf16_t*)WSP(WS_WUQ); bf16_t* QB = (bf16_t*)WSP(WS_Q);
          float* SSQ_CQ = (float*)WSP(WS_SSQ_CQ); float* COS = (float*)WSP(WS_COS); float* SIN = (float*)WSP(WS_SIN);
          pg8::Gemm gq{CQ, WUQ, 512, 512, 512}; pg8::StaticOrder Sq; Sq.init(M, 2048, G, bx);
          EpiQ Eq{QB, SSQ_CQ, q_norm_gain, COS, SIN};
          pg8::gemm_phase<EpiQ, pg8::StaticOrder, true>(lds, eps, gq, Sq, Eq, wave0); }
        { KArgsP ka = kargs(); unsigned char* ws = ka->ws; const float* k_norm_gain = IN_F(12);
          bf16_t* CKV = (bf16_t*)WSP(WS_CKV); bf16_t* WUKV = (bf16_t*)WSP(WS_WUKV); bf16_t* KB = (bf16_t*)WSP(WS_K); bf16_t* VB = (bf16_t*)WSP(WS_V);
          float* SSQ_CKV = (float*)WSP(WS_SSQ_CKV); float* KRP = (float*)WSP(WS_KRP); float* COS = (float*)WSP(WS_COS); float* SIN = (float*)WSP(WS_SIN);
          pg8::Gemm gk{CKV, WUKV, 512, 512, 512}; pg8::StaticOrder Sk; Sk.init(M, 2048, G, bx);
          EpiKV Ek{KB, VB, SSQ_CKV, KRP, k_norm_gain, COS, SIN};
          pg8::gemm_phase<EpiKV, pg8::StaticOrder, true>(lds, eps, gk, Sk, Ek, wave0); }
    }
    xcd_barrier(bar); STAMP();
    if (DBG_STOP == 2) return;

    if (PH(3)) {
        KArgsP ka = kargs(); unsigned char* ws = ka->ws;
        bf16_t* UB = (bf16_t*)WSP(WS_U); bf16_t* YMIX = (bf16_t*)WSP(WS_R1); bf16_t* QB = (bf16_t*)WSP(WS_Q); bf16_t* KB = (bf16_t*)WSP(WS_K); bf16_t* VB = (bf16_t*)WSP(WS_V);
        PHASE_IDS();
        {
            const int g = wave & 3, c0 = (32 * g + (lane & 31)) * 8, row0 = vcu * 64 + 32 * (wave >> 2) + 16 * (lane >> 5);
#define FILT_ACC(OP, V) do { a[0] OP bf_lo((V).x); a[1] OP bf_hi((V).x); a[2] OP bf_lo((V).y); a[3] OP bf_hi((V).y); a[4] OP bf_lo((V).z); a[5] OP bf_hi((V).z); a[6] OP bf_lo((V).w); a[7] OP bf_hi((V).w); } while (0)
#define FILT(W) do { const int tl0 = row0 & (SEQ - 1); const bool hist = tl0 != 0; u32x4 h[(W) + 16]; \
                _Pragma("unroll") for (int j = 0; j < (W) + 16; ++j) { const bool ok = hist || j >= (W); h[j] = *(const u32x4*)(UB + (size_t)(ok ? row0 - (W) + j : row0) * 1024 + c0); if (!ok) h[j] = (u32x4){0u, 0u, 0u, 0u}; } \
                float a[8]; _Pragma("unroll") for (int e = 0; e < 8; ++e) a[e] = 0.f; \
                _Pragma("unroll") for (int j = 0; j < (W); ++j) FILT_ACC(+=, h[j]); \
                _Pragma("unroll") for (int rI = 0; rI < 16; ++rI) { const int row = row0 + rI, tl = tl0 + rI; const int cnt = (tl + 1 < (W)) ? tl + 1 : (W); const u32x4 cur = h[(W) + rI]; \
                    FILT_ACC(+=, cur); FILT_ACC(-=, h[rI]); \
                    const float ic = 1.f / (float)cnt; u32x4 o; \
                    o.x = cvtpk(a[0] * ic - bf_lo(cur.x), a[1] * ic - bf_hi(cur.x)); o.y = cvtpk(a[2] * ic - bf_lo(cur.y), a[3] * ic - bf_hi(cur.y)); \
                    o.z = cvtpk(a[4] * ic - bf_lo(cur.z), a[5] * ic - bf_hi(cur.z)); o.w = cvtpk(a[6] * ic - bf_lo(cur.w), a[7] * ic - bf_hi(cur.w)); \
                    *(u32x4*)(YMIX + (size_t)row * DM + c0) = o; } } while (0)
            if (g == 0) FILT(2); else if (g == 1) FILT(4); else if (g == 2) FILT(8); else FILT(16);
#undef FILT
#undef FILT_ACC
        }
        if (G == 256) {
            const int bh = vcu >> 2, s = vcu & 3;
            att::attn_unit(bh >> 3, bh & 7, s, QB, KB, VB, YMIX, (char*)lds_raw, lds, wave0);
            att::attn_unit(bh >> 3, bh & 7, 7 - s, QB, KB, VB, YMIX, (char*)lds_raw, lds, wave0);
        }
    }
    xcd_barrier(bar); STAMP();
    if (DBG_STOP == 3) return;

    if (PH(4)) {
        KArgsP ka = kargs(); unsigned char* ws = ka->ws; const float* x = IN_F(0); bf16_t* H1B = (bf16_t*)WSP(WS_H2B);
        bf16_t* YMIX = (bf16_t*)WSP(WS_R1); bf16_t* WOUT = (bf16_t*)WSP(WS_WOUT); float* SSQ_H1 = (float*)WSP(WS_SSQ_H1);
        pg8::Gemm g{YMIX, WOUT, 2048, 2048, 2048}; pg8::StaticOrder S; S.init(M, 2048, G, bx);
        EpiH1 E{x, H1B, SSQ_H1};
        pg8::gemm_phase<EpiH1, pg8::StaticOrder, true>(lds, eps, g, S, E, wave0);
    }
    xcd_barrier(bar); STAMP();
    if (DBG_STOP == 4) return;

    if (PH(5)) {
        KArgsP ka = kargs(); unsigned char* ws = ka->ws;
        bf16_t* H1B = (bf16_t*)WSP(WS_H2B); bf16_t* WPQ = (bf16_t*)WSP(WS_WPQ); bf16_t* QP = (bf16_t*)WSP(WS_R1); float* SSQ_H1 = (float*)WSP(WS_SSQ_H1); float* RSTD2 = (float*)WSP(WS_RSTD2);
        pg8::Gemm g{H1B, WPQ, 2048, 2048, 2048}; pg8::PairOrder S{vcu};
        EpiQP E{QP, SSQ_H1, RSTD2};
        pg8::gemm_phase<EpiQP, pg8::PairOrder, true>(lds, eps, g, S, E, wave0);
    }
    asm volatile("s_waitcnt vmcnt(0)" ::: "memory"); __syncthreads();
    if (tid_of(wave0) == 0) { __builtin_amdgcn_fence(__ATOMIC_ACQUIRE, "agent"); asm volatile("s_waitcnt vmcnt(0)" ::: "memory"); }
    __syncthreads(); STAMP();
    if (DBG_STOP == 5) return;

    if (PH(6)) {
        KArgsP ka = kargs(); unsigned char* ws = ka->ws;
        bf16_t* QP = (bf16_t*)WSP(WS_R1); bf16_t* SKB = (bf16_t*)WSP(WS_SK); int* PIDX = (int*)WSP(WS_PIDX); float* PGATE = (float*)WSP(WS_PGATE);
        PHASE_IDS();
        LAS unsigned char* SKL = lds;
        LAS float* SC = (LAS float*)(lds + 65536 + wave * 10816);
        LAS float* TKV = (LAS float*)(lds + 65536 + wave * 10816 + 8256);
        LAS unsigned char* TKI = lds + 65536 + wave * 10816 + 8256 + 2048;
        const int fr = lane & 15, fq = lane >> 4; const int h = vcu & 7;
#pragma unroll
        for (int i = 0; i < 8; ++i) { const int p = tid + 512 * i, side = p >> 11, key = (p >> 4) & 127, c = p & 15;
            const u32x4 v = *(const u32x4*)(SKB + (size_t)side * 131072 + (size_t)h * 16384 + key * 128 + c * 8);
            *(LAS u32x4*)(SKL + side * 32768 + key * 256 + ((c ^ (key & 15)) << 4)) = v; }
        __syncthreads();
        for (int bi = 0; bi < 4; ++bi) {
            const int tb = (vcu >> 3) * 32 + wave * 4 + bi, t0 = tb * 16;
#pragma unroll 1
            for (int side = 0; side < 2; ++side) {
                bf16x8 qf[4];
#pragma unroll
                for (int kk = 0; kk < 4; ++kk) qf[kk] = *(const bf16x8*)(QP + (size_t)(t0 + fr) * DM + h * 256 + side * 128 + kk * 32 + 8 * fq);
                const LAS unsigned char* skl = SKL + side * 32768 + fr * 256;
#pragma unroll
                for (int nt = 0; nt < 8; ++nt) { f32x4 a = {0.f, 0.f, 0.f, 0.f};
#pragma unroll
                    for (int kk = 0; kk < 4; ++kk) { const bf16x8 kf = *(const LAS bf16x8*)(skl + nt * 4096 + (((kk * 4 + fq) ^ fr) << 4));
                        a = __builtin_amdgcn_mfma_f32_16x16x32_bf16(kf, qf[kk], a, 0, 0, 0); }
#pragma unroll
                    for (int i = 0; i < 4; ++i) SC[fr * 129 + nt * 16 + 4 * fq + i] = a[i]; }
                asm volatile("s_waitcnt lgkmcnt(0)" ::: "memory");
                const int tok = lane >> 2, q4 = lane & 3; float v[32];
#pragma unroll
                for (int i = 0; i < 32; ++i) v[i] = __builtin_bit_cast(float, (__builtin_bit_cast(unsigned, SC[tok * 129 + 4 * i + q4]) & ~0x7Fu) | (unsigned)(4 * i + q4));
                bitonic_sort_desc<32>(v); QUAD_MERGE16(v, 0xB1); QUAD_MERGE16(v, 0x4E);
                if (q4 == 0) {
#pragma unroll
                    for (int r = 0; r < 16; ++r) { const int bk = (int)(__builtin_bit_cast(unsigned, v[r]) & 0x7Fu); TKV[(side * 16 + tok) * 16 + r] = SC[tok * 129 + bk]; TKI[(side * 16 + tok) * 16 + r] = (unsigned char)bk; } }
                asm volatile("s_waitcnt lgkmcnt(0)" ::: "memory");
            }
            {
                const int tok = lane >> 2, q4 = lane & 3; float c[32];
                const LAS float* V1 = TKV + tok * 16; const LAS float* V2 = TKV + (16 + tok) * 16;
#define CAND(slot, a, bi) do { const int b_ = q4 + 4 * (bi); const float s_ = V1[a] + V2[b_]; \
    c[slot] = (((a) + 1) * (b_ + 1) <= 16) ? __builtin_bit_cast(float, (__builtin_bit_cast(unsigned, s_) & ~0xFFu) | (unsigned)((a) * 16 + b_)) : -INFINITY; } while (0)
                CAND(0, 0, 0); CAND(1, 0, 1); CAND(2, 0, 2); CAND(3, 0, 3); CAND(4, 1, 0); CAND(5, 1, 1); CAND(6, 2, 0); CAND(7, 2, 1);
                CAND(8, 3, 0); CAND(9, 4, 0); CAND(10, 5, 0); CAND(11, 6, 0); CAND(12, 7, 0); CAND(13, 8, 0); CAND(14, 9, 0); CAND(15, 10, 0);
                CAND(16, 11, 0); CAND(17, 12, 0); CAND(18, 13, 0); CAND(19, 14, 0); CAND(20, 15, 0);
#undef CAND
#pragma unroll
                for (int i = 21; i < 32; ++i) c[i] = -INFINITY;
                bitonic_sort_desc<32>(c); QUAD_MERGE16(c, 0xB1); QUAD_MERGE16(c, 0x4E);
                int co[4];
#pragma unroll
                for (int ri = 0; ri < 4; ++ri) { const float x_ = q4 == 0 ? c[4 * ri] : q4 == 1 ? c[4 * ri + 1] : q4 == 2 ? c[4 * ri + 2] : c[4 * ri + 3]; co[ri] = (int)(__builtin_bit_cast(unsigned, x_) & 0xFFu); }
                float sv[4]; float mx = -INFINITY;
#pragma unroll
                for (int ri = 0; ri < 4; ++ri) { sv[ri] = V1[co[ri] >> 4] + V2[co[ri] & 15]; mx = fmaxf(mx, sv[ri]); }
                mx = quad_max(mx);
                float eo[4]; float esum = 0.f;
#pragma unroll
                for (int ri = 0; ri < 4; ++ri) { eo[ri] = __builtin_amdgcn_exp2f((sv[ri] - mx) * 1.4426950408889634f); esum += eo[ri]; }
                esum = quad_sum(esum);
                const float inv = 1.f / esum;
#pragma unroll
                for (int ri = 0; ri < 4; ++ri) { const int e1 = (int)TKI[tok * 16 + (co[ri] >> 4)], e2 = (int)TKI[(16 + tok) * 16 + (co[ri] & 15)];
                    const size_t oi = (size_t)(t0 + tok) * 128 + h * 16 + 4 * ri + q4;
                    PIDX[oi] = e1 * 128 + e2; PGATE[oi] = eo[ri] * inv; }
            }
            asm volatile("s_waitcnt lgkmcnt(0)" ::: "memory");
        }
    }
    xcd_barrier(bar); STAMP();
    if (DBG_STOP == 6) return;


    if (PH(7)) {
        PHASE_IDS();
        const int xc = bx & 7, wl = (bx >> 3) * NWAVES + wave;
        const int gi = lane >> 3, cj = lane & 7; const unsigned cj16 = 16u * (unsigned)cj;
        const int tpw = M / ((G >> 3) * NWAVES);
        {
            KArgsP ka = kargs(); unsigned char* ws = ka->ws;
            const bf16_t* H1B = (const bf16_t*)WSP(WS_H2B); const unsigned char* TU = WSP(WS_EU); const int* PIDX = (const int*)WSP(WS_PIDX); const float* ffn_gain = IN_F(14);
            LAS unsigned char* xl = lds + wave * 8448; LAS float* xs = (LAS float*)(xl + 8192);
#define F1_LOADIDX(n_, EV) do { const int nn_ = (n_) < tpw ? (n_) : tpw - 1; const size_t t_ = (size_t)(wl * tpw + nn_); \
        _Pragma("unroll") for (int q = 0; q < 4; ++q) EV[q] = *(const u32x4*)(PIDX + t_ * 128 + 16 * gi + 4 * q); } while (0)
#define F1_GATHER(EV, UU) do { _Pragma("unroll") for (int q = 0; q < 4; ++q) { UU[4 * q] = *(const u32x4*)(tus + ((EV[q].x << 7) | cj16)); UU[4 * q + 1] = *(const u32x4*)(tus + ((EV[q].y << 7) | cj16)); \
        UU[4 * q + 2] = *(const u32x4*)(tus + ((EV[q].z << 7) | cj16)); UU[4 * q + 3] = *(const u32x4*)(tus + ((EV[q].w << 7) | cj16)); } } while (0)
#define F1_COMPUTE(n_, UU) do { const u32x4 xq = *(const LAS u32x4*)(xl + (n_) * 128 + cj16); const float sx = xs[(n_)]; f32x4 pr[4]; \
        _Pragma("unroll") for (int g = 0; g < 16; ++g) { int d = __builtin_amdgcn_sdot4((int)UU[g].x, (int)xq.x, 0, false); d = __builtin_amdgcn_sdot4((int)UU[g].y, (int)xq.y, d, false); \
            d = __builtin_amdgcn_sdot4((int)UU[g].z, (int)xq.z, d, false); d = __builtin_amdgcn_sdot4((int)UU[g].w, (int)xq.w, d, false); pr[g >> 2][g & 3] = (float)oct_sum_i(d) * sx; } \
        if (cj == 0) { bf16_t* po = PART + (size_t)(wl * tpw + (n_)) * 128 + 16 * gi; __builtin_nontemporal_store(pack8(pr[0], pr[1]), (u32x4*)po); __builtin_nontemporal_store(pack8(pr[2], pr[3]), (u32x4*)(po + 8)); } } while (0)
#pragma unroll 1
            for (int p = 0; p < 2; ++p) {
                const int s = 2 * xc + p; const unsigned char* tus = TU + (size_t)s * (16384 * 128);
                bf16_t* PART = (bf16_t*)(p == 0 ? WSP(WS_PART0) : WSP(WS_PART1)) + (size_t)xc * M * 128;
                {
                    float gsl[16];
#pragma unroll
                    for (int i = 0; i < 16; ++i) gsl[i] = ffn_gain[128 * s + 16 * cj + i];
#pragma unroll 2
                    for (int o = 0; o < tpw; o += 8) { const size_t t_ = (size_t)(wl * tpw + o + gi);
                        const u32x4 XA = *(const u32x4*)(H1B + t_ * DM + 128 * s + 16 * cj), XB = *(const u32x4*)(H1B + t_ * DM + 128 * s + 16 * cj + 8);
                        const unsigned xw[8] = {XA.x, XA.y, XA.z, XA.w, XB.x, XB.y, XB.z, XB.w}; float xf[16]; float mx = 0.f;
#pragma unroll
                        for (int i = 0; i < 8; ++i) { xf[2 * i] = bf_lo(xw[i]) * gsl[2 * i]; xf[2 * i + 1] = bf_hi(xw[i]) * gsl[2 * i + 1]; mx = fmaxf(mx, fmaxf(fabsf(xf[2 * i]), fabsf(xf[2 * i + 1]))); }
                        mx = oct_max(mx); const float sx = mx > 0.f ? mx * (1.f / 127.f) : 1.f; const float inv = 1.f / sx; u32x4 xq;
#pragma unroll
                        for (int i = 0; i < 4; ++i) { const int q0 = (int)rintf(xf[4 * i] * inv), q1 = (int)rintf(xf[4 * i + 1] * inv), q2 = (int)rintf(xf[4 * i + 2] * inv), q3 = (int)rintf(xf[4 * i + 3] * inv);
                            xq[i] = (unsigned)(q0 & 0xff) | ((unsigned)(q1 & 0xff) << 8) | ((unsigned)(q2 & 0xff) << 16) | ((unsigned)(q3 & 0xff) << 24); }
                        *(LAS u32x4*)(xl + (o + gi) * 128 + 16 * cj) = xq; if (cj == 0) xs[o + gi] = sx; }
                    asm volatile("s_waitcnt lgkmcnt(0)" ::: "memory");
                }
                u32x4 evA[4], evB[4], uuA[16], uuB[16];
                F1_LOADIDX(0, evA); F1_LOADIDX(1, evB); F1_GATHER(evA, uuA);
#pragma unroll 1
                for (int n = 0; n < tpw; n += 2) {
                    F1_GATHER(evB, uuB); F1_LOADIDX(n + 2, evA); F1_COMPUTE(n, uuA);
                    F1_GATHER(evA, uuA); F1_LOADIDX(n + 3, evB); F1_COMPUTE(n + 1, uuB);
                }
                asm volatile("s_waitcnt lgkmcnt(0)" ::: "memory");
            }
#undef F1_LOADIDX
#undef F1_GATHER
#undef F1_COMPUTE
        }
        xcd_barrier(bar);
        {
            KArgsP ka = kargs(); unsigned char* ws = ka->ws;
            const bf16_t* P0 = (const bf16_t*)WSP(WS_PART0); const bf16_t* P1 = (const bf16_t*)WSP(WS_PART1); const int* PIDX = (const int*)WSP(WS_PIDX); const float* PGATE = (const float*)WSP(WS_PGATE);
            const float* SU = (const float*)WSP(WS_SU); const float* SV = (const float*)WSP(WS_SV); const float* RSTD2 = (const float*)WSP(WS_RSTD2); unsigned* AQ = (unsigned*)WSP(WS_AQ); float* AS = (float*)WSP(WS_AS);
            for (int tp = gw; tp < M / 2; tp += NGW) {
                const int t = 2 * tp + (lane >> 5), li = lane & 31; const size_t i = (size_t)t * 128 + 4 * li;
                f32x4 sum = {0.f, 0.f, 0.f, 0.f};
#pragma unroll
                for (int x8 = 0; x8 < 8; ++x8) { const u32x2 a = __builtin_nontemporal_load((const u32x2*)(P0 + (size_t)x8 * M * 128 + i)), b = __builtin_nontemporal_load((const u32x2*)(P1 + (size_t)x8 * M * 128 + i));
                    sum += (f32x4){bf_lo(a.x), bf_hi(a.x), bf_lo(a.y), bf_hi(a.y)} + (f32x4){bf_lo(b.x), bf_hi(b.x), bf_lo(b.y), bf_hi(b.y)}; }
                const u32x4 e4 = *(const u32x4*)(PIDX + i); const f32x4 g4 = *(const f32x4*)(PGATE + i); const float rs = RSTD2[t];
                const unsigned ee[4] = {e4.x, e4.y, e4.z, e4.w}; float a[4]; float mx = 0.f;
#pragma unroll
                for (int c = 0; c < 4; ++c) { a[c] = gelu_tanh(sum[c] * SU[ee[c]] * rs) * g4[c] * SV[ee[c]]; mx = fmaxf(mx, fabsf(a[c])); }
                mx = oct_max(mx); mx = fmaxf(mx, DPP_F(mx, 0x128)); mx = fmaxf(mx, __shfl_xor(mx, 16));
                const float sc = mx > 0.f ? mx * (1.f / 127.f) : 1.f; const float inv = 1.f / sc;
                const int q0 = (int)rintf(a[0] * inv), q1 = (int)rintf(a[1] * inv), q2 = (int)rintf(a[2] * inv), q3 = (int)rintf(a[3] * inv);
                AQ[(size_t)t * 32 + li] = (unsigned)(q0 & 0xff) | ((unsigned)(q1 & 0xff) << 8) | ((unsigned)(q2 & 0xff) << 16) | ((unsigned)(q3 & 0xff) << 24);
                if (li == 0) AS[t] = sc;
            }
        }
        xcd_barrier(bar);
        {
            KArgsP ka = kargs(); unsigned char* ws = ka->ws;
            const unsigned char* TV = WSP(WS_EV); const int* PIDX = (const int*)WSP(WS_PIDX); const unsigned* AQ = (const unsigned*)WSP(WS_AQ); const float* AS = (const float*)WSP(WS_AS);
            bf16_t* H2B = (bf16_t*)WSP(WS_H2B); float* SSQ2 = (float*)WSP(WS_SSQ2);
            const int nit = tpw;
#define F3_LOADIDX(it_, EV, AQV) do { const int ii_ = (it_) < nit ? (it_) : nit - 1; const size_t t_ = (size_t)(wl * tpw + (ii_ >> 3) * 8 + gi); const int kb_ = ii_ & 7; \
        _Pragma("unroll") for (int q = 0; q < 4; ++q) EV[q] = *(const u32x4*)(PIDX + t_ * 128 + 16 * kb_ + 4 * q); \
        AQV = *(const u32x4*)(AQ + t_ * 32 + 4 * kb_); } while (0)
#define F3_GATHER(EV, VV) do { _Pragma("unroll") for (int q = 0; q < 4; ++q) { VV[4 * q] = *(const u32x4*)(tvs + ((EV[q].x << 7) | cj16)); VV[4 * q + 1] = *(const u32x4*)(tvs + ((EV[q].y << 7) | cj16)); \
        VV[4 * q + 2] = *(const u32x4*)(tvs + ((EV[q].z << 7) | cj16)); VV[4 * q + 3] = *(const u32x4*)(tvs + ((EV[q].w << 7) | cj16)); } } while (0)
#define F3_T4(W, Q, R0, R1, R2, R3, AW) do { const unsigned a_ = __builtin_amdgcn_perm(R1, R0, 0x05010400u), b_ = __builtin_amdgcn_perm(R1, R0, 0x07030602u), c_ = __builtin_amdgcn_perm(R3, R2, 0x05010400u), d_ = __builtin_amdgcn_perm(R3, R2, 0x07030602u); \
        acc[4 * (W) + 0] = __builtin_amdgcn_sdot4((int)__builtin_amdgcn_perm(c_, a_, 0x05040100u), (int)(AW), acc[4 * (W) + 0], false); acc[4 * (W) + 1] = __builtin_amdgcn_sdot4((int)__builtin_amdgcn_perm(c_, a_, 0x07060302u), (int)(AW), acc[4 * (W) + 1], false); \
        acc[4 * (W) + 2] = __builtin_amdgcn_sdot4((int)__builtin_amdgcn_perm(d_, b_, 0x05040100u), (int)(AW), acc[4 * (W) + 2], false); acc[4 * (W) + 3] = __builtin_amdgcn_sdot4((int)__builtin_amdgcn_perm(d_, b_, 0x07060302u), (int)(AW), acc[4 * (W) + 3], false); } while (0)
#define F3_Q(Q, VV, AW) do { F3_T4(0, Q, VV[4 * (Q)].x, VV[4 * (Q) + 1].x, VV[4 * (Q) + 2].x, VV[4 * (Q) + 3].x, AW); F3_T4(1, Q, VV[4 * (Q)].y, VV[4 * (Q) + 1].y, VV[4 * (Q) + 2].y, VV[4 * (Q) + 3].y, AW); \
        F3_T4(2, Q, VV[4 * (Q)].z, VV[4 * (Q) + 1].z, VV[4 * (Q) + 2].z, VV[4 * (Q) + 3].z, AW); F3_T4(3, Q, VV[4 * (Q)].w, VV[4 * (Q) + 1].w, VV[4 * (Q) + 2].w, VV[4 * (Q) + 3].w, AW); } while (0)
#define F3_COMPUTE(it_, VV, AQV) do { F3_Q(0, VV, AQV.x); F3_Q(1, VV, AQV.y); F3_Q(2, VV, AQV.z); F3_Q(3, VV, AQV.w); \
        if (((it_) & 7) == 7) { const size_t t_ = (size_t)(wl * tpw + ((it_) >> 3) * 8 + gi); const float as_ = AS[t_]; bf16_t* o = H2B + t_ * DM + 128 * s + 16 * cj; f32x4 hh[4]; float s2 = 0.f; \
            const u32x4 ha_ = *(const u32x4*)o, hb_ = *(const u32x4*)(o + 8); const unsigned hw_[8] = {ha_.x, ha_.y, ha_.z, ha_.w, hb_.x, hb_.y, hb_.z, hb_.w}; \
            _Pragma("unroll") for (int i = 0; i < 4; ++i) { hh[i] = (f32x4){bf_lo(hw_[2 * i]), bf_hi(hw_[2 * i]), bf_lo(hw_[2 * i + 1]), bf_hi(hw_[2 * i + 1])} + (f32x4){(float)acc[4 * i], (float)acc[4 * i + 1], (float)acc[4 * i + 2], (float)acc[4 * i + 3]} * as_; s2 += sq4(hh[i]); } \
            *(u32x4*)o = pack8(hh[0], hh[1]); *(u32x4*)(o + 8) = pack8(hh[2], hh[3]); \
            s2 = oct_sum(s2); if (cj == 0) SSQ2[t_ * 16 + s] = s2; \
            _Pragma("unroll") for (int i = 0; i < 16; ++i) acc[i] = 0; } } while (0)
#pragma unroll 1
            for (int p = 0; p < 2; ++p) {
                const int s = 2 * xc + p; const unsigned char* tvs = TV + (size_t)s * (16384 * 128);
                u32x4 evA[4], evB[4], vvA[16], vvB[16], aqA, aqB, aqC; int acc[16];
#pragma unroll
                for (int i = 0; i < 16; ++i) acc[i] = 0;
                F3_LOADIDX(0, evA, aqA); F3_LOADIDX(1, evB, aqB); F3_GATHER(evA, vvA);
#pragma unroll 1
                for (int it = 0; it < nit; it += 2) {
                    F3_GATHER(evB, vvB); F3_LOADIDX(it + 2, evA, aqC); F3_COMPUTE(it, vvA, aqA); aqA = aqC;
                    F3_GATHER(evA, vvA); F3_LOADIDX(it + 3, evB, aqC); F3_COMPUTE(it + 1, vvB, aqB); aqB = aqC;
                }
            }
#undef F3_LOADIDX
#undef F3_GATHER
#undef F3_T4
#undef F3_Q
#undef F3_COMPUTE
        }
    }
    xcd_barrier(bar); STAMP();
    if (DBG_STOP == 7) return;

    if (PH(8)) {
        KArgsP ka = kargs(); unsigned char* ws = ka->ws; float* OUT = ka->out;
        bf16_t* PB = (bf16_t*)WSP(WS_PB); bf16_t* WP = (bf16_t*)WSP(WS_WP); bf16_t* PROJ = (bf16_t*)WSP(WS_R1); bf16_t* H2B = (bf16_t*)WSP(WS_H2B); bf16_t* WG = (bf16_t*)WSP(WS_WG); float* SSQ2 = (float*)WSP(WS_SSQ2);
        pg8::StaticOrder S; S.init(M, 2048, G, bx);
        pg8::Gemm gp{PB, WP, 256, 256, 256};
        EpiStore Ep{PROJ, 2048};
        pg8::gemm_phase<EpiStore, pg8::StaticOrder, true>(lds, eps, gp, S, Ep, wave0);
        pg8::Gemm gg{H2B, WG, 2048, 2048, 2048};
        EpiGate Eg{OUT, PROJ, SSQ2, H2B};
        pg8::gemm_phase<EpiGate, pg8::StaticOrder, true>(lds, eps, gg, S, Eg, wave0);
    }
#ifdef TIMING
    xcd_barrier(bar); STAMP();
    if (blockIdx.x == 0 && threadIdx.x == 0) { KArgsP ka = kargs(); float* OUT = ka->out; OUT[0] += ts_val; }
#endif
}

extern "C" void kernel_launch(void* const* d_in, const int* in_sizes, int n_in, void* d_out, int out_size, void* d_ws, size_t ws_size, hipStream_t stream) {
    static int ready = 0;
    if (ready == 0) {
        if (n_in != 23 || out_size != M * DM || ws_size < WS_END) { fprintf(stderr, "kernel_launch: unexpected shapes (n_in %d, out %d, ws %zu)\n", n_in, out_size, ws_size); ready = -1; return; }
        if (hipFuncSetAttribute((const void*)fwd_kernel, hipFuncAttributeMaxDynamicSharedMemorySize, LDS_BYTES) != hipSuccess) { fprintf(stderr, "kernel_launch: hipFuncSetAttribute failed\n"); ready = -1; return; }
        ready = 1;
    }
    if (ready < 0) return;
    (void)hipMemsetAsync((char*)d_ws + WS_CTL, 0, CTL_ZERO_BYTES, stream);
    Args a{};
    for (int i = 0; i < 23; ++i) a.in[i] = (const float*)d_in[i];
    a.out = (float*)d_out; a.ws = (unsigned char*)d_ws;
    hipLaunchKernelGGL(fwd_kernel, dim3(256), dim3(NWAVES * 64), LDS_BYTES, stream, a);
}
```

```cpp
#include <hip/hip_runtime.h>
#include <cstdio>
#include <cstdint>
#include <type_traits>

#define LAS __attribute__((address_space(3)))
#define GAS __attribute__((address_space(1)))
typedef unsigned short bf16_t;
typedef short bf16x8 __attribute__((ext_vector_type(8)));
typedef short s16x4 __attribute__((ext_vector_type(4)));
typedef float f32x4 __attribute__((ext_vector_type(4)));
typedef float f32x2 __attribute__((ext_vector_type(2)));
typedef float f32x16 __attribute__((ext_vector_type(16)));
typedef unsigned u32x4 __attribute__((ext_vector_type(4)));
typedef int i32x4 __attribute__((ext_vector_type(4)));
typedef unsigned u32x2 __attribute__((ext_vector_type(2)));
typedef __bf16 bf16x2_t __attribute__((ext_vector_type(2)));

constexpr int M = 16384, DM = 2048, SEQ = 2048, NB = 8, NH = 8;
constexpr float EPS = 1e-6f;
constexpr size_t MiB = 1u << 20;
constexpr size_t WS_CTL = 0, CTL_ZERO_BYTES = 1 * MiB;
constexpr size_t WS_WIN = 1 * MiB;
constexpr size_t WS_WPOOL = 10 * MiB;
constexpr size_t WS_SK = 10 * MiB + 512 * 1024;
constexpr size_t WS_WUQ = 11 * MiB;
constexpr size_t WS_WUKV = 13 * MiB;
constexpr size_t WS_WOUT = 15 * MiB;
constexpr size_t WS_WPQ = 23 * MiB;
constexpr size_t WS_WG = 31 * MiB;
constexpr size_t WS_WP = 39 * MiB;
constexpr size_t WS_PB = 40 * MiB;
constexpr size_t WS_COS = 48 * MiB, WS_SIN = 50 * MiB;
constexpr size_t WS_SSQ_CQ = 52 * MiB, WS_SSQ_CKV = 52 * MiB + 512 * 1024, WS_SSQ_H1 = 53 * MiB, WS_RSTD2 = 55 * MiB, WS_RSTDX = 55 * MiB + 512 * 1024;
constexpr size_t WS_EU = 56 * MiB, WS_EV = 88 * MiB;
constexpr size_t WS_SU = 55 * MiB + 128 * 1024, WS_SV = 55 * MiB + 256 * 1024;
constexpr size_t WS_AQ = 346 * MiB, WS_AS = 349 * MiB;
constexpr size_t WS_SSQ2 = 344 * MiB;
constexpr size_t WS_XQ = 184 * MiB;
constexpr size_t WS_SBW = 55 * MiB + 640 * 1024;
constexpr size_t WS_XB = 120 * MiB;
constexpr size_t WS_PART0 = 184 * MiB, WS_PART1 = 424 * MiB;
constexpr size_t WS_R1 = 184 * MiB;
constexpr size_t WS_ZP = 248 * MiB, WS_U = 280 * MiB, WS_H2B = 248 * MiB;
constexpr size_t WS_CQ = 312 * MiB, WS_CKV = 328 * MiB, WS_KRP = 344 * MiB, WS_PIDX = 312 * MiB, WS_PGATE = 320 * MiB;
constexpr size_t WS_Q = 360 * MiB, WS_K = 408 * MiB, WS_V = 456 * MiB;
constexpr size_t WS_END = 488 * MiB;
constexpr int RING_BYTES = 131072, EPI_OFF = RING_BYTES, EPI_BYTES = 8192, LDS_BYTES = 163840, LDSCTL_OFF = LDS_BYTES - 1024, MISC_OFF = LDSCTL_OFF + 320;
constexpr int NWAVES = 8;

__device__ __forceinline__ unsigned cvtpk(float lo, float hi) { f32x2 v = {lo, hi}; bf16x2_t b = __builtin_convertvector(v, bf16x2_t); return __builtin_bit_cast(unsigned, b); }
__device__ __forceinline__ float bf_lo(unsigned w) { return __builtin_bit_cast(float, w << 16); }
__device__ __forceinline__ float bf_hi(unsigned w) { return __builtin_bit_cast(float, w & 0xffff0000u); }
__device__ __forceinline__ float ub0(unsigned w) { return (float)(w & 0xffu); }
__device__ __forceinline__ float ub1(unsigned w) { float r; asm("v_cvt_f32_ubyte1 %0, %1" : "=v"(r) : "v"(w)); return r; }
__device__ __forceinline__ float ub2(unsigned w) { float r; asm("v_cvt_f32_ubyte2 %0, %1" : "=v"(r) : "v"(w)); return r; }
__device__ __forceinline__ float ub3(unsigned w) { float r; asm("v_cvt_f32_ubyte3 %0, %1" : "=v"(r) : "v"(w)); return r; }
__device__ __forceinline__ float dpp_xor1(float x) { return __builtin_bit_cast(float, __builtin_amdgcn_mov_dpp(__builtin_bit_cast(int, x), 0xB1, 0xF, 0xF, true)); }
__device__ __forceinline__ float dpp_xor2(float x) { return __builtin_bit_cast(float, __builtin_amdgcn_mov_dpp(__builtin_bit_cast(int, x), 0x4E, 0xF, 0xF, true)); }
#define DPP_I(x, ctrl) __builtin_amdgcn_mov_dpp((x), (ctrl), 0xF, 0xF, true)
#define DPP_F(x, ctrl) __builtin_bit_cast(float, __builtin_amdgcn_mov_dpp(__builtin_bit_cast(int, (float)(x)), (ctrl), 0xF, 0xF, true))
__device__ __forceinline__ int oct_sum_i(int v) { v += DPP_I(v, 0xB1); v += DPP_I(v, 0x4E); return v + DPP_I(v, 0x141); }
__device__ __forceinline__ float oct_sum(float v) { v += DPP_F(v, 0xB1); v += DPP_F(v, 0x4E); return v + DPP_F(v, 0x141); }
__device__ __forceinline__ float oct_max(float v) { v = fmaxf(v, DPP_F(v, 0xB1)); v = fmaxf(v, DPP_F(v, 0x4E)); return fmaxf(v, DPP_F(v, 0x141)); }
template <int N> __device__ __forceinline__ void bitonic_sort_desc(float (&v)[N]) {
#pragma unroll
    for (int k = 2; k <= N; k <<= 1)
#pragma unroll
        for (int j = k >> 1; j > 0; j >>= 1)
#pragma unroll
            for (int i = 0; i < N; ++i) { const int l = i ^ j; if (l > i) { const bool desc = (i & k) == 0; const float a = v[i], b = v[l]; const float hi = fmaxf(a, b), lo = fminf(a, b); v[i] = desc ? hi : lo; v[l] = desc ? lo : hi; } }
}
#define QUAD_MERGE16(v, CTRL) do { float p_[16]; _Pragma("unroll") for (int i = 0; i < 16; ++i) p_[i] = DPP_F(v[15 - i], CTRL); \
    _Pragma("unroll") for (int i = 0; i < 16; ++i) v[i] = fmaxf(v[i], p_[i]); \
    _Pragma("unroll") for (int j = 8; j > 0; j >>= 1) _Pragma("unroll") for (int i = 0; i < 16; ++i) { const int l = i ^ j; if (l > i) { const float a = v[i], b = v[l]; v[i] = fmaxf(a, b); v[l] = fminf(a, b); } } } while (0)
template <int N> __device__ __forceinline__ float tree_max(const float* v) {
    if constexpr (N == 1) return v[0]; else return fmaxf(tree_max<N / 2>(v), tree_max<N - N / 2>(v + N / 2));
}
__device__ __forceinline__ float quad_max(float m) { m = fmaxf(m, dpp_xor1(m)); return fmaxf(m, dpp_xor2(m)); }
__device__ __forceinline__ float quad_sum(float m) { m += dpp_xor1(m); return m + dpp_xor2(m); }
__device__ __forceinline__ float wave_max(float v) {
#pragma unroll
    for (int o = 1; o < 64; o <<= 1) v = fmaxf(v, __shfl_xor(v, o));
    return v;
}
__device__ __forceinline__ int wave_sum_i(int v) {
#pragma unroll
    for (int o = 1; o < 64; o <<= 1) v += __shfl_xor(v, o);
    return v;
}
__device__ __forceinline__ float wave_sum(float v) {
#pragma unroll
    for (int o = 1; o < 64; o <<= 1) v += __shfl_xor(v, o);
    return v;
}
__device__ __forceinline__ int tid_of(int wave0) { int l; asm volatile("v_mbcnt_lo_u32_b32 %0, -1, 0\n\tv_mbcnt_hi_u32_b32 %0, -1, %0" : "=v"(l)); return wave0 * 64 + l; }
#define EPI_BAR() do { asm volatile("s_waitcnt lgkmcnt(0)" ::: "memory"); __builtin_amdgcn_s_barrier(); asm volatile("" ::: "memory"); } while (0)

namespace pg8 {
constexpr int BM = 256, BK = 64, HALF = 128, HTB = HALF * BK * 2, STAGE_BYTES = 8 * HTB, NXCD = 8, WGM = 1;
__host__ __device__ __forceinline__ int lds_byte(int r, int c) { const int st = (r >> 4) * 2 + (c >> 5), rr = r & 15, cc = c & 31, ob = rr * 64 + cc * 2; return st * 1024 + (ob ^ (((ob >> 9) & 1) << 5)); }
__host__ __device__ __forceinline__ void stage_rc(int b, int& R, int& C) { const int st = b / 1024, sb = b % 1024, swz = sb ^ (((sb >> 9) & 1) << 5); R = (st >> 1) * 16 + swz / 64; C = (st & 1) * 32 + (swz % 64) / 2; }
__host__ __device__ __forceinline__ int perm32(int rho) { const int n = rho >> 4, i = rho & 15; return 8 * (i >> 2) + 4 * n + (i & 3); }

struct Unit { int pm, pn, ka, kb; };
struct Gemm { const bf16_t* A; const bf16_t* Bt; int lda, ldb, K; };

struct StaticOrder {
    int nM, nN, nwg, G, c;
    __device__ void init(int Mr, int N, int G_, int c_) { nM = Mr / BM; nN = N / BM; nwg = nM * nN; G = G_; c = c_; }
    __device__ bool next(int i, Unit& u) const {
        const long L = (long)i * G + c; if (L >= nwg) return false;
        int wgid = (int)L; { const int q = nwg / NXCD, r = nwg % NXCD, xcd = wgid % NXCD, off = wgid / NXCD; wgid = (xcd < r ? xcd * (q + 1) : r * (q + 1) + (xcd - r) * q) + off; }
        const int nig = WGM * nN, gid = wgid / nig, fm = gid * WGM, gsz = (nM - fm) < WGM ? (nM - fm) : WGM;
        u.pm = fm + ((wgid % nig) % gsz); u.pn = (wgid % nig) / gsz; u.ka = 0; u.kb = 0; return true;
    }
};
template <int MODE> struct QuadOrder {
    int v;
    __device__ bool next(int i, Unit& u) const {
        if (i > 0) return false;
        u.pm = v >> 2; const int j = v & 3;
        if (MODE == 0) { u.pn = 8; u.ka = 512 * j; u.kb = 512 * j; } else { u.pn = j; u.ka = 256 * j; u.kb = 0; }
        return true;
    }
};

struct PairOrder {
    int v;
    __device__ bool next(int i, Unit& u) const { if (i > 1) return false; u.pm = 2 * (v >> 3) + i; u.pn = v & 7; u.ka = 0; u.kb = 0; return true; }
};
template <class Epi, class Sched, bool ALIGN_EPI, bool PRE = false, bool I8 = false>
__device__ __forceinline__ void gemm_phase(LAS unsigned char* lds, LAS unsigned char* eps, const Gemm g, const Sched& S, const Epi& E, int wave0) {
    int tid = tid_of(wave0); asm volatile("" : "+v"(tid));
    const int wid = __builtin_amdgcn_readfirstlane(tid >> 6), lane = tid & 63, wr = wid >> 2, wc = wid & 3, fr = lane & 15, fq = lane >> 4;
    constexpr int ES = I8 ? 1 : 2;
    int nt = g.K * ES / (BK * 2); asm volatile("" : "+s"(nt));
    unsigned voffA[2], voffB[2];
#pragma unroll
    for (int i = 0; i < 2; ++i) { int R, C; stage_rc(tid * 16 + i * 8192, R, C); const int Rb = Epi::PERM ? ((R & ~31) + perm32(R & 31)) : R;
        voffA[i] = (unsigned)(R * g.lda * ES + C * 2); voffB[i] = (unsigned)(Rb * g.ldb * ES + C * 2); }
    const size_t kstep = (size_t)(BK * 2);
    const size_t hstepA = (size_t)HALF * g.lda * ES, hstepB = (size_t)HALF * g.ldb * ES;
    const size_t tstepA = 2 * hstepA, tstepB = 2 * hstepB;
    const unsigned ldsw = (unsigned)wid * 1024u;
    const int aoff = lds_byte(wr * 64 + fr, fq * 8), boff = lds_byte(wc * 32 + fr, fq * 8);
#define PG8_SA(b, h) (((b) * 2 + (h)) * HTB)
#define PG8_SB(b, h) ((4 + (b) * 2 + (h)) * HTB)
#define PG8_STAGE(bufoff, gbase, voff) do { _Pragma("unroll") for (int _i = 0; _i < 2; ++_i) \
        __builtin_amdgcn_global_load_lds((const unsigned*)((const char*)(gbase) + (voff)[_i]), (LAS unsigned*)(lds + (bufoff) + ldsw + _i * 8192), 16, 0, 0); } while (0)
#define PG8_LDA(dst, b, h) do { _Pragma("unroll") for (int m = 0; m < 4; ++m) _Pragma("unroll") for (int k = 0; k < 2; ++k) dst[m][k] = *(const LAS bf16x8*)(lds + PG8_SA(b, h) + aoff + m * 2048 + k * 1024); } while (0)
#define PG8_LDB(dst, b, h) do { _Pragma("unroll") for (int n = 0; n < 2; ++n) _Pragma("unroll") for (int k = 0; k < 2; ++k) dst[n][k] = *(const LAS bf16x8*)(lds + PG8_SB(b, h) + boff + n * 2048 + k * 1024); } while (0)
#define PG8_MMA(ai, bj, At, Bt) do { __builtin_amdgcn_s_setprio(1); _Pragma("unroll") for (int m = 0; m < 4; ++m) _Pragma("unroll") for (int n = 0; n < 2; ++n) _Pragma("unroll") for (int k = 0; k < 2; ++k) \
        { if constexpr (I8) acc[ai][bj][m][n] = __builtin_bit_cast(AccT, __builtin_amdgcn_mfma_i32_16x16x64_i8(__builtin_bit_cast(i32x4, Bt[n][k]), __builtin_bit_cast(i32x4, At[m][k]), __builtin_bit_cast(i32x4, acc[ai][bj][m][n]), 0, 0, 0)); \
          else acc[ai][bj][m][n] = __builtin_bit_cast(AccT, __builtin_amdgcn_mfma_f32_16x16x32_bf16(Bt[n][k], At[m][k], __builtin_bit_cast(f32x4, acc[ai][bj][m][n]), 0, 0, 0)); } __builtin_amdgcn_s_setprio(0); } while (0)
#define PG8_WAIT_V(n) asm volatile("s_waitcnt vmcnt(" #n ")" ::: "memory")
#define PG8_WAIT_L(n) asm volatile("s_waitcnt lgkmcnt(" #n ")" ::: "memory")
#define PG8_BAR __builtin_amdgcn_s_barrier()
#define PG8_SCHED __builtin_amdgcn_sched_barrier(0)
    Unit cur, nxt; int ui = 0;
    if (!S.next(0, cur)) return;
    using AccT = typename std::conditional<I8, i32x4, f32x4>::type;
    AccT acc[2][2][4][2];
#pragma unroll
    for (int a = 0; a < 2; ++a)
#pragma unroll
        for (int b = 0; b < 2; ++b)
#pragma unroll
            for (int m = 0; m < 4; ++m)
#pragma unroll
                for (int n = 0; n < 2; ++n) acc[a][b][m][n] = (AccT){0, 0, 0, 0};
    bf16x8 At[4][2], B0[2][2], B1[2][2];
    const char* cA = (const char*)g.A + (size_t)cur.pm * tstepA + (size_t)cur.ka * ES; const char* cB = (const char*)g.Bt + (size_t)cur.pn * tstepB + (size_t)cur.kb * ES;
    PG8_STAGE(PG8_SB(0, 0), cB, voffB); PG8_STAGE(PG8_SB(0, 1), cB + hstepB, voffB); PG8_STAGE(PG8_SA(0, 0), cA, voffA); PG8_STAGE(PG8_SA(0, 1), cA + hstepA, voffA);
    if (wr == 1) PG8_BAR;
    PG8_WAIT_V(2); PG8_BAR;
    PG8_STAGE(PG8_SB(1, 0), cB + kstep, voffB); PG8_STAGE(PG8_SA(1, 0), cA + kstep, voffA); PG8_STAGE(PG8_SB(1, 1), cB + hstepB + kstep, voffB);
    PG8_WAIT_V(6); PG8_BAR;
    unsigned pre2 = 0; unsigned pre = 0;
    for (;;) {
        const bool has_next = S.next(ui + 1, nxt);
        const char* nA = has_next ? (const char*)g.A + (size_t)nxt.pm * tstepA + (size_t)nxt.ka * ES : cA; const char* nB = has_next ? (const char*)g.Bt + (size_t)nxt.pn * tstepB + (size_t)nxt.kb * ES : cB;
#pragma unroll 1
        for (int t = 0; t < nt; t += 2) {
            const bool last = (t == nt - 2);
            if constexpr (PRE) { if (last) { const unsigned* pp = E.pre_ptr(cur, tid); asm volatile("global_load_dword %0, %1, off" : "=v"(pre) : "v"(pp) : "memory");
                                           const unsigned* pq = E.pre_ptr2(cur, tid); asm volatile("global_load_dword %0, %1, off" : "=v"(pre2) : "v"(pq) : "memory"); } }
            const char* a1 = cA + (size_t)(t + 1) * kstep;
            const char* a2 = last ? nA : cA + (size_t)(t + 2) * kstep; const char* b2 = last ? nB : cB + (size_t)(t + 2) * kstep;
            const char* a3 = a2 + kstep; const char* b3 = b2 + kstep;
            PG8_LDB(B0, 0, 0); PG8_LDB(B1, 0, 1); PG8_SCHED; PG8_LDA(At, 0, 0); PG8_STAGE(PG8_SA(1, 1), a1 + hstepA, voffA);
            PG8_WAIT_V(8); PG8_WAIT_L(0); PG8_BAR; PG8_MMA(0, 0, At, B0); PG8_MMA(0, 1, At, B1); PG8_BAR; PG8_SCHED;
            PG8_LDA(At, 0, 1); PG8_STAGE(PG8_SB(0, 0), b2, voffB); PG8_STAGE(PG8_SB(0, 1), b2 + hstepB, voffB); PG8_STAGE(PG8_SA(0, 0), a2, voffA);
            PG8_WAIT_V(8); PG8_WAIT_L(0); PG8_BAR; PG8_MMA(1, 0, At, B0); PG8_MMA(1, 1, At, B1); PG8_BAR; PG8_SCHED;
            PG8_LDB(B0, 1, 0); PG8_LDB(B1, 1, 1); PG8_SCHED; PG8_LDA(At, 1, 0); PG8_STAGE(PG8_SA(0, 1), a2 + hstepA, voffA);
            PG8_WAIT_V(8); PG8_WAIT_L(0); PG8_BAR; PG8_MMA(0, 0, At, B0); PG8_MMA(0, 1, At, B1); PG8_BAR; PG8_SCHED;
            PG8_LDA(At, 1, 1); PG8_STAGE(PG8_SB(1, 0), b3, voffB); PG8_STAGE(PG8_SB(1, 1), b3 + hstepB, voffB); PG8_STAGE(PG8_SA(1, 0), a3, voffA);
            PG8_WAIT_V(8); PG8_WAIT_L(0); PG8_BAR; PG8_MMA(1, 0, At, B0); PG8_MMA(1, 1, At, B1); PG8_BAR; PG8_SCHED;
        }
        if constexpr (ALIGN_EPI) { if (wr == 0) PG8_BAR; }
        if constexpr (PRE) { asm volatile("" : "+v"(pre), "+v"(pre2)); E(acc, cur, wr, wc, fr, fq, eps, tid, pre, pre2); } else E(acc, cur, wr, wc, fr, fq, eps, tid);
        if (!has_next) break;
#pragma unroll
        for (int a = 0; a < 2; ++a)
#pragma unroll
            for (int b = 0; b < 2; ++b)
#pragma unroll
                for (int m = 0; m < 4; ++m)
#pragma unroll
                    for (int n = 0; n < 2; ++n) acc[a][b][m][n] = (AccT){0, 0, 0, 0};
        cur = nxt; cA = nA; cB = nB; ++ui;
        if constexpr (ALIGN_EPI) { if (wr == 1) PG8_BAR; }
    }
    PG8_WAIT_V(0);
    if constexpr (!ALIGN_EPI) { if (wr == 0) PG8_BAR; }
    PG8_BAR;
#undef PG8_SA
#undef PG8_SB
#undef PG8_STAGE
#undef PG8_LDA
#undef PG8_LDB
#undef PG8_MMA
#undef PG8_WAIT_V
#undef PG8_WAIT_L
#undef PG8_BAR
#undef PG8_SCHED
}
}
using pg8::Unit;
typedef const f32x4 (&AccRef)[2][2][4][2];
typedef const i32x4 (&AccRefI)[2][2][4][2];

struct Args { const float* in[23]; float* out; unsigned char* ws; };
static_assert(sizeof(Args) == 25 * 8, "no padding");
typedef const __attribute__((address_space(4))) Args* KArgsP;
__device__ __forceinline__ KArgsP kargs() { KArgsP p = (KArgsP)__builtin_amdgcn_kernarg_segment_ptr(); asm volatile("" : "+s"(p)); return p; }
#define IN_F(i) ((const float*)ka->in[i])
#define WSP(off) (ws + (off))

template <int NR>
__device__ __forceinline__ void quant_rows(const float* eu, const float* ev, unsigned* EU8, unsigned* EV8, float* SU, float* SV, int r0, int lane) {
    f32x4 v[NR][8]; float mx[NR];
#pragma unroll
    for (int a = 0; a < NR; ++a) { const int r = r0 + a; const float* srow = (r >= 16384 ? ev : eu) + (size_t)(r & 16383) * 2048 + 4 * lane; mx[a] = 0.f;
#pragma unroll
        for (int j = 0; j < 8; ++j) v[a][j] = __builtin_nontemporal_load((const f32x4*)(srow + 256 * j)); }
#pragma unroll
    for (int a = 0; a < NR; ++a) {
#pragma unroll
        for (int j = 0; j < 8; ++j) mx[a] = fmaxf(fmaxf(mx[a], fmaxf(fabsf(v[a][j][0]), fabsf(v[a][j][1]))), fmaxf(fabsf(v[a][j][2]), fabsf(v[a][j][3])));
        mx[a] = wave_max(mx[a]); }
#pragma unroll
    for (int a = 0; a < NR; ++a) { const int r = r0 + a, e = r & 16383; const bool isv = r >= 16384;
        const float sc = mx[a] > 0.f ? mx[a] * (1.f / 127.f) : 1.f; const float inv = 1.f / sc;
        unsigned* drow = (isv ? EV8 : EU8) + (size_t)(lane >> 5) * (16384 * 32) + (size_t)e * 32 + (lane & 31);
#pragma unroll
        for (int j = 0; j < 8; ++j) { const int q0 = (int)rintf(v[a][j][0] * inv), q1 = (int)rintf(v[a][j][1] * inv), q2 = (int)rintf(v[a][j][2] * inv), q3 = (int)rintf(v[a][j][3] * inv);
            drow[(size_t)(2 * j) * (16384 * 32)] = (unsigned)(q0 & 0xff) | ((unsigned)(q1 & 0xff) << 8) | ((unsigned)(q2 & 0xff) << 16) | ((unsigned)(q3 & 0xff) << 24); }
        if (lane == 0) (isv ? SV : SU)[e] = sc; }
}

#define ALOAD16(dst, ptr) asm volatile("global_load_dwordx4 %0, %1, off" : "=&v"(dst) : "v"(ptr) : "memory")
#define ALOAD16O(dst, ptr, off) asm volatile("global_load_dwordx4 %0, %1, off offset:%c2" : "=&v"(dst) : "v"(ptr), "i"(off) : "memory")
#define ALOAD16NT(dst, ptr) asm volatile("global_load_dwordx4 %0, %1, off nt" : "=&v"(dst) : "v"(ptr) : "memory")
#define ALOAD16ONT(dst, ptr, off) asm volatile("global_load_dwordx4 %0, %1, off offset:%c2 nt" : "=&v"(dst) : "v"(ptr), "i"(off) : "memory")
#define AWAIT8(a, b, c, d, e, f, g, h) asm volatile("s_waitcnt vmcnt(0)" : "+v"(a), "+v"(b), "+v"(c), "+v"(d), "+v"(e), "+v"(f), "+v"(g), "+v"(h) :: "memory")
#define AWAIT16(a, b, c, d, e, f, g, h, i, j, k, l, m, n, o, p) asm volatile("s_waitcnt vmcnt(0)" : "+v"(a), "+v"(b), "+v"(c), "+v"(d), "+v"(e), "+v"(f), "+v"(g), "+v"(h), "+v"(i), "+v"(j), "+v"(k), "+v"(l), "+v"(m), "+v"(n), "+v"(o), "+v"(p) :: "memory")

__device__ __forceinline__ u32x4 pack8(f32x4 a, f32x4 b) { u32x4 w; w.x = cvtpk(a[0], a[1]); w.y = cvtpk(a[2], a[3]); w.z = cvtpk(b[0], b[1]); w.w = cvtpk(b[2], b[3]); return w; }
__device__ __forceinline__ u32x2 pack4(f32x4 a) { u32x2 w; w.x = cvtpk(a[0], a[1]); w.y = cvtpk(a[2], a[3]); return w; }
__device__ __forceinline__ float sq4(f32x4 a) { return (a[0] * a[0] + a[1] * a[1]) + (a[2] * a[2] + a[3] * a[3]); }

struct EpiA {
    static constexpr bool PERM = true;
    bf16_t* ZP; bf16_t* CQ; bf16_t* CKV; float* ssq_cq; float* ssq_ckv; const float* RSX; const float* SBW;
    __device__ __forceinline__ const unsigned* pre_ptr(const Unit& u, int tid) const { return (const unsigned*)(RSX + u.pm * 256 + (tid & 255)); }
    __device__ __forceinline__ const unsigned* pre_ptr2(const Unit& u, int tid) const { return (const unsigned*)(SBW + u.pn * 256 + (tid & 255)); }
    __device__ __forceinline__ void operator()(AccRefI acc, const Unit& u, int wr, int wc, int fr, int fq, LAS unsigned char* eps, int tid, unsigned pre, unsigned pre2) const {
        LAS float* R = (LAS float*)(eps + 4096); LAS float* CS = (LAS float*)(eps + 5120);
        if (tid < 256) { R[tid] = __builtin_bit_cast(float, pre); CS[tid] = __builtin_bit_cast(float, pre2); }
        EPI_BAR();
        bf16_t* base; int ldc, colt; float* ssq = nullptr;
        if (u.pn < 4) { base = ZP; ldc = 1024; colt = u.pn * 256; }
        else if (u.pn < 6) { base = CQ; ldc = 512; colt = (u.pn - 4) * 256; ssq = ssq_cq + (u.pn - 4) * 4 + wc; }
        else { base = CKV; ldc = 512; colt = (u.pn - 6) * 256; ssq = ssq_ckv + (u.pn - 6) * 4 + wc; }
        const int row0 = u.pm * 256 + wr * 64 + fr, col0 = colt + wc * 32 + 8 * fq;
        f32x4 cs[2][2];
#pragma unroll
        for (int bj = 0; bj < 2; ++bj)
#pragma unroll
            for (int n = 0; n < 2; ++n) cs[bj][n] = *(const LAS f32x4*)(CS + bj * 128 + wc * 32 + 8 * fq + 4 * n);
#pragma unroll
        for (int ai = 0; ai < 2; ++ai)
#pragma unroll
            for (int m = 0; m < 4; ++m) { const int row = row0 + ai * 128 + m * 16; bf16_t* rowp = base + (size_t)row * ldc + col0; float s = 0.f; const float rs = R[ai * 128 + wr * 64 + m * 16 + fr];
#pragma unroll
                for (int bj = 0; bj < 2; ++bj) { const f32x4 v0 = __builtin_convertvector(acc[ai][bj][m][0], f32x4) * cs[bj][0] * rs, v1 = __builtin_convertvector(acc[ai][bj][m][1], f32x4) * cs[bj][1] * rs;
                    *(u32x4*)(rowp + bj * 128) = pack8(v0, v1); s += sq4(v0) + sq4(v1); }
                if (ssq) { s += __shfl_xor(s, 16); s += __shfl_xor(s, 32); if (fq == 0) ssq[(size_t)row * 8] = s; } }
        EPI_BAR();
    }
};
struct EpiKR {
    static constexpr bool PERM = false;
    float* KRP; const float* RSX; const float* SBW;
    __device__ __forceinline__ const unsigned* pre_ptr(const Unit& u, int tid) const { return (const unsigned*)(RSX + u.pm * 256 + (tid & 255)); }
    __device__ __forceinline__ const unsigned* pre_ptr2(const Unit& u, int tid) const { return (const unsigned*)(SBW + u.pn * 256 + (tid & 255)); }
    __device__ __forceinline__ void operator()(AccRefI acc, const Unit& u, int wr, int wc, int fr, int fq, LAS unsigned char* eps, int tid, unsigned pre, unsigned pre2) const {
        LAS float* R = (LAS float*)(eps + 4096); LAS float* CS = (LAS float*)(eps + 5120);
        if (tid < 256) { R[tid] = __builtin_bit_cast(float, pre); CS[tid] = __builtin_bit_cast(float, pre2); }
        EPI_BAR();
        if (wc < 2) { const int ks = u.ka >> 9; const int row0 = u.pm * 256 + wr * 64 + fr;
#pragma unroll
            for (int ai = 0; ai < 2; ++ai)
#pragma unroll
                for (int m = 0; m < 4; ++m) { const int row = row0 + ai * 128 + m * 16; const float rs = R[ai * 128 + wr * 64 + m * 16 + fr];
#pragma unroll
                    for (int n = 0; n < 2; ++n) *(f32x4*)(KRP + ((size_t)ks * M + row) * 64 + 32 * wc + 16 * n + 4 * fq) = __builtin_convertvector(acc[ai][0][m][n], f32x4) * *(const LAS f32x4*)(CS + 32 * wc + 16 * n + 4 * fq) * rs; } }
        { const int uid = u.pm * 4 + (u.ka >> 9); KArgsP ka = kargs(); unsigned char* ws = ka->ws; const float* p_in = IN_F(1); const float* sk1 = IN_F(16); const float* sk2 = IN_F(17);
          bf16_t* PB = (bf16_t*)WSP(WS_PB); bf16_t* SKB = (bf16_t*)WSP(WS_SK);
          for (int i = tid; i < 2176; i += 512) { long j = (long)uid * 2176 + i; const float* src; bf16_t* dst;
              if (j < 524288) { src = p_in; dst = PB; } else if ((j -= 524288) < 16384) { src = sk1; dst = SKB; } else { j -= 16384; src = sk2; dst = SKB + 131072; }
              const f32x4 a = *(const f32x4*)(src + j * 8), b = *(const f32x4*)(src + j * 8 + 4); *(u32x4*)(dst + j * 8) = pack8(a, b); } }
        EPI_BAR();
    }
};
struct EpiStore {
    static constexpr bool PERM = true;
    bf16_t* O; int ldc;
    __device__ __forceinline__ void operator()(AccRef acc, const Unit& u, int wr, int wc, int fr, int fq, LAS unsigned char*, int) const {
        const int row0 = u.pm * 256 + wr * 64 + fr, col0 = u.pn * 256 + wc * 32 + 8 * fq;
#pragma unroll
        for (int ai = 0; ai < 2; ++ai)
#pragma unroll
            for (int m = 0; m < 4; ++m) { bf16_t* rowp = O + (size_t)(row0 + ai * 128 + m * 16) * ldc + col0;
#pragma unroll
                for (int bj = 0; bj < 2; ++bj) *(u32x4*)(rowp + bj * 128) = pack8(acc[ai][bj][m][0], acc[ai][bj][m][1]); }
    }
};
struct EpiQ {
    static constexpr bool PERM = false;
    bf16_t* Q; const float* ssq_cq; const float* qg; const float* COS; const float* SIN;
    __device__ __forceinline__ void operator()(AccRef acc, const Unit& u, int wr, int wc, int fr, int fq, LAS unsigned char* eps, int tid) const {
        LAS float* P = (LAS float*)eps; LAS float* R = (LAS float*)(eps + 4096);
        const int h = u.pn, rowt = u.pm * 256;
        { const f32x4 a = *(const f32x4*)(ssq_cq + (size_t)(rowt + (tid >> 1)) * 8 + 4 * (tid & 1)); float s = (a[0] + a[1]) + (a[2] + a[3]); s += DPP_F(s, 0xB1);
          if ((tid & 1) == 0) R[tid >> 1] = rsqrtf(s * (1.f / 512.f) + EPS); }
#pragma unroll
        for (int ai = 0; ai < 2; ++ai)
#pragma unroll
            for (int m = 0; m < 4; ++m) { const int r = ai * 128 + wr * 64 + m * 16 + fr; float s = 0.f;
#pragma unroll
                for (int bj = 0; bj < 2; ++bj)
#pragma unroll
                    for (int n = 0; n < 2; ++n) s += sq4(acc[ai][bj][m][n]);
                s += __shfl_xor(s, 16); s += __shfl_xor(s, 32); if (fq == 0) P[r * 4 + wc] = s; }
        EPI_BAR();
        const int dn = 32 * wc + 4 * fq, j = 16 * wc + 4 * fq;
        const f32x4 g0 = *(const f32x4*)(qg + dn), g1 = *(const f32x4*)(qg + dn + 16);
        f32x4 gr1 = {0.f, 0.f, 0.f, 0.f}, gr2 = gr1; if (wc < 2) { gr1 = *(const f32x4*)(qg + 128 + j); gr2 = *(const f32x4*)(qg + 160 + j); }
#pragma unroll
        for (int ai = 0; ai < 2; ++ai)
#pragma unroll
            for (int m = 0; m < 4; ++m) { const int r = ai * 128 + wr * 64 + m * 16 + fr; const float rc = R[r]; const f32x4 pp = *(LAS f32x4*)(P + r * 4);
                const float ss = ((pp[0] + pp[1]) + (pp[2] + pp[3])) * rc * rc; const float sc = rc * rsqrtf(ss * (1.f / 192.f) + EPS);
                const size_t grow = (size_t)(rowt + r); bf16_t* qrow = Q + grow * 1536 + h * 192;
                *(u32x2*)(qrow + dn) = pack4(acc[ai][0][m][0] * sc * g0); *(u32x2*)(qrow + dn + 16) = pack4(acc[ai][0][m][1] * sc * g1);
                if (wc < 2) { const f32x4 x1 = acc[ai][1][m][0] * sc * gr1, x2 = acc[ai][1][m][1] * sc * gr2;
                    const f32x4 c4 = *(const f32x4*)(COS + grow * 32 + j), s4 = *(const f32x4*)(SIN + grow * 32 + j);
                    *(u32x2*)(qrow + 128 + j) = pack4(x1 * c4 - x2 * s4); *(u32x2*)(qrow + 160 + j) = pack4(x2 * c4 + x1 * s4); } }
    }
};
struct EpiKV {
    static constexpr bool PERM = false;
    bf16_t* K; bf16_t* V; const float* ssq_ckv; const float* KRP; const float* kg; const float* COS; const float* SIN;
    __device__ __forceinline__ void operator()(AccRef acc, const Unit& u, int wr, int wc, int fr, int fq, LAS unsigned char* eps, int tid) const {
        LAS float* P = (LAS float*)eps; LAS float* R = (LAS float*)(eps + 4096); LAS float* R2 = (LAS float*)(eps + 5120);
        const int h = u.pn, rowt = u.pm * 256;
        { const f32x4 a = *(const f32x4*)(ssq_ckv + (size_t)(rowt + (tid >> 1)) * 8 + 4 * (tid & 1)); float s = (a[0] + a[1]) + (a[2] + a[3]); s += DPP_F(s, 0xB1);
          if ((tid & 1) == 0) R[tid >> 1] = rsqrtf(s * (1.f / 512.f) + EPS); }
        int tq = tid; asm volatile("" : "+v"(tq));
        const int rc = tq & 15, rb = tq >> 4;
#pragma unroll
        for (int kb = 0; kb < 8; kb += 2) { f32x4 pv[2][4];
#pragma unroll
            for (int k = 0; k < 2; ++k) { const float* p = KRP + (size_t)(rowt + rb + 32 * (kb + k)) * 64 + 4 * rc;
#pragma unroll
                for (int q = 0; q < 4; ++q) { const float* pq = p + (size_t)q * M * 64; ALOAD16(pv[k][q], pq); } }
            AWAIT8(pv[0][0], pv[0][1], pv[0][2], pv[0][3], pv[1][0], pv[1][1], pv[1][2], pv[1][3]);
#pragma unroll
            for (int k = 0; k < 2; ++k) { const f32x4 t = (pv[k][0] + pv[k][1]) + (pv[k][2] + pv[k][3]); float s = sq4(t);
                s += DPP_F(s, 0xB1); s += DPP_F(s, 0x4E); s += DPP_F(s, 0x141); s += DPP_F(s, 0x128);
                if (rc == 0) R2[rb + 32 * (kb + k)] = s; } }
#pragma unroll
        for (int ai = 0; ai < 2; ++ai)
#pragma unroll
            for (int m = 0; m < 4; ++m) { const int r = ai * 128 + wr * 64 + m * 16 + fr; float s = sq4(acc[ai][0][m][0]) + sq4(acc[ai][0][m][1]);
                s += __shfl_xor(s, 16); s += __shfl_xor(s, 32); if (fq == 0) P[r * 4 + wc] = s; }
        EPI_BAR();
        const int dn = 32 * wc + 4 * fq;
        const f32x4 g0 = *(const f32x4*)(kg + dn), g1 = *(const f32x4*)(kg + dn + 16);
#pragma unroll
        for (int ai = 0; ai < 2; ++ai)
#pragma unroll
            for (int m = 0; m < 4; ++m) { const int r = ai * 128 + wr * 64 + m * 16 + fr; const float rc = R[r]; const f32x4 pp = *(LAS f32x4*)(P + r * 4);
                const float ssn = ((pp[0] + pp[1]) + (pp[2] + pp[3])) * rc * rc; const float sk = rc * rsqrtf((ssn + R2[r]) * (1.f / 192.f) + EPS);
                const size_t grow = (size_t)(rowt + r);
                bf16_t* vrow = V + grow * 1024 + h * 128 + dn; *(u32x2*)vrow = pack4(acc[ai][1][m][0] * rc); *(u32x2*)(vrow + 16) = pack4(acc[ai][1][m][1] * rc);
                bf16_t* krow = K + grow * 1536 + h * 192 + dn; *(u32x2*)krow = pack4(acc[ai][0][m][0] * sk * g0); *(u32x2*)(krow + 16) = pack4(acc[ai][0][m][1] * sk * g1); }
        { const int jj = 4 * (rc & 7); const bool hi8 = rc >= 8;
          const f32x4 ga = *(const f32x4*)(kg + 128 + jj), gb = *(const f32x4*)(kg + 160 + jj);
#pragma unroll
          for (int k = 0; k < 8; ++k) { f32x4 pv[4], c4, s4;
            const int row = rb + 32 * k; const size_t grw = (size_t)(rowt + row); const float* p = KRP + grw * 64 + 4 * rc;
#pragma unroll
            for (int q = 0; q < 4; ++q) { const float* pq = p + (size_t)q * M * 64; ALOAD16(pv[q], pq); }
            { const float* pc = COS + grw * 32 + jj; const float* ps = SIN + grw * 32 + jj; ALOAD16(c4, pc); ALOAD16(s4, ps); }
            asm volatile("s_waitcnt vmcnt(0)" : "+v"(pv[0]), "+v"(pv[1]), "+v"(pv[2]), "+v"(pv[3]), "+v"(c4), "+v"(s4) :: "memory");
            const f32x4 mine = (pv[0] + pv[1]) + (pv[2] + pv[3]); f32x4 oth; oth[0] = DPP_F(mine[0], 0x128); oth[1] = DPP_F(mine[1], 0x128); oth[2] = DPP_F(mine[2], 0x128); oth[3] = DPP_F(mine[3], 0x128);
            const float rc_ = R[row]; const f32x4 pp = *(LAS f32x4*)(P + row * 4); const float ssn = ((pp[0] + pp[1]) + (pp[2] + pp[3])) * rc_ * rc_;
            const float rk = rsqrtf((ssn + R2[row]) * (1.f / 192.f) + EPS);
            const f32x4 x1 = (hi8 ? oth : mine) * ga, x2 = (hi8 ? mine : oth) * gb;
            const f32x4 o = (hi8 ? (x2 * c4 + x1 * s4) : (x1 * c4 - x2 * s4)) * rk;
            *(u32x2*)(K + grw * 1536 + h * 192 + 128 + 4 * rc) = pack4(o); } }
    }
};
struct EpiH1 {
    static constexpr bool PERM = true;
    const float* X; bf16_t* H1B; float* SSQ;
    __device__ __forceinline__ void operator()(AccRef acc, const Unit& u, int wr, int wc, int fr, int fq, LAS unsigned char*, int) const {
        const int row0 = u.pm * 256 + wr * 64 + fr, col0 = u.pn * 256 + wc * 32 + 8 * fq;
#pragma unroll
        for (int ai = 0; ai < 2; ++ai) {
            f32x4 xa[4][2], xb[4][2];
#pragma unroll
            for (int m = 0; m < 4; ++m)
#pragma unroll
                for (int bj = 0; bj < 2; ++bj) { const float* p = X + (size_t)(row0 + ai * 128 + m * 16) * DM + col0 + bj * 128; ALOAD16NT(xa[m][bj], p); ALOAD16ONT(xb[m][bj], p, 16); }
            AWAIT16(xa[0][0], xa[0][1], xa[1][0], xa[1][1], xa[2][0], xa[2][1], xa[3][0], xa[3][1], xb[0][0], xb[0][1], xb[1][0], xb[1][1], xb[2][0], xb[2][1], xb[3][0], xb[3][1]);
#pragma unroll
            for (int m = 0; m < 4; ++m) { const size_t off = (size_t)(row0 + ai * 128 + m * 16) * DM + col0; float s = 0.f;
#pragma unroll
                for (int bj = 0; bj < 2; ++bj) { const f32x4 h0 = xa[m][bj] + acc[ai][bj][m][0], h1 = xb[m][bj] + acc[ai][bj][m][1];
                    *(u32x4*)(H1B + off + bj * 128) = pack8(h0, h1); s += sq4(h0) + sq4(h1); }
                s += __shfl_xor(s, 16); s += __shfl_xor(s, 32); if (fq == 0) SSQ[(size_t)(row0 + ai * 128 + m * 16) * 32 + u.pn * 4 + wc] = s; }
        }
    }
};
struct EpiQP {
    static constexpr bool PERM = true;
    bf16_t* QP; const float* SSQ; float* RSTD2;
    __device__ __forceinline__ void operator()(AccRef acc, const Unit& u, int wr, int wc, int fr, int fq, LAS unsigned char* eps, int tid) const {
        LAS float* R = (LAS float*)(eps + 4096);
#pragma unroll
        for (int k = 0; k < 4; ++k) { const int row = (tid >> 3) + 64 * k; const f32x4 a = *(const f32x4*)(SSQ + (size_t)(u.pm * 256 + row) * 32 + 4 * (tid & 7));
            const float s = oct_sum((a[0] + a[1]) + (a[2] + a[3])); const float rs = rsqrtf(s * (1.f / 2048.f) + EPS);
            if ((tid & 7) == 0) { R[row] = rs; if (u.pn == 0) RSTD2[u.pm * 256 + row] = rs; } }
        EPI_BAR();
        const int col0 = u.pn * 256 + wc * 32 + 8 * fq;
#pragma unroll
        for (int ai = 0; ai < 2; ++ai)
#pragma unroll
            for (int m = 0; m < 4; ++m) { const int r = ai * 128 + wr * 64 + m * 16 + fr; const float rs = R[r]; bf16_t* rowp = QP + (size_t)(u.pm * 256 + r) * DM + col0;
#pragma unroll
                for (int bj = 0; bj < 2; ++bj) *(u32x4*)(rowp + bj * 128) = pack8(acc[ai][bj][m][0] * rs, acc[ai][bj][m][1] * rs); }
        EPI_BAR();
    }
};
struct EpiGate {
    static constexpr bool PERM = true;
    float* OUT; const bf16_t* PROJ; const float* SSQ2; const bf16_t* H2B;
    __device__ __forceinline__ void operator()(AccRef acc, const Unit& u, int wr, int wc, int fr, int fq, LAS unsigned char* eps, int tid) const {
        LAS float* R = (LAS float*)(eps + 4096);
#pragma unroll
        for (int k = 0; k < 2; ++k) { const int row = (tid >> 2) + 128 * k; const f32x4 a = *(const f32x4*)(SSQ2 + (size_t)(u.pm * 256 + row) * 16 + 4 * (tid & 3));
            const float s = quad_sum((a[0] + a[1]) + (a[2] + a[3])); if ((tid & 3) == 0) R[row] = rsqrtf(s * (1.f / 2048.f) + EPS); }
        EPI_BAR();
        const int row0 = u.pm * 256 + wr * 64 + fr, col0 = u.pn * 256 + wc * 32 + 8 * fq;
#pragma unroll
        for (int ai = 0; ai < 2; ++ai) {
            u32x4 pj[4][2], hv[4][2];
#pragma unroll
            for (int m = 0; m < 4; ++m)
#pragma unroll
                for (int bj = 0; bj < 2; ++bj) { const size_t off = (size_t)(row0 + ai * 128 + m * 16) * DM + col0 + bj * 128; const bf16_t* pp = PROJ + off; const bf16_t* ph = H2B + off; ALOAD16(pj[m][bj], pp); ALOAD16(hv[m][bj], ph); }
            AWAIT16(pj[0][0], pj[0][1], pj[1][0], pj[1][1], pj[2][0], pj[2][1], pj[3][0], pj[3][1], hv[0][0], hv[0][1], hv[1][0], hv[1][1], hv[2][0], hv[2][1], hv[3][0], hv[3][1]);
#pragma unroll
            for (int m = 0; m < 4; ++m) { const int row = row0 + ai * 128 + m * 16; const float rs = R[ai * 128 + wr * 64 + m * 16 + fr]; const size_t off = (size_t)row * DM + col0;
#pragma unroll
                for (int bj = 0; bj < 2; ++bj) { const u32x4 pw = pj[m][bj], hw = hv[m][bj];
                    const f32x4 p0 = {bf_lo(pw.x), bf_hi(pw.x), bf_lo(pw.y), bf_hi(pw.y)}, p1 = {bf_lo(pw.z), bf_hi(pw.z), bf_lo(pw.w), bf_hi(pw.w)};
                    f32x4 g0, g1;
#pragma unroll
                    for (int e = 0; e < 4; ++e) { g0[e] = __builtin_amdgcn_rcpf(1.f + __builtin_amdgcn_exp2f(-1.4426950408889634f * rs * acc[ai][bj][m][0][e]));
                                                  g1[e] = __builtin_amdgcn_rcpf(1.f + __builtin_amdgcn_exp2f(-1.4426950408889634f * rs * acc[ai][bj][m][1][e])); }
                    float* o = OUT + off + bj * 128;
                    const f32x4 h0 = {bf_lo(hw.x), bf_hi(hw.x), bf_lo(hw.y), bf_hi(hw.y)}, h1 = {bf_lo(hw.z), bf_hi(hw.z), bf_lo(hw.w), bf_hi(hw.w)};
                    *(f32x4*)o = h0 + g0 * p0; *(f32x4*)(o + 4) = h1 + g1 * p1; } }
        }
        EPI_BAR();
    }
};

typedef GAS unsigned gu32;
#define RLX_AGENT __ATOMIC_RELAXED, __HIP_MEMORY_SCOPE_AGENT
#define XB_TMO      128
#define XB_XCNT(j)  (256  + 64 * (j))
#define XB_XSUB(j)  (1280 + 64 * (j))
#define XB_XGEN(j)  (2304 + 64 * (j))
#define XB_TOP      3328
#define XB_TOPGEN   3392
#define XCD_BAR_WORDS 3456
#define XB_SPIN_CAP (1u << 20)
__device__ __forceinline__ unsigned xb_ld(unsigned* p)              { return __hip_atomic_load(p, __ATOMIC_RELAXED, __HIP_MEMORY_SCOPE_AGENT); }
__device__ __forceinline__ unsigned xb_add(unsigned* p, unsigned v) { return __hip_atomic_fetch_add(p, v, __ATOMIC_RELAXED, __HIP_MEMORY_SCOPE_AGENT); }
__device__ __forceinline__ unsigned xb_xcc_id() { return (unsigned)__builtin_amdgcn_s_getreg((3 << 11) | 20) & 0xFu; }
#define XB_SPIN(cond, bar) do { unsigned _sp = 0; while (cond) { __builtin_amdgcn_s_sleep(1); \
    if ((++_sp & 255u) == 0u) { if (xb_ld(&(bar)[XB_TMO])) break; if (_sp > XB_SPIN_CAP) { atomicAdd(&(bar)[XB_TMO], 1u); break; } } } } while (0)
struct XcdBarrier { unsigned* bar; unsigned x; volatile LAS unsigned* st; int w0; };
__device__ __forceinline__ XcdBarrier xcd_barrier_post(unsigned* bar, volatile LAS unsigned* st, int w0) {
    XcdBarrier b; b.bar = bar; b.x = xb_xcc_id(); b.st = st; b.w0 = w0;
    if (tid_of(w0) == 0) (void)xb_add(&bar[XB_XCNT(b.x)], 1u);
    return b;
}
__device__ __forceinline__ void xcd_barrier_complete(unsigned* bar, unsigned x, unsigned& nloc, unsigned& nx) {
    const unsigned G = gridDim.x * gridDim.y * gridDim.z;
    unsigned sum, cnt, mine, sp = 0u;
    for (;;) {
        sum = 0u; cnt = 0u; mine = 0u;
#pragma unroll
        for (unsigned j = 0; j < 16; ++j) { const unsigned c = xb_ld(&bar[XB_XCNT(j)]); sum += c; cnt += (c > 0u) ? 1u : 0u; mine = (j == x) ? c : mine; }
        if (sum == G) break;
        __builtin_amdgcn_s_sleep(1);
        if ((++sp & 255u) == 0u) { if (xb_ld(&bar[XB_TMO])) break; if (sp > XB_SPIN_CAP) { atomicAdd(&bar[XB_TMO], 1u); break; } }
    }
    nloc = mine > 0u ? mine : 1u; nx = cnt > 0u ? cnt : 1u;
}
__device__ __forceinline__ void xcd_barrier(const XcdBarrier& b) {
    asm volatile("s_waitcnt vmcnt(0)" ::: "memory");
    __syncthreads();
    if (tid_of(b.w0) == 0) {
        unsigned* bar = b.bar;
        __builtin_amdgcn_s_waitcnt(0);
        unsigned nloc = b.st[0], nx = b.st[1];
        if (nloc == 0u) { xcd_barrier_complete(bar, b.x, nloc, nx); b.st[0] = nloc; b.st[1] = nx; }
        const unsigned old = xb_add(&bar[XB_XSUB(b.x)], 1u);
        const unsigned gen = old / nloc;
        if (old + 1u == (gen + 1u) * nloc) {
            __builtin_amdgcn_fence(__ATOMIC_RELEASE, "agent");
            asm volatile("s_waitcnt vmcnt(0)" ::: "memory");
            const unsigned og = xb_add(&bar[XB_TOP], 1u);
            const unsigned tg = og / nx;
            if (og + 1u == (tg + 1u) * nx) xb_add(&bar[XB_TOPGEN], 1u);
            else XB_SPIN(xb_ld(&bar[XB_TOPGEN]) == tg, bar);
            __builtin_amdgcn_fence(__ATOMIC_ACQUIRE, "agent");
            xb_add(&bar[XB_XGEN(b.x)], 1u);
            asm volatile("s_waitcnt vmcnt(0)" ::: "memory");
        } else {
            XB_SPIN(xb_ld(&bar[XB_XGEN(b.x)]) == gen, bar);
            __builtin_amdgcn_fence(__ATOMIC_ACQUIRE, "agent");
            asm volatile("s_waitcnt vmcnt(0)" ::: "memory");
        }
    }
    __syncthreads();
}

__device__ __forceinline__ int uq_row(int n) {
    const int h = n / 192, d = n - h * 192; int slot;
    if (d < 128) slot = d; else { const int j = d - 128; if (j < 32) slot = 128 + 32 * (j >> 4) + (j & 15); else { const int jj = j - 32; slot = 128 + 32 * (jj >> 4) + 16 + (jj & 15); } }
    return h * 256 + slot;
}
template <int MAP>
__device__ __forceinline__ void tr_item(const float* W, int ldw, int col_off, const float* gk, const float* gn, bf16_t* WT, int ldt, int row_off, int nblk, LAS float* scr, int item, int lane) {
    const int kb = item / nblk, nb = item - kb * nblk, k0 = 64 * kb, n0 = 32 * nb;
#pragma unroll
    for (int i = 0; i < 32; ++i) { const int kk = 2 * i + (lane >> 5); float v = W[(size_t)(k0 + kk) * ldw + col_off + n0 + (lane & 31)]; if (gk) v *= gk[k0 + kk]; scr[kk * 33 + (lane & 31)] = v; }
    asm volatile("s_waitcnt lgkmcnt(0)" ::: "memory");
    const int c = lane & 7;
#pragma unroll
    for (int j = 0; j < 4; ++j) { const int n = (lane >> 3) + 8 * j; const LAS float* s = scr + (8 * c) * 33 + n; const float g = gn ? gn[n0 + n] : 1.f;
        u32x4 o; o.x = cvtpk(s[0 * 33] * g, s[1 * 33] * g); o.y = cvtpk(s[2 * 33] * g, s[3 * 33] * g); o.z = cvtpk(s[4 * 33] * g, s[5 * 33] * g); o.w = cvtpk(s[6 * 33] * g, s[7 * 33] * g);
        const int drow = (MAP == 1) ? uq_row(n0 + n) : (row_off + n0 + n);
        *(u32x4*)(WT + (size_t)drow * ldt + k0 + 8 * c) = o; }
    asm volatile("s_waitcnt lgkmcnt(0)" ::: "memory");
}

struct TrP { const float* W; const float* gk; const float* gn; bf16_t* WT; int ldw, ldt, nblk, item, map; };
__device__ __forceinline__ void tr_load(const TrP& p, float (&v)[32], int lane) {
    const int kb = p.item / p.nblk, nb = p.item - kb * p.nblk, k0 = 64 * kb, n0 = 32 * nb;
#pragma unroll
    for (int i = 0; i < 32; ++i) { const int kk = 2 * i + (lane >> 5); v[i] = p.W[(size_t)(k0 + kk) * p.ldw + n0 + (lane & 31)]; }
    if (p.gk) {
#pragma unroll
        for (int i = 0; i < 32; ++i) v[i] *= p.gk[k0 + 2 * i + (lane >> 5)]; }
}
__device__ __forceinline__ void tr_store(const TrP& p, const float (&v)[32], LAS float* scr, int lane) {
    const int kb = p.item / p.nblk, nb = p.item - kb * p.nblk, k0 = 64 * kb, n0 = 32 * nb;
#pragma unroll
    for (int i = 0; i < 32; ++i) scr[(2 * i + (lane >> 5)) * 33 + (lane & 31)] = v[i];
    asm volatile("s_waitcnt lgkmcnt(0)" ::: "memory");
    const int c = lane & 7;
#pragma unroll
    for (int j = 0; j < 4; ++j) { const int n = (lane >> 3) + 8 * j; const LAS float* s = scr + (8 * c) * 33 + n; const float g = p.gn ? p.gn[n0 + n] : 1.f;
        u32x4 o; o.x = cvtpk(s[0 * 33] * g, s[1 * 33] * g); o.y = cvtpk(s[2 * 33] * g, s[3 * 33] * g); o.z = cvtpk(s[4 * 33] * g, s[5 * 33] * g); o.w = cvtpk(s[6 * 33] * g, s[7 * 33] * g);
        const int drow = p.map ? uq_row(n0 + n) : (n0 + n);
        *(u32x4*)(p.WT + (size_t)drow * p.ldt + k0 + 8 * c) = o; }
    asm volatile("s_waitcnt lgkmcnt(0)" ::: "memory");
}

namespace att {
constexpr int DQ = 192, DV = 128, KVBLK = 64, QBLK = 32;
constexpr int LDQ = 1536, LDV = 1024, LDO = 2048;
constexpr int SHM_V = KVBLK * DV * 2, SHM_K = KVBLK * DQ * 2;
constexpr float SCALE = 0.07216878364870322f;
constexpr float THR = 8.f;
#define KSWZ(row, colB) ((row) * 384 + ((colB) ^ ((((row) >> 1) & 7) << 4)))
#define SBAR() __builtin_amdgcn_sched_barrier(0)
__device__ __forceinline__ int crow(int r, int hi) { return (r & 3) + 8 * (r >> 2) + 4 * hi; }
__device__ __forceinline__ void partialSM(f32x16& p0, f32x16& p1, float& m_reg, float& alpha) {
    constexpr float C = SCALE * 1.4426950408889634f;
    float pmax = p0[0];
#pragma unroll
    for (int r = 1; r < 16; ++r) pmax = fmaxf(pmax, p0[r]);
#pragma unroll
    for (int r = 0; r < 16; ++r) pmax = fmaxf(pmax, p1[r]);
    { auto rr = __builtin_amdgcn_permlane32_swap(__float_as_uint(pmax), __float_as_uint(pmax), false, false);
      pmax = fmaxf(__uint_as_float(rr[0]), __uint_as_float(rr[1])); }
    float mn;
    if (__builtin_expect(__all(pmax - m_reg <= THR / SCALE), 1)) { mn = m_reg; alpha = 1.f; }
    else { mn = fmaxf(m_reg, pmax); alpha = __builtin_amdgcn_exp2f((m_reg - mn) * C); m_reg = mn; }
    const float mnC = -mn * C;
#pragma unroll
    for (int r = 0; r < 16; ++r) { p0[r] = __builtin_amdgcn_exp2f(fmaf(p0[r], C, mnC)); p1[r] = __builtin_amdgcn_exp2f(fmaf(p1[r], C, mnC)); }
}
__device__ __forceinline__ void finishSM(const f32x16& p0, const f32x16& p1, float alpha, float& l_reg, bf16x8& pa0, bf16x8& pa1, bf16x8& pa2, bf16x8& pa3) {
    float ps = 0.f;
#pragma unroll
    for (int r = 0; r < 16; ++r) ps += p0[r];
#pragma unroll
    for (int r = 0; r < 16; ++r) ps += p1[r];
    { auto rr = __builtin_amdgcn_permlane32_swap(__float_as_uint(ps), __float_as_uint(ps), false, false);
      ps = __uint_as_float(rr[0]) + __uint_as_float(rr[1]); }
    l_reg = l_reg * alpha + ps;
#define PK4(P, BASE, OUT) do { unsigned a0 = cvtpk(P[BASE + 0], P[BASE + 1]), a1 = cvtpk(P[BASE + 2], P[BASE + 3]);   \
    unsigned b0 = cvtpk(P[BASE + 4], P[BASE + 5]), b1 = cvtpk(P[BASE + 6], P[BASE + 7]);                              \
    auto r0 = __builtin_amdgcn_permlane32_swap(a0, b0, false, false); auto r1 = __builtin_amdgcn_permlane32_swap(a1, b1, false, false); \
    u32x4 w = {r0[0], r1[0], r0[1], r1[1]}; OUT = __builtin_bit_cast(bf16x8, w); } while (0)
    PK4(p0, 0, pa0); PK4(p0, 8, pa1); PK4(p1, 0, pa2); PK4(p1, 8, pa3);
#undef PK4
}
__device__ __forceinline__ void qkt(f32x16& p0, f32x16& p1, const char* Ks, const bf16x8* qr, int r32, int hi) {
    p0 = f32x16{}; p1 = f32x16{};
#pragma unroll
    for (int d0 = 0; d0 < 12; ++d0) { const int cb = (d0 * 16 + hi * 8) * 2;
        const bf16x8 b0 = *reinterpret_cast<const bf16x8*>(Ks + KSWZ(r32, cb));
        const bf16x8 b1 = *reinterpret_cast<const bf16x8*>(Ks + KSWZ(32 + r32, cb));
        p0 = __builtin_amdgcn_mfma_f32_32x32x16_bf16(b0, qr[d0], p0, 0, 0, 0);
        p1 = __builtin_amdgcn_mfma_f32_32x32x16_bf16(b1, qr[d0], p1, 0, 0, 0); }
}
__device__ __forceinline__ int v_st(int k, int c) { const int kk = (k & ~0xC) | ((k & 4) << 1) | ((k & 8) >> 1); return ((kk >> 3) * 4 + (c >> 5)) * 512 + ((kk & 7) * 32 + (c & 31)) * 2; }
__device__ __forceinline__ int v_rd_base(int lane) { return ((lane & 3) << 3) | (((lane >> 2) & 3) << 6) | (((lane >> 4) & 1) << 5) | (((lane >> 5) & 1) << 8); }
constexpr int v_rd_off(int d0, int ks, int half) { return d0 * 512 + ks * 4096 + half * 2048; }
template <int OFF> __device__ __forceinline__ s16x4 tr_read(int vb) {
    s16x4 r; asm volatile("ds_read_b64_tr_b16 %0, %1 offset:%2" : "=&v"(r) : "v"(vb), "i"(OFF) : "memory"); return r;
}
template <int D0> __device__ __forceinline__ void pv_one(f32x16& od, int vb, bf16x8 pa0, bf16x8 pa1, bf16x8 pa2, bf16x8 pa3) {
    const s16x4 l0 = tr_read<v_rd_off(D0, 0, 0)>(vb), h0 = tr_read<v_rd_off(D0, 0, 1)>(vb), l1 = tr_read<v_rd_off(D0, 1, 0)>(vb), h1 = tr_read<v_rd_off(D0, 1, 1)>(vb);
    const s16x4 l2 = tr_read<v_rd_off(D0, 2, 0)>(vb), h2 = tr_read<v_rd_off(D0, 2, 1)>(vb), l3 = tr_read<v_rd_off(D0, 3, 0)>(vb), h3 = tr_read<v_rd_off(D0, 3, 1)>(vb);
    asm volatile("s_waitcnt lgkmcnt(0)" ::: "memory"); SBAR();
#define PK(L, H) (bf16x8){L[0], L[1], L[2], L[3], H[0], H[1], H[2], H[3]}
    od = __builtin_amdgcn_mfma_f32_32x32x16_bf16(pa0, PK(l0, h0), od, 0, 0, 0);
    od = __builtin_amdgcn_mfma_f32_32x32x16_bf16(pa1, PK(l1, h1), od, 0, 0, 0);
    od = __builtin_amdgcn_mfma_f32_32x32x16_bf16(pa2, PK(l2, h2), od, 0, 0, 0);
    od = __builtin_amdgcn_mfma_f32_32x32x16_bf16(pa3, PK(l3, h3), od, 0, 0, 0);
#undef PK
}
__device__ __forceinline__ void attn_unit(int b, int h, int qt, const bf16_t* Q, const bf16_t* K, const bf16_t* V, bf16_t* Y, char* lds, LAS unsigned char* ldsl, int wave0) {
    int tid = tid_of(wave0); asm volatile("" : "+v"(tid)); const int lane = tid & 63, r32 = lane & 31, hi = lane >> 5; const int wid = __builtin_amdgcn_readfirstlane(tid >> 6);
    char* V_lds = lds; char* K_lds = lds + 3 * SHM_V;
    float* ws = (float*)(lds + 3 * SHM_V + 3 * SHM_K) + wid * 64; float* li_l = ws; float* al_l = ws + 32;
    const size_t rowbase = (size_t)b * SEQ;
    const bf16_t* Qw = Q + (rowbase + qt * 256 + wid * QBLK + r32) * LDQ + h * DQ + hi * 8;
    const bf16_t* Kh = K + rowbase * LDQ + h * DQ; const bf16_t* Vh = V + rowbase * LDV + h * DV;
    float m_reg = -1e30f, l_reg = 0.f; f32x16 o[4] = {}; bf16x8 qr[12];
#pragma unroll
    for (int d0 = 0; d0 < 12; ++d0) qr[d0] = *reinterpret_cast<const bf16x8*>(Qw + d0 * 16);
    unsigned koff[3], voff[2];
#pragma unroll
    for (int i = 0; i < 3; ++i) { const int p = (wid * 3 + i) * 64 + lane, row = p / 24, s = p - row * 24; const int sg = (s & ~7) | ((s & 7) ^ ((row >> 1) & 7)); koff[i] = (unsigned)(row * LDQ + sg * 8) * 2u; }
#pragma unroll
    for (int i = 0; i < 2; ++i) { const int p = (wid * 2 + i) * 64 + lane, st = p >> 5, kk = (st >> 2) * 8 + ((p & 31) >> 2), c = (st & 3) * 32 + (p & 3) * 8;
        const int k = (kk & ~0xC) | ((kk & 4) << 1) | ((kk & 8) >> 1); voff[i] = (unsigned)(k * LDV + c) * 2u; }
    const int vb0 = (int)(uintptr_t)V_lds + v_rd_base(lane);
    const int NT = 4 * qt + 4, climit = 4 * qt + (wid >> 1);
#define DMA_TILE(t, sl) do { const char* kg_ = (const char*)Kh + (size_t)(t) * (KVBLK * LDQ * 2); const char* vg_ = (const char*)Vh + (size_t)(t) * (KVBLK * LDV * 2); \
    _Pragma("unroll") for (int i = 0; i < 3; ++i) __builtin_amdgcn_global_load_lds((const unsigned*)(kg_ + koff[i]), (LAS unsigned*)(ldsl + 3 * SHM_V + (sl) * SHM_K + (wid * 3 + i) * 1024), 16, 0, 0); \
    _Pragma("unroll") for (int i = 0; i < 2; ++i) __builtin_amdgcn_global_load_lds((const unsigned*)(vg_ + voff[i]), (LAS unsigned*)(ldsl + (sl) * SHM_V + (wid * 2 + i) * 1024), 16, 0, 0); } while (0)
    f32x16 pA0, pA1, pB0, pB1; float alA = 1.f, alB = 1.f; bf16x8 pa0, pa1, pa2, pa3;
    int sl_k = 0, sl_v = 2, sl_n = 1;
#define RESC(a) do { if (__any((a) < 1.f)) { if (hi == 0) al_l[r32] = (a); asm volatile("s_waitcnt lgkmcnt(0)" ::: "memory"); \
    _Pragma("unroll") for (int d = 0; d < 4; ++d) _Pragma("unroll") for (int r = 0; r < 16; ++r) o[d][r] *= al_l[crow(r, hi)]; } } while (0)
#define ROT() do { const int t_ = sl_v; sl_v = sl_k; sl_k = sl_n; sl_n = t_; } while (0)
#define STEP(j, C0, C1, ALC, P0, P1, ALP) do { \
    if ((j) + 1 < NT) DMA_TILE((j) + 1, sl_n); \
    if ((j) <= climit) { SBAR(); qkt(C0, C1, K_lds + sl_k * SHM_K, qr, r32, hi); } \
    if ((j) >= 1 && (j) - 1 <= climit) { finishSM(P0, P1, ALP, l_reg, pa0, pa1, pa2, pa3); SBAR(); const int vb = vb0 + sl_v * SHM_V; \
        pv_one<0>(o[0], vb, pa0, pa1, pa2, pa3); pv_one<1>(o[1], vb, pa0, pa1, pa2, pa3); pv_one<2>(o[2], vb, pa0, pa1, pa2, pa3); pv_one<3>(o[3], vb, pa0, pa1, pa2, pa3); } \
    if ((j) <= climit) { partialSM(C0, C1, m_reg, ALC); RESC(ALC); } \
    asm volatile("s_waitcnt vmcnt(0)" ::: "memory"); __syncthreads(); ROT(); } while (0)
    DMA_TILE(0, 0); asm volatile("s_waitcnt vmcnt(0)" ::: "memory"); __syncthreads();
    for (int j = 0; j < NT; j += 2) {
        STEP(j, pA0, pA1, alA, pB0, pB1, alB);
        STEP(j + 1, pB0, pB1, alB, pA0, pA1, alA);
    }
    if (NT - 1 <= climit) { finishSM(pB0, pB1, alB, l_reg, pa0, pa1, pa2, pa3); SBAR(); const int vb = vb0 + sl_v * SHM_V;
        pv_one<0>(o[0], vb, pa0, pa1, pa2, pa3); pv_one<1>(o[1], vb, pa0, pa1, pa2, pa3); pv_one<2>(o[2], vb, pa0, pa1, pa2, pa3); pv_one<3>(o[3], vb, pa0, pa1, pa2, pa3); }
#undef STEP
#undef ROT
#undef RESC
    if (hi == 0) li_l[r32] = l_reg; asm volatile("s_waitcnt lgkmcnt(0)" ::: "memory");
    bf16_t* Ow = Y + (rowbase + qt * 256 + wid * QBLK) * LDO + 1024 + h * DV;
#pragma unroll
    for (int r = 0; r < 16; ++r) { const int orow = crow(r, hi); const float rl = __builtin_amdgcn_rcpf(li_l[orow]);
#pragma unroll
        for (int d0 = 0; d0 < 4; ++d0) Ow[(size_t)orow * LDO + d0 * 32 + r32] = (bf16_t)(cvtpk(o[d0][r] * rl, 0.f) & 0xffffu); }
    __syncthreads();
#undef DMA_TILE
}
#undef SBAR
}


__device__ __forceinline__ float dot2bf(unsigned a, unsigned b, float c) {
    return __builtin_amdgcn_fdot2_f32_bf16(__builtin_bit_cast(bf16x2_t, a), __builtin_bit_cast(bf16x2_t, b), c, false); }
__device__ __forceinline__ float gelu_tanh(float x) {
    const float y = 0.7978845608028654f * (x + 0.044715f * x * x * x);
    const float t = __builtin_amdgcn_exp2f(2.8853900817779268f * y);
    return 0.5f * x * (2.f - 2.f * __builtin_amdgcn_rcpf(t + 1.f));
}

#ifndef DBG_ONLY
#define DBG_ONLY -1
#endif
#define PH(n) (DBG_ONLY < 0 || DBG_ONLY == (n))
#ifndef DBG_STOP
#define DBG_STOP 99

#endif

__global__ void __launch_bounds__(NWAVES * 64, 2) fwd_kernel(Args args) {
    extern __shared__ __attribute__((aligned(16))) unsigned char lds_raw[];
    LAS unsigned char* lds = (LAS unsigned char*)lds_raw;
    LAS unsigned char* eps = lds + EPI_OFF;
    volatile LAS unsigned* MISC = (volatile LAS unsigned*)(lds + MISC_OFF);
    const int wave0 = __builtin_amdgcn_readfirstlane((int)threadIdx.x >> 6);
    const int G = gridDim.x, bx = blockIdx.x, vcu = (G % 8 == 0) ? (bx % 8) * (G / 8) + bx / 8 : bx;
    const int NGW = G * NWAVES; const long NGT = (long)G * 512;
#define PHASE_IDS() int tid = tid_of(wave0); asm volatile("" : "+v"(tid)); const int lane = tid & 63, wave = __builtin_amdgcn_readfirstlane(tid >> 6); const int gw = vcu * NWAVES + wave; const long gt = (long)vcu * 512 + tid; (void)lane; (void)gw; (void)gt
    for (int u = threadIdx.x; u < (LDS_BYTES - LDSCTL_OFF) / 4; u += NWAVES * 64) ((LAS unsigned*)(lds + LDSCTL_OFF))[u] = 0u;
    __syncthreads();
#ifdef TIMING
    unsigned long long ts_prev = __builtin_amdgcn_s_memrealtime(); float ts_val = 0.f; int ts_idx = 0;
#define STAMP() do { const unsigned long long now_ = __builtin_amdgcn_s_memrealtime(); if (ts_idx == TIMING) ts_val = (float)(now_ - ts_prev) * 0.0001f; ts_prev = now_; ++ts_idx; } while (0)
#else
#define STAMP() do {} while (0)
#endif
    XcdBarrier bar;
    { KArgsP ka = kargs(); unsigned char* ws = ka->ws; bar = xcd_barrier_post((unsigned*)(ws + WS_CTL) + 4096, MISC + 8, wave0); }

    if (PH(0)) {
        KArgsP ka = kargs(); unsigned char* ws = ka->ws;
        const float* x = IN_F(0); const float* p_in = IN_F(1); const int* positions = (const int*)ka->in[2];
        const float* mix_gain = IN_F(3); const float* w_in = IN_F(4); const float* w_pool = IN_F(5); const float* pool_scale = IN_F(6);
        const float* q_lat_gain = IN_F(7); const float* kv_lat_gain = IN_F(8); const float* w_uq = IN_F(9); const float* w_ukv = IN_F(10);
        const float* w_out = IN_F(13); const float* w_pq = IN_F(15); const float* sub_k1 = IN_F(16); const float* sub_k2 = IN_F(17);
        const float* expert_u = IN_F(18); const float* expert_v = IN_F(19); const float* ple_gain = IN_F(20); const float* w_ple_gate = IN_F(21); const float* w_ple_proj = IN_F(22);
        bf16_t* WIN = (bf16_t*)WSP(WS_WIN); bf16_t* WPOOL = (bf16_t*)WSP(WS_WPOOL); bf16_t* SKB = (bf16_t*)WSP(WS_SK); bf16_t* WUQ = (bf16_t*)WSP(WS_WUQ); bf16_t* WUKV = (bf16_t*)WSP(WS_WUKV);
        bf16_t* WOUT = (bf16_t*)WSP(WS_WOUT); bf16_t* WPQ = (bf16_t*)WSP(WS_WPQ); bf16_t* WG = (bf16_t*)WSP(WS_WG); bf16_t* WP = (bf16_t*)WSP(WS_WP); bf16_t* PB = (bf16_t*)WSP(WS_PB);
        float* COS = (float*)WSP(WS_COS); float* SIN = (float*)WSP(WS_SIN); unsigned* EU8 = (unsigned*)WSP(WS_EU); unsigned* EV8 = (unsigned*)WSP(WS_EV); float* SU = (float*)WSP(WS_SU); float* SV = (float*)WSP(WS_SV); float* RSTDX = (float*)WSP(WS_RSTDX); unsigned* XQ = (unsigned*)WSP(WS_XQ);
        PHASE_IDS();
        LAS float* scr = (LAS float*)(lds + wave * 16384);
        (void)p_in; (void)sub_k1; (void)sub_k2; (void)expert_u; (void)expert_v; (void)SKB; (void)PB; (void)EU8; (void)EV8; (void)SU; (void)SV;
        if (bx < 66) {
            unsigned char* WINQ = (unsigned char*)WIN; float* SBW = (float*)WSP(WS_SBW);
            const int n0 = 32 * bx, c4 = lane & 7, kr = lane >> 3;
            const float* wp = w_in + (size_t)(256 * wave + 4 * kr) * 2112 + n0 + 4 * c4; const float* gp = mix_gain + 256 * wave + 4 * kr;
            f32x4 mx = {0.f, 0.f, 0.f, 0.f};
#pragma unroll 2
            for (int i = 0; i < 8; ++i) { f32x4 v[4]; const f32x4 gk = *(const f32x4*)(gp + 32 * i);
#pragma unroll
                for (int j = 0; j < 4; ++j) v[j] = *(const f32x4*)(wp + (size_t)(32 * i + j) * 2112);
#pragma unroll
                for (int j = 0; j < 4; ++j)
#pragma unroll
                    for (int e = 0; e < 4; ++e) mx[e] = fmaxf(mx[e], fabsf(v[j][e] * gk[j])); }
#pragma unroll
            for (int e = 0; e < 4; ++e) { mx[e] = fmaxf(mx[e], __shfl_xor(mx[e], 8)); mx[e] = fmaxf(mx[e], __shfl_xor(mx[e], 16)); mx[e] = fmaxf(mx[e], __shfl_xor(mx[e], 32)); }
            LAS float* cm = (LAS float*)(lds + EPI_OFF);
            if (kr == 0) *(LAS f32x4*)(cm + wave * 32 + 4 * c4) = mx;
            __syncthreads();
            f32x4 cmax = *(const LAS f32x4*)(cm + 4 * c4);
#pragma unroll
            for (int w = 1; w < 8; ++w) { const f32x4 o = *(const LAS f32x4*)(cm + w * 32 + 4 * c4);
#pragma unroll
                for (int e = 0; e < 4; ++e) cmax[e] = fmaxf(cmax[e], o[e]); }
            f32x4 sc, inv;
#pragma unroll
            for (int e = 0; e < 4; ++e) { sc[e] = cmax[e] > 0.f ? cmax[e] * (1.f / 127.f) : 1.f; inv[e] = 1.f / sc[e]; }
            if (wave == 0 && kr == 0) *(f32x4*)(SBW + n0 + 4 * c4) = sc;
            LAS unsigned char* tb = lds + wave * 16384;
#pragma unroll 2
            for (int i = 0; i < 8; ++i) { f32x4 v[4]; const f32x4 gk = *(const f32x4*)(gp + 32 * i);
#pragma unroll
                for (int j = 0; j < 4; ++j) v[j] = *(const f32x4*)(wp + (size_t)(32 * i + j) * 2112);
#pragma unroll
                for (int e = 0; e < 4; ++e) { unsigned wd = 0;
#pragma unroll
                    for (int j = 0; j < 4; ++j) wd |= ((unsigned)((int)rintf(v[j][e] * gk[j] * inv[e]) & 0xff)) << (8 * j);
                    *(LAS unsigned*)(tb + (4 * c4 + e) * 272 + 32 * i + 4 * kr) = wd; } }
            asm volatile("s_waitcnt lgkmcnt(0)" ::: "memory");
#pragma unroll
            for (int r = 0; r < 8; ++r) { const int id = lane + 64 * r, n = id >> 4, ch = id & 15;
                *(u32x4*)(WINQ + (size_t)(n0 + n) * 2048 + 256 * wave + 16 * ch) = *(const LAS u32x4*)(tb + n * 272 + 16 * ch); }
            asm volatile("s_waitcnt lgkmcnt(0)" ::: "memory");
        }
        (void)w_pool; (void)pool_scale; (void)q_lat_gain; (void)kv_lat_gain; (void)w_uq; (void)w_ukv; (void)w_out; (void)w_pq; (void)ple_gain; (void)w_ple_gate; (void)w_ple_proj;
        (void)WPOOL; (void)WUKV; (void)WOUT; (void)WPQ; (void)WG; (void)WP;
        for (long i = gt; i < 24576 + 32768; i += NGT) {
            const u32x4 z = {0u, 0u, 0u, 0u};
            if (i < 24576) { *(u32x4*)((unsigned char*)WIN + (size_t)2112 * 2048 + i * 16) = z; if (i < 192) ((float*)WSP(WS_SBW))[2112 + i] = 1.f; }
            else { const long j = i - 24576; const int hh = (int)(j >> 12), rem = (int)(j & 4095); *(u32x4*)(WUQ + ((size_t)hh * 256 + 192) * 512 + (size_t)rem * 8) = z; }
        }
        for (int m = 2 * gw; m < M; m += 2 * NGW) {
            f32x4 v[2][8]; float s[2] = {0.f, 0.f}; float mxr[2] = {0.f, 0.f};
#pragma unroll
            for (int a = 0; a < 2; ++a) { const f32x4* xr = (const f32x4*)(x + (size_t)(m + a) * DM) + lane;
#pragma unroll
                for (int j = 0; j < 8; ++j) v[a][j] = __builtin_nontemporal_load(xr + 64 * j); }
#pragma unroll
            for (int a = 0; a < 2; ++a) {
#pragma unroll
                for (int j = 0; j < 8; ++j) { s[a] += sq4(v[a][j]); mxr[a] = fmaxf(mxr[a], fmaxf(fmaxf(fabsf(v[a][j][0]), fabsf(v[a][j][1])), fmaxf(fabsf(v[a][j][2]), fabsf(v[a][j][3])))); }
                const float rs = rsqrtf(wave_sum(s[a]) * (1.f / DM) + EPS);
                const float am = wave_max(mxr[a]), sx = am > 0.f ? am * (1.f / 127.f) : 1.f, ix = 1.f / sx;
                unsigned* q8 = XQ + (size_t)(m + a) * 512 + lane;
#pragma unroll
                for (int j = 0; j < 8; ++j) { const f32x4 t = v[a][j] * ix;
                    q8[64 * j] = ((unsigned)((int)rintf(t[0]) & 0xff)) | (((unsigned)((int)rintf(t[1]) & 0xff)) << 8) | (((unsigned)((int)rintf(t[2]) & 0xff)) << 16) | (((unsigned)((int)rintf(t[3]) & 0xff)) << 24); }
                if (lane == 0) RSTDX[m + a] = rs * sx; }
        }
        for (long i = gt; i < (long)M * 32; i += NGT) {
            const int row = (int)(i >> 5), j = (int)(i & 31);
            const float inv = __builtin_amdgcn_exp2f(-(float)j * (13.287712379549449f / 32.f));
            const float ang = (float)positions[row] * inv;
            const float kq = rintf(ang * 0.15915494309189535f);
            float r = fmaf(-kq, 6.2831854820251465f, ang); r = fmaf(-kq, -1.7484555e-7f, r);
            const float rev = r * 0.15915494309189535f;
            COS[i] = __builtin_amdgcn_cosf(rev); SIN[i] = __builtin_amdgcn_sinf(rev);
        }
    }
    xcd_barrier(bar); STAMP();
    if (DBG_STOP == 0) return;

    if (PH(1)) {
        KArgsP ka = kargs(); unsigned char* ws = ka->ws;
        bf16_t* XN = (bf16_t*)WSP(WS_XQ); const float* RSTDX = (const float*)WSP(WS_RSTDX); const float* SBW = (const float*)WSP(WS_SBW); bf16_t* WIN = (bf16_t*)WSP(WS_WIN); bf16_t* ZP = (bf16_t*)WSP(WS_ZP); bf16_t* CQ = (bf16_t*)WSP(WS_CQ); bf16_t* CKV = (bf16_t*)WSP(WS_CKV);
        float* SSQ_CQ = (float*)WSP(WS_SSQ_CQ); float* SSQ_CKV = (float*)WSP(WS_SSQ_CKV); float* KRP = (float*)WSP(WS_KRP);
#define PHASE_A_SIDE() do { KArgsP kb = kargs(); unsigned char* ws = kb->ws; PHASE_IDS(); LAS float* scr = (LAS float*)(lds + wave * 16384); \
        { const float* eu = (const float*)kb->in[18]; const float* ev = (const float*)kb->in[19]; unsigned* EU8 = (unsigned*)WSP(WS_EU); unsigned* EV8 = (unsigned*)WSP(WS_EV); float* SU = (float*)WSP(WS_SU); float* SV = (float*)WSP(WS_SV); \
          for (int r = gw * 16; r < gw * 16 + 16; r += 4) quant_rows<4>(eu, ev, EU8, EV8, SU, SV, r, lane); } \
        { const float* w_pool = (const float*)kb->in[5]; const float* pool_scale = (const float*)kb->in[6]; const float* q_lat_gain = (const float*)kb->in[7]; const float* kv_lat_gain = (const float*)kb->in[8]; \
          const float* w_uq = (const float*)kb->in[9]; const float* w_ukv = (const float*)kb->in[10]; const float* w_out = (const float*)kb->in[13]; const float* w_pq = (const float*)kb->in[15]; const float* ffn_gain = (const float*)kb->in[14]; \
          const float* ple_gain = (const float*)kb->in[20]; const float* w_ple_gate = (const float*)kb->in[21]; const float* w_ple_proj = (const float*)kb->in[22]; \
          bf16_t* WPOOL = (bf16_t*)WSP(WS_WPOOL); bf16_t* WUQ = (bf16_t*)WSP(WS_WUQ); bf16_t* WUKV = (bf16_t*)WSP(WS_WUKV); bf16_t* WOUT = (bf16_t*)WSP(WS_WOUT); bf16_t* WPQ = (bf16_t*)WSP(WS_WPQ); bf16_t* WG = (bf16_t*)WSP(WS_WG); bf16_t* WP = (bf16_t*)WSP(WS_WP); \
          constexpr int I_POOL = 4 * 4 * 8, I_UQ = 8 * 48, I_UKV = 8 * 64, I_SQ = 32 * 64, I_WP = 4 * 64, NITEMS = I_POOL + I_UQ + I_UKV + 3 * I_SQ + I_WP; \
          auto trp = [&](int r) -> TrP { \
            if (r < I_POOL) { const int g_ = r >> 5; return TrP{w_pool + g_ * 65536, nullptr, pool_scale + g_ * 256, WPOOL + g_ * 65536, 256, 256, 8, r & 31, 0}; } r -= I_POOL; \
            if (r < I_UQ) return TrP{w_uq, q_lat_gain, nullptr, WUQ, 1536, 512, 48, r, 1}; r -= I_UQ; \
            if (r < I_UKV) return TrP{w_ukv, kv_lat_gain, nullptr, WUKV, 2048, 512, 64, r, 0}; r -= I_UKV; \
            if (r < I_SQ) return TrP{w_out, nullptr, nullptr, WOUT, 2048, 2048, 64, r, 0}; r -= I_SQ; \
            if (r < I_SQ) return TrP{w_pq, ffn_gain, nullptr, WPQ, 2048, 2048, 64, r, 0}; r -= I_SQ; \
            if (r < I_SQ) return TrP{w_ple_gate, ple_gain, nullptr, WG, 2048, 2048, 64, r, 0}; r -= I_SQ; \
            return TrP{w_ple_proj, nullptr, nullptr, WP, 2048, 256, 64, r, 0}; }; \
          for (int it = gw; it < NITEMS; it += 2 * NGW) { const bool two = it + NGW < NITEMS; const TrP pa = trp(it), pb = trp(two ? it + NGW : it); \
            float va[32], vb[32]; tr_load(pa, va, lane); if (two) tr_load(pb, vb, lane); \
            tr_store(pa, va, scr, lane); if (two) tr_store(pb, vb, scr, lane); } } \
        asm volatile("s_waitcnt vmcnt(0) lgkmcnt(0)" ::: "memory"); __syncthreads(); } while (0)
        if (vcu & 1) PHASE_A_SIDE();
        pg8::Gemm g{XN, WIN, 2048, 2048, 2048}; pg8::StaticOrder S; S.init(M, 2048, G, bx);
        EpiA E{ZP, CQ, CKV, SSQ_CQ, SSQ_CKV, RSTDX, SBW};
        pg8::gemm_phase<EpiA, pg8::StaticOrder, true, true, true>(lds, eps, g, S, E, wave0);
        pg8::Gemm g2{XN, WIN, 2048, 2048, 512}; pg8::QuadOrder<0> S2{vcu};
        EpiKR E2{KRP, RSTDX, SBW};
        pg8::gemm_phase<EpiKR, pg8::QuadOrder<0>, true, true, true>(lds, eps, g2, S2, E2, wave0);
        if (!(vcu & 1)) PHASE_A_SIDE();
#undef PHASE_A_SIDE
    }
    xcd_barrier(bar); STAMP();
    if (DBG_STOP == 1) return;

    if (PH(2)) {
        { KArgsP ka = kargs(); unsigned char* ws = ka->ws;
          bf16_t* ZP = (bf16_t*)WSP(WS_ZP); bf16_t* WPOOL = (bf16_t*)WSP(WS_WPOOL); bf16_t* UB = (bf16_t*)WSP(WS_U);
          pg8::Gemm gp{ZP, WPOOL, 1024, 256, 256}; pg8::QuadOrder<1> Sp{vcu};
          EpiStore Ep{UB, 1024};
          pg8::gemm_phase<EpiStore, pg8::QuadOrder<1>, true>(lds, eps, gp, Sp, Ep, wave0); }
        { KArgsP ka = kargs(); unsigned char* ws = ka->ws; const float* q_norm_gain = IN_F(11);
          bf16_t* CQ = (bf16_t*)WSP(WS_CQ); bf16_t* WUQ = (bf16_t*)WSP(WS_WUQ); bf16_t* QB = (bf16_t*)WSP(WS_Q);
          float* SSQ_CQ = (float*)WSP(WS_SSQ_CQ); float* COS = (float*)WSP(WS_COS); float* SIN = (float*)WSP(WS_SIN);
          pg8::Gemm gq{CQ, WUQ, 512, 512, 512}; pg8::StaticOrder Sq; Sq.init(M, 2048, G, bx);
          EpiQ Eq{QB, SSQ_CQ, q_norm_gain, COS, SIN};
          pg8::gemm_phase<EpiQ, pg8::StaticOrder, true>(lds, eps, gq, Sq, Eq, wave0); }
        { KArgsP ka = kargs(); unsigned char* ws = ka->ws; const float* k_norm_gain = IN_F(12);
          bf16_t* CKV = (bf16_t*)WSP(WS_CKV); bf16_t* WUKV = (bf16_t*)WSP(WS_WUKV); bf16_t* KB = (bf16_t*)WSP(WS_K); bf16_t* VB = (bf16_t*)WSP(WS_V);
          float* SSQ_CKV = (float*)WSP(WS_SSQ_CKV); float* KRP = (float*)WSP(WS_KRP); float* COS = (float*)WSP(WS_COS); float* SIN = (float*)WSP(WS_SIN);
          pg8::Gemm gk{CKV, WUKV, 512, 512, 512}; pg8::StaticOrder Sk; Sk.init(M, 2048, G, bx);
          EpiKV Ek{KB, VB, SSQ_CKV, KRP, k_norm_gain, COS, SIN};
          pg8::gemm_phase<EpiKV, pg8::StaticOrder, true>(lds, eps, gk, Sk, Ek, wave0); }
    }
    xcd_barrier(bar); STAMP();
    if (DBG_STOP == 2) return;

    if (PH(3)) {
        KArgsP ka = kargs(); unsigned char* ws = ka->ws;
        bf16_t* UB = (bf16_t*)WSP(WS_U); bf16_t* YMIX = (bf16_t*)WSP(WS_R1); bf16_t* QB = (bf16_t*)WSP(WS_Q); bf16_t* KB = (bf16_t*)WSP(WS_K); bf16_t* VB = (bf16_t*)WSP(WS_V);
        PHASE_IDS();
        {
            const int g = wave & 3, c0 = (32 * g + (lane & 31)) * 8, row0 = vcu * 64 + 32 * (wave >> 2) + 16 * (lane >> 5);
#define FILT_ACC(OP, V) do { a[0] OP bf_lo((V).x); a[1] OP bf_hi((V).x); a[2] OP bf_lo((V).y); a[3] OP bf_hi((V).y); a[4] OP bf_lo((V).z); a[5] OP bf_hi((V).z); a[6] OP bf_lo((V).w); a[7] OP bf_hi((V).w); } while (0)
#define FILT(W) do { const int tl0 = row0 & (SEQ - 1); const bool hist = tl0 != 0; u32x4 h[(W) + 16]; \
                _Pragma("unroll") for (int j = 0; j < (W) + 16; ++j) { const bool ok = hist || j >= (W); h[j] = *(const u32x4*)(UB + (size_t)(ok ? row0 - (W) + j : row0) * 1024 + c0); if (!ok) h[j] = (u32x4){0u, 0u, 0u, 0u}; } \
                float a[8]; _Pragma("unroll") for (int e = 0; e < 8; ++e) a[e] = 0.f; \
                _Pragma("unroll") for (int j = 0; j < (W); ++j) FILT_ACC(+=, h[j]); \
                _Pragma("unroll") for (int rI = 0; rI < 16; ++rI) { const int row = row0 + rI, tl = tl0 + rI; const int cnt = (tl + 1 < (W)) ? tl + 1 : (W); const u32x4 cur = h[(W) + rI]; \
                    FILT_ACC(+=, cur); FILT_ACC(-=, h[rI]); \
                    const float ic = 1.f / (float)cnt; u32x4 o; \
                    o.x = cvtpk(a[0] * ic - bf_lo(cur.x), a[1] * ic - bf_hi(cur.x)); o.y = cvtpk(a[2] * ic - bf_lo(cur.y), a[3] * ic - bf_hi(cur.y)); \
                    o.z = cvtpk(a[4] * ic - bf_lo(cur.z), a[5] * ic - bf_hi(cur.z)); o.w = cvtpk(a[6] * ic - bf_lo(cur.w), a[7] * ic - bf_hi(cur.w)); \
                    *(u32x4*)(YMIX + (size_t)row * DM + c0) = o; } } while (0)
            if (g == 0) FILT(2); else if (g == 1) FILT(4); else if (g == 2) FILT(8); else FILT(16);
#undef FILT
#undef FILT_ACC
        }
        if (G == 256) {
            const int bh = vcu >> 2, s = vcu & 3;
            att::attn_unit(bh >> 3, bh & 7, s, QB, KB, VB, YMIX, (char*)lds_raw, lds, wave0);
            att::attn_unit(bh >> 3, bh & 7, 7 - s, QB, KB, VB, YMIX, (char*)lds_raw, lds, wave0);
        }
    }
    xcd_barrier(bar); STAMP();
    if (DBG_STOP == 3) return;

    if (PH(4)) {
        KArgsP ka = kargs(); unsigned char* ws = ka->ws; const float* x = IN_F(0); bf16_t* H1B = (bf16_t*)WSP(WS_H2B);
        bf16_t* YMIX = (bf16_t*)WSP(WS_R1); bf16_t* WOUT = (bf16_t*)WSP(WS_WOUT); float* SSQ_H1 = (float*)WSP(WS_SSQ_H1);
        pg8::Gemm g{YMIX, WOUT, 2048, 2048, 2048}; pg8::StaticOrder S; S.init(M, 2048, G, bx);
        EpiH1 E{x, H1B, SSQ_H1};
        pg8::gemm_phase<EpiH1, pg8::StaticOrder, true>(lds, eps, g, S, E, wave0);
    }
    xcd_barrier(bar); STAMP();
    if (DBG_STOP == 4) return;

    if (PH(5)) {
        KArgsP ka = kargs(); unsigned char* ws = ka->ws;
        bf16_t* H1B = (bf16_t*)WSP(WS_H2B); bf16_t* WPQ = (bf16_t*)WSP(WS_WPQ); bf16_t* QP = (bf16_t*)WSP(WS_R1); float* SSQ_H1 = (float*)WSP(WS_SSQ_H1); float* RSTD2 = (float*)WSP(WS_RSTD2);
        pg8::Gemm g{H1B, WPQ, 2048, 2048, 2048}; pg8::PairOrder S{vcu};
        EpiQP E{QP, SSQ_H1, RSTD2};
        pg8::gemm_phase<EpiQP, pg8::PairOrder, true>(lds, eps, g, S, E, wave0);
    }
    asm volatile("s_waitcnt vmcnt(0)" ::: "memory"); __syncthreads();
    if (tid_of(wave0) == 0) { __builtin_amdgcn_fence(__ATOMIC_ACQUIRE, "agent"); asm volatile("s_waitcnt vmcnt(0)" ::: "memory"); }
    __syncthreads(); STAMP();
    if (DBG_STOP == 5) return;

    if (PH(6)) {
        KArgsP ka = kargs(); unsigned char* ws = ka->ws;
        bf16_t* QP = (bf16_t*)WSP(WS_R1); bf16_t* SKB = (bf16_t*)WSP(WS_SK); int* PIDX = (int*)WSP(WS_PIDX); float* PGATE = (float*)WSP(WS_PGATE);
        PHASE_IDS();
        LAS unsigned char* SKL = lds;
        LAS float* SC = (LAS float*)(lds + 65536 + wave * 10816);
        LAS float* TKV = (LAS float*)(lds + 65536 + wave * 10816 + 8256);
        LAS unsigned char* TKI = lds + 65536 + wave * 10816 + 8256 + 2048;
        const int fr = lane & 15, fq = lane >> 4; const int h = vcu & 7;
#pragma unroll
        for (int i = 0; i < 8; ++i) { const int p = tid + 512 * i, side = p >> 11, key = (p >> 4) & 127, c = p & 15;
            const u32x4 v = *(const u32x4*)(SKB + (size_t)side * 131072 + (size_t)h * 16384 + key * 128 + c * 8);
            *(LAS u32x4*)(SKL + side * 32768 + key * 256 + ((c ^ (key & 15)) << 4)) = v; }
        __syncthreads();
        for (int bi = 0; bi < 4; ++bi) {
            const int tb = (vcu >> 3) * 32 + wave * 4 + bi, t0 = tb * 16;
#pragma unroll 1
            for (int side = 0; side < 2; ++side) {
                bf16x8 qf[4];
#pragma unroll
                for (int kk = 0; kk < 4; ++kk) qf[kk] = *(const bf16x8*)(QP + (size_t)(t0 + fr) * DM + h * 256 + side * 128 + kk * 32 + 8 * fq);
                const LAS unsigned char* skl = SKL + side * 32768 + fr * 256;
#pragma unroll
                for (int nt = 0; nt < 8; ++nt) { f32x4 a = {0.f, 0.f, 0.f, 0.f};
#pragma unroll
                    for (int kk = 0; kk < 4; ++kk) { const bf16x8 kf = *(const LAS bf16x8*)(skl + nt * 4096 + (((kk * 4 + fq) ^ fr) << 4));
                        a = __builtin_amdgcn_mfma_f32_16x16x32_bf16(kf, qf[kk], a, 0, 0, 0); }
#pragma unroll
                    for (int i = 0; i < 4; ++i) SC[fr * 129 + nt * 16 + 4 * fq + i] = a[i]; }
                asm volatile("s_waitcnt lgkmcnt(0)" ::: "memory");
                const int tok = lane >> 2, q4 = lane & 3; float v[32];
#pragma unroll
                for (int i = 0; i < 32; ++i) v[i] = __builtin_bit_cast(float, (__builtin_bit_cast(unsigned, SC[tok * 129 + 4 * i + q4]) & ~0x7Fu) | (unsigned)(4 * i + q4));
                bitonic_sort_desc<32>(v); QUAD_MERGE16(v, 0xB1); QUAD_MERGE16(v, 0x4E);
                if (q4 == 0) {
#pragma unroll
                    for (int r = 0; r < 16; ++r) { const int bk = (int)(__builtin_bit_cast(unsigned, v[r]) & 0x7Fu); TKV[(side * 16 + tok) * 16 + r] = SC[tok * 129 + bk]; TKI[(side * 16 + tok) * 16 + r] = (unsigned char)bk; } }
                asm volatile("s_waitcnt lgkmcnt(0)" ::: "memory");
            }
            {
                const int tok = lane >> 2, q4 = lane & 3; float c[32];
                const LAS float* V1 = TKV + tok * 16; const LAS float* V2 = TKV + (16 + tok) * 16;
#define CAND(slot, a, bi) do { const int b_ = q4 + 4 * (bi); const float s_ = V1[a] + V2[b_]; \
    c[slot] = (((a) + 1) * (b_ + 1) <= 16) ? __builtin_bit_cast(float, (__builtin_bit_cast(unsigned, s_) & ~0xFFu) | (unsigned)((a) * 16 + b_)) : -INFINITY; } while (0)
                CAND(0, 0, 0); CAND(1, 0, 1); CAND(2, 0, 2); CAND(3, 0, 3); CAND(4, 1, 0); CAND(5, 1, 1); CAND(6, 2, 0); CAND(7, 2, 1);
                CAND(8, 3, 0); CAND(9, 4, 0); CAND(10, 5, 0); CAND(11, 6, 0); CAND(12, 7, 0); CAND(13, 8, 0); CAND(14, 9, 0); CAND(15, 10, 0);
                CAND(16, 11, 0); CAND(17, 12, 0); CAND(18, 13, 0); CAND(19, 14, 0); CAND(20, 15, 0);
#undef CAND
#pragma unroll
                for (int i = 21; i < 32; ++i) c[i] = -INFINITY;
                bitonic_sort_desc<32>(c); QUAD_MERGE16(c, 0xB1); QUAD_MERGE16(c, 0x4E);
                int co[4];
#pragma unroll
                for (int ri = 0; ri < 4; ++ri) { const float x_ = q4 == 0 ? c[4 * ri] : q4 == 1 ? c[4 * ri + 1] : q4 == 2 ? c[4 * ri + 2] : c[4 * ri + 3]; co[ri] = (int)(__builtin_bit_cast(unsigned, x_) & 0xFFu); }
                float sv[4]; float mx = -INFINITY;
#pragma unroll
                for (int ri = 0; ri < 4; ++ri) { sv[ri] = V1[co[ri] >> 4] + V2[co[ri] & 15]; mx = fmaxf(mx, sv[ri]); }
                mx = quad_max(mx);
                float eo[4]; float esum = 0.f;
#pragma unroll
                for (int ri = 0; ri < 4; ++ri) { eo[ri] = __builtin_amdgcn_exp2f((sv[ri] - mx) * 1.4426950408889634f); esum += eo[ri]; }
                esum = quad_sum(esum);
                const float inv = 1.f / esum;
#pragma unroll
                for (int ri = 0; ri < 4; ++ri) { const int e1 = (int)TKI[tok * 16 + (co[ri] >> 4)], e2 = (int)TKI[(16 + tok) * 16 + (co[ri] & 15)];
                    const size_t oi = (size_t)(t0 + tok) * 128 + h * 16 + 4 * ri + q4;
                    PIDX[oi] = e1 * 128 + e2; PGATE[oi] = eo[ri] * inv; }
            }
            asm volatile("s_waitcnt lgkmcnt(0)" ::: "memory");
        }
    }
    xcd_barrier(bar); STAMP();
    if (DBG_STOP == 6) return;


    if (PH(7)) {
        PHASE_IDS();
        const int xc = bx & 7, wl = (bx >> 3) * NWAVES + wave;
        const int gi = lane >> 3, cj = lane & 7; const unsigned cj16 = 16u * (unsigned)cj;
        const int tpw = M / ((G >> 3) * NWAVES);
        {
            KArgsP ka = kargs(); unsigned char* ws = ka->ws;
            const bf16_t* H1B = (const bf16_t*)WSP(WS_H2B); const unsigned char* TU = WSP(WS_EU); const int* PIDX = (const int*)WSP(WS_PIDX); const float* ffn_gain = IN_F(14);
            LAS unsigned char* xl = lds + wave * 8448; LAS float* xs = (LAS float*)(xl + 8192);
#define F1_LOADIDX(n_, EV) do { const int nn_ = (n_) < tpw ? (n_) : tpw - 1; const size_t t_ = (size_t)(wl * tpw + nn_); \
        _Pragma("unroll") for (int q = 0; q < 4; ++q) EV[q] = *(const u32x4*)(PIDX + t_ * 128 + 16 * gi + 4 * q); } while (0)
#define F1_GATHER(EV, UU) do { _Pragma("unroll") for (int q = 0; q < 4; ++q) { UU[4 * q] = *(const u32x4*)(tus + ((EV[q].x << 7) | cj16)); UU[4 * q + 1] = *(const u32x4*)(tus + ((EV[q].y << 7) | cj16)); \
        UU[4 * q + 2] = *(const u32x4*)(tus + ((EV[q].z << 7) | cj16)); UU[4 * q + 3] = *(const u32x4*)(tus + ((EV[q].w << 7) | cj16)); } } while (0)
#define F1_COMPUTE(n_, UU) do { const u32x4 xq = *(const LAS u32x4*)(xl + (n_) * 128 + cj16); const float sx = xs[(n_)]; f32x4 pr[4]; \
        _Pragma("unroll") for (int g = 0; g < 16; ++g) { int d = __builtin_amdgcn_sdot4((int)UU[g].x, (int)xq.x, 0, false); d = __builtin_amdgcn_sdot4((int)UU[g].y, (int)xq.y, d, false); \
            d = __builtin_amdgcn_sdot4((int)UU[g].z, (int)xq.z, d, false); d = __builtin_amdgcn_sdot4((int)UU[g].w, (int)xq.w, d, false); pr[g >> 2][g & 3] = (float)oct_sum_i(d) * sx; } \
        if (cj == 0) { bf16_t* po = PART + (size_t)(wl * tpw + (n_)) * 128 + 16 * gi; __builtin_nontemporal_store(pack8(pr[0], pr[1]), (u32x4*)po); __builtin_nontemporal_store(pack8(pr[2], pr[3]), (u32x4*)(po + 8)); } } while (0)
#pragma unroll 1
            for (int p = 0; p < 2; ++p) {
                const int s = 2 * xc + p; const unsigned char* tus = TU + (size_t)s * (16384 * 128);
                bf16_t* PART = (bf16_t*)(p == 0 ? WSP(WS_PART0) : WSP(WS_PART1)) + (size_t)xc * M * 128;
                {
                    float gsl[16];
#pragma unroll
                    for (int i = 0; i < 16; ++i) gsl[i] = ffn_gain[128 * s + 16 * cj + i];
#pragma unroll 2
                    for (int o = 0; o < tpw; o += 8) { const size_t t_ = (size_t)(wl * tpw + o + gi);
                        const u32x4 XA = *(const u32x4*)(H1B + t_ * DM + 128 * s + 16 * cj), XB = *(const u32x4*)(H1B + t_ * DM + 128 * s + 16 * cj + 8);
                        const unsigned xw[8] = {XA.x, XA.y, XA.z, XA.w, XB.x, XB.y, XB.z, XB.w}; float xf[16]; float mx = 0.f;
#pragma unroll
                        for (int i = 0; i < 8; ++i) { xf[2 * i] = bf_lo(xw[i]) * gsl[2 * i]; xf[2 * i + 1] = bf_hi(xw[i]) * gsl[2 * i + 1]; mx = fmaxf(mx, fmaxf(fabsf(xf[2 * i]), fabsf(xf[2 * i + 1]))); }
                        mx = oct_max(mx); const float sx = mx > 0.f ? mx * (1.f / 127.f) : 1.f; const float inv = 1.f / sx; u32x4 xq;
#pragma unroll
                        for (int i = 0; i < 4; ++i) { const int q0 = (int)rintf(xf[4 * i] * inv), q1 = (int)rintf(xf[4 * i + 1] * inv), q2 = (int)rintf(xf[4 * i + 2] * inv), q3 = (int)rintf(xf[4 * i + 3] * inv);
                            xq[i] = (unsigned)(q0 & 0xff) | ((unsigned)(q1 & 0xff) << 8) | ((unsigned)(q2 & 0xff) << 16) | ((unsigned)(q3 & 0xff) << 24); }
                        *(LAS u32x4*)(xl + (o + gi) * 128 + 16 * cj) = xq; if (cj == 0) xs[o + gi] = sx; }
                    asm volatile("s_waitcnt lgkmcnt(0)" ::: "memory");
                }
                u32x4 evA[4], evB[4], uuA[16], uuB[16];
                F1_LOADIDX(0, evA); F1_LOADIDX(1, evB); F1_GATHER(evA, uuA);
#pragma unroll 1
                for (int n = 0; n < tpw; n += 2) {
                    F1_GATHER(evB, uuB); F1_LOADIDX(n + 2, evA); F1_COMPUTE(n, uuA);
                    F1_GATHER(evA, uuA); F1_LOADIDX(n + 3, evB); F1_COMPUTE(n + 1, uuB);
                }
                asm volatile("s_waitcnt lgkmcnt(0)" ::: "memory");
            }
#undef F1_LOADIDX
#undef F1_GATHER
#undef F1_COMPUTE
        }
        xcd_barrier(bar);
        {
            KArgsP ka = kargs(); unsigned char* ws = ka->ws;
            const bf16_t* P0 = (const bf16_t*)WSP(WS_PART0); const bf16_t* P1 = (const bf16_t*)WSP(WS_PART1); const int* PIDX = (const int*)WSP(WS_PIDX); const float* PGATE = (const float*)WSP(WS_PGATE);
            const float* SU = (const float*)WSP(WS_SU); const float* SV = (const float*)WSP(WS_SV); const float* RSTD2 = (const float*)WSP(WS_RSTD2); unsigned* AQ = (unsigned*)WSP(WS_AQ); float* AS = (float*)WSP(WS_AS);
            for (int tp = gw; tp < M / 2; tp += NGW) {
                const int t = 2 * tp + (lane >> 5), li = lane & 31; const size_t i = (size_t)t * 128 + 4 * li;
                f32x4 sum = {0.f, 0.f, 0.f, 0.f};
#pragma unroll
                for (int x8 = 0; x8 < 8; ++x8) { const u32x2 a = __builtin_nontemporal_load((const u32x2*)(P0 + (size_t)x8 * M * 128 + i)), b = __builtin_nontemporal_load((const u32x2*)(P1 + (size_t)x8 * M * 128 + i));
                    sum += (f32x4){bf_lo(a.x), bf_hi(a.x), bf_lo(a.y), bf_hi(a.y)} + (f32x4){bf_lo(b.x), bf_hi(b.x), bf_lo(b.y), bf_hi(b.y)}; }
                const u32x4 e4 = *(const u32x4*)(PIDX + i); const f32x4 g4 = *(const f32x4*)(PGATE + i); const float rs = RSTD2[t];
                const unsigned ee[4] = {e4.x, e4.y, e4.z, e4.w}; float a[4]; float mx = 0.f;
#pragma unroll
                for (int c = 0; c < 4; ++c) { a[c] = gelu_tanh(sum[c] * SU[ee[c]] * rs) * g4[c] * SV[ee[c]]; mx = fmaxf(mx, fabsf(a[c])); }
                mx = oct_max(mx); mx = fmaxf(mx, DPP_F(mx, 0x128)); mx = fmaxf(mx, __shfl_xor(mx, 16));
                const float sc = mx > 0.f ? mx * (1.f / 127.f) : 1.f; const float inv = 1.f / sc;
                const int q0 = (int)rintf(a[0] * inv), q1 = (int)rintf(a[1] * inv), q2 = (int)rintf(a[2] * inv), q3 = (int)rintf(a[3] * inv);
                AQ[(size_t)t * 32 + li] = (unsigned)(q0 & 0xff) | ((unsigned)(q1 & 0xff) << 8) | ((unsigned)(q2 & 0xff) << 16) | ((unsigned)(q3 & 0xff) << 24);
                if (li == 0) AS[t] = sc;
            }
        }
        xcd_barrier(bar);
        {
            KArgsP ka = kargs(); unsigned char* ws = ka->ws;
            const unsigned char* TV = WSP(WS_EV); const int* PIDX = (const int*)WSP(WS_PIDX); const unsigned* AQ = (const unsigned*)WSP(WS_AQ); const float* AS = (const float*)WSP(WS_AS);
            bf16_t* H2B = (bf16_t*)WSP(WS_H2B); float* SSQ2 = (float*)WSP(WS_SSQ2);
            const int nit = tpw;
#define F3_LOADIDX(it_, EV, AQV) do { const int ii_ = (it_) < nit ? (it_) : nit - 1; const size_t t_ = (size_t)(wl * tpw + (ii_ >> 3) * 8 + gi); const int kb_ = ii_ & 7; \
        _Pragma("unroll") for (int q = 0; q < 4; ++q) EV[q] = *(const u32x4*)(PIDX + t_ * 128 + 16 * kb_ + 4 * q); \
        AQV = *(const u32x4*)(AQ + t_ * 32 + 4 * kb_); } while (0)
#define F3_GATHER(EV, VV) do { _Pragma("unroll") for (int q = 0; q < 4; ++q) { VV[4 * q] = *(const u32x4*)(tvs + ((EV[q].x << 7) | cj16)); VV[4 * q + 1] = *(const u32x4*)(tvs + ((EV[q].y << 7) | cj16)); \
        VV[4 * q + 2] = *(const u32x4*)(tvs + ((EV[q].z << 7) | cj16)); VV[4 * q + 3] = *(const u32x4*)(tvs + ((EV[q].w << 7) | cj16)); } } while (0)
#define F3_T4(W, Q, R0, R1, R2, R3, AW) do { const unsigned a_ = __builtin_amdgcn_perm(R1, R0, 0x05010400u), b_ = __builtin_amdgcn_perm(R1, R0, 0x07030602u), c_ = __builtin_amdgcn_perm(R3, R2, 0x05010400u), d_ = __builtin_amdgcn_perm(R3, R2, 0x07030602u); \
        acc[4 * (W) + 0] = __builtin_amdgcn_sdot4((int)__builtin_amdgcn_perm(c_, a_, 0x05040100u), (int)(AW), acc[4 * (W) + 0], false); acc[4 * (W) + 1] = __builtin_amdgcn_sdot4((int)__builtin_amdgcn_perm(c_, a_, 0x07060302u), (int)(AW), acc[4 * (W) + 1], false); \
        acc[4 * (W) + 2] = __builtin_amdgcn_sdot4((int)__builtin_amdgcn_perm(d_, b_, 0x05040100u), (int)(AW), acc[4 * (W) + 2], false); acc[4 * (W) + 3] = __builtin_amdgcn_sdot4((int)__builtin_amdgcn_perm(d_, b_, 0x07060302u), (int)(AW), acc[4 * (W) + 3], false); } while (0)
#define F3_Q(Q, VV, AW) do { F3_T4(0, Q, VV[4 * (Q)].x, VV[4 * (Q) + 1].x, VV[4 * (Q) + 2].x, VV[4 * (Q) + 3].x, AW); F3_T4(1, Q, VV[4 * (Q)].y, VV[4 * (Q) + 1].y, VV[4 * (Q) + 2].y, VV[4 * (Q) + 3].y, AW); \
        F3_T4(2, Q, VV[4 * (Q)].z, VV[4 * (Q) + 1].z, VV[4 * (Q) + 2].z, VV[4 * (Q) + 3].z, AW); F3_T4(3, Q, VV[4 * (Q)].w, VV[4 * (Q) + 1].w, VV[4 * (Q) + 2].w, VV[4 * (Q) + 3].w, AW); } while (0)
#define F3_COMPUTE(it_, VV, AQV) do { F3_Q(0, VV, AQV.x); F3_Q(1, VV, AQV.y); F3_Q(2, VV, AQV.z); F3_Q(3, VV, AQV.w); \
        if (((it_) & 7) == 7) { const size_t t_ = (size_t)(wl * tpw + ((it_) >> 3) * 8 + gi); const float as_ = AS[t_]; bf16_t* o = H2B + t_ * DM + 128 * s + 16 * cj; f32x4 hh[4]; float s2 = 0.f; \
            const u32x4 ha_ = *(const u32x4*)o, hb_ = *(const u32x4*)(o + 8); const unsigned hw_[8] = {ha_.x, ha_.y, ha_.z, ha_.w, hb_.x, hb_.y, hb_.z, hb_.w}; \
            _Pragma("unroll") for (int i = 0; i < 4; ++i) { hh[i] = (f32x4){bf_lo(hw_[2 * i]), bf_hi(hw_[2 * i]), bf_lo(hw_[2 * i + 1]), bf_hi(hw_[2 * i + 1])} + (f32x4){(float)acc[4 * i], (float)acc[4 * i + 1], (float)acc[4 * i + 2], (float)acc[4 * i + 3]} * as_; s2 += sq4(hh[i]); } \
            *(u32x4*)o = pack8(hh[0], hh[1]); *(u32x4*)(o + 8) = pack8(hh[2], hh[3]); \
            s2 = oct_sum(s2); if (cj == 0) SSQ2[t_ * 16 + s] = s2; \
            _Pragma("unroll") for (int i = 0; i < 16; ++i) acc[i] = 0; } } while (0)
#pragma unroll 1
            for (int p = 0; p < 2; ++p) {
                const int s = 2 * xc + p; const unsigned char* tvs = TV + (size_t)s * (16384 * 128);
                u32x4 evA[4], evB[4], vvA[16], vvB[16], aqA, aqB, aqC; int acc[16];
#pragma unroll
                for (int i = 0; i < 16; ++i) acc[i] = 0;
                F3_LOADIDX(0, evA, aqA); F3_LOADIDX(1, evB, aqB); F3_GATHER(evA, vvA);
#pragma unroll 1
                for (int it = 0; it < nit; it += 2) {
                    F3_GATHER(evB, vvB); F3_LOADIDX(it + 2, evA, aqC); F3_COMPUTE(it, vvA, aqA); aqA = aqC;
                    F3_GATHER(evA, vvA); F3_LOADIDX(it + 3, evB, aqC); F3_COMPUTE(it + 1, vvB, aqB); aqB = aqC;
                }
            }
#undef F3_LOADIDX
#undef F3_GATHER
#undef F3_T4
#undef F3_Q
#undef F3_COMPUTE
        }
    }
    xcd_barrier(bar); STAMP();
    if (DBG_STOP == 7) return;

    if (PH(8)) {
        KArgsP ka = kargs(); unsigned char* ws = ka->ws; float* OUT = ka->out;
        bf16_t* PB = (bf16_t*)WSP(WS_PB); bf16_t* WP = (bf16_t*)WSP(WS_WP); bf16_t* PROJ = (bf16_t*)WSP(WS_R1); bf16_t* H2B = (bf16_t*)WSP(WS_H2B); bf16_t* WG = (bf16_t*)WSP(WS_WG); float* SSQ2 = (float*)WSP(WS_SSQ2);
        pg8::StaticOrder S; S.init(M, 2048, G, bx);
        pg8::Gemm gp{PB, WP, 256, 256, 256};
        EpiStore Ep{PROJ, 2048};
        pg8::gemm_phase<EpiStore, pg8::StaticOrder, true>(lds, eps, gp, S, Ep, wave0);
        pg8::Gemm gg{H2B, WG, 2048, 2048, 2048};
        EpiGate Eg{OUT, PROJ, SSQ2, H2B};
        pg8::gemm_phase<EpiGate, pg8::StaticOrder, true>(lds, eps, gg, S, Eg, wave0);
    }
#ifdef TIMING
    xcd_barrier(bar); STAMP();
    if (blockIdx.x == 0 && threadIdx.x == 0) { KArgsP ka = kargs(); float* OUT = ka->out; OUT[0] += ts_val; }
#endif
}

extern "C" void kernel_launch(void* const* d_in, const int* in_sizes, int n_in, void* d_out, int out_size, void* d_ws, size_t ws_size, hipStream_t stream) {
    static int ready = 0;
    if (ready == 0) {
        if (n_in != 23 || out_size != M * DM || ws_size < WS_END) { fprintf(stderr, "kernel_launch: unexpected shapes (n_in %d, out %d, ws %zu)\n", n_in, out_size, ws_size); ready = -1; return; }
        if (hipFuncSetAttribute((const void*)fwd_kernel, hipFuncAttributeMaxDynamicSharedMemorySize, LDS_BYTES) != hipSuccess) { fprintf(stderr, "kernel_launch: hipFuncSetAttribute failed\n"); ready = -1; return; }
        ready = 1;
    }
    if (ready < 0) return;
    (void)hipMemsetAsync((char*)d_ws + WS_CTL, 0, CTL_ZERO_BYTES, stream);
    Args a{};
    for (int i = 0; i < 23; ++i) a.in[i] = (const float*)d_in[i];
    a.out = (float*)d_out; a.ws = (unsigned char*)d_ws;
    hipLaunchKernelGGL(fwd_kernel, dim3(256), dim3(NWAVES * 64), LDS_BYTES, stream, a);
}
```

```cpp
#include <hip/hip_runtime.h>
#include <cstdio>
#include <cstdint>
#include <type_traits>

#define LAS __attribute__((address_space(3)))
#define GAS __attribute__((address_space(1)))
typedef unsigned short bf16_t;
typedef short bf16x8 __attribute__((ext_vector_type(8)));
typedef short s16x4 __attribute__((ext_vector_type(4)));
typedef float f32x4 __attribute__((ext_vector_type(4)));
typedef float f32x2 __attribute__((ext_vector_type(2)));
typedef float f32x16 __attribute__((ext_vector_type(16)));
typedef unsigned u32x4 __attribute__((ext_vector_type(4)));
typedef int i32x4 __attribute__((ext_vector_type(4)));
typedef unsigned u32x2 __attribute__((ext_vector_type(2)));
typedef __bf16 bf16x2_t __attribute__((ext_vector_type(2)));

constexpr int M = 16384, DM = 2048, SEQ = 2048, NB = 8, NH = 8;
constexpr float EPS = 1e-6f;
constexpr size_t MiB = 1u << 20;
constexpr size_t WS_CTL = 0, CTL_ZERO_BYTES = 1 * MiB;
constexpr size_t WS_WIN = 1 * MiB;
constexpr size_t WS_WPOOL = 10 * MiB;
constexpr size_t WS_SK = 10 * MiB + 512 * 1024;
constexpr size_t WS_WUQ = 11 * MiB;
constexpr size_t WS_WUKV = 13 * MiB;
constexpr size_t WS_WOUT = 15 * MiB;
constexpr size_t WS_WPQ = 23 * MiB;
constexpr size_t WS_WG = 31 * MiB;
constexpr size_t WS_WP = 39 * MiB;
constexpr size_t WS_PB = 40 * MiB;
constexpr size_t WS_COS = 48 * MiB, WS_SIN = 50 * MiB;
constexpr size_t WS_SSQ_CQ = 52 * MiB, WS_SSQ_CKV = 52 * MiB + 512 * 1024, WS_SSQ_H1 = 53 * MiB, WS_RSTD2 = 55 * MiB, WS_RSTDX = 55 * MiB + 512 * 1024;
constexpr size_t WS_EU = 56 * MiB, WS_EV = 88 * MiB;
constexpr size_t WS_SU = 55 * MiB + 128 * 1024, WS_SV = 55 * MiB + 256 * 1024;
constexpr size_t WS_AQ = 346 * MiB, WS_AS = 349 * MiB;
constexpr size_t WS_SSQ2 = 344 * MiB;
constexpr size_t WS_XQ = 184 * MiB;
constexpr size_t WS_SBW = 55 * MiB + 640 * 1024;
constexpr size_t WS_XB = 120 * MiB;
constexpr size_t WS_PART0 = 184 * MiB, WS_PART1 = 424 * MiB;
constexpr size_t WS_R1 = 184 * MiB;
constexpr size_t WS_ZP = 248 * MiB, WS_U = 280 * MiB, WS_H2B = 248 * MiB;
constexpr size_t WS_CQ = 312 * MiB, WS_CKV = 328 * MiB, WS_KRP = 344 * MiB, WS_PIDX = 312 * MiB, WS_PGATE = 320 * MiB;
constexpr size_t WS_Q = 360 * MiB, WS_K = 408 * MiB, WS_V = 456 * MiB;
constexpr size_t WS_END = 488 * MiB;
constexpr int RING_BYTES = 131072, EPI_OFF = RING_BYTES, EPI_BYTES = 8192, LDS_BYTES = 163840, LDSCTL_OFF = LDS_BYTES - 1024, MISC_OFF = LDSCTL_OFF + 320;
constexpr int NWAVES = 8;

__device__ __forceinline__ unsigned cvtpk(float lo, float hi) { f32x2 v = {lo, hi}; bf16x2_t b = __builtin_convertvector(v, bf16x2_t); return __builtin_bit_cast(unsigned, b); }
__device__ __forceinline__ float bf_lo(unsigned w) { return __builtin_bit_cast(float, w << 16); }
__device__ __forceinline__ float bf_hi(unsigned w) { return __builtin_bit_cast(float, w & 0xffff0000u); }
__device__ __forceinline__ float ub0(unsigned w) { return (float)(w & 0xffu); }
__device__ __forceinline__ float ub1(unsigned w) { float r; asm("v_cvt_f32_ubyte1 %0, %1" : "=v"(r) : "v"(w)); return r; }
__device__ __forceinline__ float ub2(unsigned w) { float r; asm("v_cvt_f32_ubyte2 %0, %1" : "=v"(r) : "v"(w)); return r; }
__device__ __forceinline__ float ub3(unsigned w) { float r; asm("v_cvt_f32_ubyte3 %0, %1" : "=v"(r) : "v"(w)); return r; }
__device__ __forceinline__ float dpp_xor1(float x) { return __builtin_bit_cast(float, __builtin_amdgcn_mov_dpp(__builtin_bit_cast(int, x), 0xB1, 0xF, 0xF, true)); }
__device__ __forceinline__ float dpp_xor2(float x) { return __builtin_bit_cast(float, __builtin_amdgcn_mov_dpp(__builtin_bit_cast(int, x), 0x4E, 0xF, 0xF, true)); }
#define DPP_I(x, ctrl) __builtin_amdgcn_mov_dpp((x), (ctrl), 0xF, 0xF, true)
#define DPP_F(x, ctrl) __builtin_bit_cast(float, __builtin_amdgcn_mov_dpp(__builtin_bit_cast(int, (float)(x)), (ctrl), 0xF, 0xF, true))
__device__ __forceinline__ int oct_sum_i(int v) { v += DPP_I(v, 0xB1); v += DPP_I(v, 0x4E); return v + DPP_I(v, 0x141); }
__device__ __forceinline__ float oct_sum(float v) { v += DPP_F(v, 0xB1); v += DPP_F(v, 0x4E); return v + DPP_F(v, 0x141); }
__device__ __forceinline__ float oct_max(float v) { v = fmaxf(v, DPP_F(v, 0xB1)); v = fmaxf(v, DPP_F(v, 0x4E)); return fmaxf(v, DPP_F(v, 0x141)); }
template <int N> __device__ __forceinline__ void bitonic_sort_desc(float (&v)[N]) {
#pragma unroll
    for (int k = 2; k <= N; k <<= 1)
#pragma unroll
        for (int j = k >> 1; j > 0; j >>= 1)
#pragma unroll
            for (int i = 0; i < N; ++i) { const int l = i ^ j; if (l > i) { const bool desc = (i & k) == 0; const float a = v[i], b = v[l]; const float hi = fmaxf(a, b), lo = fminf(a, b); v[i] = desc ? hi : lo; v[l] = desc ? lo : hi; } }
}
#define QUAD_MERGE16(v, CTRL) do { float p_[16]; _Pragma("unroll") for (int i = 0; i < 16; ++i) p_[i] = DPP_F(v[15 - i], CTRL); \
    _Pragma("unroll") for (int i = 0; i < 16; ++i) v[i] = fmaxf(v[i], p_[i]); \
    _Pragma("unroll") for (int j = 8; j > 0; j >>= 1) _Pragma("unroll") for (int i = 0; i < 16; ++i) { const int l = i ^ j; if (l > i) { const float a = v[i], b = v[l]; v[i] = fmaxf(a, b); v[l] = fminf(a, b); } } } while (0)
template <int N> __device__ __forceinline__ float tree_max(const float* v) {
    if constexpr (N == 1) return v[0]; else return fmaxf(tree_max<N / 2>(v), tree_max<N - N / 2>(v + N / 2));
}
__device__ __forceinline__ float quad_max(float m) { m = fmaxf(m, dpp_xor1(m)); return fmaxf(m, dpp_xor2(m)); }
__device__ __forceinline__ float quad_sum(float m) { m += dpp_xor1(m); return m + dpp_xor2(m); }
__device__ __forceinline__ float wave_max(float v) {
#pragma unroll
    for (int o = 1; o < 64; o <<= 1) v = fmaxf(v, __shfl_xor(v, o));
    return v;
}
__device__ __forceinline__ int wave_sum_i(int v) {
#pragma unroll
    for (int o = 1; o < 64; o <<= 1) v += __shfl_xor(v, o);
    return v;
}
__device__ __forceinline__ float wave_sum(float v) {
#pragma unroll
    for (int o = 1; o < 64; o <<= 1) v += __shfl_xor(v, o);
    return v;
}
__device__ __forceinline__ int tid_of(int wave0) { int l; asm volatile("v_mbcnt_lo_u32_b32 %0, -1, 0\n\tv_mbcnt_hi_u32_b32 %0, -1, %0" : "=v"(l)); return wave0 * 64 + l; }
#define EPI_BAR() do { asm volatile("s_waitcnt lgkmcnt(0)" ::: "memory"); __builtin_amdgcn_s_barrier(); asm volatile("" ::: "memory"); } while (0)

namespace pg8 {
constexpr int BM = 256, BK = 64, HALF = 128, HTB = HALF * BK * 2, STAGE_BYTES = 8 * HTB, NXCD = 8, WGM = 1;
__host__ __device__ __forceinline__ int lds_byte(int r, int c) { const int st = (r >> 4) * 2 + (c >> 5), rr = r & 15, cc = c & 31, ob = rr * 64 + cc * 2; return st * 1024 + (ob ^ (((ob >> 9) & 1) << 5)); }
__host__ __device__ __forceinline__ void stage_rc(int b, int& R, int& C) { const int st = b / 1024, sb = b % 1024, swz = sb ^ (((sb >> 9) & 1) << 5); R = (st >> 1) * 16 + swz / 64; C = (st & 1) * 32 + (swz % 64) / 2; }
__host__ __device__ __forceinline__ int perm32(int rho) { const int n = rho >> 4, i = rho & 15; return 8 * (i >> 2) + 4 * n + (i & 3); }

struct Unit { int pm, pn, ka, kb; };
struct Gemm { const bf16_t* A; const bf16_t* Bt; int lda, ldb, K; };

struct StaticOrder {
    int nM, nN, nwg, G, c;
    __device__ void init(int Mr, int N, int G_, int c_) { nM = Mr / BM; nN = N / BM; nwg = nM * nN; G = G_; c = c_; }
    __device__ bool next(int i, Unit& u) const {
        const long L = (long)i * G + c; if (L >= nwg) return false;
        int wgid = (int)L; { const int q = nwg / NXCD, r = nwg % NXCD, xcd = wgid % NXCD, off = wgid / NXCD; wgid = (xcd < r ? xcd * (q + 1) : r * (q + 1) + (xcd - r) * q) + off; }
        const int nig = WGM * nN, gid = wgid / nig, fm = gid * WGM, gsz = (nM - fm) < WGM ? (nM - fm) : WGM;
        u.pm = fm + ((wgid % nig) % gsz); u.pn = (wgid % nig) / gsz; u.ka = 0; u.kb = 0; return true;
    }
};
template <int MODE> struct QuadOrder {
    int v;
    __device__ bool next(int i, Unit& u) const {
        if (i > 0) return false;
        u.pm = v >> 2; const int j = v & 3;
        if (MODE == 0) { u.pn = 8; u.ka = 512 * j; u.kb = 512 * j; } else { u.pn = j; u.ka = 256 * j; u.kb = 0; }
        return true;
    }
};

struct PairOrder {
    int v;
    __device__ bool next(int i, Unit& u) const { if (i > 1) return false; u.pm = 2 * (v >> 3) + i; u.pn = v & 7; u.ka = 0; u.kb = 0; return true; }
};
template <class Epi, class Sched, bool ALIGN_EPI, bool PRE = false, bool I8 = false>
__device__ __forceinline__ void gemm_phase(LAS unsigned char* lds, LAS unsigned char* eps, const Gemm g, const Sched& S, const Epi& E, int wave0) {
    int tid = tid_of(wave0); asm volatile("" : "+v"(tid));
    const int wid = __builtin_amdgcn_readfirstlane(tid >> 6), lane = tid & 63, wr = wid >> 2, wc = wid & 3, fr = lane & 15, fq = lane >> 4;
    constexpr int ES = I8 ? 1 : 2;
    int nt = g.K * ES / (BK * 2); asm volatile("" : "+s"(nt));
    unsigned voffA[2], voffB[2];
#pragma unroll
    for (int i = 0; i < 2; ++i) { int R, C; stage_rc(tid * 16 + i * 8192, R, C); const int Rb = Epi::PERM ? ((R & ~31) + perm32(R & 31)) : R;
        voffA[i] = (unsigned)(R * g.lda * ES + C * 2); voffB[i] = (unsigned)(Rb * g.ldb * ES + C * 2); }
    const size_t kstep = (size_t)(BK * 2);
    const size_t hstepA = (size_t)HALF * g.lda * ES, hstepB = (size_t)HALF * g.ldb * ES;
    const size_t tstepA = 2 * hstepA, tstepB = 2 * hstepB;
    const unsigned ldsw = (unsigned)wid * 1024u;
    const int aoff = lds_byte(wr * 64 + fr, fq * 8), boff = lds_byte(wc * 32 + fr, fq * 8);
#define PG8_SA(b, h) (((b) * 2 + (h)) * HTB)
#define PG8_SB(b, h) ((4 + (b) * 2 + (h)) * HTB)
#define PG8_STAGE(bufoff, gbase, voff) do { _Pragma("unroll") for (int _i = 0; _i < 2; ++_i) \
        __builtin_amdgcn_global_load_lds((const unsigned*)((const char*)(gbase) + (voff)[_i]), (LAS unsigned*)(lds + (bufoff) + ldsw + _i * 8192), 16, 0, 0); } while (0)
#define PG8_LDA(dst, b, h) do { _Pragma("unroll") for (int m = 0; m < 4; ++m) _Pragma("unroll") for (int k = 0; k < 2; ++k) dst[m][k] = *(const LAS bf16x8*)(lds + PG8_SA(b, h) + aoff + m * 2048 + k * 1024); } while (0)
#define PG8_LDB(dst, b, h) do { _Pragma("unroll") for (int n = 0; n < 2; ++n) _Pragma("unroll") for (int k = 0; k < 2; ++k) dst[n][k] = *(const LAS bf16x8*)(lds + PG8_SB(b, h) + boff + n * 2048 + k * 1024); } while (0)
#define PG8_MMA(ai, bj, At, Bt) do { __builtin_amdgcn_s_setprio(1); _Pragma("unroll") for (int m = 0; m < 4; ++m) _Pragma("unroll") for (int n = 0; n < 2; ++n) _Pragma("unroll") for (int k = 0; k < 2; ++k) \
        { if constexpr (I8) acc[ai][bj][m][n] = __builtin_bit_cast(AccT, __builtin_amdgcn_mfma_i32_16x16x64_i8(__builtin_bit_cast(i32x4, Bt[n][k]), __builtin_bit_cast(i32x4, At[m][k]), __builtin_bit_cast(i32x4, acc[ai][bj][m][n]), 0, 0, 0)); \
          else acc[ai][bj][m][n] = __builtin_bit_cast(AccT, __builtin_amdgcn_mfma_f32_16x16x32_bf16(Bt[n][k], At[m][k], __builtin_bit_cast(f32x4, acc[ai][bj][m][n]), 0, 0, 0)); } __builtin_amdgcn_s_setprio(0); } while (0)
#define PG8_WAIT_V(n) asm volatile("s_waitcnt vmcnt(" #n ")" ::: "memory")
#define PG8_WAIT_L(n) asm volatile("s_waitcnt lgkmcnt(" #n ")" ::: "memory")
#define PG8_BAR __builtin_amdgcn_s_barrier()
#define PG8_SCHED __builtin_amdgcn_sched_barrier(0)
    Unit cur, nxt; int ui = 0;
    if (!S.next(0, cur)) return;
    using AccT = typename std::conditional<I8, i32x4, f32x4>::type;
    AccT acc[2][2][4][2];
#pragma unroll
    for (int a = 0; a < 2; ++a)
#pragma unroll
        for (int b = 0; b < 2; ++b)
#pragma unroll
            for (int m = 0; m < 4; ++m)
#pragma unroll
                for (int n = 0; n < 2; ++n) acc[a][b][m][n] = (AccT){0, 0, 0, 0};
    bf16x8 At[4][2], B0[2][2], B1[2][2];
    const char* cA = (const char*)g.A + (size_t)cur.pm * tstepA + (size_t)cur.ka * ES; const char* cB = (const char*)g.Bt + (size_t)cur.pn * tstepB + (size_t)cur.kb * ES;
    PG8_STAGE(PG8_SB(0, 0), cB, voffB); PG8_STAGE(PG8_SB(0, 1), cB + hstepB, voffB); PG8_STAGE(PG8_SA(0, 0), cA, voffA); PG8_STAGE(PG8_SA(0, 1), cA + hstepA, voffA);
    if (wr == 1) PG8_BAR;
    PG8_WAIT_V(2); PG8_BAR;
    PG8_STAGE(PG8_SB(1, 0), cB + kstep, voffB); PG8_STAGE(PG8_SA(1, 0), cA + kstep, voffA); PG8_STAGE(PG8_SB(1, 1), cB + hstepB + kstep, voffB);
    PG8_WAIT_V(6); PG8_BAR;
    unsigned pre2 = 0; unsigned pre = 0;
    for (;;) {
        const bool has_next = S.next(ui + 1, nxt);
        const char* nA = has_next ? (const char*)g.A + (size_t)nxt.pm * tstepA + (size_t)nxt.ka * ES : cA; const char* nB = has_next ? (const char*)g.Bt + (size_t)nxt.pn * tstepB + (size_t)nxt.kb * ES : cB;
#pragma unroll 1
        for (int t = 0; t < nt; t += 2) {
            const bool last = (t == nt - 2);
            if constexpr (PRE) { if (last) { const unsigned* pp = E.pre_ptr(cur, tid); asm volatile("global_load_dword %0, %1, off" : "=v"(pre) : "v"(pp) : "memory");
                                           const unsigned* pq = E.pre_ptr2(cur, tid); asm volatile("global_load_dword %0, %1, off" : "=v"(pre2) : "v"(pq) : "memory"); } }
            const char* a1 = cA + (size_t)(t + 1) * kstep;
            const char* a2 = last ? nA : cA + (size_t)(t + 2) * kstep; const char* b2 = last ? nB : cB + (size_t)(t + 2) * kstep;
            const char* a3 = a2 + kstep; const char* b3 = b2 + kstep;
            PG8_LDB(B0, 0, 0); PG8_LDB(B1, 0, 1); PG8_SCHED; PG8_LDA(At, 0, 0); PG8_STAGE(PG8_SA(1, 1), a1 + hstepA, voffA);
            PG8_WAIT_V(8); PG8_WAIT_L(0); PG8_BAR; PG8_MMA(0, 0, At, B0); PG8_MMA(0, 1, At, B1); PG8_BAR; PG8_SCHED;
            PG8_LDA(At, 0, 1); PG8_STAGE(PG8_SB(0, 0), b2, voffB); PG8_STAGE(PG8_SB(0, 1), b2 + hstepB, voffB); PG8_STAGE(PG8_SA(0, 0), a2, voffA);
            PG8_WAIT_V(8); PG8_WAIT_L(0); PG8_BAR; PG8_MMA(1, 0, At, B0); PG8_MMA(1, 1, At, B1); PG8_BAR; PG8_SCHED;
            PG8_LDB(B0, 1, 0); PG8_LDB(B1, 1, 1); PG8_SCHED; PG8_LDA(At, 1, 0); PG8_STAGE(PG8_SA(0, 1), a2 + hstepA, voffA);
            PG8_WAIT_V(8); PG8_WAIT_L(0); PG8_BAR; PG8_MMA(0, 0, At, B0); PG8_MMA(0, 1, At, B1); PG8_BAR; PG8_SCHED;
            PG8_LDA(At, 1, 1); PG8_STAGE(PG8_SB(1, 0), b3, voffB); PG8_STAGE(PG8_SB(1, 1), b3 + hstepB, voffB); PG8_STAGE(PG8_SA(1, 0), a3, voffA);
            PG8_WAIT_V(8); PG8_WAIT_L(0); PG8_BAR; PG8_MMA(1, 0, At, B0); PG8_MMA(1, 1, At, B1); PG8_BAR; PG8_SCHED;
        }
        if constexpr (ALIGN_EPI) { if (wr == 0) PG8_BAR; }
        if constexpr (PRE) { asm volatile("" : "+v"(pre), "+v"(pre2)); E(acc, cur, wr, wc, fr, fq, eps, tid, pre, pre2); } else E(acc, cur, wr, wc, fr, fq, eps, tid);
        if (!has_next) break;
#pragma unroll
        for (int a = 0; a < 2; ++a)
#pragma unroll
            for (int b = 0; b < 2; ++b)
#pragma unroll
                for (int m = 0; m < 4; ++m)
#pragma unroll
                    for (int n = 0; n < 2; ++n) acc[a][b][m][n] = (AccT){0, 0, 0, 0};
        cur = nxt; cA = nA; cB = nB; ++ui;
        if constexpr (ALIGN_EPI) { if (wr == 1) PG8_BAR; }
    }
    PG8_WAIT_V(0);
    if constexpr (!ALIGN_EPI) { if (wr == 0) PG8_BAR; }
    PG8_BAR;
#undef PG8_SA
#undef PG8_SB
#undef PG8_STAGE
#undef PG8_LDA
#undef PG8_LDB
#undef PG8_MMA
#undef PG8_WAIT_V
#undef PG8_WAIT_L
#undef PG8_BAR
#undef PG8_SCHED
}
}
using pg8::Unit;
typedef const f32x4 (&AccRef)[2][2][4][2];
typedef const i32x4 (&AccRefI)[2][2][4][2];

struct Args { const float* in[23]; float* out; unsigned char* ws; };
static_assert(sizeof(Args) == 25 * 8, "no padding");
typedef const __attribute__((address_space(4))) Args* KArgsP;
__device__ __forceinline__ KArgsP kargs() { KArgsP p = (KArgsP)__builtin_amdgcn_kernarg_segment_ptr(); asm volatile("" : "+s"(p)); return p; }
#define IN_F(i) ((const float*)ka->in[i])
#define WSP(off) (ws + (off))

template <int NR>
__device__ __forceinline__ void quant_rows(const float* eu, const float* ev, unsigned* EU8, unsigned* EV8, float* SU, float* SV, int r0, int lane) {
    f32x4 v[NR][8]; float mx[NR];
#pragma unroll
    for (int a = 0; a < NR; ++a) { const int r = r0 + a; const float* srow = (r >= 16384 ? ev : eu) + (size_t)(r & 16383) * 2048 + 4 * lane; mx[a] = 0.f;
#pragma unroll
        for (int j = 0; j < 8; ++j) v[a][j] = __builtin_nontemporal_load((const f32x4*)(srow + 256 * j)); }
#pragma unroll
    for (int a = 0; a < NR; ++a) {
#pragma unroll
        for (int j = 0; j < 8; ++j) mx[a] = fmaxf(fmaxf(mx[a], fmaxf(fabsf(v[a][j][0]), fabsf(v[a][j][1]))), fmaxf(fabsf(v[a][j][2]), fabsf(v[a][j][3])));
        mx[a] = wave_max(mx[a]); }
#pragma unroll
    for (int a = 0; a < NR; ++a) { const int r = r0 + a, e = r & 16383; const bool isv = r >= 16384;
        const float sc = mx[a] > 0.f ? mx[a] * (1.f / 127.f) : 1.f; const float inv = 1.f / sc;
        unsigned* drow = (isv ? EV8 : EU8) + (size_t)(lane >> 5) * (16384 * 32) + (size_t)e * 32 + (lane & 31);
#pragma unroll
        for (int j = 0; j < 8; ++j) { const int q0 = (int)rintf(v[a][j][0] * inv), q1 = (int)rintf(v[a][j][1] * inv), q2 = (int)rintf(v[a][j][2] * inv), q3 = (int)rintf(v[a][j][3] * inv);
            drow[(size_t)(2 * j) * (16384 * 32)] = (unsigned)(q0 & 0xff) | ((unsigned)(q1 & 0xff) << 8) | ((unsigned)(q2 & 0xff) << 16) | ((unsigned)(q3 & 0xff) << 24); }
        if (lane == 0) (isv ? SV : SU)[e] = sc; }
}

#define ALOAD16(dst, ptr) asm volatile("global_load_dwordx4 %0, %1, off" : "=&v"(dst) : "v"(ptr) : "memory")
#define ALOAD16O(dst, ptr, off) asm volatile("global_load_dwordx4 %0, %1, off offset:%c2" : "=&v"(dst) : "v"(ptr), "i"(off) : "memory")
#define ALOAD16NT(dst, ptr) asm volatile("global_load_dwordx4 %0, %1, off nt" : "=&v"(dst) : "v"(ptr) : "memory")
#define ALOAD16ONT(dst, ptr, off) asm volatile("global_load_dwordx4 %0, %1, off offset:%c2 nt" : "=&v"(dst) : "v"(ptr), "i"(off) : "memory")
#define AWAIT8(a, b, c, d, e, f, g, h) asm volatile("s_waitcnt vmcnt(0)" : "+v"(a), "+v"(b), "+v"(c), "+v"(d), "+v"(e), "+v"(f), "+v"(g), "+v"(h) :: "memory")
#define AWAIT16(a, b, c, d, e, f, g, h, i, j, k, l, m, n, o, p) asm volatile("s_waitcnt vmcnt(0)" : "+v"(a), "+v"(b), "+v"(c), "+v"(d), "+v"(e), "+v"(f), "+v"(g), "+v"(h), "+v"(i), "+v"(j), "+v"(k), "+v"(l), "+v"(m), "+v"(n), "+v"(o), "+v"(p) :: "memory")

__device__ __forceinline__ u32x4 pack8(f32x4 a, f32x4 b) { u32x4 w; w.x = cvtpk(a[0], a[1]); w.y = cvtpk(a[2], a[3]); w.z = cvtpk(b[0], b[1]); w.w = cvtpk(b[2], b[3]); return w; }
__device__ __forceinline__ u32x2 pack4(f32x4 a) { u32x2 w; w.x = cvtpk(a[0], a[1]); w.y = cvtpk(a[2], a[3]); return w; }
__device__ __forceinline__ float sq4(f32x4 a) { return (a[0] * a[0] + a[1] * a[1]) + (a[2] * a[2] + a[3] * a[3]); }

struct EpiA {
    static constexpr bool PERM = true;
    bf16_t* ZP; bf16_t* CQ; bf16_t* CKV; float* ssq_cq; float* ssq_ckv; const float* RSX; const float* SBW;
    __device__ __forceinline__ const unsigned* pre_ptr(const Unit& u, int tid) const { return (const unsigned*)(RSX + u.pm * 256 + (tid & 255)); }
    __device__ __forceinline__ const unsigned* pre_ptr2(const Unit& u, int tid) const { return (const unsigned*)(SBW + u.pn * 256 + (tid & 255)); }
    __device__ __forceinline__ void operator()(AccRefI acc, const Unit& u, int wr, int wc, int fr, int fq, LAS unsigned char* eps, int tid, unsigned pre, unsigned pre2) const {
        LAS float* R = (LAS float*)(eps + 4096); LAS float* CS = (LAS float*)(eps + 5120);
        if (tid < 256) { R[tid] = __builtin_bit_cast(float, pre); CS[tid] = __builtin_bit_cast(float, pre2); }
        EPI_BAR();
        bf16_t* base; int ldc, colt; float* ssq = nullptr;
        if (u.pn < 4) { base = ZP; ldc = 1024; colt = u.pn * 256; }
        else if (u.pn < 6) { base = CQ; ldc = 512; colt = (u.pn - 4) * 256; ssq = ssq_cq + (u.pn - 4) * 4 + wc; }
        else { base = CKV; ldc = 512; colt = (u.pn - 6) * 256; ssq = ssq_ckv + (u.pn - 6) * 4 + wc; }
        const int row0 = u.pm * 256 + wr * 64 + fr, col0 = colt + wc * 32 + 8 * fq;
        f32x4 cs[2][2];
#pragma unroll
        for (int bj = 0; bj < 2; ++bj)
#pragma unroll
            for (int n = 0; n < 2; ++n) cs[bj][n] = *(const LAS f32x4*)(CS + bj * 128 + wc * 32 + 8 * fq + 4 * n);
#pragma unroll
        for (int ai = 0; ai < 2; ++ai)
#pragma unroll
            for (int m = 0; m < 4; ++m) { const int row = row0 + ai * 128 + m * 16; bf16_t* rowp = base + (size_t)row * ldc + col0; float s = 0.f; const float rs = R[ai * 128 + wr * 64 + m * 16 + fr];
#pragma unroll
                for (int bj = 0; bj < 2; ++bj) { const f32x4 v0 = __builtin_convertvector(acc[ai][bj][m][0], f32x4) * cs[bj][0] * rs, v1 = __builtin_convertvector(acc[ai][bj][m][1], f32x4) * cs[bj][1] * rs;
                    *(u32x4*)(rowp + bj * 128) = pack8(v0, v1); s += sq4(v0) + sq4(v1); }
                if (ssq) { s += __shfl_xor(s, 16); s += __shfl_xor(s, 32); if (fq == 0) ssq[(size_t)row * 8] = s; } }
        EPI_BAR();
    }
};
struct EpiKR {
    static constexpr bool PERM = false;
    float* KRP; const float* RSX; const float* SBW;
    __device__ __forceinline__ const unsigned* pre_ptr(const Unit& u, int tid) const { return (const unsigned*)(RSX + u.pm * 256 + (tid & 255)); }
    __device__ __forceinline__ const unsigned* pre_ptr2(const Unit& u, int tid) const { return (const unsigned*)(SBW + u.pn * 256 + (tid & 255)); }
    __device__ __forceinline__ void operator()(AccRefI acc, const Unit& u, int wr, int wc, int fr, int fq, LAS unsigned char* eps, int tid, unsigned pre, unsigned pre2) const {
        LAS float* R = (LAS float*)(eps + 4096); LAS float* CS = (LAS float*)(eps + 5120);
        if (tid < 256) { R[tid] = __builtin_bit_cast(float, pre); CS[tid] = __builtin_bit_cast(float, pre2); }
        EPI_BAR();
        if (wc < 2) { const int ks = u.ka >> 9; const int row0 = u.pm * 256 + wr * 64 + fr;
#pragma unroll
            for (int ai = 0; ai < 2; ++ai)
#pragma unroll
                for (int m = 0; m < 4; ++m) { const int row = row0 + ai * 128 + m * 16; const float rs = R[ai * 128 + wr * 64 + m * 16 + fr];
#pragma unroll
                    for (int n = 0; n < 2; ++n) *(f32x4*)(KRP + ((size_t)ks * M + row) * 64 + 32 * wc + 16 * n + 4 * fq) = __builtin_convertvector(acc[ai][0][m][n], f32x4) * *(const LAS f32x4*)(CS + 32 * wc + 16 * n + 4 * fq) * rs; } }
        { const int uid = u.pm * 4 + (u.ka >> 9); KArgsP ka = kargs(); unsigned char* ws = ka->ws; const float* p_in = IN_F(1); const float* sk1 = IN_F(16); const float* sk2 = IN_F(17);
          bf16_t* PB = (bf16_t*)WSP(WS_PB); bf16_t* SKB = (bf16_t*)WSP(WS_SK);
          for (int i = tid; i < 2176; i += 512) { long j = (long)uid * 2176 + i; const float* src; bf16_t* dst;
              if (j < 524288) { src = p_in; dst = PB; } else if ((j -= 524288) < 16384) { src = sk1; dst = SKB; } else { j -= 16384; src = sk2; dst = SKB + 131072; }
              const f32x4 a = *(const f32x4*)(src + j * 8), b = *(const f32x4*)(src + j * 8 + 4); *(u32x4*)(dst + j * 8) = pack8(a, b); } }
        EPI_BAR();
    }
};
struct EpiStore {
    static constexpr bool PERM = true;
    bf16_t* O; int ldc;
    __device__ __forceinline__ void operator()(AccRef acc, const Unit& u, int wr, int wc, int fr, int fq, LAS unsigned char*, int) const {
        const int row0 = u.pm * 256 + wr * 64 + fr, col0 = u.pn * 256 + wc * 32 + 8 * fq;
#pragma unroll
        for (int ai = 0; ai < 2; ++ai)
#pragma unroll
            for (int m = 0; m < 4; ++m) { bf16_t* rowp = O + (size_t)(row0 + ai * 128 + m * 16) * ldc + col0;
#pragma unroll
                for (int bj = 0; bj < 2; ++bj) *(u32x4*)(rowp + bj * 128) = pack8(acc[ai][bj][m][0], acc[ai][bj][m][1]); }
    }
};
struct EpiQ {
    static constexpr bool PERM = false;
    bf16_t* Q; const float* ssq_cq; const float* qg; const float* COS; const float* SIN;
    __device__ __forceinline__ void operator()(AccRef acc, const Unit& u, int wr, int wc, int fr, int fq, LAS unsigned char* eps, int tid) const {
        LAS float* P = (LAS float*)eps; LAS float* R = (LAS float*)(eps + 4096);
        const int h = u.pn, rowt = u.pm * 256;
        { const f32x4 a = *(const f32x4*)(ssq_cq + (size_t)(rowt + (tid >> 1)) * 8 + 4 * (tid & 1)); float s = (a[0] + a[1]) + (a[2] + a[3]); s += DPP_F(s, 0xB1);
          if ((tid & 1) == 0) R[tid >> 1] = rsqrtf(s * (1.f / 512.f) + EPS); }
#pragma unroll
        for (int ai = 0; ai < 2; ++ai)
#pragma unroll
            for (int m = 0; m < 4; ++m) { const int r = ai * 128 + wr * 64 + m * 16 + fr; float s = 0.f;
#pragma unroll
                for (int bj = 0; bj < 2; ++bj)
#pragma unroll
                    for (int n = 0; n < 2; ++n) s += sq4(acc[ai][bj][m][n]);
                s += __shfl_xor(s, 16); s += __shfl_xor(s, 32); if (fq == 0) P[r * 4 + wc] = s; }
        EPI_BAR();
        const int dn = 32 * wc + 4 * fq, j = 16 * wc + 4 * fq;
        const f32x4 g0 = *(const f32x4*)(qg + dn), g1 = *(const f32x4*)(qg + dn + 16);
        f32x4 gr1 = {0.f, 0.f, 0.f, 0.f}, gr2 = gr1; if (wc < 2) { gr1 = *(const f32x4*)(qg + 128 + j); gr2 = *(const f32x4*)(qg + 160 + j); }
#pragma unroll
        for (int ai = 0; ai < 2; ++ai)
#pragma unroll
            for (int m = 0; m < 4; ++m) { const int r = ai * 128 + wr * 64 + m * 16 + fr; const float rc = R[r]; const f32x4 pp = *(LAS f32x4*)(P + r * 4);
                const float ss = ((pp[0] + pp[1]) + (pp[2] + pp[3])) * rc * rc; const float sc = rc * rsqrtf(ss * (1.f / 192.f) + EPS);
                const size_t grow = (size_t)(rowt + r); bf16_t* qrow = Q + grow * 1536 + h * 192;
                *(u32x2*)(qrow + dn) = pack4(acc[ai][0][m][0] * sc * g0); *(u32x2*)(qrow + dn + 16) = pack4(acc[ai][0][m][1] * sc * g1);
                if (wc < 2) { const f32x4 x1 = acc[ai][1][m][0] * sc * gr1, x2 = acc[ai][1][m][1] * sc * gr2;
                    const f32x4 c4 = *(const f32x4*)(COS + grow * 32 + j), s4 = *(const f32x4*)(SIN + grow * 32 + j);
                    *(u32x2*)(qrow + 128 + j) = pack4(x1 * c4 - x2 * s4); *(u32x2*)(qrow + 160 + j) = pack4(x2 * c4 + x1 * s4); } }
    }
};
struct EpiKV {
    static constexpr bool PERM = false;
    bf16_t* K; bf16_t* V; const float* ssq_ckv; const float* KRP; const float* kg; const float* COS; const float* SIN;
    __device__ __forceinline__ void operator()(AccRef acc, const Unit& u, int wr, int wc, int fr, int fq, LAS unsigned char* eps, int tid) const {
        LAS float* P = (LAS float*)eps; LAS float* R = (LAS float*)(eps + 4096); LAS float* R2 = (LAS float*)(eps + 5120);
        const int h = u.pn, rowt = u.pm * 256;
        { const f32x4 a = *(const f32x4*)(ssq_ckv + (size_t)(rowt + (tid >> 1)) * 8 + 4 * (tid & 1)); float s = (a[0] + a[1]) + (a[2] + a[3]); s += DPP_F(s, 0xB1);
          if ((tid & 1) == 0) R[tid >> 1] = rsqrtf(s * (1.f / 512.f) + EPS); }
        int tq = tid; asm volatile("" : "+v"(tq));
        const int rc = tq & 15, rb = tq >> 4;
#pragma unroll
        for (int kb = 0; kb < 8; kb += 2) { f32x4 pv[2][4];
#pragma unroll
            for (int k = 0; k < 2; ++k) { const float* p = KRP + (size_t)(rowt + rb + 32 * (kb + k)) * 64 + 4 * rc;
#pragma unroll
                for (int q = 0; q < 4; ++q) { const float* pq = p + (size_t)q * M * 64; ALOAD16(pv[k][q], pq); } }
            AWAIT8(pv[0][0], pv[0][1], pv[0][2], pv[0][3], pv[1][0], pv[1][1], pv[1][2], pv[1][3]);
#pragma unroll
            for (int k = 0; k < 2; ++k) { const f32x4 t = (pv[k][0] + pv[k][1]) + (pv[k][2] + pv[k][3]); float s = sq4(t);
                s += DPP_F(s, 0xB1); s += DPP_F(s, 0x4E); s += DPP_F(s, 0x141); s += DPP_F(s, 0x128);
                if (rc == 0) R2[rb + 32 * (kb + k)] = s; } }
#pragma unroll
        for (int ai = 0; ai < 2; ++ai)
#pragma unroll
            for (int m = 0; m < 4; ++m) { const int r = ai * 128 + wr * 64 + m * 16 + fr; float s = sq4(acc[ai][0][m][0]) + sq4(acc[ai][0][m][1]);
                s += __shfl_xor(s, 16); s += __shfl_xor(s, 32); if (fq == 0) P[r * 4 + wc] = s; }
        EPI_BAR();
        const int dn = 32 * wc + 4 * fq;
        const f32x4 g0 = *(const f32x4*)(kg + dn), g1 = *(const f32x4*)(kg + dn + 16);
#pragma unroll
        for (int ai = 0; ai < 2; ++ai)
#pragma unroll
            for (int m = 0; m < 4; ++m) { const int r = ai * 128 + wr * 64 + m * 16 + fr; const float rc = R[r]; const f32x4 pp = *(LAS f32x4*)(P + r * 4);
                const float ssn = ((pp[0] + pp[1]) + (pp[2] + pp[3])) * rc * rc; const float sk = rc * rsqrtf((ssn + R2[r]) * (1.f / 192.f) + EPS);
                const size_t grow = (size_t)(rowt + r);
                bf16_t* vrow = V + grow * 1024 + h * 128 + dn; *(u32x2*)vrow = pack4(acc[ai][1][m][0] * rc); *(u32x2*)(vrow + 16) = pack4(acc[ai][1][m][1] * rc);
                bf16_t* krow = K + grow * 1536 + h * 192 + dn; *(u32x2*)krow = pack4(acc[ai][0][m][0] * sk * g0); *(u32x2*)(krow + 16) = pack4(acc[ai][0][m][1] * sk * g1); }
        { const int jj = 4 * (rc & 7); const bool hi8 = rc >= 8;
          const f32x4 ga = *(const f32x4*)(kg + 128 + jj), gb = *(const f32x4*)(kg + 160 + jj);
#pragma unroll
          for (int k = 0; k < 8; ++k) { f32x4 pv[4], c4, s4;
            const int row = rb + 32 * k; const size_t grw = (size_t)(rowt + row); const float* p = KRP + grw * 64 + 4 * rc;
#pragma unroll
            for (int q = 0; q < 4; ++q) { const float* pq = p + (size_t)q * M * 64; ALOAD16(pv[q], pq); }
            { const float* pc = COS + grw * 32 + jj; const float* ps = SIN + grw * 32 + jj; ALOAD16(c4, pc); ALOAD16(s4, ps); }
            asm volatile("s_waitcnt vmcnt(0)" : "+v"(pv[0]), "+v"(pv[1]), "+v"(pv[2]), "+v"(pv[3]), "+v"(c4), "+v"(s4) :: "memory");
            const f32x4 mine = (pv[0] + pv[1]) + (pv[2] + pv[3]); f32x4 oth; oth[0] = DPP_F(mine[0], 0x128); oth[1] = DPP_F(mine[1], 0x128); oth[2] = DPP_F(mine[2], 0x128); oth[3] = DPP_F(mine[3], 0x128);
            const float rc_ = R[row]; const f32x4 pp = *(LAS f32x4*)(P + row * 4); const float ssn = ((pp[0] + pp[1]) + (pp[2] + pp[3])) * rc_ * rc_;
            const float rk = rsqrtf((ssn + R2[row]) * (1.f / 192.f) + EPS);
            const f32x4 x1 = (hi8 ? oth : mine) * ga, x2 = (hi8 ? mine : oth) * gb;
            const f32x4 o = (hi8 ? (x2 * c4 + x1 * s4) : (x1 * c4 - x2 * s4)) * rk;
            *(u32x2*)(K + grw * 1536 + h * 192 + 128 + 4 * rc) = pack4(o); } }
    }
};
struct EpiH1 {
    static constexpr bool PERM = true;
    const float* X; bf16_t* H1B; float* SSQ;
    __device__ __forceinline__ void operator()(AccRef acc, const Unit& u, int wr, int wc, int fr, int fq, LAS unsigned char*, int) const {
        const int row0 = u.pm * 256 + wr * 64 + fr, col0 = u.pn * 256 + wc * 32 + 8 * fq;
#pragma unroll
        for (int ai = 0; ai < 2; ++ai) {
            f32x4 xa[4][2], xb[4][2];
#pragma unroll
            for (int m = 0; m < 4; ++m)
#pragma unroll
                for (int bj = 0; bj < 2; ++bj) { const float* p = X + (size_t)(row0 + ai * 128 + m * 16) * DM + col0 + bj * 128; ALOAD16NT(xa[m][bj], p); ALOAD16ONT(xb[m][bj], p, 16); }
            AWAIT16(xa[0][0], xa[0][1], xa[1][0], xa[1][1], xa[2][0], xa[2][1], xa[3][0], xa[3][1], xb[0][0], xb[0][1], xb[1][0], xb[1][1], xb[2][0], xb[2][1], xb[3][0], xb[3][1]);
#pragma unroll
            for (int m = 0; m < 4; ++m) { const size_t off = (size_t)(row0 + ai * 128 + m * 16) * DM + col0; float s = 0.f;
#pragma unroll
                for (int bj = 0; bj < 2; ++bj) { const f32x4 h0 = xa[m][bj] + acc[ai][bj][m][0], h1 = xb[m][bj] + acc[ai][bj][m][1];
                    *(u32x4*)(H1B + off + bj * 128) = pack8(h0, h1); s += sq4(h0) + sq4(h1); }
                s += __shfl_xor(s, 16); s += __shfl_xor(s, 32); if (fq == 0) SSQ[(size_t)(row0 + ai * 128 + m * 16) * 32 + u.pn * 4 + wc] = s; }
        }
    }
};
struct EpiQP {
    static constexpr bool PERM = true;
    bf16_t* QP; const float* SSQ; float* RSTD2;
    __device__ __forceinline__ void operator()(AccRef acc, const Unit& u, int wr, int wc, int fr, int fq, LAS unsigned char* eps, int tid) const {
        LAS float* R = (LAS float*)(eps + 4096);
#pragma unroll
        for (int k = 0; k < 4; ++k) { const int row = (tid >> 3) + 64 * k; const f32x4 a = *(const f32x4*)(SSQ + (size_t)(u.pm * 256 + row) * 32 + 4 * (tid & 7));
            const float s = oct_sum((a[0] + a[1]) + (a[2] + a[3])); const float rs = rsqrtf(s * (1.f / 2048.f) + EPS);
            if ((tid & 7) == 0) { R[row] = rs; if (u.pn == 0) RSTD2[u.pm * 256 + row] = rs; } }
        EPI_BAR();
        const int col0 = u.pn * 256 + wc * 32 + 8 * fq;
#pragma unroll
        for (int ai = 0; ai < 2; ++ai)
#pragma unroll
            for (int m = 0; m < 4; ++m) { const int r = ai * 128 + wr * 64 + m * 16 + fr; const float rs = R[r]; bf16_t* rowp = QP + (size_t)(u.pm * 256 + r) * DM + col0;
#pragma unroll
                for (int bj = 0; bj < 2; ++bj) *(u32x4*)(rowp + bj * 128) = pack8(acc[ai][bj][m][0] * rs, acc[ai][bj][m][1] * rs); }
        EPI_BAR();
    }
};
struct EpiGate {
    static constexpr bool PERM = true;
    float* OUT; const bf16_t* PROJ; const float* SSQ2; const bf16_t* H2B;
    __device__ __forceinline__ void operator()(AccRef acc, const Unit& u, int wr, int wc, int fr, int fq, LAS unsigned char* eps, int tid) const {
        LAS float* R = (LAS float*)(eps + 4096);
#pragma unroll
        for (int k = 0; k < 2; ++k) { const int row = (tid >> 2) + 128 * k; const f32x4 a = *(const f32x4*)(SSQ2 + (size_t)(u.pm * 256 + row) * 16 + 4 * (tid & 3));
            const float s = quad_sum((a[0] + a[1]) + (a[2] + a[3])); if ((tid & 3) == 0) R[row] = rsqrtf(s * (1.f / 2048.f) + EPS); }
        EPI_BAR();
        const int row0 = u.pm * 256 + wr * 64 + fr, col0 = u.pn * 256 + wc * 32 + 8 * fq;
#pragma unroll
        for (int ai = 0; ai < 2; ++ai) {
            u32x4 pj[4][2], hv[4][2];
#pragma unroll
            for (int m = 0; m < 4; ++m)
#pragma unroll
                for (int bj = 0; bj < 2; ++bj) { const size_t off = (size_t)(row0 + ai * 128 + m * 16) * DM + col0 + bj * 128; const bf16_t* pp = PROJ + off; const bf16_t* ph = H2B + off; ALOAD16(pj[m][bj], pp); ALOAD16(hv[m][bj], ph); }
            AWAIT16(pj[0][0], pj[0][1], pj[1][0], pj[1][1], pj[2][0], pj[2][1], pj[3][0], pj[3][1], hv[0][0], hv[0][1], hv[1][0], hv[1][1], hv[2][0], hv[2][1], hv[3][0], hv[3][1]);
#pragma unroll
            for (int m = 0; m < 4; ++m) { const int row = row0 + ai * 128 + m * 16; const float rs = R[ai * 128 + wr * 64 + m * 16 + fr]; const size_t off = (size_t)row * DM + col0;
#pragma unroll
                for (int bj = 0; bj < 2; ++bj) { const u32x4 pw = pj[m][bj], hw = hv[m][bj];
                    const f32x4 p0 = {bf_lo(pw.x), bf_hi(pw.x), bf_lo(pw.y), bf_hi(pw.y)}, p1 = {bf_lo(pw.z), bf_hi(pw.z), bf_lo(pw.w), bf_hi(pw.w)};
                    f32x4 g0, g1;
#pragma unroll
                    for (int e = 0; e < 4; ++e) { g0[e] = __builtin_amdgcn_rcpf(1.f + __builtin_amdgcn_exp2f(-1.4426950408889634f * rs * acc[ai][bj][m][0][e]));
                                                  g1[e] = __builtin_amdgcn_rcpf(1.f + __builtin_amdgcn_exp2f(-1.4426950408889634f * rs * acc[ai][bj][m][1][e])); }
                    float* o = OUT + off + bj * 128;
                    const f32x4 h0 = {bf_lo(hw.x), bf_hi(hw.x), bf_lo(hw.y), bf_hi(hw.y)}, h1 = {bf_lo(hw.z), bf_hi(hw.z), bf_lo(hw.w), bf_hi(hw.w)};
                    *(f32x4*)o = h0 + g0 * p0; *(f32x4*)(o + 4) = h1 + g1 * p1; } }
        }
        EPI_BAR();
    }
};

typedef GAS unsigned gu32;
#define RLX_AGENT __ATOMIC_RELAXED, __HIP_MEMORY_SCOPE_AGENT
#define XB_TMO      128
#define XB_XCNT(j)  (256  + 64 * (j))
#define XB_XSUB(j)  (1280 + 64 * (j))
#define XB_XGEN(j)  (2304 + 64 * (j))
#define XB_TOP      3328
#define XB_TOPGEN   3392
#define XCD_BAR_WORDS 3456
#define XB_SPIN_CAP (1u << 20)
__device__ __forceinline__ unsigned xb_ld(unsigned* p)              { return __hip_atomic_load(p, __ATOMIC_RELAXED, __HIP_MEMORY_SCOPE_AGENT); }
__device__ __forceinline__ unsigned xb_add(unsigned* p, unsigned v) { return __hip_atomic_fetch_add(p, v, __ATOMIC_RELAXED, __HIP_MEMORY_SCOPE_AGENT); }
__device__ __forceinline__ unsigned xb_xcc_id() { return (unsigned)__builtin_amdgcn_s_getreg((3 << 11) | 20) & 0xFu; }
#define XB_SPIN(cond, bar) do { unsigned _sp = 0; while (cond) { __builtin_amdgcn_s_sleep(1); \
    if ((++_sp & 255u) == 0u) { if (xb_ld(&(bar)[XB_TMO])) break; if (_sp > XB_SPIN_CAP) { atomicAdd(&(bar)[XB_TMO], 1u); break; } } } } while (0)
struct XcdBarrier { unsigned* bar; unsigned x; volatile LAS unsigned* st; int w0; };
__device__ __forceinline__ XcdBarrier xcd_barrier_post(unsigned* bar, volatile LAS unsigned* st, int w0) {
    XcdBarrier b; b.bar = bar; b.x = xb_xcc_id(); b.st = st; b.w0 = w0;
    if (tid_of(w0) == 0) (void)xb_add(&bar[XB_XCNT(b.x)], 1u);
    return b;
}
__device__ __forceinline__ void xcd_barrier_complete(unsigned* bar, unsigned x, unsigned& nloc, unsigned& nx) {
    const unsigned G = gridDim.x * gridDim.y * gridDim.z;
    unsigned sum, cnt, mine, sp = 0u;
    for (;;) {
        sum = 0u; cnt = 0u; mine = 0u;
#pragma unroll
        for (unsigned j = 0; j < 16; ++j) { const unsigned c = xb_ld(&bar[XB_XCNT(j)]); sum += c; cnt += (c > 0u) ? 1u : 0u; mine = (j == x) ? c : mine; }
        if (sum == G) break;
        __builtin_amdgcn_s_sleep(1);
        if ((++sp & 255u) == 0u) { if (xb_ld(&bar[XB_TMO])) break; if (sp > XB_SPIN_CAP) { atomicAdd(&bar[XB_TMO], 1u); break; } }
    }
    nloc = mine > 0u ? mine : 1u; nx = cnt > 0u ? cnt : 1u;
}
__device__ __forceinline__ void xcd_barrier(const XcdBarrier& b) {
    asm volatile("s_waitcnt vmcnt(0)" ::: "memory");
    __syncthreads();
    if (tid_of(b.w0) == 0) {
        unsigned* bar = b.bar;
        __builtin_amdgcn_s_waitcnt(0);
        unsigned nloc = b.st[0], nx = b.st[1];
        if (nloc == 0u) { xcd_barrier_complete(bar, b.x, nloc, nx); b.st[0] = nloc; b.st[1] = nx; }
        const unsigned old = xb_add(&bar[XB_XSUB(b.x)], 1u);
        const unsigned gen = old / nloc;
        if (old + 1u == (gen + 1u) * nloc) {
            __builtin_amdgcn_fence(__ATOMIC_RELEASE, "agent");
            asm volatile("s_waitcnt vmcnt(0)" ::: "memory");
            const unsigned og = xb_add(&bar[XB_TOP], 1u);
            const unsigned tg = og / nx;
            if (og + 1u == (tg + 1u) * nx) xb_add(&bar[XB_TOPGEN], 1u);
            else XB_SPIN(xb_ld(&bar[XB_TOPGEN]) == tg, bar);
            __builtin_amdgcn_fence(__ATOMIC_ACQUIRE, "agent");
            xb_add(&bar[XB_XGEN(b.x)], 1u);
            asm volatile("s_waitcnt vmcnt(0)" ::: "memory");
        } else {
            XB_SPIN(xb_ld(&bar[XB_XGEN(b.x)]) == gen, bar);
            __builtin_amdgcn_fence(__ATOMIC_ACQUIRE, "agent");
            asm volatile("s_waitcnt vmcnt(0)" ::: "memory");
        }
    }
    __syncthreads();
}

__device__ __forceinline__ int uq_row(int n) {
    const int h = n / 192, d = n - h * 192; int slot;
    if (d < 128) slot = d; else { const int j = d - 128; if (j < 32) slot = 128 + 32 * (j >> 4) + (j & 15); else { const int jj = j - 32; slot = 128 + 32 * (jj >> 4) + 16 + (jj & 15); } }
    return h * 256 + slot;
}
template <int MAP>
__device__ __forceinline__ void tr_item(const float* W, int ldw, int col_off, const float* gk, const float* gn, bf16_t* WT, int ldt, int row_off, int nblk, LAS float* scr, int item, int lane) {
    const int kb = item / nblk, nb = item - kb * nblk, k0 = 64 * kb, n0 = 32 * nb;
#pragma unroll
    for (int i = 0; i < 32; ++i) { const int kk = 2 * i + (lane >> 5); float v = W[(size_t)(k0 + kk) * ldw + col_off + n0 + (lane & 31)]; if (gk) v *= gk[k0 + kk]; scr[kk * 33 + (lane & 31)] = v; }
    asm volatile("s_waitcnt lgkmcnt(0)" ::: "memory");
    const int c = lane & 7;
#pragma unroll
    for (int j = 0; j < 4; ++j) { const int n = (lane >> 3) + 8 * j; const LAS float* s = scr + (8 * c) * 33 + n; const float g = gn ? gn[n0 + n] : 1.f;
        u32x4 o; o.x = cvtpk(s[0 * 33] * g, s[1 * 33] * g); o.y = cvtpk(s[2 * 33] * g, s[3 * 33] * g); o.z = cvtpk(s[4 * 33] * g, s[5 * 33] * g); o.w = cvtpk(s[6 * 33] * g, s[7 * 33] * g);
        const int drow = (MAP == 1) ? uq_row(n0 + n) : (row_off + n0 + n);
        *(u32x4*)(WT + (size_t)drow * ldt + k0 + 8 * c) = o; }
    asm volatile("s_waitcnt lgkmcnt(0)" ::: "memory");
}

struct TrP { const float* W; const float* gk; const float* gn; bf16_t* WT; int ldw, ldt, nblk, item, map; };
__device__ __forceinline__ void tr_load(const TrP& p, float (&v)[32], int lane) {
    const int kb = p.item / p.nblk, nb = p.item - kb * p.nblk, k0 = 64 * kb, n0 = 32 * nb;
#pragma unroll
    for (int i = 0; i < 32; ++i) { const int kk = 2 * i + (lane >> 5); v[i] = p.W[(size_t)(k0 + kk) * p.ldw + n0 + (lane & 31)]; }
    if (p.gk) {
#pragma unroll
        for (int i = 0; i < 32; ++i) v[i] *= p.gk[k0 + 2 * i + (lane >> 5)]; }
}
__device__ __forceinline__ void tr_store(const TrP& p, const float (&v)[32], LAS float* scr, int lane) {
    const int kb = p.item / p.nblk, nb = p.item - kb * p.nblk, k0 = 64 * kb, n0 = 32 * nb;
#pragma unroll
    for (int i = 0; i < 32; ++i) scr[(2 * i + (lane >> 5)) * 33 + (lane & 31)] = v[i];
    asm volatile("s_waitcnt lgkmcnt(0)" ::: "memory");
    const int c = lane & 7;
#pragma unroll
    for (int j = 0; j < 4; ++j) { const int n = (lane >> 3) + 8 * j; const LAS float* s = scr + (8 * c) * 33 + n; const float g = p.gn ? p.gn[n0 + n] : 1.f;
        u32x4 o; o.x = cvtpk(s[0 * 33] * g, s[1 * 33] * g); o.y = cvtpk(s[2 * 33] * g, s[3 * 33] * g); o.z = cvtpk(s[4 * 33] * g, s[5 * 33] * g); o.w = cvtpk(s[6 * 33] * g, s[7 * 33] * g);
        const int drow = p.map ? uq_row(n0 + n) : (n0 + n);
        *(u32x4*)(p.WT + (size_t)drow * p.ldt + k0 + 8 * c) = o; }
    asm volatile("s_waitcnt lgkmcnt(0)" ::: "memory");
}

__device__ __forceinline__ void tr_strip(const float* W, int ldw, const float* gk, bf16_t* WT, int n0, LAS unsigned char* lds, int wave, int lane) {
    const int c4 = lane & 7, kr = lane >> 3;
    const float* wp = W + (size_t)(256 * wave + 4 * kr) * ldw + n0 + 4 * c4; const float* gp = gk + 256 * wave + 4 * kr;
    LAS unsigned char* tb = lds + wave * 16384;
#pragma unroll 4
    for (int i = 0; i < 8; ++i) { f32x4 v[4]; f32x4 g4 = {1.f, 1.f, 1.f, 1.f}; if (gk) g4 = *(const f32x4*)(gp + 32 * i);
#pragma unroll
        for (int j = 0; j < 4; ++j) v[j] = __builtin_nontemporal_load((const f32x4*)(wp + (size_t)(32 * i + j) * ldw));
#pragma unroll
        for (int e = 0; e < 4; ++e) { const int n = 4 * c4 + e; u32x2 w2; w2.x = cvtpk(v[0][e] * g4[0], v[1][e] * g4[1]); w2.y = cvtpk(v[2][e] * g4[2], v[3][e] * g4[3]);
            const int ch = (4 * i + (kr >> 1)) ^ n;
            *(LAS u32x2*)(tb + n * 512 + (ch << 4) + ((kr & 1) << 3)) = w2; } }
    asm volatile("s_waitcnt lgkmcnt(0)" ::: "memory");
#pragma unroll 4
    for (int r = 0; r < 16; ++r) { const int id = lane + 64 * r, n = id >> 5, ch = id & 31;
        *(u32x4*)(WT + (size_t)(n0 + n) * 2048 + 256 * wave + 8 * ch) = *(const LAS u32x4*)(tb + n * 512 + ((ch ^ n) << 4)); }
    asm volatile("s_waitcnt lgkmcnt(0)" ::: "memory");
}

namespace att {
constexpr int DQ = 192, DV = 128, KVBLK = 64, QBLK = 32;
constexpr int LDQ = 1536, LDV = 1024, LDO = 2048;
constexpr int SHM_V = KVBLK * DV * 2, SHM_K = KVBLK * DQ * 2;
constexpr float SCALE = 0.07216878364870322f;
constexpr float THR = 8.f;
#define KSWZ(row, colB) ((row) * 384 + ((colB) ^ ((((row) >> 1) & 7) << 4)))
#define SBAR() __builtin_amdgcn_sched_barrier(0)
__device__ __forceinline__ int crow(int r, int hi) { return (r & 3) + 8 * (r >> 2) + 4 * hi; }
__device__ __forceinline__ void partialSM(f32x16& p0, f32x16& p1, float& m_reg, float& alpha) {
    constexpr float C = SCALE * 1.4426950408889634f;
    float pmax = p0[0];
#pragma unroll
    for (int r = 1; r < 16; ++r) pmax = fmaxf(pmax, p0[r]);
#pragma unroll
    for (int r = 0; r < 16; ++r) pmax = fmaxf(pmax, p1[r]);
    { auto rr = __builtin_amdgcn_permlane32_swap(__float_as_uint(pmax), __float_as_uint(pmax), false, false);
      pmax = fmaxf(__uint_as_float(rr[0]), __uint_as_float(rr[1])); }
    float mn;
    if (__builtin_expect(__all(pmax - m_reg <= THR / SCALE), 1)) { mn = m_reg; alpha = 1.f; }
    else { mn = fmaxf(m_reg, pmax); alpha = __builtin_amdgcn_exp2f((m_reg - mn) * C); m_reg = mn; }
    const float mnC = -mn * C;
#pragma unroll
    for (int r = 0; r < 16; ++r) { p0[r] = __builtin_amdgcn_exp2f(fmaf(p0[r], C, mnC)); p1[r] = __builtin_amdgcn_exp2f(fmaf(p1[r], C, mnC)); }
}
__device__ __forceinline__ void finishSM(const f32x16& p0, const f32x16& p1, float alpha, float& l_reg, bf16x8& pa0, bf16x8& pa1, bf16x8& pa2, bf16x8& pa3) {
    float ps = 0.f;
#pragma unroll
    for (int r = 0; r < 16; ++r) ps += p0[r];
#pragma unroll
    for (int r = 0; r < 16; ++r) ps += p1[r];
    { auto rr = __builtin_amdgcn_permlane32_swap(__float_as_uint(ps), __float_as_uint(ps), false, false);
      ps = __uint_as_float(rr[0]) + __uint_as_float(rr[1]); }
    l_reg = l_reg * alpha + ps;
#define PK4(P, BASE, OUT) do { unsigned a0 = cvtpk(P[BASE + 0], P[BASE + 1]), a1 = cvtpk(P[BASE + 2], P[BASE + 3]);   \
    unsigned b0 = cvtpk(P[BASE + 4], P[BASE + 5]), b1 = cvtpk(P[BASE + 6], P[BASE + 7]);                              \
    auto r0 = __builtin_amdgcn_permlane32_swap(a0, b0, false, false); auto r1 = __builtin_amdgcn_permlane32_swap(a1, b1, false, false); \
    u32x4 w = {r0[0], r1[0], r0[1], r1[1]}; OUT = __builtin_bit_cast(bf16x8, w); } while (0)
    PK4(p0, 0, pa0); PK4(p0, 8, pa1); PK4(p1, 0, pa2); PK4(p1, 8, pa3);
#undef PK4
}
__device__ __forceinline__ void qkt(f32x16& p0, f32x16& p1, const char* Ks, const bf16x8* qr, int r32, int hi) {
    p0 = f32x16{}; p1 = f32x16{};
#pragma unroll
    for (int d0 = 0; d0 < 12; ++d0) { const int cb = (d0 * 16 + hi * 8) * 2;
        const bf16x8 b0 = *reinterpret_cast<const bf16x8*>(Ks + KSWZ(r32, cb));
        const bf16x8 b1 = *reinterpret_cast<const bf16x8*>(Ks + KSWZ(32 + r32, cb));
        p0 = __builtin_amdgcn_mfma_f32_32x32x16_bf16(b0, qr[d0], p0, 0, 0, 0);
        p1 = __builtin_amdgcn_mfma_f32_32x32x16_bf16(b1, qr[d0], p1, 0, 0, 0); }
}
__device__ __forceinline__ int v_st(int k, int c) { const int kk = (k & ~0xC) | ((k & 4) << 1) | ((k & 8) >> 1); return ((kk >> 3) * 4 + (c >> 5)) * 512 + ((kk & 7) * 32 + (c & 31)) * 2; }
__device__ __forceinline__ int v_rd_base(int lane) { return ((lane & 3) << 3) | (((lane >> 2) & 3) << 6) | (((lane >> 4) & 1) << 5) | (((lane >> 5) & 1) << 8); }
constexpr int v_rd_off(int d0, int ks, int half) { return d0 * 512 + ks * 4096 + half * 2048; }
template <int OFF> __device__ __forceinline__ s16x4 tr_read(int vb) {
    s16x4 r; asm volatile("ds_read_b64_tr_b16 %0, %1 offset:%2" : "=&v"(r) : "v"(vb), "i"(OFF) : "memory"); return r;
}
template <int D0> __device__ __forceinline__ void pv_one(f32x16& od, int vb, bf16x8 pa0, bf16x8 pa1, bf16x8 pa2, bf16x8 pa3) {
    const s16x4 l0 = tr_read<v_rd_off(D0, 0, 0)>(vb), h0 = tr_read<v_rd_off(D0, 0, 1)>(vb), l1 = tr_read<v_rd_off(D0, 1, 0)>(vb), h1 = tr_read<v_rd_off(D0, 1, 1)>(vb);
    const s16x4 l2 = tr_read<v_rd_off(D0, 2, 0)>(vb), h2 = tr_read<v_rd_off(D0, 2, 1)>(vb), l3 = tr_read<v_rd_off(D0, 3, 0)>(vb), h3 = tr_read<v_rd_off(D0, 3, 1)>(vb);
    asm volatile("s_waitcnt lgkmcnt(0)" ::: "memory"); SBAR();
#define PK(L, H) (bf16x8){L[0], L[1], L[2], L[3], H[0], H[1], H[2], H[3]}
    od = __builtin_amdgcn_mfma_f32_32x32x16_bf16(pa0, PK(l0, h0), od, 0, 0, 0);
    od = __builtin_amdgcn_mfma_f32_32x32x16_bf16(pa1, PK(l1, h1), od, 0, 0, 0);
    od = __builtin_amdgcn_mfma_f32_32x32x16_bf16(pa2, PK(l2, h2), od, 0, 0, 0);
    od = __builtin_amdgcn_mfma_f32_32x32x16_bf16(pa3, PK(l3, h3), od, 0, 0, 0);
#undef PK
}
__device__ __forceinline__ void attn_unit(int b, int h, int qt, const bf16_t* Q, const bf16_t* K, const bf16_t* V, bf16_t* Y, char* lds, LAS unsigned char* ldsl, int wave0) {
    int tid = tid_of(wave0); asm volatile("" : "+v"(tid)); const int lane = tid & 63, r32 = lane & 31, hi = lane >> 5; const int wid = __builtin_amdgcn_readfirstlane(tid >> 6);
    char* V_lds = lds; char* K_lds = lds + 3 * SHM_V;
    float* ws = (float*)(lds + 3 * SHM_V + 3 * SHM_K) + wid * 64; float* li_l = ws; float* al_l = ws + 32;
    const size_t rowbase = (size_t)b * SEQ;
    const bf16_t* Qw = Q + (rowbase + qt * 256 + wid * QBLK + r32) * LDQ + h * DQ + hi * 8;
    const bf16_t* Kh = K + rowbase * LDQ + h * DQ; const bf16_t* Vh = V + rowbase * LDV + h * DV;
    float m_reg = -1e30f, l_reg = 0.f; f32x16 o[4] = {}; bf16x8 qr[12];
#pragma unroll
    for (int d0 = 0; d0 < 12; ++d0) qr[d0] = *reinterpret_cast<const bf16x8*>(Qw + d0 * 16);
    unsigned koff[3], voff[2];
#pragma unroll
    for (int i = 0; i < 3; ++i) { const int p = (wid * 3 + i) * 64 + lane, row = p / 24, s = p - row * 24; const int sg = (s & ~7) | ((s & 7) ^ ((row >> 1) & 7)); koff[i] = (unsigned)(row * LDQ + sg * 8) * 2u; }
#pragma unroll
    for (int i = 0; i < 2; ++i) { const int p = (wid * 2 + i) * 64 + lane, st = p >> 5, kk = (st >> 2) * 8 + ((p & 31) >> 2), c = (st & 3) * 32 + (p & 3) * 8;
        const int k = (kk & ~0xC) | ((kk & 4) << 1) | ((kk & 8) >> 1); voff[i] = (unsigned)(k * LDV + c) * 2u; }
    const int vb0 = (int)(uintptr_t)V_lds + v_rd_base(lane);
    const int NT = 4 * qt + 4, climit = 4 * qt + (wid >> 1);
#define DMA_TILE(t, sl) do { const char* kg_ = (const char*)Kh + (size_t)(t) * (KVBLK * LDQ * 2); const char* vg_ = (const char*)Vh + (size_t)(t) * (KVBLK * LDV * 2); \
    _Pragma("unroll") for (int i = 0; i < 3; ++i) __builtin_amdgcn_global_load_lds((const unsigned*)(kg_ + koff[i]), (LAS unsigned*)(ldsl + 3 * SHM_V + (sl) * SHM_K + (wid * 3 + i) * 1024), 16, 0, 0); \
    _Pragma("unroll") for (int i = 0; i < 2; ++i) __builtin_amdgcn_global_load_lds((const unsigned*)(vg_ + voff[i]), (LAS unsigned*)(ldsl + (sl) * SHM_V + (wid * 2 + i) * 1024), 16, 0, 0); } while (0)
    f32x16 pA0, pA1, pB0, pB1; float alA = 1.f, alB = 1.f; bf16x8 pa0, pa1, pa2, pa3;
    int sl_k = 0, sl_v = 2, sl_n = 1;
#define RESC(a) do { if (__any((a) < 1.f)) { if (hi == 0) al_l[r32] = (a); asm volatile("s_waitcnt lgkmcnt(0)" ::: "memory"); \
    _Pragma("unroll") for (int d = 0; d < 4; ++d) _Pragma("unroll") for (int r = 0; r < 16; ++r) o[d][r] *= al_l[crow(r, hi)]; } } while (0)
#define ROT() do { const int t_ = sl_v; sl_v = sl_k; sl_k = sl_n; sl_n = t_; } while (0)
#define STEP(j, C0, C1, ALC, P0, P1, ALP) do { \
    if ((j) + 1 < NT) DMA_TILE((j) + 1, sl_n); \
    if ((j) <= climit) { SBAR(); qkt(C0, C1, K_lds + sl_k * SHM_K, qr, r32, hi); } \
    if ((j) >= 1 && (j) - 1 <= climit) { finishSM(P0, P1, ALP, l_reg, pa0, pa1, pa2, pa3); SBAR(); const int vb = vb0 + sl_v * SHM_V; \
        pv_one<0>(o[0], vb, pa0, pa1, pa2, pa3); pv_one<1>(o[1], vb, pa0, pa1, pa2, pa3); pv_one<2>(o[2], vb, pa0, pa1, pa2, pa3); pv_one<3>(o[3], vb, pa0, pa1, pa2, pa3); } \
    if ((j) <= climit) { partialSM(C0, C1, m_reg, ALC); RESC(ALC); } \
    asm volatile("s_waitcnt vmcnt(0)" ::: "memory"); __syncthreads(); ROT(); } while (0)
    DMA_TILE(0, 0); asm volatile("s_waitcnt vmcnt(0)" ::: "memory"); __syncthreads();
    for (int j = 0; j < NT; j += 2) {
        STEP(j, pA0, pA1, alA, pB0, pB1, alB);
        STEP(j + 1, pB0, pB1, alB, pA0, pA1, alA);
    }
    if (NT - 1 <= climit) { finishSM(pB0, pB1, alB, l_reg, pa0, pa1, pa2, pa3); SBAR(); const int vb = vb0 + sl_v * SHM_V;
        pv_one<0>(o[0], vb, pa0, pa1, pa2, pa3); pv_one<1>(o[1], vb, pa0, pa1, pa2, pa3); pv_one<2>(o[2], vb, pa0, pa1, pa2, pa3); pv_one<3>(o[3], vb, pa0, pa1, pa2, pa3); }
#undef STEP
#undef ROT
#undef RESC
    if (hi == 0) li_l[r32] = l_reg; asm volatile("s_waitcnt lgkmcnt(0)" ::: "memory");
    bf16_t* Ow = Y + (rowbase + qt * 256 + wid * QBLK) * LDO + 1024 + h * DV;
#pragma unroll
    for (int r = 0; r < 16; ++r) { const int orow = crow(r, hi); const float rl = __builtin_amdgcn_rcpf(li_l[orow]);
#pragma unroll
        for (int d0 = 0; d0 < 4; ++d0) Ow[(size_t)orow * LDO + d0 * 32 + r32] = (bf16_t)(cvtpk(o[d0][r] * rl, 0.f) & 0xffffu); }
    __syncthreads();
#undef DMA_TILE
}
#undef SBAR
}


__device__ __forceinline__ float dot2bf(unsigned a, unsigned b, float c) {
    return __builtin_amdgcn_fdot2_f32_bf16(__builtin_bit_cast(bf16x2_t, a), __builtin_bit_cast(bf16x2_t, b), c, false); }
__device__ __forceinline__ float gelu_tanh(float x) {
    const float y = 0.7978845608028654f * (x + 0.044715f * x * x * x);
    const float t = __builtin_amdgcn_exp2f(2.8853900817779268f * y);
    return 0.5f * x * (2.f - 2.f * __builtin_amdgcn_rcpf(t + 1.f));
}

#ifndef DBG_ONLY
#define DBG_ONLY -1
#endif
#define PH(n) (DBG_ONLY < 0 || DBG_ONLY == (n))
#ifndef DBG_STOP
#define DBG_STOP 99

#endif

__global__ void __launch_bounds__(NWAVES * 64, 2) fwd_kernel(Args args) {
    extern __shared__ __attribute__((aligned(16))) unsigned char lds_raw[];
    LAS unsigned char* lds = (LAS unsigned char*)lds_raw;
    LAS unsigned char* eps = lds + EPI_OFF;
    volatile LAS unsigned* MISC = (volatile LAS unsigned*)(lds + MISC_OFF);
    const int wave0 = __builtin_amdgcn_readfirstlane((int)threadIdx.x >> 6);
    const int G = gridDim.x, bx = blockIdx.x, vcu = (G % 8 == 0) ? (bx % 8) * (G / 8) + bx / 8 : bx;
    const int NGW = G * NWAVES; const long NGT = (long)G * 512;
#define PHASE_IDS() int tid = tid_of(wave0); asm volatile("" : "+v"(tid)); const int lane = tid & 63, wave = __builtin_amdgcn_readfirstlane(tid >> 6); const int gw = vcu * NWAVES + wave; const long gt = (long)vcu * 512 + tid; (void)lane; (void)gw; (void)gt
    for (int u = threadIdx.x; u < (LDS_BYTES - LDSCTL_OFF) / 4; u += NWAVES * 64) ((LAS unsigned*)(lds + LDSCTL_OFF))[u] = 0u;
    __syncthreads();
#ifdef TIMING
    unsigned long long ts_prev = __builtin_amdgcn_s_memrealtime(); float ts_val = 0.f; int ts_idx = 0;
#define STAMP() do { const unsigned long long now_ = __builtin_amdgcn_s_memrealtime(); if (ts_idx == TIMING) ts_val = (float)(now_ - ts_prev) * 0.0001f; ts_prev = now_; ++ts_idx; } while (0)
#else
#define STAMP() do {} while (0)
#endif
    XcdBarrier bar;
    { KArgsP ka = kargs(); unsigned char* ws = ka->ws; bar = xcd_barrier_post((unsigned*)(ws + WS_CTL) + 4096, MISC + 8, wave0); }

    if (PH(0)) {
        KArgsP ka = kargs(); unsigned char* ws = ka->ws;
        const float* x = IN_F(0); const float* p_in = IN_F(1); const int* positions = (const int*)ka->in[2];
        const float* mix_gain = IN_F(3); const float* w_in = IN_F(4); const float* w_pool = IN_F(5); const float* pool_scale = IN_F(6);
        const float* q_lat_gain = IN_F(7); const float* kv_lat_gain = IN_F(8); const float* w_uq = IN_F(9); const float* w_ukv = IN_F(10);
        const float* w_out = IN_F(13); const float* w_pq = IN_F(15); const float* sub_k1 = IN_F(16); const float* sub_k2 = IN_F(17);
        const float* expert_u = IN_F(18); const float* expert_v = IN_F(19); const float* ple_gain = IN_F(20); const float* w_ple_gate = IN_F(21); const float* w_ple_proj = IN_F(22);
        bf16_t* WIN = (bf16_t*)WSP(WS_WIN); bf16_t* WPOOL = (bf16_t*)WSP(WS_WPOOL); bf16_t* SKB = (bf16_t*)WSP(WS_SK); bf16_t* WUQ = (bf16_t*)WSP(WS_WUQ); bf16_t* WUKV = (bf16_t*)WSP(WS_WUKV);
        bf16_t* WOUT = (bf16_t*)WSP(WS_WOUT); bf16_t* WPQ = (bf16_t*)WSP(WS_WPQ); bf16_t* WG = (bf16_t*)WSP(WS_WG); bf16_t* WP = (bf16_t*)WSP(WS_WP); bf16_t* PB = (bf16_t*)WSP(WS_PB);
        float* COS = (float*)WSP(WS_COS); float* SIN = (float*)WSP(WS_SIN); unsigned* EU8 = (unsigned*)WSP(WS_EU); unsigned* EV8 = (unsigned*)WSP(WS_EV); float* SU = (float*)WSP(WS_SU); float* SV = (float*)WSP(WS_SV); float* RSTDX = (float*)WSP(WS_RSTDX); unsigned* XQ = (unsigned*)WSP(WS_XQ);
        PHASE_IDS();
        LAS float* scr = (LAS float*)(lds + wave * 16384);
        (void)p_in; (void)sub_k1; (void)sub_k2; (void)expert_u; (void)expert_v; (void)SKB; (void)PB; (void)EU8; (void)EV8; (void)SU; (void)SV;
        if (bx < 66) {
            unsigned char* WINQ = (unsigned char*)WIN; float* SBW = (float*)WSP(WS_SBW);
            const int n0 = 32 * bx, c4 = lane & 7, kr = lane >> 3;
            const float* wp = w_in + (size_t)(256 * wave + 4 * kr) * 2112 + n0 + 4 * c4; const float* gp = mix_gain + 256 * wave + 4 * kr;
            f32x4 mx = {0.f, 0.f, 0.f, 0.f};
#pragma unroll 2
            for (int i = 0; i < 8; ++i) { f32x4 v[4]; const f32x4 gk = *(const f32x4*)(gp + 32 * i);
#pragma unroll
                for (int j = 0; j < 4; ++j) v[j] = *(const f32x4*)(wp + (size_t)(32 * i + j) * 2112);
#pragma unroll
                for (int j = 0; j < 4; ++j)
#pragma unroll
                    for (int e = 0; e < 4; ++e) mx[e] = fmaxf(mx[e], fabsf(v[j][e] * gk[j])); }
#pragma unroll
            for (int e = 0; e < 4; ++e) { mx[e] = fmaxf(mx[e], __shfl_xor(mx[e], 8)); mx[e] = fmaxf(mx[e], __shfl_xor(mx[e], 16)); mx[e] = fmaxf(mx[e], __shfl_xor(mx[e], 32)); }
            LAS float* cm = (LAS float*)(lds + EPI_OFF);
            if (kr == 0) *(LAS f32x4*)(cm + wave * 32 + 4 * c4) = mx;
            __syncthreads();
            f32x4 cmax = *(const LAS f32x4*)(cm + 4 * c4);
#pragma unroll
            for (int w = 1; w < 8; ++w) { const f32x4 o = *(const LAS f32x4*)(cm + w * 32 + 4 * c4);
#pragma unroll
                for (int e = 0; e < 4; ++e) cmax[e] = fmaxf(cmax[e], o[e]); }
            f32x4 sc, inv;
#pragma unroll
            for (int e = 0; e < 4; ++e) { sc[e] = cmax[e] > 0.f ? cmax[e] * (1.f / 127.f) : 1.f; inv[e] = 1.f / sc[e]; }
            if (wave == 0 && kr == 0) *(f32x4*)(SBW + n0 + 4 * c4) = sc;
            LAS unsigned char* tb = lds + wave * 16384;
#pragma unroll 2
            for (int i = 0; i < 8; ++i) { f32x4 v[4]; const f32x4 gk = *(const f32x4*)(gp + 32 * i);
#pragma unroll
                for (int j = 0; j < 4; ++j) v[j] = *(const f32x4*)(wp + (size_t)(32 * i + j) * 2112);
#pragma unroll
                for (int e = 0; e < 4; ++e) { unsigned wd = 0;
#pragma unroll
                    for (int j = 0; j < 4; ++j) wd |= ((unsigned)((int)rintf(v[j][e] * gk[j] * inv[e]) & 0xff)) << (8 * j);
                    *(LAS unsigned*)(tb + (4 * c4 + e) * 272 + 32 * i + 4 * kr) = wd; } }
            asm volatile("s_waitcnt lgkmcnt(0)" ::: "memory");
#pragma unroll
            for (int r = 0; r < 8; ++r) { const int id = lane + 64 * r, n = id >> 4, ch = id & 15;
                *(u32x4*)(WINQ + (size_t)(n0 + n) * 2048 + 256 * wave + 16 * ch) = *(const LAS u32x4*)(tb + n * 272 + 16 * ch); }
            asm volatile("s_waitcnt lgkmcnt(0)" ::: "memory");
        }
        (void)w_pool; (void)pool_scale; (void)q_lat_gain; (void)kv_lat_gain; (void)w_uq; (void)w_ukv; (void)w_out; (void)w_pq; (void)ple_gain; (void)w_ple_gate; (void)w_ple_proj;
        (void)WPOOL; (void)WUKV; (void)WOUT; (void)WPQ; (void)WG; (void)WP;
        for (long i = gt; i < 24576 + 32768; i += NGT) {
            const u32x4 z = {0u, 0u, 0u, 0u};
            if (i < 24576) { *(u32x4*)((unsigned char*)WIN + (size_t)2112 * 2048 + i * 16) = z; if (i < 192) ((float*)WSP(WS_SBW))[2112 + i] = 1.f; }
            else { const long j = i - 24576; const int hh = (int)(j >> 12), rem = (int)(j & 4095); *(u32x4*)(WUQ + ((size_t)hh * 256 + 192) * 512 + (size_t)rem * 8) = z; }
        }
        for (int m = 2 * gw; m < M; m += 2 * NGW) {
            f32x4 v[2][8]; float s[2] = {0.f, 0.f}; float mxr[2] = {0.f, 0.f};
#pragma unroll
            for (int a = 0; a < 2; ++a) { const f32x4* xr = (const f32x4*)(x + (size_t)(m + a) * DM) + lane;
#pragma unroll
                for (int j = 0; j < 8; ++j) v[a][j] = __builtin_nontemporal_load(xr + 64 * j); }
#pragma unroll
            for (int a = 0; a < 2; ++a) {
#pragma unroll
                for (int j = 0; j < 8; ++j) { s[a] += sq4(v[a][j]); mxr[a] = fmaxf(mxr[a], fmaxf(fmaxf(fabsf(v[a][j][0]), fabsf(v[a][j][1])), fmaxf(fabsf(v[a][j][2]), fabsf(v[a][j][3])))); }
                const float rs = rsqrtf(wave_sum(s[a]) * (1.f / DM) + EPS);
                const float am = wave_max(mxr[a]), sx = am > 0.f ? am * (1.f / 127.f) : 1.f, ix = 1.f / sx;
                unsigned* q8 = XQ + (size_t)(m + a) * 512 + lane;
#pragma unroll
                for (int j = 0; j < 8; ++j) { const f32x4 t = v[a][j] * ix;
                    q8[64 * j] = ((unsigned)((int)rintf(t[0]) & 0xff)) | (((unsigned)((int)rintf(t[1]) & 0xff)) << 8) | (((unsigned)((int)rintf(t[2]) & 0xff)) << 16) | (((unsigned)((int)rintf(t[3]) & 0xff)) << 24); }
                if (lane == 0) RSTDX[m + a] = rs * sx; }
        }
        for (long i = gt; i < (long)M * 32; i += NGT) {
            const int row = (int)(i >> 5), j = (int)(i & 31);
            const float inv = __builtin_amdgcn_exp2f(-(float)j * (13.287712379549449f / 32.f));
            const float ang = (float)positions[row] * inv;
            const float kq = rintf(ang * 0.15915494309189535f);
            float r = fmaf(-kq, 6.2831854820251465f, ang); r = fmaf(-kq, -1.7484555e-7f, r);
            const float rev = r * 0.15915494309189535f;
            COS[i] = __builtin_amdgcn_cosf(rev); SIN[i] = __builtin_amdgcn_sinf(rev);
        }
    }
    xcd_barrier(bar); STAMP();
    if (DBG_STOP == 0) return;

    if (PH(1)) {
        KArgsP ka = kargs(); unsigned char* ws = ka->ws;
        bf16_t* XN = (bf16_t*)WSP(WS_XQ); const float* RSTDX = (const float*)WSP(WS_RSTDX); const float* SBW = (const float*)WSP(WS_SBW); bf16_t* WIN = (bf16_t*)WSP(WS_WIN); bf16_t* ZP = (bf16_t*)WSP(WS_ZP); bf16_t* CQ = (bf16_t*)WSP(WS_CQ); bf16_t* CKV = (bf16_t*)WSP(WS_CKV);
        float* SSQ_CQ = (float*)WSP(WS_SSQ_CQ); float* SSQ_CKV = (float*)WSP(WS_SSQ_CKV); float* KRP = (float*)WSP(WS_KRP);
#define PHASE_A_SIDE() do { KArgsP kb = kargs(); unsigned char* ws = kb->ws; PHASE_IDS(); LAS float* scr = (LAS float*)(lds + wave * 16384); \
        { const float* eu = (const float*)kb->in[18]; const float* ev = (const float*)kb->in[19]; unsigned* EU8 = (unsigned*)WSP(WS_EU); unsigned* EV8 = (unsigned*)WSP(WS_EV); float* SU = (float*)WSP(WS_SU); float* SV = (float*)WSP(WS_SV); \
          for (int r = gw * 16; r < gw * 16 + 16; r += 4) quant_rows<4>(eu, ev, EU8, EV8, SU, SV, r, lane); } \
        { const float* w_pool = (const float*)kb->in[5]; const float* pool_scale = (const float*)kb->in[6]; const float* q_lat_gain = (const float*)kb->in[7]; const float* kv_lat_gain = (const float*)kb->in[8]; \
          const float* w_uq = (const float*)kb->in[9]; const float* w_ukv = (const float*)kb->in[10]; const float* w_out = (const float*)kb->in[13]; const float* w_pq = (const float*)kb->in[15]; const float* ffn_gain = (const float*)kb->in[14]; \
          const float* ple_gain = (const float*)kb->in[20]; const float* w_ple_gate = (const float*)kb->in[21]; const float* w_ple_proj = (const float*)kb->in[22]; \
          bf16_t* WPOOL = (bf16_t*)WSP(WS_WPOOL); bf16_t* WUQ = (bf16_t*)WSP(WS_WUQ); bf16_t* WUKV = (bf16_t*)WSP(WS_WUKV); bf16_t* WOUT = (bf16_t*)WSP(WS_WOUT); bf16_t* WPQ = (bf16_t*)WSP(WS_WPQ); bf16_t* WG = (bf16_t*)WSP(WS_WG); bf16_t* WP = (bf16_t*)WSP(WS_WP); \
          constexpr int I_POOL = 4 * 4 * 8, I_UQ = 8 * 48, I_UKV = 8 * 64, I_WP = 4 * 64, NITEMS = I_POOL + I_UQ + I_UKV + I_WP; \
          if (vcu < 192) { const int sw = vcu >> 6, sn = vcu & 63; \
            if (sw == 0) tr_strip(w_out, 2048, nullptr, WOUT, 32 * sn, lds, wave, lane); else if (sw == 1) tr_strip(w_pq, 2048, ffn_gain, WPQ, 32 * sn, lds, wave, lane); \
            else tr_strip(w_ple_gate, 2048, ple_gain, WG, 32 * sn, lds, wave, lane); } \
          auto trp = [&](int r) -> TrP { \
            if (r < I_POOL) { const int g_ = r >> 5; return TrP{w_pool + g_ * 65536, nullptr, pool_scale + g_ * 256, WPOOL + g_ * 65536, 256, 256, 8, r & 31, 0}; } r -= I_POOL; \
            if (r < I_UQ) return TrP{w_uq, q_lat_gain, nullptr, WUQ, 1536, 512, 48, r, 1}; r -= I_UQ; \
            if (r < I_UKV) return TrP{w_ukv, kv_lat_gain, nullptr, WUKV, 2048, 512, 64, r, 0}; r -= I_UKV; \
            return TrP{w_ple_proj, nullptr, nullptr, WP, 2048, 256, 64, r, 0}; }; \
          for (int it = NGW - 1 - gw; it < NITEMS; it += 2 * NGW) { const bool two = it + NGW < NITEMS; const TrP pa = trp(it), pb = trp(two ? it + NGW : it); \
            float va[32], vb[32]; tr_load(pa, va, lane); if (two) tr_load(pb, vb, lane); \
            tr_store(pa, va, scr, lane); if (two) tr_store(pb, vb, scr, lane); } } \
        asm volatile("s_waitcnt vmcnt(0) lgkmcnt(0)" ::: "memory"); __syncthreads(); } while (0)
        if (vcu & 1) PHASE_A_SIDE();
        pg8::Gemm g{XN, WIN, 2048, 2048, 2048}; pg8::StaticOrder S; S.init(M, 2048, G, bx);
        EpiA E{ZP, CQ, CKV, SSQ_CQ, SSQ_CKV, RSTDX, SBW};
        pg8::gemm_phase<EpiA, pg8::StaticOrder, true, true, true>(lds, eps, g, S, E, wave0);
        pg8::Gemm g2{XN, WIN, 2048, 2048, 512}; pg8::QuadOrder<0> S2{vcu};
        EpiKR E2{KRP, RSTDX, SBW};
        pg8::gemm_phase<EpiKR, pg8::QuadOrder<0>, true, true, true>(lds, eps, g2, S2, E2, wave0);
        if (!(vcu & 1)) PHASE_A_SIDE();
#undef PHASE_A_SIDE
    }
    xcd_barrier(bar); STAMP();
    if (DBG_STOP == 1) return;

    if (PH(2)) {
        { KArgsP ka = kargs(); unsigned char* ws = ka->ws;
          bf16_t* ZP = (bf16_t*)WSP(WS_ZP); bf16_t* WPOOL = (bf16_t*)WSP(WS_WPOOL); bf16_t* UB = (bf16_t*)WSP(WS_U);
          pg8::Gemm gp{ZP, WPOOL, 1024, 256, 256}; pg8::QuadOrder<1> Sp{vcu};
          EpiStore Ep{UB, 1024};
          pg8::gemm_phase<EpiStore, pg8::QuadOrder<1>, true>(lds, eps, gp, Sp, Ep, wave0); }
        { KArgsP ka = kargs(); unsigned char* ws = ka->ws; const float* q_norm_gain = IN_F(11);
          bf16_t* CQ = (bf16_t*)WSP(WS_CQ); bf16_t* WUQ = (bf16_t*)WSP(WS_WUQ); bf16_t* QB = (bf16_t*)WSP(WS_Q);
          float* SSQ_CQ = (float*)WSP(WS_SSQ_CQ); float* COS = (float*)WSP(WS_COS); float* SIN = (float*)WSP(WS_SIN);
          pg8::Gemm gq{CQ, WUQ, 512, 512, 512}; pg8::StaticOrder Sq; Sq.init(M, 2048, G, bx);
          EpiQ Eq{QB, SSQ_CQ, q_norm_gain, COS, SIN};
          pg8::gemm_phase<EpiQ, pg8::StaticOrder, true>(lds, eps, gq, Sq, Eq, wave0); }
        { KArgsP ka = kargs(); unsigned char* ws = ka->ws; const float* k_norm_gain = IN_F(12);
          bf16_t* CKV = (bf16_t*)WSP(WS_CKV); bf16_t* WUKV = (bf16_t*)WSP(WS_WUKV); bf16_t* KB = (bf16_t*)WSP(WS_K); bf16_t* VB = (bf16_t*)WSP(WS_V);
          float* SSQ_CKV = (float*)WSP(WS_SSQ_CKV); float* KRP = (float*)WSP(WS_KRP); float* COS = (float*)WSP(WS_COS); float* SIN = (float*)WSP(WS_SIN);
          pg8::Gemm gk{CKV, WUKV, 512, 512, 512}; pg8::StaticOrder Sk; Sk.init(M, 2048, G, bx);
          EpiKV Ek{KB, VB, SSQ_CKV, KRP, k_norm_gain, COS, SIN};
          pg8::gemm_phase<EpiKV, pg8::StaticOrder, true>(lds, eps, gk, Sk, Ek, wave0); }
    }
    xcd_barrier(bar); STAMP();
    if (DBG_STOP == 2) return;

    if (PH(3)) {
        KArgsP ka = kargs(); unsigned char* ws = ka->ws;
        bf16_t* UB = (bf16_t*)WSP(WS_U); bf16_t* YMIX = (bf16_t*)WSP(WS_R1); bf16_t* QB = (bf16_t*)WSP(WS_Q); bf16_t* KB = (bf16_t*)WSP(WS_K); bf16_t* VB = (bf16_t*)WSP(WS_V);
        PHASE_IDS();
        {
            const int g = wave & 3, c0 = (32 * g + (lane & 31)) * 8, row0 = vcu * 64 + 32 * (wave >> 2) + 16 * (lane >> 5);
#define FILT_ACC(OP, V) do { a[0] OP bf_lo((V).x); a[1] OP bf_hi((V).x); a[2] OP bf_lo((V).y); a[3] OP bf_hi((V).y); a[4] OP bf_lo((V).z); a[5] OP bf_hi((V).z); a[6] OP bf_lo((V).w); a[7] OP bf_hi((V).w); } while (0)
#define FILT(W) do { const int tl0 = row0 & (SEQ - 1); const bool hist = tl0 != 0; u32x4 h[(W) + 16]; \
                _Pragma("unroll") for (int j = 0; j < (W) + 16; ++j) { const bool ok = hist || j >= (W); h[j] = *(const u32x4*)(UB + (size_t)(ok ? row0 - (W) + j : row0) * 1024 + c0); if (!ok) h[j] = (u32x4){0u, 0u, 0u, 0u}; } \
                float a[8]; _Pragma("unroll") for (int e = 0; e < 8; ++e) a[e] = 0.f; \
                _Pragma("unroll") for (int j = 0; j < (W); ++j) FILT_ACC(+=, h[j]); \
                _Pragma("unroll") for (int rI = 0; rI < 16; ++rI) { const int row = row0 + rI, tl = tl0 + rI; const int cnt = (tl + 1 < (W)) ? tl + 1 : (W); const u32x4 cur = h[(W) + rI]; \
                    FILT_ACC(+=, cur); FILT_ACC(-=, h[rI]); \
                    const float ic = 1.f / (float)cnt; u32x4 o; \
                    o.x = cvtpk(a[0] * ic - bf_lo(cur.x), a[1] * ic - bf_hi(cur.x)); o.y = cvtpk(a[2] * ic - bf_lo(cur.y), a[3] * ic - bf_hi(cur.y)); \
                    o.z = cvtpk(a[4] * ic - bf_lo(cur.z), a[5] * ic - bf_hi(cur.z)); o.w = cvtpk(a[6] * ic - bf_lo(cur.w), a[7] * ic - bf_hi(cur.w)); \
                    *(u32x4*)(YMIX + (size_t)row * DM + c0) = o; } } while (0)
            if (g == 0) FILT(2); else if (g == 1) FILT(4); else if (g == 2) FILT(8); else FILT(16);
#undef FILT
#undef FILT_ACC
        }
        if (G == 256) {
            const int bh = vcu >> 2, s = vcu & 3;
            att::attn_unit(bh >> 3, bh & 7, s, QB, KB, VB, YMIX, (char*)lds_raw, lds, wave0);
            att::attn_unit(bh >> 3, bh & 7, 7 - s, QB, KB, VB, YMIX, (char*)lds_raw, lds, wave0);
        }
    }
    xcd_barrier(bar); STAMP();
    if (DBG_STOP == 3) return;

    if (PH(4)) {
        KArgsP ka = kargs(); unsigned char* ws = ka->ws; const float* x = IN_F(0); bf16_t* H1B = (bf16_t*)WSP(WS_H2B);
        bf16_t* YMIX = (bf16_t*)WSP(WS_R1); bf16_t* WOUT = (bf16_t*)WSP(WS_WOUT); float* SSQ_H1 = (float*)WSP(WS_SSQ_H1);
        pg8::Gemm g{YMIX, WOUT, 2048, 2048, 2048}; pg8::StaticOrder S; S.init(M, 2048, G, bx);
        EpiH1 E{x, H1B, SSQ_H1};
        pg8::gemm_phase<EpiH1, pg8::StaticOrder, true>(lds, eps, g, S, E, wave0);
    }
    xcd_barrier(bar); STAMP();
    if (DBG_STOP == 4) return;

    if (PH(5)) {
        KArgsP ka = kargs(); unsigned char* ws = ka->ws;
        bf16_t* H1B = (bf16_t*)WSP(WS_H2B); bf16_t* WPQ = (bf16_t*)WSP(WS_WPQ); bf16_t* QP = (bf16_t*)WSP(WS_R1); float* SSQ_H1 = (float*)WSP(WS_SSQ_H1); float* RSTD2 = (float*)WSP(WS_RSTD2);
        pg8::Gemm g{H1B, WPQ, 2048, 2048, 2048}; pg8::PairOrder S{vcu};
        EpiQP E{QP, SSQ_H1, RSTD2};
        pg8::gemm_phase<EpiQP, pg8::PairOrder, true>(lds, eps, g, S, E, wave0);
    }
    asm volatile("s_waitcnt vmcnt(0)" ::: "memory"); __syncthreads();
    if (tid_of(wave0) == 0) { __builtin_amdgcn_fence(__ATOMIC_ACQUIRE, "agent"); asm volatile("s_waitcnt vmcnt(0)" ::: "memory"); }
    __syncthreads(); STAMP();
    if (DBG_STOP == 5) return;

    if (PH(6)) {
        KArgsP ka = kargs(); unsigned char* ws = ka->ws;
        bf16_t* QP = (bf16_t*)WSP(WS_R1); bf16_t* SKB = (bf16_t*)WSP(WS_SK); int* PIDX = (int*)WSP(WS_PIDX); float* PGATE = (float*)WSP(WS_PGATE);
        PHASE_IDS();
        LAS unsigned char* SKL = lds;
        LAS float* SC = (LAS float*)(lds + 65536 + wave * 10816);
        LAS float* TKV = (LAS float*)(lds + 65536 + wave * 10816 + 8256);
        LAS unsigned char* TKI = lds + 65536 + wave * 10816 + 8256 + 2048;
        const int fr = lane & 15, fq = lane >> 4; const int h = vcu & 7;
#pragma unroll
        for (int i = 0; i < 8; ++i) { const int p = tid + 512 * i, side = p >> 11, key = (p >> 4) & 127, c = p & 15;
            const u32x4 v = *(const u32x4*)(SKB + (size_t)side * 131072 + (size_t)h * 16384 + key * 128 + c * 8);
            *(LAS u32x4*)(SKL + side * 32768 + key * 256 + ((c ^ (key & 15)) << 4)) = v; }
        __syncthreads();
        for (int bi = 0; bi < 4; ++bi) {
            const int tb = (vcu >> 3) * 32 + wave * 4 + bi, t0 = tb * 16;
#pragma unroll 1
            for (int side = 0; side < 2; ++side) {
                bf16x8 qf[4];
#pragma unroll
                for (int kk = 0; kk < 4; ++kk) qf[kk] = *(const bf16x8*)(QP + (size_t)(t0 + fr) * DM + h * 256 + side * 128 + kk * 32 + 8 * fq);
                const LAS unsigned char* skl = SKL + side * 32768 + fr * 256;
#pragma unroll
                for (int nt = 0; nt < 8; ++nt) { f32x4 a = {0.f, 0.f, 0.f, 0.f};
#pragma unroll
                    for (int kk = 0; kk < 4; ++kk) { const bf16x8 kf = *(const LAS bf16x8*)(skl + nt * 4096 + (((kk * 4 + fq) ^ fr) << 4));
                        a = __builtin_amdgcn_mfma_f32_16x16x32_bf16(kf, qf[kk], a, 0, 0, 0); }
#pragma unroll
                    for (int i = 0; i < 4; ++i) SC[fr * 129 + nt * 16 + 4 * fq + i] = a[i]; }
                asm volatile("s_waitcnt lgkmcnt(0)" ::: "memory");
                const int tok = lane >> 2, q4 = lane & 3; float v[32];
#pragma unroll
                for (int i = 0; i < 32; ++i) v[i] = __builtin_bit_cast(float, (__builtin_bit_cast(unsigned, SC[tok * 129 + 4 * i + q4]) & ~0x7Fu) | (unsigned)(4 * i + q4));
                bitonic_sort_desc<32>(v); QUAD_MERGE16(v, 0xB1); QUAD_MERGE16(v, 0x4E);
                if (q4 == 0) {
#pragma unroll
                    for (int r = 0; r < 16; ++r) { const int bk = (int)(__builtin_bit_cast(unsigned, v[r]) & 0x7Fu); TKV[(side * 16 + tok) * 16 + r] = SC[tok * 129 + bk]; TKI[(side * 16 + tok) * 16 + r] = (unsigned char)bk; } }
                asm volatile("s_waitcnt lgkmcnt(0)" ::: "memory");
            }
            {
                const int tok = lane >> 2, q4 = lane & 3; float c[32];
                const LAS float* V1 = TKV + tok * 16; const LAS float* V2 = TKV + (16 + tok) * 16;
#define CAND(slot, a, bi) do { const int b_ = q4 + 4 * (bi); const float s_ = V1[a] + V2[b_]; \
    c[slot] = (((a) + 1) * (b_ + 1) <= 16) ? __builtin_bit_cast(float, (__builtin_bit_cast(unsigned, s_) & ~0xFFu) | (unsigned)((a) * 16 + b_)) : -INFINITY; } while (0)
                CAND(0, 0, 0); CAND(1, 0, 1); CAND(2, 0, 2); CAND(3, 0, 3); CAND(4, 1, 0); CAND(5, 1, 1); CAND(6, 2, 0); CAND(7, 2, 1);
                CAND(8, 3, 0); CAND(9, 4, 0); CAND(10, 5, 0); CAND(11, 6, 0); CAND(12, 7, 0); CAND(13, 8, 0); CAND(14, 9, 0); CAND(15, 10, 0);
                CAND(16, 11, 0); CAND(17, 12, 0); CAND(18, 13, 0); CAND(19, 14, 0); CAND(20, 15, 0);
#undef CAND
#pragma unroll
                for (int i = 21; i < 32; ++i) c[i] = -INFINITY;
                bitonic_sort_desc<32>(c); QUAD_MERGE16(c, 0xB1); QUAD_MERGE16(c, 0x4E);
                int co[4];
#pragma unroll
                for (int ri = 0; ri < 4; ++ri) { const float x_ = q4 == 0 ? c[4 * ri] : q4 == 1 ? c[4 * ri + 1] : q4 == 2 ? c[4 * ri + 2] : c[4 * ri + 3]; co[ri] = (int)(__builtin_bit_cast(unsigned, x_) & 0xFFu); }
                float sv[4]; float mx = -INFINITY;
#pragma unroll
                for (int ri = 0; ri < 4; ++ri) { sv[ri] = V1[co[ri] >> 4] + V2[co[ri] & 15]; mx = fmaxf(mx, sv[ri]); }
                mx = quad_max(mx);
                float eo[4]; float esum = 0.f;
#pragma unroll
                for (int ri = 0; ri < 4; ++ri) { eo[ri] = __builtin_amdgcn_exp2f((sv[ri] - mx) * 1.4426950408889634f); esum += eo[ri]; }
                esum = quad_sum(esum);
                const float inv = 1.f / esum;
#pragma unroll
                for (int ri = 0; ri < 4; ++ri) { const int e1 = (int)TKI[tok * 16 + (co[ri] >> 4)], e2 = (int)TKI[(16 + tok) * 16 + (co[ri] & 15)];
                    const size_t oi = (size_t)(t0 + tok) * 128 + h * 16 + 4 * ri + q4;
                    PIDX[oi] = e1 * 128 + e2; PGATE[oi] = eo[ri] * inv; }
            }
            asm volatile("s_waitcnt lgkmcnt(0)" ::: "memory");
        }
    }
    xcd_barrier(bar); STAMP();
    if (DBG_STOP == 6) return;


    if (PH(7)) {
        PHASE_IDS();
        const int xc = bx & 7, wl = (bx >> 3) * NWAVES + wave;
        const int gi = lane >> 3, cj = lane & 7; const unsigned cj16 = 16u * (unsigned)cj;
        const int tpw = M / ((G >> 3) * NWAVES);
        {
            KArgsP ka = kargs(); unsigned char* ws = ka->ws;
            const bf16_t* H1B = (const bf16_t*)WSP(WS_H2B); const unsigned char* TU = WSP(WS_EU); const int* PIDX = (const int*)WSP(WS_PIDX); const float* ffn_gain = IN_F(14);
            LAS unsigned char* xl = lds + wave * 8448; LAS float* xs = (LAS float*)(xl + 8192);
#define F1_LOADIDX(n_, EV) do { const int nn_ = (n_) < tpw ? (n_) : tpw - 1; const size_t t_ = (size_t)(wl * tpw + nn_); \
        _Pragma("unroll") for (int q = 0; q < 4; ++q) EV[q] = *(const u32x4*)(PIDX + t_ * 128 + 16 * gi + 4 * q); } while (0)
#define F1_GATHER(EV, UU) do { _Pragma("unroll") for (int q = 0; q < 4; ++q) { UU[4 * q] = *(const u32x4*)(tus + ((EV[q].x << 7) | cj16)); UU[4 * q + 1] = *(const u32x4*)(tus + ((EV[q].y << 7) | cj16)); \
        UU[4 * q + 2] = *(const u32x4*)(tus + ((EV[q].z << 7) | cj16)); UU[4 * q + 3] = *(const u32x4*)(tus + ((EV[q].w << 7) | cj16)); } } while (0)
#define F1_COMPUTE(n_, UU) do { const u32x4 xq = *(const LAS u32x4*)(xl + (n_) * 128 + cj16); const float sx = xs[(n_)]; f32x4 pr[4]; \
        _Pragma("unroll") for (int g = 0; g < 16; ++g) { int d = __builtin_amdgcn_sdot4((int)UU[g].x, (int)xq.x, 0, false); d = __builtin_amdgcn_sdot4((int)UU[g].y, (int)xq.y, d, false); \
            d = __builtin_amdgcn_sdot4((int)UU[g].z, (int)xq.z, d, false); d = __builtin_amdgcn_sdot4((int)UU[g].w, (int)xq.w, d, false); pr[g >> 2][g & 3] = (float)oct_sum_i(d) * sx; } \
        if (cj == 0) { bf16_t* po = PART + (size_t)(wl * tpw + (n_)) * 128 + 16 * gi; __builtin_nontemporal_store(pack8(pr[0], pr[1]), (u32x4*)po); __builtin_nontemporal_store(pack8(pr[2], pr[3]), (u32x4*)(po + 8)); } } while (0)
#pragma unroll 1
            for (int p = 0; p < 2; ++p) {
                const int s = 2 * xc + p; const unsigned char* tus = TU + (size_t)s * (16384 * 128);
                bf16_t* PART = (bf16_t*)(p == 0 ? WSP(WS_PART0) : WSP(WS_PART1)) + (size_t)xc * M * 128;
                {
                    float gsl[16];
#pragma unroll
                    for (int i = 0; i < 16; ++i) gsl[i] = ffn_gain[128 * s + 16 * cj + i];
#pragma unroll 2
                    for (int o = 0; o < tpw; o += 8) { const size_t t_ = (size_t)(wl * tpw + o + gi);
                        const u32x4 XA = *(const u32x4*)(H1B + t_ * DM + 128 * s + 16 * cj), XB = *(const u32x4*)(H1B + t_ * DM + 128 * s + 16 * cj + 8);
                        const unsigned xw[8] = {XA.x, XA.y, XA.z, XA.w, XB.x, XB.y, XB.z, XB.w}; float xf[16]; float mx = 0.f;
#pragma unroll
                        for (int i = 0; i < 8; ++i) { xf[2 * i] = bf_lo(xw[i]) * gsl[2 * i]; xf[2 * i + 1] = bf_hi(xw[i]) * gsl[2 * i + 1]; mx = fmaxf(mx, fmaxf(fabsf(xf[2 * i]), fabsf(xf[2 * i + 1]))); }
                        mx = oct_max(mx); const float sx = mx > 0.f ? mx * (1.f / 127.f) : 1.f; const float inv = 1.f / sx; u32x4 xq;
#pragma unroll
                        for (int i = 0; i < 4; ++i) { const int q0 = (int)rintf(xf[4 * i] * inv), q1 = (int)rintf(xf[4 * i + 1] * inv), q2 = (int)rintf(xf[4 * i + 2] * inv), q3 = (int)rintf(xf[4 * i + 3] * inv);
                            xq[i] = (unsigned)(q0 & 0xff) | ((unsigned)(q1 & 0xff) << 8) | ((unsigned)(q2 & 0xff) << 16) | ((unsigned)(q3 & 0xff) << 24); }
                        *(LAS u32x4*)(xl + (o + gi) * 128 + 16 * cj) = xq; if (cj == 0) xs[o + gi] = sx; }
                    asm volatile("s_waitcnt lgkmcnt(0)" ::: "memory");
                }
                u32x4 evA[4], evB[4], uuA[16], uuB[16];
                F1_LOADIDX(0, evA); F1_LOADIDX(1, evB); F1_GATHER(evA, uuA);
#pragma unroll 1
                for (int n = 0; n < tpw; n += 2) {
                    F1_GATHER(evB, uuB); F1_LOADIDX(n + 2, evA); F1_COMPUTE(n, uuA);
                    F1_GATHER(evA, uuA); F1_LOADIDX(n + 3, evB); F1_COMPUTE(n + 1, uuB);
                }
                asm volatile("s_waitcnt lgkmcnt(0)" ::: "memory");
            }
#undef F1_LOADIDX
#undef F1_GATHER
#undef F1_COMPUTE
        }
        xcd_barrier(bar);
        {
            KArgsP ka = kargs(); unsigned char* ws = ka->ws;
            const bf16_t* P0 = (const bf16_t*)WSP(WS_PART0); const bf16_t* P1 = (const bf16_t*)WSP(WS_PART1); const int* PIDX = (const int*)WSP(WS_PIDX); const float* PGATE = (const float*)WSP(WS_PGATE);
            const float* SU = (const float*)WSP(WS_SU); const float* SV = (const float*)WSP(WS_SV); const float* RSTD2 = (const float*)WSP(WS_RSTD2); unsigned* AQ = (unsigned*)WSP(WS_AQ); float* AS = (float*)WSP(WS_AS);
            for (int tp = gw; tp < M / 2; tp += NGW) {
                const int t = 2 * tp + (lane >> 5), li = lane & 31; const size_t i = (size_t)t * 128 + 4 * li;
                f32x4 sum = {0.f, 0.f, 0.f, 0.f};
#pragma unroll
                for (int x8 = 0; x8 < 8; ++x8) { const u32x2 a = __builtin_nontemporal_load((const u32x2*)(P0 + (size_t)x8 * M * 128 + i)), b = __builtin_nontemporal_load((const u32x2*)(P1 + (size_t)x8 * M * 128 + i));
                    sum += (f32x4){bf_lo(a.x), bf_hi(a.x), bf_lo(a.y), bf_hi(a.y)} + (f32x4){bf_lo(b.x), bf_hi(b.x), bf_lo(b.y), bf_hi(b.y)}; }
                const u32x4 e4 = *(const u32x4*)(PIDX + i); const f32x4 g4 = *(const f32x4*)(PGATE + i); const float rs = RSTD2[t];
                const unsigned ee[4] = {e4.x, e4.y, e4.z, e4.w}; float a[4]; float mx = 0.f;
#pragma unroll
                for (int c = 0; c < 4; ++c) { a[c] = gelu_tanh(sum[c] * SU[ee[c]] * rs) * g4[c] * SV[ee[c]]; mx = fmaxf(mx, fabsf(a[c])); }
                mx = oct_max(mx); mx = fmaxf(mx, DPP_F(mx, 0x128)); mx = fmaxf(mx, __shfl_xor(mx, 16));
                const float sc = mx > 0.f ? mx * (1.f / 127.f) : 1.f; const float inv = 1.f / sc;
                const int q0 = (int)rintf(a[0] * inv), q1 = (int)rintf(a[1] * inv), q2 = (int)rintf(a[2] * inv), q3 = (int)rintf(a[3] * inv);
                AQ[(size_t)t * 32 + li] = (unsigned)(q0 & 0xff) | ((unsigned)(q1 & 0xff) << 8) | ((unsigned)(q2 & 0xff) << 16) | ((unsigned)(q3 & 0xff) << 24);
                if (li == 0) AS[t] = sc;
            }
        }
        xcd_barrier(bar);
        {
            KArgsP ka = kargs(); unsigned char* ws = ka->ws;
            const unsigned char* TV = WSP(WS_EV); const int* PIDX = (const int*)WSP(WS_PIDX); const unsigned* AQ = (const unsigned*)WSP(WS_AQ); const float* AS = (const float*)WSP(WS_AS);
            bf16_t* H2B = (bf16_t*)WSP(WS_H2B); float* SSQ2 = (float*)WSP(WS_SSQ2);
            const int nit = tpw;
#define F3_LOADIDX(it_, EV, AQV) do { const int ii_ = (it_) < nit ? (it_) : nit - 1; const size_t t_ = (size_t)(wl * tpw + (ii_ >> 3) * 8 + gi); const int kb_ = ii_ & 7; \
        _Pragma("unroll") for (int q = 0; q < 4; ++q) EV[q] = *(const u32x4*)(PIDX + t_ * 128 + 16 * kb_ + 4 * q); \
        AQV = *(const u32x4*)(AQ + t_ * 32 + 4 * kb_); } while (0)
#define F3_GATHER(EV, VV) do { _Pragma("unroll") for (int q = 0; q < 4; ++q) { VV[4 * q] = *(const u32x4*)(tvs + ((EV[q].x << 7) | cj16)); VV[4 * q + 1] = *(const u32x4*)(tvs + ((EV[q].y << 7) | cj16)); \
        VV[4 * q + 2] = *(const u32x4*)(tvs + ((EV[q].z << 7) | cj16)); VV[4 * q + 3] = *(const u32x4*)(tvs + ((EV[q].w << 7) | cj16)); } } while (0)
#define F3_T4(W, Q, R0, R1, R2, R3, AW) do { const unsigned a_ = __builtin_amdgcn_perm(R1, R0, 0x05010400u), b_ = __builtin_amdgcn_perm(R1, R0, 0x07030602u), c_ = __builtin_amdgcn_perm(R3, R2, 0x05010400u), d_ = __builtin_amdgcn_perm(R3, R2, 0x07030602u); \
        acc[4 * (W) + 0] = __builtin_amdgcn_sdot4((int)__builtin_amdgcn_perm(c_, a_, 0x05040100u), (int)(AW), acc[4 * (W) + 0], false); acc[4 * (W) + 1] = __builtin_amdgcn_sdot4((int)__builtin_amdgcn_perm(c_, a_, 0x07060302u), (int)(AW), acc[4 * (W) + 1], false); \
        acc[4 * (W) + 2] = __builtin_amdgcn_sdot4((int)__builtin_amdgcn_perm(d_, b_, 0x05040100u), (int)(AW), acc[4 * (W) + 2], false); acc[4 * (W) + 3] = __builtin_amdgcn_sdot4((int)__builtin_amdgcn_perm(d_, b_, 0x07060302u), (int)(AW), acc[4 * (W) + 3], false); } while (0)
#define F3_Q(Q, VV, AW) do { F3_T4(0, Q, VV[4 * (Q)].x, VV[4 * (Q) + 1].x, VV[4 * (Q) + 2].x, VV[4 * (Q) + 3].x, AW); F3_T4(1, Q, VV[4 * (Q)].y, VV[4 * (Q) + 1].y, VV[4 * (Q) + 2].y, VV[4 * (Q) + 3].y, AW); \
        F3_T4(2, Q, VV[4 * (Q)].z, VV[4 * (Q) + 1].z, VV[4 * (Q) + 2].z, VV[4 * (Q) + 3].z, AW); F3_T4(3, Q, VV[4 * (Q)].w, VV[4 * (Q) + 1].w, VV[4 * (Q) + 2].w, VV[4 * (Q) + 3].w, AW); } while (0)
#define F3_COMPUTE(it_, VV, AQV) do { F3_Q(0, VV, AQV.x); F3_Q(1, VV, AQV.y); F3_Q(2, VV, AQV.z); F3_Q(3, VV, AQV.w); \
        if (((it_) & 7) == 7) { const size_t t_ = (size_t)(wl * tpw + ((it_) >> 3) * 8 + gi); const float as_ = AS[t_]; bf16_t* o = H2B + t_ * DM + 128 * s + 16 * cj; f32x4 hh[4]; float s2 = 0.f; \
            const u32x4 ha_ = *(const u32x4*)o, hb_ = *(const u32x4*)(o + 8); const unsigned hw_[8] = {ha_.x, ha_.y, ha_.z, ha_.w, hb_.x, hb_.y, hb_.z, hb_.w}; \
            _Pragma("unroll") for (int i = 0; i < 4; ++i) { hh[i] = (f32x4){bf_lo(hw_[2 * i]), bf_hi(hw_[2 * i]), bf_lo(hw_[2 * i + 1]), bf_hi(hw_[2 * i + 1])} + (f32x4){(float)acc[4 * i], (float)acc[4 * i + 1], (float)acc[4 * i + 2], (float)acc[4 * i + 3]} * as_; s2 += sq4(hh[i]); } \
            *(u32x4*)o = pack8(hh[0], hh[1]); *(u32x4*)(o + 8) = pack8(hh[2], hh[3]); \
            s2 = oct_sum(s2); if (cj == 0) SSQ2[t_ * 16 + s] = s2; \
            _Pragma("unroll") for (int i = 0; i < 16; ++i) acc[i] = 0; } } while (0)
#pragma unroll 1
            for (int p = 0; p < 2; ++p) {
                const int s = 2 * xc + p; const unsigned char* tvs = TV + (size_t)s * (16384 * 128);
                u32x4 evA[4], evB[4], vvA[16], vvB[16], aqA, aqB, aqC; int acc[16];
#pragma unroll
                for (int i = 0; i < 16; ++i) acc[i] = 0;
                F3_LOADIDX(0, evA, aqA); F3_LOADIDX(1, evB, aqB); F3_GATHER(evA, vvA);
#pragma unroll 1
                for (int it = 0; it < nit; it += 2) {
                    F3_GATHER(evB, vvB); F3_LOADIDX(it + 2, evA, aqC); F3_COMPUTE(it, vvA, aqA); aqA = aqC;
                    F3_GATHER(evA, vvA); F3_LOADIDX(it + 3, evB, aqC); F3_COMPUTE(it + 1, vvB, aqB); aqB = aqC;
                }
            }
#undef F3_LOADIDX
#undef F3_GATHER
#undef F3_T4
#undef F3_Q
#undef F3_COMPUTE
        }
    }
    xcd_barrier(bar); STAMP();
    if (DBG_STOP == 7) return;

    if (PH(8)) {
        KArgsP ka = kargs(); unsigned char* ws = ka->ws; float* OUT = ka->out;
        bf16_t* PB = (bf16_t*)WSP(WS_PB); bf16_t* WP = (bf16_t*)WSP(WS_WP); bf16_t* PROJ = (bf16_t*)WSP(WS_R1); bf16_t* H2B = (bf16_t*)WSP(WS_H2B); bf16_t* WG = (bf16_t*)WSP(WS_WG); float* SSQ2 = (float*)WSP(WS_SSQ2);
        pg8::StaticOrder S; S.init(M, 2048, G, bx);
        pg8::Gemm gp{PB, WP, 256, 256, 256};
        EpiStore Ep{PROJ, 2048};
        pg8::gemm_phase<EpiStore, pg8::StaticOrder, true>(lds, eps, gp, S, Ep, wave0);
        pg8::Gemm gg{H2B, WG, 2048, 2048, 2048};
        EpiGate Eg{OUT, PROJ, SSQ2, H2B};
        pg8::gemm_phase<EpiGate, pg8::StaticOrder, true>(lds, eps, gg, S, Eg, wave0);
    }
#ifdef TIMING
    xcd_barrier(bar); STAMP();
    if (blockIdx.x == 0 && threadIdx.x == 0) { KArgsP ka = kargs(); float* OUT = ka->out; OUT[0] += ts_val; }
#endif
}

extern "C" void kernel_launch(void* const* d_in, const int* in_sizes, int n_in, void* d_out, int out_size, void* d_ws, size_t ws_size, hipStream_t stream) {
    static int ready = 0;
    if (ready == 0) {
        if (n_in != 23 || out_size != M * DM || ws_size < WS_END) { fprintf(stderr, "kernel_launch: unexpected shapes (n_in %d, out %d, ws %zu)\n", n_in, out_size, ws_size); ready = -1; return; }
        if (hipFuncSetAttribute((const void*)fwd_kernel, hipFuncAttributeMaxDynamicSharedMemorySize, LDS_BYTES) != hipSuccess) { fprintf(stderr, "kernel_launch: hipFuncSetAttribute failed\n"); ready = -1; return; }
        ready = 1;
    }
    if (ready < 0) return;
    (void)hipMemsetAsync((char*)d_ws + WS_CTL, 0, CTL_ZERO_BYTES, stream);
    Args a{};
    for (int i = 0; i < 23; ++i) a.in[i] = (const float*)d_in[i];
    a.out = (float*)d_out; a.ws = (unsigned char*)d_ws;
    hipLaunchKernelGGL(fwd_kernel, dim3(256), dim3(NWAVES * 64), LDS_BYTES, stream, a);
}
```

```cpp
#include <hip/hip_runtime.h>
#include <cstdio>
#include <cstdint>
#include <type_traits>

#define LAS __attribute__((address_space(3)))
#define GAS __attribute__((address_space(1)))
typedef unsigned short bf16_t;
typedef short bf16x8 __attribute__((ext_vector_type(8)));
typedef short s16x4 __attribute__((ext_vector_type(4)));
typedef float f32x4 __attribute__((ext_vector_type(4)));
typedef float f32x2 __attribute__((ext_vector_type(2)));
typedef float f32x16 __attribute__((ext_vector_type(16)));
typedef unsigned u32x4 __attribute__((ext_vector_type(4)));
typedef int i32x4 __attribute__((ext_vector_type(4)));
typedef unsigned u32x2 __attribute__((ext_vector_type(2)));
typedef __bf16 bf16x2_t __attribute__((ext_vector_type(2)));

constexpr int M = 16384, DM = 2048, SEQ = 2048, NB = 8, NH = 8;
constexpr float EPS = 1e-6f;
constexpr size_t MiB = 1u << 20;
constexpr size_t WS_CTL = 0, CTL_ZERO_BYTES = 1 * MiB;
constexpr size_t WS_WIN = 1 * MiB;
constexpr size_t WS_WPOOL = 10 * MiB;
constexpr size_t WS_SK = 10 * MiB + 512 * 1024;
constexpr size_t WS_WUQ = 11 * MiB;
constexpr size_t WS_WUKV = 13 * MiB;
constexpr size_t WS_WOUT = 15 * MiB;
constexpr size_t WS_WPQ = 23 * MiB;
constexpr size_t WS_WG = 31 * MiB;
constexpr size_t WS_WP = 39 * MiB;
constexpr size_t WS_PB = 40 * MiB;
constexpr size_t WS_COS = 48 * MiB, WS_SIN = 50 * MiB;
constexpr size_t WS_SSQ_CQ = 52 * MiB, WS_SSQ_CKV = 52 * MiB + 512 * 1024, WS_SSQ_H1 = 53 * MiB, WS_RSTD2 = 55 * MiB, WS_RSTDX = 55 * MiB + 512 * 1024;
constexpr size_t WS_EU = 56 * MiB, WS_EV = 88 * MiB;
constexpr size_t WS_SU = 55 * MiB + 128 * 1024, WS_SV = 55 * MiB + 256 * 1024;
constexpr size_t WS_AQ = 346 * MiB, WS_AS = 349 * MiB;
constexpr size_t WS_SSQ2 = 344 * MiB;
constexpr size_t WS_XQ = 152 * MiB;
constexpr size_t WS_SBW = 55 * MiB + 640 * 1024;
constexpr size_t WS_H1Q = 120 * MiB;
constexpr size_t WS_SBQ = 55 * MiB + 672 * 1024;
constexpr size_t WS_RQ2 = 55 * MiB + 704 * 1024;
constexpr size_t WS_YQ = 120 * MiB;
constexpr size_t WS_SBO = 55 * MiB + 680 * 1024;
constexpr size_t WS_SY = 55 * MiB + 768 * 1024;
constexpr size_t WS_H2Q = 120 * MiB;
constexpr size_t WS_SBG = 55 * MiB + 688 * 1024;
constexpr size_t WS_RQ3 = 55 * MiB + 832 * 1024;
constexpr size_t WS_PSC = 350 * MiB;
constexpr size_t WS_SXA = 55 * MiB + 896 * 1024;
constexpr size_t WS_XB = 120 * MiB;
constexpr size_t WS_PART0 = 184 * MiB, WS_PART1 = 424 * MiB;
constexpr size_t WS_R1 = 184 * MiB;
constexpr size_t WS_ZP = 248 * MiB, WS_U = 280 * MiB, WS_H2B = 248 * MiB;
constexpr size_t WS_CQ = 312 * MiB, WS_CKV = 328 * MiB, WS_KRP = 344 * MiB, WS_PIDX = 312 * MiB, WS_PGATE = 320 * MiB;
constexpr size_t WS_Q = 360 * MiB, WS_K = 408 * MiB, WS_V = 456 * MiB;
constexpr size_t WS_END = 488 * MiB;
constexpr int RING_BYTES = 131072, EPI_OFF = RING_BYTES, EPI_BYTES = 8192, LDS_BYTES = 163840, LDSCTL_OFF = LDS_BYTES - 1024, MISC_OFF = LDSCTL_OFF + 320;
constexpr int NWAVES = 8;

__device__ __forceinline__ unsigned cvtpk(float lo, float hi) { f32x2 v = {lo, hi}; bf16x2_t b = __builtin_convertvector(v, bf16x2_t); return __builtin_bit_cast(unsigned, b); }
__device__ __forceinline__ float bf_lo(unsigned w) { return __builtin_bit_cast(float, w << 16); }
__device__ __forceinline__ float bf_hi(unsigned w) { return __builtin_bit_cast(float, w & 0xffff0000u); }
__device__ __forceinline__ float ub0(unsigned w) { return (float)(w & 0xffu); }
__device__ __forceinline__ float ub1(unsigned w) { float r; asm("v_cvt_f32_ubyte1 %0, %1" : "=v"(r) : "v"(w)); return r; }
__device__ __forceinline__ float ub2(unsigned w) { float r; asm("v_cvt_f32_ubyte2 %0, %1" : "=v"(r) : "v"(w)); return r; }
__device__ __forceinline__ float ub3(unsigned w) { float r; asm("v_cvt_f32_ubyte3 %0, %1" : "=v"(r) : "v"(w)); return r; }
__device__ __forceinline__ float dpp_xor1(float x) { return __builtin_bit_cast(float, __builtin_amdgcn_mov_dpp(__builtin_bit_cast(int, x), 0xB1, 0xF, 0xF, true)); }
__device__ __forceinline__ float dpp_xor2(float x) { return __builtin_bit_cast(float, __builtin_amdgcn_mov_dpp(__builtin_bit_cast(int, x), 0x4E, 0xF, 0xF, true)); }
#define DPP_I(x, ctrl) __builtin_amdgcn_mov_dpp((x), (ctrl), 0xF, 0xF, true)
#define DPP_F(x, ctrl) __builtin_bit_cast(float, __builtin_amdgcn_mov_dpp(__builtin_bit_cast(int, (float)(x)), (ctrl), 0xF, 0xF, true))
__device__ __forceinline__ int oct_sum_i(int v) { v += DPP_I(v, 0xB1); v += DPP_I(v, 0x4E); return v + DPP_I(v, 0x141); }
__device__ __forceinline__ float oct_sum(float v) { v += DPP_F(v, 0xB1); v += DPP_F(v, 0x4E); return v + DPP_F(v, 0x141); }
__device__ __forceinline__ float oct_max(float v) { v = fmaxf(v, DPP_F(v, 0xB1)); v = fmaxf(v, DPP_F(v, 0x4E)); return fmaxf(v, DPP_F(v, 0x141)); }
template <int N> __device__ __forceinline__ void bitonic_sort_desc(float (&v)[N]) {
#pragma unroll
    for (int k = 2; k <= N; k <<= 1)
#pragma unroll
        for (int j = k >> 1; j > 0; j >>= 1)
#pragma unroll
            for (int i = 0; i < N; ++i) { const int l = i ^ j; if (l > i) { const bool desc = (i & k) == 0; const float a = v[i], b = v[l]; const float hi = fmaxf(a, b), lo = fminf(a, b); v[i] = desc ? hi : lo; v[l] = desc ? lo : hi; } }
}
#define QUAD_MERGE16(v, CTRL) do { float p_[16]; _Pragma("unroll") for (int i = 0; i < 16; ++i) p_[i] = DPP_F(v[15 - i], CTRL); \
    _Pragma("unroll") for (int i = 0; i < 16; ++i) v[i] = fmaxf(v[i], p_[i]); \
    _Pragma("unroll") for (int j = 8; j > 0; j >>= 1) _Pragma("unroll") for (int i = 0; i < 16; ++i) { const int l = i ^ j; if (l > i) { const float a = v[i], b = v[l]; v[i] = fmaxf(a, b); v[l] = fminf(a, b); } } } while (0)
template <int N> __device__ __forceinline__ float tree_max(const float* v) {
    if constexpr (N == 1) return v[0]; else return fmaxf(tree_max<N / 2>(v), tree_max<N - N / 2>(v + N / 2));
}
__device__ __forceinline__ float quad_max(float m) { m = fmaxf(m, dpp_xor1(m)); return fmaxf(m, dpp_xor2(m)); }
__device__ __forceinline__ float quad_sum(float m) { m += dpp_xor1(m); return m + dpp_xor2(m); }
__device__ __forceinline__ float wave_max(float v) {
#pragma unroll
    for (int o = 1; o < 64; o <<= 1) v = fmaxf(v, __shfl_xor(v, o));
    return v;
}
__device__ __forceinline__ int wave_sum_i(int v) {
#pragma unroll
    for (int o = 1; o < 64; o <<= 1) v += __shfl_xor(v, o);
    return v;
}
__device__ __forceinline__ float wave_sum(float v) {
#pragma unroll
    for (int o = 1; o < 64; o <<= 1) v += __shfl_xor(v, o);
    return v;
}
__device__ __forceinline__ int tid_of(int wave0) { int l; asm volatile("v_mbcnt_lo_u32_b32 %0, -1, 0\n\tv_mbcnt_hi_u32_b32 %0, -1, %0" : "=v"(l)); return wave0 * 64 + l; }
#define EPI_BAR() do { asm volatile("s_waitcnt lgkmcnt(0)" ::: "memory"); __builtin_amdgcn_s_barrier(); asm volatile("" ::: "memory"); } while (0)

namespace pg8 {
constexpr int BM = 256, BK = 64, HALF = 128, HTB = HALF * BK * 2, STAGE_BYTES = 8 * HTB, NXCD = 8, WGM = 1;
__host__ __device__ __forceinline__ int lds_byte(int r, int c) { const int st = (r >> 4) * 2 + (c >> 5), rr = r & 15, cc = c & 31, ob = rr * 64 + cc * 2; return st * 1024 + (ob ^ (((ob >> 9) & 1) << 5)); }
__host__ __device__ __forceinline__ void stage_rc(int b, int& R, int& C) { const int st = b / 1024, sb = b % 1024, swz = sb ^ (((sb >> 9) & 1) << 5); R = (st >> 1) * 16 + swz / 64; C = (st & 1) * 32 + (swz % 64) / 2; }
__host__ __device__ __forceinline__ int perm32(int rho) { const int n = rho >> 4, i = rho & 15; return 8 * (i >> 2) + 4 * n + (i & 3); }

struct Unit { int pm, pn, ka, kb; };
struct Gemm { const bf16_t* A; const bf16_t* Bt; int lda, ldb, K; };

struct StaticOrder {
    int nM, nN, nwg, G, c;
    __device__ __forceinline__ void init(int Mr, int N, int G_, int c_) { nM = Mr / BM; nN = N / BM; nwg = nM * nN; G = G_; c = c_; }
    __device__ __forceinline__ bool next(int i, Unit& u) const {
        const long L = (long)i * G + c; if (L >= nwg) return false;
        int wgid = (int)L; { const int q = nwg / NXCD, r = nwg % NXCD, xcd = wgid % NXCD, off = wgid / NXCD; wgid = (xcd < r ? xcd * (q + 1) : r * (q + 1) + (xcd - r) * q) + off; }
        const int nig = WGM * nN, gid = wgid / nig, fm = gid * WGM, gsz = (nM - fm) < WGM ? (nM - fm) : WGM;
        u.pm = fm + ((wgid % nig) % gsz); u.pn = (wgid % nig) / gsz; u.ka = 0; u.kb = 0; return true;
    }
};
template <int MODE> struct QuadOrder {
    int v;
    __device__ bool next(int i, Unit& u) const {
        if (i > 0) return false;
        u.pm = v >> 2; const int j = v & 3;
        if (MODE == 0) { u.pn = 8; u.ka = 512 * j; u.kb = 512 * j; } else { u.pn = j; u.ka = 256 * j; u.kb = 0; }
        return true;
    }
};

struct PairOrder {
    int v;
    __device__ bool next(int i, Unit& u) const { if (i > 1) return false; u.pm = 2 * (v >> 3) + i; u.pn = v & 7; u.ka = 0; u.kb = 0; return true; }
};
template <class Epi, class Sched, bool ALIGN_EPI, bool PRE = false, bool I8 = false>
__device__ __forceinline__ void gemm_phase(LAS unsigned char* lds, LAS unsigned char* eps, const Gemm g, const Sched& S, const Epi& E, int wave0) {
    int tid = tid_of(wave0); asm volatile("" : "+v"(tid));
    const int wid = __builtin_amdgcn_readfirstlane(tid >> 6), lane = tid & 63, wr = wid >> 2, wc = wid & 3, fr = lane & 15, fq = lane >> 4;
    constexpr int ES = I8 ? 1 : 2;
    int nt = g.K * ES / (BK * 2); asm volatile("" : "+s"(nt));
    unsigned voffA[2], voffB[2];
#pragma unroll
    for (int i = 0; i < 2; ++i) { int R, C; stage_rc(tid * 16 + i * 8192, R, C); const int Rb = Epi::PERM ? ((R & ~31) + perm32(R & 31)) : R;
        voffA[i] = (unsigned)(R * g.lda * ES + C * 2); voffB[i] = (unsigned)(Rb * g.ldb * ES + C * 2); }
    const size_t kstep = (size_t)(BK * 2);
    const size_t hstepA = (size_t)HALF * g.lda * ES, hstepB = (size_t)HALF * g.ldb * ES;
    const size_t tstepA = 2 * hstepA, tstepB = 2 * hstepB;
    const unsigned ldsw = (unsigned)wid * 1024u;
    const int aoff = lds_byte(wr * 64 + fr, fq * 8), boff = lds_byte(wc * 32 + fr, fq * 8);
#define PG8_SA(b, h) (((b) * 2 + (h)) * HTB)
#define PG8_SB(b, h) ((4 + (b) * 2 + (h)) * HTB)
#define PG8_STAGE(bufoff, gbase, voff) do { _Pragma("unroll") for (int _i = 0; _i < 2; ++_i) \
        __builtin_amdgcn_global_load_lds((const unsigned*)((const char*)(gbase) + (voff)[_i]), (LAS unsigned*)(lds + (bufoff) + ldsw + _i * 8192), 16, 0, 0); } while (0)
#define PG8_LDA(dst, b, h) do { _Pragma("unroll") for (int m = 0; m < 4; ++m) _Pragma("unroll") for (int k = 0; k < 2; ++k) dst[m][k] = *(const LAS bf16x8*)(lds + PG8_SA(b, h) + aoff + m * 2048 + k * 1024); } while (0)
#define PG8_LDB(dst, b, h) do { _Pragma("unroll") for (int n = 0; n < 2; ++n) _Pragma("unroll") for (int k = 0; k < 2; ++k) dst[n][k] = *(const LAS bf16x8*)(lds + PG8_SB(b, h) + boff + n * 2048 + k * 1024); } while (0)
#define PG8_MMA(ai, bj, At, Bt) do { __builtin_amdgcn_s_setprio(1); _Pragma("unroll") for (int m = 0; m < 4; ++m) _Pragma("unroll") for (int n = 0; n < 2; ++n) _Pragma("unroll") for (int k = 0; k < 2; ++k) \
        { if constexpr (I8) acc[ai][bj][m][n] = __builtin_bit_cast(AccT, __builtin_amdgcn_mfma_i32_16x16x64_i8(__builtin_bit_cast(i32x4, Bt[n][k]), __builtin_bit_cast(i32x4, At[m][k]), __builtin_bit_cast(i32x4, acc[ai][bj][m][n]), 0, 0, 0)); \
          else acc[ai][bj][m][n] = __builtin_bit_cast(AccT, __builtin_amdgcn_mfma_f32_16x16x32_bf16(Bt[n][k], At[m][k], __builtin_bit_cast(f32x4, acc[ai][bj][m][n]), 0, 0, 0)); } __builtin_amdgcn_s_setprio(0); } while (0)
#define PG8_WAIT_V(n) asm volatile("s_waitcnt vmcnt(" #n ")" ::: "memory")
#define PG8_WAIT_L(n) asm volatile("s_waitcnt lgkmcnt(" #n ")" ::: "memory")
#define PG8_BAR __builtin_amdgcn_s_barrier()
#define PG8_SCHED __builtin_amdgcn_sched_barrier(0)
    Unit cur, nxt; int ui = 0;
    if (!S.next(0, cur)) return;
    using AccT = typename std::conditional<I8, i32x4, f32x4>::type;
    AccT acc[2][2][4][2];
#pragma unroll
    for (int a = 0; a < 2; ++a)
#pragma unroll
        for (int b = 0; b < 2; ++b)
#pragma unroll
            for (int m = 0; m < 4; ++m)
#pragma unroll
                for (int n = 0; n < 2; ++n) acc[a][b][m][n] = (AccT){0, 0, 0, 0};
    bf16x8 At[4][2], B0[2][2], B1[2][2];
    const char* cA = (const char*)g.A + (size_t)cur.pm * tstepA + (size_t)cur.ka * ES; const char* cB = (const char*)g.Bt + (size_t)cur.pn * tstepB + (size_t)cur.kb * ES;
    PG8_STAGE(PG8_SB(0, 0), cB, voffB); PG8_STAGE(PG8_SB(0, 1), cB + hstepB, voffB); PG8_STAGE(PG8_SA(0, 0), cA, voffA); PG8_STAGE(PG8_SA(0, 1), cA + hstepA, voffA);
    if (wr == 1) PG8_BAR;
    PG8_WAIT_V(2); PG8_BAR;
    PG8_STAGE(PG8_SB(1, 0), cB + kstep, voffB); PG8_STAGE(PG8_SA(1, 0), cA + kstep, voffA); PG8_STAGE(PG8_SB(1, 1), cB + hstepB + kstep, voffB);
    PG8_WAIT_V(6); PG8_BAR;
    unsigned pre2 = 0; unsigned pre = 0;
    for (;;) {
        const bool has_next = S.next(ui + 1, nxt);
        const char* nA = has_next ? (const char*)g.A + (size_t)nxt.pm * tstepA + (size_t)nxt.ka * ES : cA; const char* nB = has_next ? (const char*)g.Bt + (size_t)nxt.pn * tstepB + (size_t)nxt.kb * ES : cB;
#pragma unroll 1
        for (int t = 0; t < nt; t += 2) {
            const bool last = (t == nt - 2);
            if constexpr (PRE) { if (last) { const unsigned* pp = E.pre_ptr(cur, tid); asm volatile("global_load_dword %0, %1, off" : "=v"(pre) : "v"(pp) : "memory");
                                           const unsigned* pq = E.pre_ptr2(cur, tid); asm volatile("global_load_dword %0, %1, off" : "=v"(pre2) : "v"(pq) : "memory"); } }
            const char* a1 = cA + (size_t)(t + 1) * kstep;
            const char* a2 = last ? nA : cA + (size_t)(t + 2) * kstep; const char* b2 = last ? nB : cB + (size_t)(t + 2) * kstep;
            const char* a3 = a2 + kstep; const char* b3 = b2 + kstep;
            PG8_LDB(B0, 0, 0); PG8_LDB(B1, 0, 1); PG8_SCHED; PG8_LDA(At, 0, 0); PG8_STAGE(PG8_SA(1, 1), a1 + hstepA, voffA);
            PG8_WAIT_V(8); PG8_WAIT_L(0); PG8_BAR; PG8_MMA(0, 0, At, B0); PG8_MMA(0, 1, At, B1); PG8_BAR; PG8_SCHED;
            PG8_LDA(At, 0, 1); PG8_STAGE(PG8_SB(0, 0), b2, voffB); PG8_STAGE(PG8_SB(0, 1), b2 + hstepB, voffB); PG8_STAGE(PG8_SA(0, 0), a2, voffA);
            PG8_WAIT_V(8); PG8_WAIT_L(0); PG8_BAR; PG8_MMA(1, 0, At, B0); PG8_MMA(1, 1, At, B1); PG8_BAR; PG8_SCHED;
            PG8_LDB(B0, 1, 0); PG8_LDB(B1, 1, 1); PG8_SCHED; PG8_LDA(At, 1, 0); PG8_STAGE(PG8_SA(0, 1), a2 + hstepA, voffA);
            PG8_WAIT_V(8); PG8_WAIT_L(0); PG8_BAR; PG8_MMA(0, 0, At, B0); PG8_MMA(0, 1, At, B1); PG8_BAR; PG8_SCHED;
            PG8_LDA(At, 1, 1); PG8_STAGE(PG8_SB(1, 0), b3, voffB); PG8_STAGE(PG8_SB(1, 1), b3 + hstepB, voffB); PG8_STAGE(PG8_SA(1, 0), a3, voffA);
            PG8_WAIT_V(8); PG8_WAIT_L(0); PG8_BAR; PG8_MMA(1, 0, At, B0); PG8_MMA(1, 1, At, B1); PG8_BAR; PG8_SCHED;
        }
        if constexpr (ALIGN_EPI) { if (wr == 0) PG8_BAR; }
        if constexpr (PRE) { asm volatile("" : "+v"(pre), "+v"(pre2)); E(acc, cur, wr, wc, fr, fq, eps, tid, pre, pre2); } else E(acc, cur, wr, wc, fr, fq, eps, tid);
        if (!has_next) break;
#pragma unroll
        for (int a = 0; a < 2; ++a)
#pragma unroll
            for (int b = 0; b < 2; ++b)
#pragma unroll
                for (int m = 0; m < 4; ++m)
#pragma unroll
                    for (int n = 0; n < 2; ++n) acc[a][b][m][n] = (AccT){0, 0, 0, 0};
        cur = nxt; cA = nA; cB = nB; ++ui;
        if constexpr (ALIGN_EPI) { if (wr == 1) PG8_BAR; }
    }
    PG8_WAIT_V(0);
    if constexpr (!ALIGN_EPI) { if (wr == 0) PG8_BAR; }
    PG8_BAR;
#undef PG8_SA
#undef PG8_SB
#undef PG8_STAGE
#undef PG8_LDA
#undef PG8_LDB
#undef PG8_MMA
#undef PG8_WAIT_V
#undef PG8_WAIT_L
#undef PG8_BAR
#undef PG8_SCHED
}
}
using pg8::Unit;
typedef const f32x4 (&AccRef)[2][2][4][2];
typedef const i32x4 (&AccRefI)[2][2][4][2];

struct Args { const float* in[23]; float* out; unsigned char* ws; };
static_assert(sizeof(Args) == 25 * 8, "no padding");
typedef const __attribute__((address_space(4))) Args* KArgsP;
__device__ __forceinline__ KArgsP kargs() { KArgsP p = (KArgsP)__builtin_amdgcn_kernarg_segment_ptr(); asm volatile("" : "+s"(p)); return p; }
#define IN_F(i) ((const float*)ka->in[i])
#define WSP(off) (ws + (off))

template <int NR>
__device__ __forceinline__ void quant_rows(const float* eu, const float* ev, unsigned* EU8, unsigned* EV8, float* SU, float* SV, int r0, int lane) {
    f32x4 v[NR][8]; float mx[NR];
#pragma unroll
    for (int a = 0; a < NR; ++a) { const int r = r0 + a; const float* srow = (r >= 16384 ? ev : eu) + (size_t)(r & 16383) * 2048 + 4 * lane; mx[a] = 0.f;
#pragma unroll
        for (int j = 0; j < 8; ++j) v[a][j] = __builtin_nontemporal_load((const f32x4*)(srow + 256 * j)); }
#pragma unroll
    for (int a = 0; a < NR; ++a) {
#pragma unroll
        for (int j = 0; j < 8; ++j) mx[a] = fmaxf(fmaxf(mx[a], fmaxf(fabsf(v[a][j][0]), fabsf(v[a][j][1]))), fmaxf(fabsf(v[a][j][2]), fabsf(v[a][j][3])));
        mx[a] = wave_max(mx[a]); }
#pragma unroll
    for (int a = 0; a < NR; ++a) { const int r = r0 + a, e = r & 16383; const bool isv = r >= 16384;
        const float sc = mx[a] > 0.f ? mx[a] * (1.f / 127.f) : 1.f; const float inv = 1.f / sc;
        unsigned* drow = (isv ? EV8 : EU8) + (size_t)(lane >> 5) * (16384 * 32) + (size_t)e * 32 + (lane & 31);
#pragma unroll
        for (int j = 0; j < 8; ++j) { const int q0 = (int)rintf(v[a][j][0] * inv), q1 = (int)rintf(v[a][j][1] * inv), q2 = (int)rintf(v[a][j][2] * inv), q3 = (int)rintf(v[a][j][3] * inv);
            __builtin_nontemporal_store((unsigned)(q0 & 0xff) | ((unsigned)(q1 & 0xff) << 8) | ((unsigned)(q2 & 0xff) << 16) | ((unsigned)(q3 & 0xff) << 24), drow + (size_t)(2 * j) * (16384 * 32)); }
        if (lane == 0) (isv ? SV : SU)[e] = sc; }
}

#define ALOAD16(dst, ptr) asm volatile("global_load_dwordx4 %0, %1, off" : "=&v"(dst) : "v"(ptr) : "memory")
#define ALOAD8(dst, ptr) asm volatile("global_load_dwordx2 %0, %1, off" : "=&v"(dst) : "v"(ptr) : "memory")
#define ALOAD16O(dst, ptr, off) asm volatile("global_load_dwordx4 %0, %1, off offset:%c2" : "=&v"(dst) : "v"(ptr), "i"(off) : "memory")
#define ALOAD16NT(dst, ptr) asm volatile("global_load_dwordx4 %0, %1, off nt" : "=&v"(dst) : "v"(ptr) : "memory")
#define ALOAD16ONT(dst, ptr, off) asm volatile("global_load_dwordx4 %0, %1, off offset:%c2 nt" : "=&v"(dst) : "v"(ptr), "i"(off) : "memory")
#define AWAIT8(a, b, c, d, e, f, g, h) asm volatile("s_waitcnt vmcnt(0)" : "+v"(a), "+v"(b), "+v"(c), "+v"(d), "+v"(e), "+v"(f), "+v"(g), "+v"(h) :: "memory")
#define AWAIT16(a, b, c, d, e, f, g, h, i, j, k, l, m, n, o, p) asm volatile("s_waitcnt vmcnt(0)" : "+v"(a), "+v"(b), "+v"(c), "+v"(d), "+v"(e), "+v"(f), "+v"(g), "+v"(h), "+v"(i), "+v"(j), "+v"(k), "+v"(l), "+v"(m), "+v"(n), "+v"(o), "+v"(p) :: "memory")

__device__ __forceinline__ u32x4 pack8(f32x4 a, f32x4 b) { u32x4 w; w.x = cvtpk(a[0], a[1]); w.y = cvtpk(a[2], a[3]); w.z = cvtpk(b[0], b[1]); w.w = cvtpk(b[2], b[3]); return w; }
__device__ __forceinline__ u32x2 pack4(f32x4 a) { u32x2 w; w.x = cvtpk(a[0], a[1]); w.y = cvtpk(a[2], a[3]); return w; }
__device__ __forceinline__ float sq4(f32x4 a) { return (a[0] * a[0] + a[1] * a[1]) + (a[2] * a[2] + a[3] * a[3]); }

struct EpiA {
    static constexpr bool PERM = true;
    bf16_t* ZP; bf16_t* CQ; bf16_t* CKV; float* ssq_cq; float* ssq_ckv; const float* RSX; const float* SBW;
    __device__ __forceinline__ const unsigned* pre_ptr(const Unit& u, int tid) const { return (const unsigned*)(RSX + u.pm * 256 + (tid & 255)); }
    __device__ __forceinline__ const unsigned* pre_ptr2(const Unit& u, int tid) const { return (const unsigned*)(SBW + u.pn * 256 + (tid & 255)); }
    __device__ __forceinline__ void operator()(AccRefI acc, const Unit& u, int wr, int wc, int fr, int fq, LAS unsigned char* eps, int tid, unsigned pre, unsigned pre2) const {
        LAS float* R = (LAS float*)(eps + 4096); LAS float* CS = (LAS float*)(eps + 5120);
        if (tid < 256) { R[tid] = __builtin_bit_cast(float, pre); CS[tid] = __builtin_bit_cast(float, pre2); }
        EPI_BAR();
        bf16_t* base; int ldc, colt; float* ssq = nullptr;
        if (u.pn < 4) { base = ZP; ldc = 1024; colt = u.pn * 256; }
        else if (u.pn < 6) { base = CQ; ldc = 512; colt = (u.pn - 4) * 256; ssq = ssq_cq + (u.pn - 4) * 4 + wc; }
        else { base = CKV; ldc = 512; colt = (u.pn - 6) * 256; ssq = ssq_ckv + (u.pn - 6) * 4 + wc; }
        const int row0 = u.pm * 256 + wr * 64 + fr, col0 = colt + wc * 32 + 8 * fq;
        f32x4 cs[2][2];
#pragma unroll
        for (int bj = 0; bj < 2; ++bj)
#pragma unroll
            for (int n = 0; n < 2; ++n) cs[bj][n] = *(const LAS f32x4*)(CS + bj * 128 + wc * 32 + 8 * fq + 4 * n);
#pragma unroll
        for (int ai = 0; ai < 2; ++ai)
#pragma unroll
            for (int m = 0; m < 4; ++m) { const int row = row0 + ai * 128 + m * 16; bf16_t* rowp = base + (size_t)row * ldc + col0; float s = 0.f; const float rs = R[ai * 128 + wr * 64 + m * 16 + fr];
#pragma unroll
                for (int bj = 0; bj < 2; ++bj) { const f32x4 v0 = __builtin_convertvector(acc[ai][bj][m][0], f32x4) * cs[bj][0] * rs, v1 = __builtin_convertvector(acc[ai][bj][m][1], f32x4) * cs[bj][1] * rs;
                    *(u32x4*)(rowp + bj * 128) = pack8(v0, v1); s += sq4(v0) + sq4(v1); }
                if (ssq) { s += __shfl_xor(s, 16); s += __shfl_xor(s, 32); if (fq == 0) ssq[(size_t)row * 8] = s; } }
        EPI_BAR();
    }
};
struct EpiKR {
    static constexpr bool PERM = false;
    bf16_t* KRP; const float* RSX; const float* SBW;
    __device__ __forceinline__ const unsigned* pre_ptr(const Unit& u, int tid) const { return (const unsigned*)(RSX + u.pm * 256 + (tid & 255)); }
    __device__ __forceinline__ const unsigned* pre_ptr2(const Unit& u, int tid) const { return (const unsigned*)(SBW + u.pn * 256 + (tid & 255)); }
    __device__ __forceinline__ void operator()(AccRefI acc, const Unit& u, int wr, int wc, int fr, int fq, LAS unsigned char* eps, int tid, unsigned pre, unsigned pre2) const {
        LAS float* R = (LAS float*)(eps + 4096); LAS float* CS = (LAS float*)(eps + 5120);
        if (tid < 256) { R[tid] = __builtin_bit_cast(float, pre); CS[tid] = __builtin_bit_cast(float, pre2); }
        EPI_BAR();
        if (wc < 2) { const int ks = u.ka >> 9; const int row0 = u.pm * 256 + wr * 64 + fr;
#pragma unroll
            for (int ai = 0; ai < 2; ++ai)
#pragma unroll
                for (int m = 0; m < 4; ++m) { const int row = row0 + ai * 128 + m * 16; const float rs = R[ai * 128 + wr * 64 + m * 16 + fr];
#pragma unroll
                    for (int n = 0; n < 2; ++n) *(u32x2*)(KRP + ((size_t)ks * M + row) * 64 + 32 * wc + 16 * n + 4 * fq) = pack4(__builtin_convertvector(acc[ai][0][m][n], f32x4) * *(const LAS f32x4*)(CS + 32 * wc + 16 * n + 4 * fq) * rs); } }
        { const int uid = u.pm * 4 + (u.ka >> 9); KArgsP ka = kargs(); unsigned char* ws = ka->ws; const float* p_in = IN_F(1); const float* sk1 = IN_F(16); const float* sk2 = IN_F(17);
          bf16_t* PB = (bf16_t*)WSP(WS_PB); bf16_t* SKB = (bf16_t*)WSP(WS_SK);
          for (int i = tid; i < 2176; i += 512) { long j = (long)uid * 2176 + i; const float* src; bf16_t* dst;
              if (j < 524288) { src = p_in; dst = PB; } else if ((j -= 524288) < 16384) { src = sk1; dst = SKB; } else { j -= 16384; src = sk2; dst = SKB + 131072; }
              const f32x4 a = *(const f32x4*)(src + j * 8), b = *(const f32x4*)(src + j * 8 + 4); *(u32x4*)(dst + j * 8) = pack8(a, b); } }
        EPI_BAR();
    }
};
struct EpiStore {
    static constexpr bool PERM = true;
    bf16_t* O; int ldc;
    __device__ __forceinline__ void operator()(AccRef acc, const Unit& u, int wr, int wc, int fr, int fq, LAS unsigned char*, int) const {
        const int row0 = u.pm * 256 + wr * 64 + fr, col0 = u.pn * 256 + wc * 32 + 8 * fq;
#pragma unroll
        for (int ai = 0; ai < 2; ++ai)
#pragma unroll
            for (int m = 0; m < 4; ++m) { bf16_t* rowp = O + (size_t)(row0 + ai * 128 + m * 16) * ldc + col0;
#pragma unroll
                for (int bj = 0; bj < 2; ++bj) *(u32x4*)(rowp + bj * 128) = pack8(acc[ai][bj][m][0], acc[ai][bj][m][1]); }
    }
};
struct EpiQ {
    static constexpr bool PERM = false;
    bf16_t* Q; const float* ssq_cq; const float* qg; const float* COS; const float* SIN;
    __device__ __forceinline__ void operator()(AccRef acc, const Unit& u, int wr, int wc, int fr, int fq, LAS unsigned char* eps, int tid) const {
        LAS float* P = (LAS float*)eps; LAS float* R = (LAS float*)(eps + 4096);
        const int h = u.pn, rowt = u.pm * 256;
        { const f32x4 a = *(const f32x4*)(ssq_cq + (size_t)(rowt + (tid >> 1)) * 8 + 4 * (tid & 1)); float s = (a[0] + a[1]) + (a[2] + a[3]); s += DPP_F(s, 0xB1);
          if ((tid & 1) == 0) R[tid >> 1] = rsqrtf(s * (1.f / 512.f) + EPS); }
#pragma unroll
        for (int ai = 0; ai < 2; ++ai)
#pragma unroll
            for (int m = 0; m < 4; ++m) { const int r = ai * 128 + wr * 64 + m * 16 + fr; float s = 0.f;
#pragma unroll
                for (int bj = 0; bj < 2; ++bj)
#pragma unroll
                    for (int n = 0; n < 2; ++n) s += sq4(acc[ai][bj][m][n]);
                s += __shfl_xor(s, 16); s += __shfl_xor(s, 32); if (fq == 0) P[r * 4 + wc] = s; }
        EPI_BAR();
        const int dn = 32 * wc + 4 * fq, j = 16 * wc + 4 * fq;
        const f32x4 g0 = *(const f32x4*)(qg + dn), g1 = *(const f32x4*)(qg + dn + 16);
        f32x4 gr1 = {0.f, 0.f, 0.f, 0.f}, gr2 = gr1; if (wc < 2) { gr1 = *(const f32x4*)(qg + 128 + j); gr2 = *(const f32x4*)(qg + 160 + j); }
#pragma unroll
        for (int ai = 0; ai < 2; ++ai)
#pragma unroll
            for (int m = 0; m < 4; ++m) { const int r = ai * 128 + wr * 64 + m * 16 + fr; const float rc = R[r]; const f32x4 pp = *(LAS f32x4*)(P + r * 4);
                const float ss = ((pp[0] + pp[1]) + (pp[2] + pp[3])) * rc * rc; const float sc = rc * rsqrtf(ss * (1.f / 192.f) + EPS);
                const size_t grow = (size_t)(rowt + r); bf16_t* qrow = Q + grow * 1536 + h * 192;
                *(u32x2*)(qrow + dn) = pack4(acc[ai][0][m][0] * sc * g0); *(u32x2*)(qrow + dn + 16) = pack4(acc[ai][0][m][1] * sc * g1);
                if (wc < 2) { const f32x4 x1 = acc[ai][1][m][0] * sc * gr1, x2 = acc[ai][1][m][1] * sc * gr2;
                    const u32x4 cw = *(const u32x4*)((const bf16_t*)COS + grow * 64 + 2 * j); const f32x4 c4 = {bf_lo(cw.x), bf_hi(cw.x), bf_lo(cw.y), bf_hi(cw.y)}, s4 = {bf_lo(cw.z), bf_hi(cw.z), bf_lo(cw.w), bf_hi(cw.w)};
                    *(u32x2*)(qrow + 128 + j) = pack4(x1 * c4 - x2 * s4); *(u32x2*)(qrow + 160 + j) = pack4(x2 * c4 + x1 * s4); } }
    }
};
struct EpiKV {
    static constexpr bool PERM = true;
    bf16_t* K; bf16_t* V; const float* ssq_ckv; const bf16_t* KRP; const float* kg; const float* COS; const float* SIN;
    __device__ __forceinline__ void operator()(AccRef acc, const Unit& u, int wr, int wc, int fr, int fq, LAS unsigned char* eps, int tid) const {
        LAS float* P = (LAS float*)eps; LAS float* R = (LAS float*)(eps + 4096); LAS float* R2 = (LAS float*)(eps + 5120);
        const int h = u.pn, rowt = u.pm * 256;
        { const f32x4 a = *(const f32x4*)(ssq_ckv + (size_t)(rowt + (tid >> 1)) * 8 + 4 * (tid & 1)); float s = (a[0] + a[1]) + (a[2] + a[3]); s += DPP_F(s, 0xB1);
          if ((tid & 1) == 0) R[tid >> 1] = rsqrtf(s * (1.f / 512.f) + EPS); }
        int tq = tid; asm volatile("" : "+v"(tq));
        const int rc = tq & 15, rb = tq >> 4;
#pragma unroll
        for (int ai = 0; ai < 2; ++ai)
#pragma unroll
            for (int m = 0; m < 4; ++m) { const int r = ai * 128 + wr * 64 + m * 16 + fr; float s = sq4(acc[ai][0][m][0]) + sq4(acc[ai][0][m][1]);
                s += __shfl_xor(s, 16); s += __shfl_xor(s, 32); if (fq == 0) P[r * 4 + wc] = s; }
        EPI_BAR();
        { const int jj = 4 * (rc & 7); const bool hi8 = rc >= 8;
          const f32x4 ga = *(const f32x4*)(kg + 128 + jj), gb = *(const f32x4*)(kg + 160 + jj);
#pragma unroll
          for (int k = 0; k < 8; ++k) { u32x2 pw[4]; u32x4 cw; f32x4 pv[4], c4, s4;
            const int row = rb + 32 * k; const size_t grw = (size_t)(rowt + row); const bf16_t* p = KRP + grw * 64 + 4 * rc;
#pragma unroll
            for (int q = 0; q < 4; ++q) { const bf16_t* pq = p + (size_t)q * M * 64; ALOAD8(pw[q], pq); }
            { const bf16_t* pc = (const bf16_t*)COS + grw * 64 + 2 * jj; ALOAD16(cw, pc); }
            asm volatile("s_waitcnt vmcnt(0)" : "+v"(pw[0]), "+v"(pw[1]), "+v"(pw[2]), "+v"(pw[3]), "+v"(cw) :: "memory");
            c4 = (f32x4){bf_lo(cw.x), bf_hi(cw.x), bf_lo(cw.y), bf_hi(cw.y)}; s4 = (f32x4){bf_lo(cw.z), bf_hi(cw.z), bf_lo(cw.w), bf_hi(cw.w)};
#pragma unroll
            for (int q = 0; q < 4; ++q) pv[q] = (f32x4){bf_lo(pw[q].x), bf_hi(pw[q].x), bf_lo(pw[q].y), bf_hi(pw[q].y)};
            const f32x4 mine = (pv[0] + pv[1]) + (pv[2] + pv[3]); float s2 = sq4(mine); s2 += DPP_F(s2, 0xB1); s2 += DPP_F(s2, 0x4E); s2 += DPP_F(s2, 0x141); s2 += DPP_F(s2, 0x128); if (rc == 0) R2[row] = s2; f32x4 oth; oth[0] = DPP_F(mine[0], 0x128); oth[1] = DPP_F(mine[1], 0x128); oth[2] = DPP_F(mine[2], 0x128); oth[3] = DPP_F(mine[3], 0x128);
            const float rc_ = R[row]; const f32x4 pp = *(LAS f32x4*)(P + row * 4); const float ssn = ((pp[0] + pp[1]) + (pp[2] + pp[3])) * rc_ * rc_;
            const float rk = rsqrtf((ssn + s2) * (1.f / 192.f) + EPS);
            const f32x4 x1 = (hi8 ? oth : mine) * ga, x2 = (hi8 ? mine : oth) * gb;
            const f32x4 o = (hi8 ? (x2 * c4 + x1 * s4) : (x1 * c4 - x2 * s4)) * rk;
            *(u32x2*)(K + grw * 1536 + h * 192 + 128 + 4 * rc) = pack4(o); } }
        EPI_BAR();
        const int dn = 32 * wc + 8 * fq;
        const f32x4 g0 = *(const f32x4*)(kg + dn), g1 = *(const f32x4*)(kg + dn + 4);
#pragma unroll
        for (int ai = 0; ai < 2; ++ai)
#pragma unroll
            for (int m = 0; m < 4; ++m) { const int r = ai * 128 + wr * 64 + m * 16 + fr; const float rc = R[r]; const f32x4 pp = *(LAS f32x4*)(P + r * 4);
                const float ssn = ((pp[0] + pp[1]) + (pp[2] + pp[3])) * rc * rc; const float sk = rc * rsqrtf((ssn + R2[r]) * (1.f / 192.f) + EPS);
                const size_t grow = (size_t)(rowt + r);
                bf16_t* vrow = V + grow * 1024 + h * 128 + dn; *(u32x4*)vrow = pack8(acc[ai][1][m][0] * rc, acc[ai][1][m][1] * rc);
                bf16_t* krow = K + grow * 1536 + h * 192 + dn; *(u32x4*)krow = pack8(acc[ai][0][m][0] * sk * g0, acc[ai][0][m][1] * sk * g1); }
    }
};
struct EpiH1 {
    static constexpr bool PERM = true;
    const unsigned char* XQ; const float* SXA; bf16_t* H1B; const float* SY; const float* SBO;
    __device__ __forceinline__ const unsigned* pre_ptr(const Unit& u, int tid) const { return tid < 256 ? (const unsigned*)(SY + u.pm * 256 + tid) : (const unsigned*)(SXA + u.pm * 256 + tid - 256); }
    __device__ __forceinline__ const unsigned* pre_ptr2(const Unit& u, int tid) const { return (const unsigned*)(SBO + u.pn * 256 + (tid & 255)); }
    __device__ __forceinline__ void operator()(AccRefI acc, const Unit& u, int wr, int wc, int fr, int fq, LAS unsigned char* eps, int tid, unsigned pre, unsigned pre2) const {
        LAS float* R = (LAS float*)(eps + 4096); LAS float* CS = (LAS float*)(eps + 5120); LAS float* XS = (LAS float*)(eps + 6144);
        asm volatile("" : "+v"(fr), "+v"(fq));
        if (tid < 256) { R[tid] = __builtin_bit_cast(float, pre); CS[tid] = __builtin_bit_cast(float, pre2); } else XS[tid - 256] = __builtin_bit_cast(float, pre);
        EPI_BAR();
        const int row0 = u.pm * 256 + wr * 64 + fr, col0 = u.pn * 256 + wc * 32 + 8 * fq;
#pragma unroll
        for (int ai = 0; ai < 2; ++ai) {
            u32x2 xq[4][2];
#pragma unroll
            for (int m = 0; m < 4; ++m)
#pragma unroll
                for (int bj = 0; bj < 2; ++bj) { const unsigned char* p = XQ + (size_t)(row0 + ai * 128 + m * 16) * DM + col0 + bj * 128; ALOAD8(xq[m][bj], p); }
            AWAIT8(xq[0][0], xq[0][1], xq[1][0], xq[1][1], xq[2][0], xq[2][1], xq[3][0], xq[3][1]);
#pragma unroll
            for (int m = 0; m < 4; ++m) { const int r = ai * 128 + wr * 64 + m * 16 + fr; const size_t off = (size_t)(u.pm * 256 + r) * DM + col0; const float rs = R[r], sx = XS[r];
#pragma unroll
                for (int bj = 0; bj < 2; ++bj) { const u32x2 w = xq[m][bj]; const LAS float* cp = CS + bj * 128 + wc * 32 + 8 * fq;
                    const f32x4 x0 = (f32x4){(float)((int)(w.x << 24) >> 24), (float)((int)(w.x << 16) >> 24), (float)((int)(w.x << 8) >> 24), (float)((int)w.x >> 24)} * sx,
                                x1 = (f32x4){(float)((int)(w.y << 24) >> 24), (float)((int)(w.y << 16) >> 24), (float)((int)(w.y << 8) >> 24), (float)((int)w.y >> 24)} * sx;
                    const f32x4 h0 = x0 + __builtin_convertvector(acc[ai][bj][m][0], f32x4) * *(const LAS f32x4*)cp * rs, h1 = x1 + __builtin_convertvector(acc[ai][bj][m][1], f32x4) * *(const LAS f32x4*)(cp + 4) * rs;
                    *(u32x4*)(H1B + off + bj * 128) = pack8(h0, h1); } }
        }
        EPI_BAR();
    }
};
struct EpiQP {
    static constexpr bool PERM = true;
    bf16_t* QP; const float* RQ2; const float* SBQ;
    __device__ __forceinline__ const unsigned* pre_ptr(const Unit& u, int tid) const { return (const unsigned*)(RQ2 + u.pm * 256 + (tid & 255)); }
    __device__ __forceinline__ const unsigned* pre_ptr2(const Unit& u, int tid) const { return (const unsigned*)(SBQ + u.pn * 256 + (tid & 255)); }
    __device__ __forceinline__ void operator()(AccRefI acc, const Unit& u, int wr, int wc, int fr, int fq, LAS unsigned char* eps, int tid, unsigned pre, unsigned pre2) const {
        LAS float* R = (LAS float*)(eps + 4096); LAS float* CS = (LAS float*)(eps + 5120);
        if (tid < 256) { R[tid] = __builtin_bit_cast(float, pre); CS[tid] = __builtin_bit_cast(float, pre2); }
        EPI_BAR();
        const int col0 = u.pn * 256 + wc * 32 + 8 * fq;
        f32x4 cs[2][2];
#pragma unroll
        for (int bj = 0; bj < 2; ++bj)
#pragma unroll
            for (int n = 0; n < 2; ++n) cs[bj][n] = *(const LAS f32x4*)(CS + bj * 128 + wc * 32 + 8 * fq + 4 * n);
#pragma unroll
        for (int ai = 0; ai < 2; ++ai)
#pragma unroll
            for (int m = 0; m < 4; ++m) { const int r = ai * 128 + wr * 64 + m * 16 + fr; const float rs = R[r]; bf16_t* rowp = QP + (size_t)(u.pm * 256 + r) * DM + col0;
#pragma unroll
                for (int bj = 0; bj < 2; ++bj) *(u32x4*)(rowp + bj * 128) = pack8(__builtin_convertvector(acc[ai][bj][m][0], f32x4) * cs[bj][0] * rs, __builtin_convertvector(acc[ai][bj][m][1], f32x4) * cs[bj][1] * rs); }
        EPI_BAR();
    }
};
struct EpiStoreQ {
    static constexpr bool PERM = true;
    unsigned char* PQ; float* PSC;
    __device__ __forceinline__ void operator()(AccRef acc, const Unit& u, int wr, int wc, int fr, int fq, LAS unsigned char* eps, int) const {
        LAS float* P = (LAS float*)eps;
#pragma unroll
        for (int ai = 0; ai < 2; ++ai)
#pragma unroll
            for (int m = 0; m < 4; ++m) { const int r = ai * 128 + wr * 64 + m * 16 + fr; float mx = 0.f;
#pragma unroll
                for (int bj = 0; bj < 2; ++bj)
#pragma unroll
                    for (int n = 0; n < 2; ++n) { const f32x4 v = acc[ai][bj][m][n]; mx = fmaxf(mx, fmaxf(fmaxf(fabsf(v[0]), fabsf(v[1])), fmaxf(fabsf(v[2]), fabsf(v[3])))); }
                mx = fmaxf(mx, __shfl_xor(mx, 16)); mx = fmaxf(mx, __shfl_xor(mx, 32)); if (fq == 0) P[r * 4 + wc] = mx; }
        EPI_BAR();
        const int col0 = u.pn * 256 + wc * 32 + 8 * fq;
#pragma unroll
        for (int ai = 0; ai < 2; ++ai)
#pragma unroll
            for (int m = 0; m < 4; ++m) { const int r = ai * 128 + wr * 64 + m * 16 + fr; const f32x4 pp = *(LAS f32x4*)(P + r * 4);
                const float rm = fmaxf(fmaxf(pp[0], pp[1]), fmaxf(pp[2], pp[3])); const float sc = rm > 0.f ? rm * (1.f / 127.f) : 1.f, inv = 1.f / sc;
                const size_t row = (size_t)(u.pm * 256 + r);
#pragma unroll
                for (int bj = 0; bj < 2; ++bj) { u32x2 o;
#pragma unroll
                    for (int n = 0; n < 2; ++n) { const f32x4 v = acc[ai][bj][m][n] * inv; const unsigned wd = (unsigned)((int)rintf(v[0]) & 0xff) | ((unsigned)((int)rintf(v[1]) & 0xff) << 8) | ((unsigned)((int)rintf(v[2]) & 0xff) << 16) | ((unsigned)((int)rintf(v[3]) & 0xff) << 24);
                        if (n == 0) o.x = wd; else o.y = wd; }
                    *(u32x2*)(PQ + row * 2048 + col0 + bj * 128) = o; }
                if (wc == 0 && fq == 0) PSC[row * 8 + u.pn] = sc; }
        EPI_BAR();
    }
};
struct EpiGate {
    static constexpr bool PERM = true;
    float* OUT; const unsigned char* PQ; const float* PSC; const float* RQ3; const float* SBG; const bf16_t* H2B;
    __device__ __forceinline__ const unsigned* pre_ptr(const Unit& u, int tid) const { return tid < 256 ? (const unsigned*)(RQ3 + u.pm * 256 + tid) : (const unsigned*)(PSC + (size_t)(u.pm * 256 + tid - 256) * 8 + u.pn); }
    __device__ __forceinline__ const unsigned* pre_ptr2(const Unit& u, int tid) const { return (const unsigned*)(SBG + u.pn * 256 + (tid & 255)); }
    __device__ __forceinline__ void operator()(AccRefI acc, const Unit& u, int wr, int wc, int fr, int fq, LAS unsigned char* eps, int tid, unsigned pre, unsigned pre2) const {
        LAS float* R = (LAS float*)(eps + 4096); LAS float* CS = (LAS float*)(eps + 5120); LAS float* PS = (LAS float*)(eps + 6144);
        if (tid < 256) { R[tid] = __builtin_bit_cast(float, pre); CS[tid] = __builtin_bit_cast(float, pre2); } else PS[tid - 256] = __builtin_bit_cast(float, pre);
        EPI_BAR();
        const int row0 = u.pm * 256 + wr * 64 + fr, col0 = u.pn * 256 + wc * 32 + 8 * fq;
#pragma unroll
        for (int ai = 0; ai < 2; ++ai) {
            u32x2 pj[4][2]; u32x4 hv[4][2];
#pragma unroll
            for (int m = 0; m < 4; ++m)
#pragma unroll
                for (int bj = 0; bj < 2; ++bj) { const size_t off = (size_t)(row0 + ai * 128 + m * 16) * DM + col0 + bj * 128; const unsigned char* pp = PQ + off; const bf16_t* ph = H2B + off; ALOAD8(pj[m][bj], pp); ALOAD16(hv[m][bj], ph); }
            AWAIT16(pj[0][0], pj[0][1], pj[1][0], pj[1][1], pj[2][0], pj[2][1], pj[3][0], pj[3][1], hv[0][0], hv[0][1], hv[1][0], hv[1][1], hv[2][0], hv[2][1], hv[3][0], hv[3][1]);
#pragma unroll
            for (int m = 0; m < 4; ++m) { const int row = row0 + ai * 128 + m * 16; const float rs = R[ai * 128 + wr * 64 + m * 16 + fr], ps = PS[ai * 128 + wr * 64 + m * 16 + fr]; const size_t off = (size_t)row * DM + col0;
#pragma unroll
                for (int bj = 0; bj < 2; ++bj) { const u32x2 pw = pj[m][bj]; const u32x4 hw = hv[m][bj];
                    const f32x4 p0 = (f32x4){(float)((int)(pw.x << 24) >> 24), (float)((int)(pw.x << 16) >> 24), (float)((int)(pw.x << 8) >> 24), (float)((int)pw.x >> 24)} * ps,
                                p1 = (f32x4){(float)((int)(pw.y << 24) >> 24), (float)((int)(pw.y << 16) >> 24), (float)((int)(pw.y << 8) >> 24), (float)((int)pw.y >> 24)} * ps;
                    const float rn = rs * -1.4426950408889634f; const LAS float* cp = CS + bj * 128 + wc * 32 + 8 * fq;
                    const f32x4 a0 = __builtin_convertvector(acc[ai][bj][m][0], f32x4) * *(const LAS f32x4*)cp * rn, a1 = __builtin_convertvector(acc[ai][bj][m][1], f32x4) * *(const LAS f32x4*)(cp + 4) * rn;
                    f32x4 g0, g1;
#pragma unroll
                    for (int e = 0; e < 4; ++e) { g0[e] = __builtin_amdgcn_rcpf(1.f + __builtin_amdgcn_exp2f(a0[e])); g1[e] = __builtin_amdgcn_rcpf(1.f + __builtin_amdgcn_exp2f(a1[e])); }
                    float* o = OUT + off + bj * 128;
                    const f32x4 h0 = {bf_lo(hw.x), bf_hi(hw.x), bf_lo(hw.y), bf_hi(hw.y)}, h1 = {bf_lo(hw.z), bf_hi(hw.z), bf_lo(hw.w), bf_hi(hw.w)};
                    *(f32x4*)o = h0 + g0 * p0; *(f32x4*)(o + 4) = h1 + g1 * p1; } }
        }
        EPI_BAR();
    }
};

typedef GAS unsigned gu32;
#define RLX_AGENT __ATOMIC_RELAXED, __HIP_MEMORY_SCOPE_AGENT
#define XB_TMO      128
#define XB_XCNT(j)  (256  + 64 * (j))
#define XB_XSUB(j)  (1280 + 64 * (j))
#define XB_XGEN(j)  (2304 + 64 * (j))
#define XB_TOP      3328
#define XB_TOPGEN   3392
#define XCD_BAR_WORDS 3456
#define XB_SPIN_CAP (1u << 20)
__device__ __forceinline__ unsigned xb_ld(unsigned* p)              { return __hip_atomic_load(p, __ATOMIC_RELAXED, __HIP_MEMORY_SCOPE_AGENT); }
__device__ __forceinline__ unsigned xb_add(unsigned* p, unsigned v) { return __hip_atomic_fetch_add(p, v, __ATOMIC_RELAXED, __HIP_MEMORY_SCOPE_AGENT); }
__device__ __forceinline__ unsigned xb_xcc_id() { return (unsigned)__builtin_amdgcn_s_getreg((3 << 11) | 20) & 0xFu; }
#define XB_SPIN(cond, bar) do { unsigned _sp = 0; while (cond) { __builtin_amdgcn_s_sleep(1); \
    if ((++_sp & 255u) == 0u) { if (xb_ld(&(bar)[XB_TMO])) break; if (_sp > XB_SPIN_CAP) { atomicAdd(&(bar)[XB_TMO], 1u); break; } } } } while (0)
struct XcdBarrier { unsigned* bar; unsigned x; volatile LAS unsigned* st; int w0; };
__device__ __forceinline__ XcdBarrier xcd_barrier_post(unsigned* bar, volatile LAS unsigned* st, int w0) {
    XcdBarrier b; b.bar = bar; b.x = xb_xcc_id(); b.st = st; b.w0 = w0;
    if (tid_of(w0) == 0) (void)xb_add(&bar[XB_XCNT(b.x)], 1u);
    return b;
}
__device__ __forceinline__ void xcd_barrier_complete(unsigned* bar, unsigned x, unsigned& nloc, unsigned& nx) {
    const unsigned G = gridDim.x * gridDim.y * gridDim.z;
    unsigned sum, cnt, mine, sp = 0u;
    for (;;) {
        sum = 0u; cnt = 0u; mine = 0u;
#pragma unroll
        for (unsigned j = 0; j < 16; ++j) { const unsigned c = xb_ld(&bar[XB_XCNT(j)]); sum += c; cnt += (c > 0u) ? 1u : 0u; mine = (j == x) ? c : mine; }
        if (sum == G) break;
        __builtin_amdgcn_s_sleep(1);
        if ((++sp & 255u) == 0u) { if (xb_ld(&bar[XB_TMO])) break; if (sp > XB_SPIN_CAP) { atomicAdd(&bar[XB_TMO], 1u); break; } }
    }
    nloc = mine > 0u ? mine : 1u; nx = cnt > 0u ? cnt : 1u;
}
__device__ __forceinline__ void xcd_barrier(const XcdBarrier& b) {
    asm volatile("s_waitcnt vmcnt(0)" ::: "memory");
    __syncthreads();
    if (tid_of(b.w0) == 0) {
        unsigned* bar = b.bar;
        __builtin_amdgcn_s_waitcnt(0);
        unsigned nloc = b.st[0], nx = b.st[1];
        if (nloc == 0u) { xcd_barrier_complete(bar, b.x, nloc, nx); b.st[0] = nloc; b.st[1] = nx; }
        const unsigned old = xb_add(&bar[XB_XSUB(b.x)], 1u);
        const unsigned gen = old / nloc;
        if (old + 1u == (gen + 1u) * nloc) {
            __builtin_amdgcn_fence(__ATOMIC_RELEASE, "agent");
            asm volatile("s_waitcnt vmcnt(0)" ::: "memory");
            const unsigned og = xb_add(&bar[XB_TOP], 1u);
            const unsigned tg = og / nx;
            if (og + 1u == (tg + 1u) * nx) xb_add(&bar[XB_TOPGEN], 1u);
            else XB_SPIN(xb_ld(&bar[XB_TOPGEN]) == tg, bar);
            __builtin_amdgcn_fence(__ATOMIC_ACQUIRE, "agent");
            xb_add(&bar[XB_XGEN(b.x)], 1u);
            asm volatile("s_waitcnt vmcnt(0)" ::: "memory");
        } else {
            XB_SPIN(xb_ld(&bar[XB_XGEN(b.x)]) == gen, bar);
            __builtin_amdgcn_fence(__ATOMIC_ACQUIRE, "agent");
            asm volatile("s_waitcnt vmcnt(0)" ::: "memory");
        }
    }
    __syncthreads();
}

__device__ __forceinline__ int uq_row(int n) {
    const int h = n / 192, d = n - h * 192; int slot;
    if (d < 128) slot = d; else { const int j = d - 128; if (j < 32) slot = 128 + 32 * (j >> 4) + (j & 15); else { const int jj = j - 32; slot = 128 + 32 * (jj >> 4) + 16 + (jj & 15); } }
    return h * 256 + slot;
}
template <int MAP>
__device__ __forceinline__ void tr_item(const float* W, int ldw, int col_off, const float* gk, const float* gn, bf16_t* WT, int ldt, int row_off, int nblk, LAS float* scr, int item, int lane) {
    const int kb = item / nblk, nb = item - kb * nblk, k0 = 64 * kb, n0 = 32 * nb;
#pragma unroll
    for (int i = 0; i < 32; ++i) { const int kk = 2 * i + (lane >> 5); float v = W[(size_t)(k0 + kk) * ldw + col_off + n0 + (lane & 31)]; if (gk) v *= gk[k0 + kk]; scr[kk * 33 + (lane & 31)] = v; }
    asm volatile("s_waitcnt lgkmcnt(0)" ::: "memory");
    const int c = lane & 7;
#pragma unroll
    for (int j = 0; j < 4; ++j) { const int n = (lane >> 3) + 8 * j; const LAS float* s = scr + (8 * c) * 33 + n; const float g = gn ? gn[n0 + n] : 1.f;
        u32x4 o; o.x = cvtpk(s[0 * 33] * g, s[1 * 33] * g); o.y = cvtpk(s[2 * 33] * g, s[3 * 33] * g); o.z = cvtpk(s[4 * 33] * g, s[5 * 33] * g); o.w = cvtpk(s[6 * 33] * g, s[7 * 33] * g);
        const int drow = (MAP == 1) ? uq_row(n0 + n) : (row_off + n0 + n);
        *(u32x4*)(WT + (size_t)drow * ldt + k0 + 8 * c) = o; }
    asm volatile("s_waitcnt lgkmcnt(0)" ::: "memory");
}

struct TrP { const float* W; const float* gk; const float* gn; bf16_t* WT; int ldw, ldt, nblk, item, map; };
__device__ __forceinline__ void tr_load(const TrP& p, float (&v)[32], int lane) {
    const int kb = p.item / p.nblk, nb = p.item - kb * p.nblk, k0 = 64 * kb, n0 = 32 * nb;
#pragma unroll
    for (int i = 0; i < 32; ++i) { const int kk = 2 * i + (lane >> 5); v[i] = p.W[(size_t)(k0 + kk) * p.ldw + n0 + (lane & 31)]; }
    if (p.gk) {
#pragma unroll
        for (int i = 0; i < 32; ++i) v[i] *= p.gk[k0 + 2 * i + (lane >> 5)]; }
}
__device__ __forceinline__ void tr_store(const TrP& p, const float (&v)[32], LAS float* scr, int lane) {
    const int kb = p.item / p.nblk, nb = p.item - kb * p.nblk, k0 = 64 * kb, n0 = 32 * nb;
#pragma unroll
    for (int i = 0; i < 32; ++i) scr[(2 * i + (lane >> 5)) * 33 + (lane & 31)] = v[i];
    asm volatile("s_waitcnt lgkmcnt(0)" ::: "memory");
    const int c = lane & 7;
#pragma unroll
    for (int j = 0; j < 4; ++j) { const int n = (lane >> 3) + 8 * j; const LAS float* s = scr + (8 * c) * 33 + n; const float g = p.gn ? p.gn[n0 + n] : 1.f;
        u32x4 o; o.x = cvtpk(s[0 * 33] * g, s[1 * 33] * g); o.y = cvtpk(s[2 * 33] * g, s[3 * 33] * g); o.z = cvtpk(s[4 * 33] * g, s[5 * 33] * g); o.w = cvtpk(s[6 * 33] * g, s[7 * 33] * g);
        const int drow = p.map ? uq_row(n0 + n) : (n0 + n);
        *(u32x4*)(p.WT + (size_t)drow * p.ldt + k0 + 8 * c) = o; }
    asm volatile("s_waitcnt lgkmcnt(0)" ::: "memory");
}

__device__ __forceinline__ void i8_strip(const float* W, int ldw, const float* gk, unsigned char* WQ, float* SB, int n0, LAS unsigned char* lds, int wave, int lane) {
    const int c4 = lane & 7, kr = lane >> 3;
    const float* wp = W + (size_t)(256 * wave + 4 * kr) * ldw + n0 + 4 * c4; const float* gp = gk + 256 * wave + 4 * kr;
    f32x4 v[8][4];
    f32x4 mx = {0.f, 0.f, 0.f, 0.f};
#pragma unroll
    for (int i = 0; i < 8; ++i)
#pragma unroll
        for (int j = 0; j < 4; ++j) v[i][j] = __builtin_nontemporal_load((const f32x4*)(wp + (size_t)(32 * i + j) * ldw));
#pragma unroll
    for (int i = 0; i < 8; ++i) { f32x4 g4 = {1.f, 1.f, 1.f, 1.f}; if (gk) g4 = *(const f32x4*)(gp + 32 * i);
#pragma unroll
        for (int j = 0; j < 4; ++j) { v[i][j] *= g4[j];
#pragma unroll
            for (int e = 0; e < 4; ++e) mx[e] = fmaxf(mx[e], fabsf(v[i][j][e])); } }
#pragma unroll
    for (int e = 0; e < 4; ++e) { mx[e] = fmaxf(mx[e], __shfl_xor(mx[e], 8)); mx[e] = fmaxf(mx[e], __shfl_xor(mx[e], 16)); mx[e] = fmaxf(mx[e], __shfl_xor(mx[e], 32)); }
    LAS float* cm = (LAS float*)(lds + EPI_OFF);
    if (kr == 0) *(LAS f32x4*)(cm + wave * 32 + 4 * c4) = mx;
    __syncthreads();
    f32x4 cmax = *(const LAS f32x4*)(cm + 4 * c4);
#pragma unroll
    for (int w = 1; w < 8; ++w) { const f32x4 o = *(const LAS f32x4*)(cm + w * 32 + 4 * c4);
#pragma unroll
        for (int e = 0; e < 4; ++e) cmax[e] = fmaxf(cmax[e], o[e]); }
    f32x4 sc, inv;
#pragma unroll
    for (int e = 0; e < 4; ++e) { sc[e] = cmax[e] > 0.f ? cmax[e] * (1.f / 127.f) : 1.f; inv[e] = 1.f / sc[e]; }
    if (wave == 0 && kr == 0) *(f32x4*)(SB + n0 + 4 * c4) = sc;
    LAS unsigned char* tb = lds + wave * 16384;
#pragma unroll
    for (int i = 0; i < 8; ++i)
#pragma unroll
        for (int e = 0; e < 4; ++e) { unsigned wd = 0;
#pragma unroll
            for (int j = 0; j < 4; ++j) wd |= ((unsigned)((int)rintf(v[i][j][e] * inv[e]) & 0xff)) << (8 * j);
            *(LAS unsigned*)(tb + (4 * c4 + e) * 272 + 32 * i + 4 * kr) = wd; }
    asm volatile("s_waitcnt lgkmcnt(0)" ::: "memory");
#pragma unroll
    for (int r = 0; r < 8; ++r) { const int id = lane + 64 * r, n = id >> 4, ch = id & 15;
        *(u32x4*)(WQ + (size_t)(n0 + n) * 2048 + 256 * wave + 16 * ch) = *(const LAS u32x4*)(tb + n * 272 + 16 * ch); }
    asm volatile("s_waitcnt lgkmcnt(0)" ::: "memory");
    __syncthreads();
}
template <int NR, bool NORM> __device__ __forceinline__ void quant_act_rows(const bf16_t* src, unsigned char* dstq, float* rq, float* rstd_out, int row0, int lane) {
    u32x4 v[NR][4];
#pragma unroll
    for (int a = 0; a < NR; ++a)
#pragma unroll
        for (int j = 0; j < 4; ++j) v[a][j] = *(const u32x4*)(src + (size_t)(row0 + a) * 2048 + 8 * lane + 512 * j);
#pragma unroll
    for (int a = 0; a < NR; ++a) { float f[32]; float ss = 0.f, mx = 0.f;
#pragma unroll
        for (int j = 0; j < 4; ++j) { const unsigned w[4] = {v[a][j].x, v[a][j].y, v[a][j].z, v[a][j].w};
#pragma unroll
            for (int i = 0; i < 4; ++i) { f[8 * j + 2 * i] = bf_lo(w[i]); f[8 * j + 2 * i + 1] = bf_hi(w[i]); } }
#pragma unroll
        for (int i = 0; i < 32; ++i) { ss += f[i] * f[i]; mx = fmaxf(mx, fabsf(f[i])); }
        mx = wave_max(mx); const float st = mx > 0.f ? mx * (1.f / 127.f) : 1.f, inv = 1.f / st;
        float rs = 1.f; if (NORM) rs = rsqrtf(wave_sum(ss) * (1.f / 2048.f) + EPS);
#pragma unroll
        for (int j = 0; j < 4; ++j) { u32x2 o;
#pragma unroll
            for (int h2 = 0; h2 < 2; ++h2) { unsigned wd = 0;
#pragma unroll
                for (int i = 0; i < 4; ++i) wd |= ((unsigned)((int)rintf(f[8 * j + 4 * h2 + i] * inv) & 0xff)) << (8 * i);
                if (h2 == 0) o.x = wd; else o.y = wd; }
            *(u32x2*)(dstq + (size_t)(row0 + a) * 2048 + 8 * lane + 512 * j) = o; }
        if (lane == 0) { rq[row0 + a] = rs * st; if (NORM && rstd_out) rstd_out[row0 + a] = rs; } }
}
__device__ __forceinline__ void tr_strip(const float* W, int ldw, const float* gk, bf16_t* WT, int n0, LAS unsigned char* lds, int wave, int lane) {
    const int c4 = lane & 7, kr = lane >> 3;
    const float* wp = W + (size_t)(256 * wave + 4 * kr) * ldw + n0 + 4 * c4; const float* gp = gk + 256 * wave + 4 * kr;
    LAS unsigned char* tb = lds + wave * 16384;
#pragma unroll 4
    for (int i = 0; i < 8; ++i) { f32x4 v[4]; f32x4 g4 = {1.f, 1.f, 1.f, 1.f}; if (gk) g4 = *(const f32x4*)(gp + 32 * i);
#pragma unroll
        for (int j = 0; j < 4; ++j) v[j] = __builtin_nontemporal_load((const f32x4*)(wp + (size_t)(32 * i + j) * ldw));
#pragma unroll
        for (int e = 0; e < 4; ++e) { const int n = 4 * c4 + e; u32x2 w2; w2.x = cvtpk(v[0][e] * g4[0], v[1][e] * g4[1]); w2.y = cvtpk(v[2][e] * g4[2], v[3][e] * g4[3]);
            const int ch = (4 * i + (kr >> 1)) ^ n;
            *(LAS u32x2*)(tb + n * 512 + (ch << 4) + ((kr & 1) << 3)) = w2; } }
    asm volatile("s_waitcnt lgkmcnt(0)" ::: "memory");
#pragma unroll 4
    for (int r = 0; r < 16; ++r) { const int id = lane + 64 * r, n = id >> 5, ch = id & 31;
        *(u32x4*)(WT + (size_t)(n0 + n) * 2048 + 256 * wave + 8 * ch) = *(const LAS u32x4*)(tb + n * 512 + ((ch ^ n) << 4)); }
    asm volatile("s_waitcnt lgkmcnt(0)" ::: "memory");
}

namespace att {
constexpr int DQ = 192, DV = 128, KVBLK = 64, QBLK = 32;
constexpr int LDQ = 1536, LDV = 1024, LDO = 2048;
constexpr int SHM_V = KVBLK * DV * 2, SHM_K = KVBLK * DQ * 2;
constexpr float SCALE = 0.07216878364870322f;
constexpr float THR = 8.f;
#define KSWZ(row, colB) ((row) * 384 + ((colB) ^ ((((row) >> 1) & 7) << 4)))
#define SBAR() __builtin_amdgcn_sched_barrier(0)
__device__ __forceinline__ int crow(int r, int hi) { return (r & 3) + 8 * (r >> 2) + 4 * hi; }
__device__ __forceinline__ void partialSM(f32x16& p0, f32x16& p1, float& m_reg, float& alpha) {
    constexpr float C = SCALE * 1.4426950408889634f;
    float pmax = p0[0];
#pragma unroll
    for (int r = 1; r < 16; ++r) pmax = fmaxf(pmax, p0[r]);
#pragma unroll
    for (int r = 0; r < 16; ++r) pmax = fmaxf(pmax, p1[r]);
    { auto rr = __builtin_amdgcn_permlane32_swap(__float_as_uint(pmax), __float_as_uint(pmax), false, false);
      pmax = fmaxf(__uint_as_float(rr[0]), __uint_as_float(rr[1])); }
    float mn;
    if (__builtin_expect(__all(pmax - m_reg <= THR / SCALE), 1)) { mn = m_reg; alpha = 1.f; }
    else { mn = fmaxf(m_reg, pmax); alpha = __builtin_amdgcn_exp2f((m_reg - mn) * C); m_reg = mn; }
    const float mnC = -mn * C;
#pragma unroll
    for (int r = 0; r < 16; ++r) { p0[r] = __builtin_amdgcn_exp2f(fmaf(p0[r], C, mnC)); p1[r] = __builtin_amdgcn_exp2f(fmaf(p1[r], C, mnC)); }
}
__device__ __forceinline__ void finishSM(const f32x16& p0, const f32x16& p1, float alpha, float& l_reg, bf16x8& pa0, bf16x8& pa1, bf16x8& pa2, bf16x8& pa3) {
    float ps = 0.f;
#pragma unroll
    for (int r = 0; r < 16; ++r) ps += p0[r];
#pragma unroll
    for (int r = 0; r < 16; ++r) ps += p1[r];
    { auto rr = __builtin_amdgcn_permlane32_swap(__float_as_uint(ps), __float_as_uint(ps), false, false);
      ps = __uint_as_float(rr[0]) + __uint_as_float(rr[1]); }
    l_reg = l_reg * alpha + ps;
#define PK4(P, BASE, OUT) do { unsigned a0 = cvtpk(P[BASE + 0], P[BASE + 1]), a1 = cvtpk(P[BASE + 2], P[BASE + 3]);   \
    unsigned b0 = cvtpk(P[BASE + 4], P[BASE + 5]), b1 = cvtpk(P[BASE + 6], P[BASE + 7]);                              \
    auto r0 = __builtin_amdgcn_permlane32_swap(a0, b0, false, false); auto r1 = __builtin_amdgcn_permlane32_swap(a1, b1, false, false); \
    u32x4 w = {r0[0], r1[0], r0[1], r1[1]}; OUT = __builtin_bit_cast(bf16x8, w); } while (0)
    PK4(p0, 0, pa0); PK4(p0, 8, pa1); PK4(p1, 0, pa2); PK4(p1, 8, pa3);
#undef PK4
}
__device__ __forceinline__ void qkt(f32x16& p0, f32x16& p1, const char* Ks, const bf16x8* qr, int r32, int hi) {
    p0 = f32x16{}; p1 = f32x16{};
#pragma unroll
    for (int d0 = 0; d0 < 12; ++d0) { const int cb = (d0 * 16 + hi * 8) * 2;
        const bf16x8 b0 = *reinterpret_cast<const bf16x8*>(Ks + KSWZ(r32, cb));
        const bf16x8 b1 = *reinterpret_cast<const bf16x8*>(Ks + KSWZ(32 + r32, cb));
        p0 = __builtin_amdgcn_mfma_f32_32x32x16_bf16(b0, qr[d0], p0, 0, 0, 0);
        p1 = __builtin_amdgcn_mfma_f32_32x32x16_bf16(b1, qr[d0], p1, 0, 0, 0); }
}
__device__ __forceinline__ int v_st(int k, int c) { const int kk = (k & ~0xC) | ((k & 4) << 1) | ((k & 8) >> 1); return ((kk >> 3) * 4 + (c >> 5)) * 512 + ((kk & 7) * 32 + (c & 31)) * 2; }
__device__ __forceinline__ int v_rd_base(int lane) { return ((lane & 3) << 3) | (((lane >> 2) & 3) << 6) | (((lane >> 4) & 1) << 5) | (((lane >> 5) & 1) << 8); }
constexpr int v_rd_off(int d0, int ks, int half) { return d0 * 512 + ks * 4096 + half * 2048; }
template <int OFF> __device__ __forceinline__ s16x4 tr_read(int vb) {
    s16x4 r; asm volatile("ds_read_b64_tr_b16 %0, %1 offset:%2" : "=&v"(r) : "v"(vb), "i"(OFF) : "memory"); return r;
}
template <int D0> __device__ __forceinline__ void pv_one(f32x16& od, int vb, bf16x8 pa0, bf16x8 pa1, bf16x8 pa2, bf16x8 pa3) {
    const s16x4 l0 = tr_read<v_rd_off(D0, 0, 0)>(vb), h0 = tr_read<v_rd_off(D0, 0, 1)>(vb), l1 = tr_read<v_rd_off(D0, 1, 0)>(vb), h1 = tr_read<v_rd_off(D0, 1, 1)>(vb);
    const s16x4 l2 = tr_read<v_rd_off(D0, 2, 0)>(vb), h2 = tr_read<v_rd_off(D0, 2, 1)>(vb), l3 = tr_read<v_rd_off(D0, 3, 0)>(vb), h3 = tr_read<v_rd_off(D0, 3, 1)>(vb);
    asm volatile("s_waitcnt lgkmcnt(0)" ::: "memory"); SBAR();
#define PK(L, H) (bf16x8){L[0], L[1], L[2], L[3], H[0], H[1], H[2], H[3]}
    od = __builtin_amdgcn_mfma_f32_32x32x16_bf16(pa0, PK(l0, h0), od, 0, 0, 0);
    od = __builtin_amdgcn_mfma_f32_32x32x16_bf16(pa1, PK(l1, h1), od, 0, 0, 0);
    od = __builtin_amdgcn_mfma_f32_32x32x16_bf16(pa2, PK(l2, h2), od, 0, 0, 0);
    od = __builtin_amdgcn_mfma_f32_32x32x16_bf16(pa3, PK(l3, h3), od, 0, 0, 0);
#undef PK
}
__device__ __forceinline__ void attn_unit(int b, int h, int qt, const bf16_t* Q, const bf16_t* K, const bf16_t* V, bf16_t* Y, char* lds, LAS unsigned char* ldsl, int wave0) {
    int tid = tid_of(wave0); asm volatile("" : "+v"(tid)); const int lane = tid & 63, r32 = lane & 31, hi = lane >> 5; const int wid = __builtin_amdgcn_readfirstlane(tid >> 6);
    char* V_lds = lds; char* K_lds = lds + 3 * SHM_V;
    float* ws = (float*)(lds + 3 * SHM_V + 3 * SHM_K) + wid * 64; float* li_l = ws; float* al_l = ws + 32;
    const size_t rowbase = (size_t)b * SEQ;
    const bf16_t* Qw = Q + (rowbase + qt * 256 + wid * QBLK + r32) * LDQ + h * DQ + hi * 8;
    const bf16_t* Kh = K + rowbase * LDQ + h * DQ; const bf16_t* Vh = V + rowbase * LDV + h * DV;
    float m_reg = -1e30f, l_reg = 0.f; f32x16 o[4] = {}; bf16x8 qr[12];
#pragma unroll
    for (int d0 = 0; d0 < 12; ++d0) qr[d0] = *reinterpret_cast<const bf16x8*>(Qw + d0 * 16);
    unsigned koff[3], voff[2];
#pragma unroll
    for (int i = 0; i < 3; ++i) { const int p = (wid * 3 + i) * 64 + lane, row = p / 24, s = p - row * 24; const int sg = (s & ~7) | ((s & 7) ^ ((row >> 1) & 7)); koff[i] = (unsigned)(row * LDQ + sg * 8) * 2u; }
#pragma unroll
    for (int i = 0; i < 2; ++i) { const int p = (wid * 2 + i) * 64 + lane, st = p >> 5, kk = (st >> 2) * 8 + ((p & 31) >> 2), c = (st & 3) * 32 + (p & 3) * 8;
        const int k = (kk & ~0xC) | ((kk & 4) << 1) | ((kk & 8) >> 1); voff[i] = (unsigned)(k * LDV + c) * 2u; }
    const int vb0 = (int)(uintptr_t)V_lds + v_rd_base(lane);
    const int NT = 4 * qt + 4, climit = 4 * qt + (wid >> 1);
#define DMA_TILE(t, sl) do { const char* kg_ = (const char*)Kh + (size_t)(t) * (KVBLK * LDQ * 2); const char* vg_ = (const char*)Vh + (size_t)(t) * (KVBLK * LDV * 2); \
    _Pragma("unroll") for (int i = 0; i < 3; ++i) __builtin_amdgcn_global_load_lds((const unsigned*)(kg_ + koff[i]), (LAS unsigned*)(ldsl + 3 * SHM_V + (sl) * SHM_K + (wid * 3 + i) * 1024), 16, 0, 0); \
    _Pragma("unroll") for (int i = 0; i < 2; ++i) __builtin_amdgcn_global_load_lds((const unsigned*)(vg_ + voff[i]), (LAS unsigned*)(ldsl + (sl) * SHM_V + (wid * 2 + i) * 1024), 16, 0, 0); } while (0)
    f32x16 pA0, pA1, pB0, pB1; float alA = 1.f, alB = 1.f; bf16x8 pa0, pa1, pa2, pa3;
    int sl_k = 0, sl_v = 2, sl_n = 1;
#define RESC(a) do { if (__any((a) < 1.f)) { if (hi == 0) al_l[r32] = (a); asm volatile("s_waitcnt lgkmcnt(0)" ::: "memory"); \
    _Pragma("unroll") for (int d = 0; d < 4; ++d) _Pragma("unroll") for (int r = 0; r < 16; ++r) o[d][r] *= al_l[crow(r, hi)]; } } while (0)
#define ROT() do { const int t_ = sl_v; sl_v = sl_k; sl_k = sl_n; sl_n = t_; } while (0)
#define STEP(j, C0, C1, ALC, P0, P1, ALP) do { \
    if ((j) + 1 < NT) DMA_TILE((j) + 1, sl_n); \
    if ((j) <= climit) { SBAR(); qkt(C0, C1, K_lds + sl_k * SHM_K, qr, r32, hi); } \
    if ((j) >= 1 && (j) - 1 <= climit) { finishSM(P0, P1, ALP, l_reg, pa0, pa1, pa2, pa3); SBAR(); const int vb = vb0 + sl_v * SHM_V; \
        pv_one<0>(o[0], vb, pa0, pa1, pa2, pa3); pv_one<1>(o[1], vb, pa0, pa1, pa2, pa3); pv_one<2>(o[2], vb, pa0, pa1, pa2, pa3); pv_one<3>(o[3], vb, pa0, pa1, pa2, pa3); } \
    if ((j) <= climit) { partialSM(C0, C1, m_reg, ALC); RESC(ALC); } \
    asm volatile("s_waitcnt vmcnt(0)" ::: "memory"); __syncthreads(); ROT(); } while (0)
    DMA_TILE(0, 0); asm volatile("s_waitcnt vmcnt(0)" ::: "memory"); __syncthreads();
    for (int j = 0; j < NT; j += 2) {
        STEP(j, pA0, pA1, alA, pB0, pB1, alB);
        STEP(j + 1, pB0, pB1, alB, pA0, pA1, alA);
    }
    if (NT - 1 <= climit) { finishSM(pB0, pB1, alB, l_reg, pa0, pa1, pa2, pa3); SBAR(); const int vb = vb0 + sl_v * SHM_V;
        pv_one<0>(o[0], vb, pa0, pa1, pa2, pa3); pv_one<1>(o[1], vb, pa0, pa1, pa2, pa3); pv_one<2>(o[2], vb, pa0, pa1, pa2, pa3); pv_one<3>(o[3], vb, pa0, pa1, pa2, pa3); }
#undef STEP
#undef ROT
#undef RESC
    if (hi == 0) li_l[r32] = l_reg; asm volatile("s_waitcnt lgkmcnt(0)" ::: "memory");
    bf16_t* Ow = Y + (rowbase + qt * 256 + wid * QBLK) * LDO + 1024 + h * DV;
#pragma unroll
    for (int r = 0; r < 16; ++r) { const int orow = crow(r, hi); const float rl = __builtin_amdgcn_rcpf(li_l[orow]);
#pragma unroll
        for (int d0 = 0; d0 < 4; ++d0) Ow[(size_t)orow * LDO + d0 * 32 + r32] = (bf16_t)(cvtpk(o[d0][r] * rl, 0.f) & 0xffffu); }
    __syncthreads();
#undef DMA_TILE
}
#undef SBAR
}


__device__ __forceinline__ float dot2bf(unsigned a, unsigned b, float c) {
    return __builtin_amdgcn_fdot2_f32_bf16(__builtin_bit_cast(bf16x2_t, a), __builtin_bit_cast(bf16x2_t, b), c, false); }
__device__ __forceinline__ float gelu_tanh(float x) {
    const float y = 0.7978845608028654f * (x + 0.044715f * x * x * x);
    const float t = __builtin_amdgcn_exp2f(2.8853900817779268f * y);
    return 0.5f * x * (2.f - 2.f * __builtin_amdgcn_rcpf(t + 1.f));
}

#ifndef DBG_ONLY
#define DBG_ONLY -1
#endif
#define PH(n) (DBG_ONLY < 0 || DBG_ONLY == (n))
#ifndef DBG_STOP
#define DBG_STOP 99

#endif

__global__ void __launch_bounds__(NWAVES * 64, 2) fwd_kernel(Args args) {
    extern __shared__ __attribute__((aligned(16))) unsigned char lds_raw[];
    LAS unsigned char* lds = (LAS unsigned char*)lds_raw;
    LAS unsigned char* eps = lds + EPI_OFF;
    volatile LAS unsigned* MISC = (volatile LAS unsigned*)(lds + MISC_OFF);
    const int wave0 = __builtin_amdgcn_readfirstlane((int)threadIdx.x >> 6);
    const int G = gridDim.x, bx = blockIdx.x, vcu = (G % 8 == 0) ? (bx % 8) * (G / 8) + bx / 8 : bx;
    const int NGW = G * NWAVES; const long NGT = (long)G * 512;
#define PHASE_IDS() int tid = tid_of(wave0); asm volatile("" : "+v"(tid)); const int lane = tid & 63, wave = __builtin_amdgcn_readfirstlane(tid >> 6); const int gw = vcu * NWAVES + wave; const long gt = (long)vcu * 512 + tid; (void)lane; (void)gw; (void)gt
    for (int u = threadIdx.x; u < (LDS_BYTES - LDSCTL_OFF) / 4; u += NWAVES * 64) ((LAS unsigned*)(lds + LDSCTL_OFF))[u] = 0u;
    __syncthreads();
#ifdef TIMING
    unsigned long long ts_prev = __builtin_amdgcn_s_memrealtime(); float ts_val = 0.f; int ts_idx = 0;
#define STAMP() do { const unsigned long long now_ = __builtin_amdgcn_s_memrealtime(); if (ts_idx == TIMING) ts_val = (float)(now_ - ts_prev) * 0.0001f; ts_prev = now_; ++ts_idx; } while (0)
#else
#define STAMP() do {} while (0)
#endif
    XcdBarrier bar;
    { KArgsP ka = kargs(); unsigned char* ws = ka->ws; bar = xcd_barrier_post((unsigned*)(ws + WS_CTL) + 4096, MISC + 8, wave0); }

    if (PH(0)) {
        KArgsP ka = kargs(); unsigned char* ws = ka->ws;
        const float* x = IN_F(0); const float* p_in = IN_F(1); const int* positions = (const int*)ka->in[2];
        const float* mix_gain = IN_F(3); const float* w_in = IN_F(4); const float* w_pool = IN_F(5); const float* pool_scale = IN_F(6);
        const float* q_lat_gain = IN_F(7); const float* kv_lat_gain = IN_F(8); const float* w_uq = IN_F(9); const float* w_ukv = IN_F(10);
        const float* w_out = IN_F(13); const float* w_pq = IN_F(15); const float* sub_k1 = IN_F(16); const float* sub_k2 = IN_F(17);
        const float* expert_u = IN_F(18); const float* expert_v = IN_F(19); const float* ple_gain = IN_F(20); const float* w_ple_gate = IN_F(21); const float* w_ple_proj = IN_F(22);
        bf16_t* WIN = (bf16_t*)WSP(WS_WIN); bf16_t* WPOOL = (bf16_t*)WSP(WS_WPOOL); bf16_t* SKB = (bf16_t*)WSP(WS_SK); bf16_t* WUQ = (bf16_t*)WSP(WS_WUQ); bf16_t* WUKV = (bf16_t*)WSP(WS_WUKV);
        bf16_t* WOUT = (bf16_t*)WSP(WS_WOUT); bf16_t* WPQ = (bf16_t*)WSP(WS_WPQ); bf16_t* WG = (bf16_t*)WSP(WS_WG); bf16_t* WP = (bf16_t*)WSP(WS_WP); bf16_t* PB = (bf16_t*)WSP(WS_PB);
        float* COS = (float*)WSP(WS_COS); float* SIN = (float*)WSP(WS_SIN); unsigned* EU8 = (unsigned*)WSP(WS_EU); unsigned* EV8 = (unsigned*)WSP(WS_EV); float* SU = (float*)WSP(WS_SU); float* SV = (float*)WSP(WS_SV); float* RSTDX = (float*)WSP(WS_RSTDX); unsigned* XQ = (unsigned*)WSP(WS_XQ);
        PHASE_IDS();
        LAS float* scr = (LAS float*)(lds + wave * 16384);
        (void)p_in; (void)sub_k1; (void)sub_k2; (void)expert_u; (void)expert_v; (void)SKB; (void)PB; (void)EU8; (void)EV8; (void)SU; (void)SV;
        if (bx < 66) i8_strip(w_in, 2112, mix_gain, (unsigned char*)WIN, (float*)WSP(WS_SBW), 32 * bx, lds, wave, lane);
        for (long i = gt; i < 24576 + 32768; i += NGT) {
            const u32x4 z = {0u, 0u, 0u, 0u};
            if (i < 24576) { *(u32x4*)((unsigned char*)WIN + (size_t)2112 * 2048 + i * 16) = z; if (i < 192) ((float*)WSP(WS_SBW))[2112 + i] = 1.f; }
            else { const long j = i - 24576; const int hh = (int)(j >> 12), rem = (int)(j & 4095); *(u32x4*)(WUQ + ((size_t)hh * 256 + 192) * 512 + (size_t)rem * 8) = z; }
        }
        for (int m = 2 * gw; m < M; m += 2 * NGW) {
            f32x4 v[2][8]; float s[2] = {0.f, 0.f}; float mxr[2] = {0.f, 0.f};
#pragma unroll
            for (int a = 0; a < 2; ++a) { const f32x4* xr = (const f32x4*)(x + (size_t)(m + a) * DM) + lane;
#pragma unroll
                for (int j = 0; j < 8; ++j) v[a][j] = __builtin_nontemporal_load(xr + 64 * j); }
#pragma unroll
            for (int a = 0; a < 2; ++a) {
#pragma unroll
                for (int j = 0; j < 8; ++j) { s[a] += sq4(v[a][j]); mxr[a] = fmaxf(mxr[a], fmaxf(fmaxf(fabsf(v[a][j][0]), fabsf(v[a][j][1])), fmaxf(fabsf(v[a][j][2]), fabsf(v[a][j][3])))); }
                const float rs = rsqrtf(wave_sum(s[a]) * (1.f / DM) + EPS);
                const float am = wave_max(mxr[a]), sx = am > 0.f ? am * (1.f / 127.f) : 1.f, ix = 1.f / sx;
                unsigned* q8 = XQ + (size_t)(m + a) * 512 + lane;
#pragma unroll
                for (int j = 0; j < 8; ++j) { const f32x4 t = v[a][j] * ix;
                    q8[64 * j] = ((unsigned)((int)rintf(t[0]) & 0xff)) | (((unsigned)((int)rintf(t[1]) & 0xff)) << 8) | (((unsigned)((int)rintf(t[2]) & 0xff)) << 16) | (((unsigned)((int)rintf(t[3]) & 0xff)) << 24); }
                if (lane == 0) { RSTDX[m + a] = rs * sx; ((float*)WSP(WS_SXA))[m + a] = sx; } }
        }
        for (long i = gt; i < (long)M * 8; i += NGT) {
            const int row = (int)(i >> 3), j0 = 4 * (int)(i & 7); float cv[4], sv_[4];
#pragma unroll
            for (int e = 0; e < 4; ++e) { const int j = j0 + e;
                const float inv = __builtin_amdgcn_exp2f(-(float)j * (13.287712379549449f / 32.f));
                const float ang = (float)positions[row] * inv;
                const float kq = rintf(ang * 0.15915494309189535f);
                float r = fmaf(-kq, 6.2831854820251465f, ang); r = fmaf(-kq, -1.7484555e-7f, r);
                const float rev = r * 0.15915494309189535f;
                cv[e] = __builtin_amdgcn_cosf(rev); sv_[e] = __builtin_amdgcn_sinf(rev); }
            u32x4 w; w.x = cvtpk(cv[0], cv[1]); w.y = cvtpk(cv[2], cv[3]); w.z = cvtpk(sv_[0], sv_[1]); w.w = cvtpk(sv_[2], sv_[3]);
            *(u32x4*)((bf16_t*)COS + i * 8) = w; (void)SIN;
        }
    }
    xcd_barrier(bar); STAMP();
    if (DBG_STOP == 0) return;

    if (PH(1)) {
        KArgsP ka = kargs(); unsigned char* ws = ka->ws;
        bf16_t* XN = (bf16_t*)WSP(WS_XQ); const float* RSTDX = (const float*)WSP(WS_RSTDX); const float* SBW = (const float*)WSP(WS_SBW); bf16_t* WIN = (bf16_t*)WSP(WS_WIN); bf16_t* ZP = (bf16_t*)WSP(WS_ZP); bf16_t* CQ = (bf16_t*)WSP(WS_CQ); bf16_t* CKV = (bf16_t*)WSP(WS_CKV);
        float* SSQ_CQ = (float*)WSP(WS_SSQ_CQ); float* SSQ_CKV = (float*)WSP(WS_SSQ_CKV); bf16_t* KRP = (bf16_t*)WSP(WS_KRP);
#define PHASE_A_SIDE() do { KArgsP kb = kargs(); unsigned char* ws = kb->ws; PHASE_IDS(); LAS float* scr = (LAS float*)(lds + wave * 16384); \
        { const float* eu = (const float*)kb->in[18]; const float* ev = (const float*)kb->in[19]; unsigned* EU8 = (unsigned*)WSP(WS_EU); unsigned* EV8 = (unsigned*)WSP(WS_EV); float* SU = (float*)WSP(WS_SU); float* SV = (float*)WSP(WS_SV); \
          for (int r = gw * 16; r < gw * 16 + 16; r += 4) quant_rows<4>(eu, ev, EU8, EV8, SU, SV, r, lane); } \
        { const float* w_pool = (const float*)kb->in[5]; const float* pool_scale = (const float*)kb->in[6]; const float* q_lat_gain = (const float*)kb->in[7]; const float* kv_lat_gain = (const float*)kb->in[8]; \
          const float* w_uq = (const float*)kb->in[9]; const float* w_ukv = (const float*)kb->in[10]; const float* w_out = (const float*)kb->in[13]; const float* w_pq = (const float*)kb->in[15]; const float* ffn_gain = (const float*)kb->in[14]; \
          const float* ple_gain = (const float*)kb->in[20]; const float* w_ple_gate = (const float*)kb->in[21]; const float* w_ple_proj = (const float*)kb->in[22]; \
          bf16_t* WPOOL = (bf16_t*)WSP(WS_WPOOL); bf16_t* WUQ = (bf16_t*)WSP(WS_WUQ); bf16_t* WUKV = (bf16_t*)WSP(WS_WUKV); bf16_t* WOUT = (bf16_t*)WSP(WS_WOUT); bf16_t* WPQ = (bf16_t*)WSP(WS_WPQ); bf16_t* WG = (bf16_t*)WSP(WS_WG); bf16_t* WP = (bf16_t*)WSP(WS_WP); \
          constexpr int I_POOL = 4 * 4 * 8, I_UQ = 8 * 48, I_UKV = 8 * 64, I_WP = 4 * 64, NITEMS = I_POOL + I_UQ + I_UKV + I_WP; \
          if (vcu < 192) { const int sw = vcu >> 6, sn = vcu & 63; \
            if (sw == 0) i8_strip(w_out, 2048, nullptr, (unsigned char*)WOUT, (float*)WSP(WS_SBO), 32 * sn, lds, wave, lane); else if (sw == 1) i8_strip(w_pq, 2048, ffn_gain, (unsigned char*)WPQ, (float*)WSP(WS_SBQ), 32 * sn, lds, wave, lane); \
            else i8_strip(w_ple_gate, 2048, ple_gain, (unsigned char*)WG, (float*)WSP(WS_SBG), 32 * sn, lds, wave, lane); } \
          auto trp = [&](int r) -> TrP { \
            if (r < I_POOL) { const int g_ = r >> 5; return TrP{w_pool + g_ * 65536, nullptr, pool_scale + g_ * 256, WPOOL + g_ * 65536, 256, 256, 8, r & 31, 0}; } r -= I_POOL; \
            if (r < I_UQ) return TrP{w_uq, q_lat_gain, nullptr, WUQ, 1536, 512, 48, r, 1}; r -= I_UQ; \
            if (r < I_UKV) return TrP{w_ukv, kv_lat_gain, nullptr, WUKV, 2048, 512, 64, r, 0}; r -= I_UKV; \
            return TrP{w_ple_proj, nullptr, nullptr, WP, 2048, 256, 64, r, 0}; }; \
          for (int it = NGW - 1 - gw; it < NITEMS; it += 2 * NGW) { const bool two = it + NGW < NITEMS; const TrP pa = trp(it), pb = trp(two ? it + NGW : it); \
            float va[32], vb[32]; tr_load(pa, va, lane); if (two) tr_load(pb, vb, lane); \
            tr_store(pa, va, scr, lane); if (two) tr_store(pb, vb, scr, lane); } } \
        asm volatile("s_waitcnt vmcnt(0) lgkmcnt(0)" ::: "memory"); __syncthreads(); } while (0)
        if (vcu & 1) PHASE_A_SIDE();
        pg8::Gemm g{XN, WIN, 2048, 2048, 2048}; pg8::StaticOrder S; S.init(M, 2048, G, bx);
        EpiA E{ZP, CQ, CKV, SSQ_CQ, SSQ_CKV, RSTDX, SBW};
        pg8::gemm_phase<EpiA, pg8::StaticOrder, true, true, true>(lds, eps, g, S, E, wave0);
        pg8::Gemm g2{XN, WIN, 2048, 2048, 512}; pg8::QuadOrder<0> S2{vcu};
        EpiKR E2{KRP, RSTDX, SBW};
        pg8::gemm_phase<EpiKR, pg8::QuadOrder<0>, true, true, true>(lds, eps, g2, S2, E2, wave0);
        if (!(vcu & 1)) PHASE_A_SIDE();
#undef PHASE_A_SIDE
    }
    xcd_barrier(bar); STAMP();
    if (DBG_STOP == 1) return;

    if (PH(2)) {
#pragma unroll 1
        for (int st = 0; st < 3; ++st) { const int sel = (vcu & 1) ? 2 - st : st;
          if (sel == 0) {
          { KArgsP ka = kargs(); unsigned char* ws = ka->ws;
          bf16_t* ZP = (bf16_t*)WSP(WS_ZP); bf16_t* WPOOL = (bf16_t*)WSP(WS_WPOOL); bf16_t* UB = (bf16_t*)WSP(WS_U);
          pg8::Gemm gp{ZP, WPOOL, 1024, 256, 256}; pg8::QuadOrder<1> Sp{vcu};
          EpiStore Ep{UB, 1024};
          pg8::gemm_phase<EpiStore, pg8::QuadOrder<1>, true>(lds, eps, gp, Sp, Ep, wave0); }
          } else if (sel == 1) {
          { KArgsP ka = kargs(); unsigned char* ws = ka->ws; const float* q_norm_gain = IN_F(11);
          bf16_t* CQ = (bf16_t*)WSP(WS_CQ); bf16_t* WUQ = (bf16_t*)WSP(WS_WUQ); bf16_t* QB = (bf16_t*)WSP(WS_Q);
          float* SSQ_CQ = (float*)WSP(WS_SSQ_CQ); float* COS = (float*)WSP(WS_COS); float* SIN = (float*)WSP(WS_SIN);
          pg8::Gemm gq{CQ, WUQ, 512, 512, 512}; pg8::StaticOrder Sq; Sq.init(M, 2048, G, bx);
          EpiQ Eq{QB, SSQ_CQ, q_norm_gain, COS, SIN};
          pg8::gemm_phase<EpiQ, pg8::StaticOrder, true>(lds, eps, gq, Sq, Eq, wave0); }
          } else {
          { KArgsP ka = kargs(); unsigned char* ws = ka->ws; const float* k_norm_gain = IN_F(12);
          bf16_t* CKV = (bf16_t*)WSP(WS_CKV); bf16_t* WUKV = (bf16_t*)WSP(WS_WUKV); bf16_t* KB = (bf16_t*)WSP(WS_K); bf16_t* VB = (bf16_t*)WSP(WS_V);
          float* SSQ_CKV = (float*)WSP(WS_SSQ_CKV); bf16_t* KRP = (bf16_t*)WSP(WS_KRP); float* COS = (float*)WSP(WS_COS); float* SIN = (float*)WSP(WS_SIN);
          pg8::Gemm gk{CKV, WUKV, 512, 512, 512}; pg8::StaticOrder Sk; Sk.init(M, 2048, G, bx);
          EpiKV Ek{KB, VB, SSQ_CKV, KRP, k_norm_gain, COS, SIN};
          pg8::gemm_phase<EpiKV, pg8::StaticOrder, true>(lds, eps, gk, Sk, Ek, wave0); }
          }
        }
    }
    xcd_barrier(bar); STAMP();
    if (DBG_STOP == 2) return;

    if (PH(3)) {
        KArgsP ka = kargs(); unsigned char* ws = ka->ws;
        bf16_t* UB = (bf16_t*)WSP(WS_U); bf16_t* YMIX = (bf16_t*)WSP(WS_R1); bf16_t* QB = (bf16_t*)WSP(WS_Q); bf16_t* KB = (bf16_t*)WSP(WS_K); bf16_t* VB = (bf16_t*)WSP(WS_V);
        PHASE_IDS();
        {
            const int g = wave & 3, c0 = (32 * g + (lane & 31)) * 8, row0 = vcu * 64 + 32 * (wave >> 2) + 16 * (lane >> 5);
#define FILT_ACC(OP, V) do { a[0] OP bf_lo((V).x); a[1] OP bf_hi((V).x); a[2] OP bf_lo((V).y); a[3] OP bf_hi((V).y); a[4] OP bf_lo((V).z); a[5] OP bf_hi((V).z); a[6] OP bf_lo((V).w); a[7] OP bf_hi((V).w); } while (0)
#define FILT(W) do { const int tl0 = row0 & (SEQ - 1); const bool hist = tl0 != 0; u32x4 h[(W) + 16]; \
                _Pragma("unroll") for (int j = 0; j < (W) + 16; ++j) { const bool ok = hist || j >= (W); h[j] = *(const u32x4*)(UB + (size_t)(ok ? row0 - (W) + j : row0) * 1024 + c0); if (!ok) h[j] = (u32x4){0u, 0u, 0u, 0u}; } \
                float a[8]; _Pragma("unroll") for (int e = 0; e < 8; ++e) a[e] = 0.f; \
                _Pragma("unroll") for (int j = 0; j < (W); ++j) FILT_ACC(+=, h[j]); \
                _Pragma("unroll") for (int rI = 0; rI < 16; ++rI) { const int row = row0 + rI, tl = tl0 + rI; const int cnt = (tl + 1 < (W)) ? tl + 1 : (W); const u32x4 cur = h[(W) + rI]; \
                    FILT_ACC(+=, cur); FILT_ACC(-=, h[rI]); \
                    const float ic = 1.f / (float)cnt; u32x4 o; \
                    o.x = cvtpk(a[0] * ic - bf_lo(cur.x), a[1] * ic - bf_hi(cur.x)); o.y = cvtpk(a[2] * ic - bf_lo(cur.y), a[3] * ic - bf_hi(cur.y)); \
                    o.z = cvtpk(a[4] * ic - bf_lo(cur.z), a[5] * ic - bf_hi(cur.z)); o.w = cvtpk(a[6] * ic - bf_lo(cur.w), a[7] * ic - bf_hi(cur.w)); \
                    *(u32x4*)(YMIX + (size_t)row * DM + c0) = o; } } while (0)
            if (g == 0) FILT(2); else if (g == 1) FILT(4); else if (g == 2) FILT(8); else FILT(16);
#undef FILT
#undef FILT_ACC
        }
        if (G == 256) {
            const int bh = vcu >> 2, s = vcu & 3;
            att::attn_unit(bh >> 3, bh & 7, s, QB, KB, VB, YMIX, (char*)lds_raw, lds, wave0);
            att::attn_unit(bh >> 3, bh & 7, 7 - s, QB, KB, VB, YMIX, (char*)lds_raw, lds, wave0);
        }
    }
    xcd_barrier(bar);
    if (PH(3)) { KArgsP kc = kargs(); unsigned char* ws = kc->ws; PHASE_IDS();
        const bf16_t* YMIX = (const bf16_t*)WSP(WS_R1); unsigned char* YQ = WSP(WS_YQ); float* SY = (float*)WSP(WS_SY);
        for (int r = gw * 8; r < M; r += NGW * 8) { quant_act_rows<4, false>(YMIX, YQ, SY, nullptr, r, lane); quant_act_rows<4, false>(YMIX, YQ, SY, nullptr, r + 4, lane); } }
    xcd_barrier(bar); STAMP();
    if (DBG_STOP == 3) return;

    if (PH(4)) {
        KArgsP ka = kargs(); unsigned char* ws = ka->ws; const float* x = IN_F(0); bf16_t* H1B = (bf16_t*)WSP(WS_H2B);
        bf16_t* YQ = (bf16_t*)WSP(WS_YQ); bf16_t* WOUT = (bf16_t*)WSP(WS_WOUT);
        pg8::Gemm g{YQ, WOUT, 2048, 2048, 2048}; pg8::StaticOrder S; S.init(M, 2048, G, bx);
        EpiH1 E{(const unsigned char*)WSP(WS_XQ), (const float*)WSP(WS_SXA), H1B, (const float*)WSP(WS_SY), (const float*)WSP(WS_SBO)}; (void)x;
        pg8::gemm_phase<EpiH1, pg8::StaticOrder, true, true, true>(lds, eps, g, S, E, wave0);
    }
    xcd_barrier(bar);
    if (PH(4)) { KArgsP kc = kargs(); unsigned char* ws = kc->ws; PHASE_IDS();
        const bf16_t* H1B = (const bf16_t*)WSP(WS_H2B); unsigned char* H1Q = WSP(WS_H1Q); float* RQ2 = (float*)WSP(WS_RQ2); float* RSTD2 = (float*)WSP(WS_RSTD2);
        for (int r = gw * 8; r < M; r += NGW * 8) { quant_act_rows<4, true>(H1B, H1Q, RQ2, RSTD2, r, lane); quant_act_rows<4, true>(H1B, H1Q, RQ2, RSTD2, r + 4, lane); } }
    xcd_barrier(bar); STAMP();
    if (DBG_STOP == 4) return;

    if (PH(5)) {
        KArgsP ka = kargs(); unsigned char* ws = ka->ws;
        bf16_t* H1Q = (bf16_t*)WSP(WS_H1Q); bf16_t* WPQ = (bf16_t*)WSP(WS_WPQ); bf16_t* QP = (bf16_t*)WSP(WS_R1);
        pg8::Gemm g{H1Q, WPQ, 2048, 2048, 2048}; pg8::PairOrder S{vcu};
        EpiQP E{QP, (const float*)WSP(WS_RQ2), (const float*)WSP(WS_SBQ)};
        pg8::gemm_phase<EpiQP, pg8::PairOrder, true, true, true>(lds, eps, g, S, E, wave0);
    }
    asm volatile("s_waitcnt vmcnt(0)" ::: "memory"); __syncthreads();
    if (tid_of(wave0) == 0) { __builtin_amdgcn_fence(__ATOMIC_ACQUIRE, "agent"); asm volatile("s_waitcnt vmcnt(0)" ::: "memory"); }
    __syncthreads(); STAMP();
    if (DBG_STOP == 5) return;

    if (PH(6)) {
        KArgsP ka = kargs(); unsigned char* ws = ka->ws;
        bf16_t* QP = (bf16_t*)WSP(WS_R1); bf16_t* SKB = (bf16_t*)WSP(WS_SK); int* PIDX = (int*)WSP(WS_PIDX); float* PGATE = (float*)WSP(WS_PGATE);
        PHASE_IDS();
        LAS unsigned char* SKL = lds;
        LAS float* SC = (LAS float*)(lds + 65536 + wave * 10816);
        LAS float* TKV = (LAS float*)(lds + 65536 + wave * 10816 + 8256);
        LAS unsigned char* TKI = lds + 65536 + wave * 10816 + 8256 + 2048;
        const int fr = lane & 15, fq = lane >> 4; const int h = vcu & 7;
#pragma unroll
        for (int i = 0; i < 8; ++i) { const int p = tid + 512 * i, side = p >> 11, key = (p >> 4) & 127, c = p & 15;
            const u32x4 v = *(const u32x4*)(SKB + (size_t)side * 131072 + (size_t)h * 16384 + key * 128 + c * 8);
            *(LAS u32x4*)(SKL + side * 32768 + key * 256 + ((c ^ (key & 15)) << 4)) = v; }
        __syncthreads();
        for (int bi = 0; bi < 4; ++bi) {
            const int tb = (vcu >> 3) * 32 + wave * 4 + bi, t0 = tb * 16;
#pragma unroll 1
            for (int side = 0; side < 2; ++side) {
                bf16x8 qf[4];
#pragma unroll
                for (int kk = 0; kk < 4; ++kk) qf[kk] = *(const bf16x8*)(QP + (size_t)(t0 + fr) * DM + h * 256 + side * 128 + kk * 32 + 8 * fq);
                const LAS unsigned char* skl = SKL + side * 32768 + fr * 256;
#pragma unroll
                for (int nt = 0; nt < 8; ++nt) { f32x4 a = {0.f, 0.f, 0.f, 0.f};
#pragma unroll
                    for (int kk = 0; kk < 4; ++kk) { const bf16x8 kf = *(const LAS bf16x8*)(skl + nt * 4096 + (((kk * 4 + fq) ^ fr) << 4));
                        a = __builtin_amdgcn_mfma_f32_16x16x32_bf16(kf, qf[kk], a, 0, 0, 0); }
#pragma unroll
                    for (int i = 0; i < 4; ++i) SC[fr * 129 + nt * 16 + 4 * fq + i] = a[i]; }
                asm volatile("s_waitcnt lgkmcnt(0)" ::: "memory");
                const int tok = lane >> 2, q4 = lane & 3; float v[32];
#pragma unroll
                for (int i = 0; i < 32; ++i) v[i] = __builtin_bit_cast(float, (__builtin_bit_cast(unsigned, SC[tok * 129 + 4 * i + q4]) & ~0x7Fu) | (unsigned)(4 * i + q4));
                bitonic_sort_desc<32>(v); QUAD_MERGE16(v, 0xB1); QUAD_MERGE16(v, 0x4E);
                if (q4 == 0) {
#pragma unroll
                    for (int r = 0; r < 16; ++r) { const int bk = (int)(__builtin_bit_cast(unsigned, v[r]) & 0x7Fu); TKV[(side * 16 + tok) * 16 + r] = SC[tok * 129 + bk]; TKI[(side * 16 + tok) * 16 + r] = (unsigned char)bk; } }
                asm volatile("s_waitcnt lgkmcnt(0)" ::: "memory");
            }
            {
                const int tok = lane >> 2, q4 = lane & 3; float c[32];
                const LAS float* V1 = TKV + tok * 16; const LAS float* V2 = TKV + (16 + tok) * 16;
#define CAND(slot, a, bi) do { const int b_ = q4 + 4 * (bi); const float s_ = V1[a] + V2[b_]; \
    c[slot] = (((a) + 1) * (b_ + 1) <= 16) ? __builtin_bit_cast(float, (__builtin_bit_cast(unsigned, s_) & ~0xFFu) | (unsigned)((a) * 16 + b_)) : -INFINITY; } while (0)
                CAND(0, 0, 0); CAND(1, 0, 1); CAND(2, 0, 2); CAND(3, 0, 3); CAND(4, 1, 0); CAND(5, 1, 1); CAND(6, 2, 0); CAND(7, 2, 1);
                CAND(8, 3, 0); CAND(9, 4, 0); CAND(10, 5, 0); CAND(11, 6, 0); CAND(12, 7, 0); CAND(13, 8, 0); CAND(14, 9, 0); CAND(15, 10, 0);
                CAND(16, 11, 0); CAND(17, 12, 0); CAND(18, 13, 0); CAND(19, 14, 0); CAND(20, 15, 0);
#undef CAND
#pragma unroll
                for (int i = 21; i < 32; ++i) c[i] = -INFINITY;
                bitonic_sort_desc<32>(c); QUAD_MERGE16(c, 0xB1); QUAD_MERGE16(c, 0x4E);
                int co[4];
#pragma unroll
                for (int ri = 0; ri < 4; ++ri) { const float x_ = q4 == 0 ? c[4 * ri] : q4 == 1 ? c[4 * ri + 1] : q4 == 2 ? c[4 * ri + 2] : c[4 * ri + 3]; co[ri] = (int)(__builtin_bit_cast(unsigned, x_) & 0xFFu); }
                float sv[4]; float mx = -INFINITY;
#pragma unroll
                for (int ri = 0; ri < 4; ++ri) { sv[ri] = V1[co[ri] >> 4] + V2[co[ri] & 15]; mx = fmaxf(mx, sv[ri]); }
                mx = quad_max(mx);
                float eo[4]; float esum = 0.f;
#pragma unroll
                for (int ri = 0; ri < 4; ++ri) { eo[ri] = __builtin_amdgcn_exp2f((sv[ri] - mx) * 1.4426950408889634f); esum += eo[ri]; }
                esum = quad_sum(esum);
                const float inv = 1.f / esum;
#pragma unroll
                for (int ri = 0; ri < 4; ++ri) { const int e1 = (int)TKI[tok * 16 + (co[ri] >> 4)], e2 = (int)TKI[(16 + tok) * 16 + (co[ri] & 15)];
                    const size_t oi = (size_t)(t0 + tok) * 128 + h * 16 + 4 * ri + q4;
                    PIDX[oi] = e1 * 128 + e2; PGATE[oi] = eo[ri] * inv; }
            }
            asm volatile("s_waitcnt lgkmcnt(0)" ::: "memory");
        }
    }
    xcd_barrier(bar); STAMP();
    if (DBG_STOP == 6) return;


    if (PH(7)) {
        PHASE_IDS();
        const int xc = bx & 7, wl = (bx >> 3) * NWAVES + wave;
        const int gi = lane >> 3, cj = lane & 7; const unsigned cj16 = 16u * (unsigned)cj;
        const int tpw = M / ((G >> 3) * NWAVES);
        {
            KArgsP ka = kargs(); unsigned char* ws = ka->ws;
            const bf16_t* H1B = (const bf16_t*)WSP(WS_H2B); const unsigned char* TU = WSP(WS_EU); const int* PIDX = (const int*)WSP(WS_PIDX); const float* ffn_gain = IN_F(14);
            LAS unsigned char* xl = lds + wave * 8448; LAS float* xs = (LAS float*)(xl + 8192);
#define F1_LOADIDX(n_, EV) do { const int nn_ = (n_) < tpw ? (n_) : tpw - 1; const size_t t_ = (size_t)(wl * tpw + nn_); \
        _Pragma("unroll") for (int q = 0; q < 4; ++q) EV[q] = *(const u32x4*)(PIDX + t_ * 128 + 16 * gi + 4 * q); } while (0)
#define F1_GATHER(EV, UU) do { _Pragma("unroll") for (int q = 0; q < 4; ++q) { UU[4 * q] = *(const u32x4*)(tus + ((EV[q].x << 7) | cj16)); UU[4 * q + 1] = *(const u32x4*)(tus + ((EV[q].y << 7) | cj16)); \
        UU[4 * q + 2] = *(const u32x4*)(tus + ((EV[q].z << 7) | cj16)); UU[4 * q + 3] = *(const u32x4*)(tus + ((EV[q].w << 7) | cj16)); } } while (0)
#define F1_COMPUTE(n_, UU) do { const u32x4 xq = *(const LAS u32x4*)(xl + (n_) * 128 + cj16); const float sx = xs[(n_)]; f32x4 pr[4]; \
        _Pragma("unroll") for (int g = 0; g < 16; ++g) { int d = __builtin_amdgcn_sdot4((int)UU[g].x, (int)xq.x, 0, false); d = __builtin_amdgcn_sdot4((int)UU[g].y, (int)xq.y, d, false); \
            d = __builtin_amdgcn_sdot4((int)UU[g].z, (int)xq.z, d, false); d = __builtin_amdgcn_sdot4((int)UU[g].w, (int)xq.w, d, false); pr[g >> 2][g & 3] = (float)oct_sum_i(d) * sx; } \
        if (cj == 0) { bf16_t* po = PART + (size_t)(wl * tpw + (n_)) * 128 + 16 * gi; __builtin_nontemporal_store(pack8(pr[0], pr[1]), (u32x4*)po); __builtin_nontemporal_store(pack8(pr[2], pr[3]), (u32x4*)(po + 8)); } } while (0)
#pragma unroll 1
            for (int p = 0; p < 2; ++p) {
                const int s = 2 * xc + p; const unsigned char* tus = TU + (size_t)s * (16384 * 128);
                bf16_t* PART = (bf16_t*)(p == 0 ? WSP(WS_PART0) : WSP(WS_PART1)) + (size_t)xc * M * 128;
                {
                    float gsl[16];
#pragma unroll
                    for (int i = 0; i < 16; ++i) gsl[i] = ffn_gain[128 * s + 16 * cj + i];
#pragma unroll 2
                    for (int o = 0; o < tpw; o += 8) { const size_t t_ = (size_t)(wl * tpw + o + gi);
                        const u32x4 XA = *(const u32x4*)(H1B + t_ * DM + 128 * s + 16 * cj), XB = *(const u32x4*)(H1B + t_ * DM + 128 * s + 16 * cj + 8);
                        const unsigned xw[8] = {XA.x, XA.y, XA.z, XA.w, XB.x, XB.y, XB.z, XB.w}; float xf[16]; float mx = 0.f;
#pragma unroll
                        for (int i = 0; i < 8; ++i) { xf[2 * i] = bf_lo(xw[i]) * gsl[2 * i]; xf[2 * i + 1] = bf_hi(xw[i]) * gsl[2 * i + 1]; mx = fmaxf(mx, fmaxf(fabsf(xf[2 * i]), fabsf(xf[2 * i + 1]))); }
                        mx = oct_max(mx); const float sx = mx > 0.f ? mx * (1.f / 127.f) : 1.f; const float inv = 1.f / sx; u32x4 xq;
#pragma unroll
                        for (int i = 0; i < 4; ++i) { const int q0 = (int)rintf(xf[4 * i] * inv), q1 = (int)rintf(xf[4 * i + 1] * inv), q2 = (int)rintf(xf[4 * i + 2] * inv), q3 = (int)rintf(xf[4 * i + 3] * inv);
                            xq[i] = (unsigned)(q0 & 0xff) | ((unsigned)(q1 & 0xff) << 8) | ((unsigned)(q2 & 0xff) << 16) | ((unsigned)(q3 & 0xff) << 24); }
                        *(LAS u32x4*)(xl + (o + gi) * 128 + 16 * cj) = xq; if (cj == 0) xs[o + gi] = sx; }
                    asm volatile("s_waitcnt lgkmcnt(0)" ::: "memory");
                }
                u32x4 evA[4], evB[4], uuA[16], uuB[16];
                F1_LOADIDX(0, evA); F1_LOADIDX(1, evB); F1_GATHER(evA, uuA);
#pragma unroll 1
                for (int n = 0; n < tpw; n += 2) {
                    F1_GATHER(evB, uuB); F1_LOADIDX(n + 2, evA); F1_COMPUTE(n, uuA);
                    F1_GATHER(evA, uuA); F1_LOADIDX(n + 3, evB); F1_COMPUTE(n + 1, uuB);
                }
                asm volatile("s_waitcnt lgkmcnt(0)" ::: "memory");
            }
#undef F1_LOADIDX
#undef F1_GATHER
#undef F1_COMPUTE
        }
        xcd_barrier(bar);
        {
            KArgsP ka = kargs(); unsigned char* ws = ka->ws;
            const bf16_t* P0 = (const bf16_t*)WSP(WS_PART0); const bf16_t* P1 = (const bf16_t*)WSP(WS_PART1); const int* PIDX = (const int*)WSP(WS_PIDX); const float* PGATE = (const float*)WSP(WS_PGATE);
            const float* SU = (const float*)WSP(WS_SU); const float* SV = (const float*)WSP(WS_SV); const float* RSTD2 = (const float*)WSP(WS_RSTD2); unsigned* AQ = (unsigned*)WSP(WS_AQ); float* AS = (float*)WSP(WS_AS);
            for (int tp = gw; tp < M / 2; tp += NGW) {
                const int t = 2 * tp + (lane >> 5), li = lane & 31; const size_t i = (size_t)t * 128 + 4 * li;
                f32x4 sum = {0.f, 0.f, 0.f, 0.f};
#pragma unroll
                for (int x8 = 0; x8 < 8; ++x8) { const u32x2 a = __builtin_nontemporal_load((const u32x2*)(P0 + (size_t)x8 * M * 128 + i)), b = __builtin_nontemporal_load((const u32x2*)(P1 + (size_t)x8 * M * 128 + i));
                    sum += (f32x4){bf_lo(a.x), bf_hi(a.x), bf_lo(a.y), bf_hi(a.y)} + (f32x4){bf_lo(b.x), bf_hi(b.x), bf_lo(b.y), bf_hi(b.y)}; }
                const u32x4 e4 = *(const u32x4*)(PIDX + i); const f32x4 g4 = *(const f32x4*)(PGATE + i); const float rs = RSTD2[t];
                const unsigned ee[4] = {e4.x, e4.y, e4.z, e4.w}; float a[4]; float mx = 0.f;
#pragma unroll
                for (int c = 0; c < 4; ++c) { a[c] = gelu_tanh(sum[c] * SU[ee[c]] * rs) * g4[c] * SV[ee[c]]; mx = fmaxf(mx, fabsf(a[c])); }
                mx = oct_max(mx); mx = fmaxf(mx, DPP_F(mx, 0x128)); mx = fmaxf(mx, __shfl_xor(mx, 16));
                const float sc = mx > 0.f ? mx * (1.f / 127.f) : 1.f; const float inv = 1.f / sc;
                const int q0 = (int)rintf(a[0] * inv), q1 = (int)rintf(a[1] * inv), q2 = (int)rintf(a[2] * inv), q3 = (int)rintf(a[3] * inv);
                AQ[(size_t)t * 32 + li] = (unsigned)(q0 & 0xff) | ((unsigned)(q1 & 0xff) << 8) | ((unsigned)(q2 & 0xff) << 16) | ((unsigned)(q3 & 0xff) << 24);
                if (li == 0) AS[t] = sc;
            }
        }
        xcd_barrier(bar);
        {
            KArgsP ka = kargs(); unsigned char* ws = ka->ws;
            const unsigned char* TV = WSP(WS_EV); const int* PIDX = (const int*)WSP(WS_PIDX); const unsigned* AQ = (const unsigned*)WSP(WS_AQ); const float* AS = (const float*)WSP(WS_AS);
            bf16_t* H2B = (bf16_t*)WSP(WS_H2B);
            const int nit = tpw;
#define F3_LOADIDX(it_, EV, AQV) do { const int ii_ = (it_) < nit ? (it_) : nit - 1; const size_t t_ = (size_t)(wl * tpw + (ii_ >> 3) * 8 + gi); const int kb_ = ii_ & 7; \
        _Pragma("unroll") for (int q = 0; q < 4; ++q) EV[q] = *(const u32x4*)(PIDX + t_ * 128 + 16 * kb_ + 4 * q); \
        AQV = *(const u32x4*)(AQ + t_ * 32 + 4 * kb_); } while (0)
#define F3_GATHER(EV, VV) do { _Pragma("unroll") for (int q = 0; q < 4; ++q) { VV[4 * q] = *(const u32x4*)(tvs + ((EV[q].x << 7) | cj16)); VV[4 * q + 1] = *(const u32x4*)(tvs + ((EV[q].y << 7) | cj16)); \
        VV[4 * q + 2] = *(const u32x4*)(tvs + ((EV[q].z << 7) | cj16)); VV[4 * q + 3] = *(const u32x4*)(tvs + ((EV[q].w << 7) | cj16)); } } while (0)
#define F3_T4(W, Q, R0, R1, R2, R3, AW) do { const unsigned a_ = __builtin_amdgcn_perm(R1, R0, 0x05010400u), b_ = __builtin_amdgcn_perm(R1, R0, 0x07030602u), c_ = __builtin_amdgcn_perm(R3, R2, 0x05010400u), d_ = __builtin_amdgcn_perm(R3, R2, 0x07030602u); \
        acc[4 * (W) + 0] = __builtin_amdgcn_sdot4((int)__builtin_amdgcn_perm(c_, a_, 0x05040100u), (int)(AW), acc[4 * (W) + 0], false); acc[4 * (W) + 1] = __builtin_amdgcn_sdot4((int)__builtin_amdgcn_perm(c_, a_, 0x07060302u), (int)(AW), acc[4 * (W) + 1], false); \
        acc[4 * (W) + 2] = __builtin_amdgcn_sdot4((int)__builtin_amdgcn_perm(d_, b_, 0x05040100u), (int)(AW), acc[4 * (W) + 2], false); acc[4 * (W) + 3] = __builtin_amdgcn_sdot4((int)__builtin_amdgcn_perm(d_, b_, 0x07060302u), (int)(AW), acc[4 * (W) + 3], false); } while (0)
#define F3_Q(Q, VV, AW) do { F3_T4(0, Q, VV[4 * (Q)].x, VV[4 * (Q) + 1].x, VV[4 * (Q) + 2].x, VV[4 * (Q) + 3].x, AW); F3_T4(1, Q, VV[4 * (Q)].y, VV[4 * (Q) + 1].y, VV[4 * (Q) + 2].y, VV[4 * (Q) + 3].y, AW); \
        F3_T4(2, Q, VV[4 * (Q)].z, VV[4 * (Q) + 1].z, VV[4 * (Q) + 2].z, VV[4 * (Q) + 3].z, AW); F3_T4(3, Q, VV[4 * (Q)].w, VV[4 * (Q) + 1].w, VV[4 * (Q) + 2].w, VV[4 * (Q) + 3].w, AW); } while (0)
#define F3_COMPUTE(it_, VV, AQV) do { F3_Q(0, VV, AQV.x); F3_Q(1, VV, AQV.y); F3_Q(2, VV, AQV.z); F3_Q(3, VV, AQV.w); \
        if (((it_) & 7) == 7) { const size_t t_ = (size_t)(wl * tpw + ((it_) >> 3) * 8 + gi); const float as_ = AS[t_]; bf16_t* o = H2B + t_ * DM + 128 * s + 16 * cj; f32x4 hh[4]; float s2 = 0.f; \
            const u32x4 ha_ = *(const u32x4*)o, hb_ = *(const u32x4*)(o + 8); const unsigned hw_[8] = {ha_.x, ha_.y, ha_.z, ha_.w, hb_.x, hb_.y, hb_.z, hb_.w}; \
            _Pragma("unroll") for (int i = 0; i < 4; ++i) { hh[i] = (f32x4){bf_lo(hw_[2 * i]), bf_hi(hw_[2 * i]), bf_lo(hw_[2 * i + 1]), bf_hi(hw_[2 * i + 1])} + (f32x4){(float)acc[4 * i], (float)acc[4 * i + 1], (float)acc[4 * i + 2], (float)acc[4 * i + 3]} * as_; s2 += sq4(hh[i]); } \
            *(u32x4*)o = pack8(hh[0], hh[1]); *(u32x4*)(o + 8) = pack8(hh[2], hh[3]); \
            (void)s2; \
            _Pragma("unroll") for (int i = 0; i < 16; ++i) acc[i] = 0; } } while (0)
#pragma unroll 1
            for (int p = 0; p < 2; ++p) {
                const int s = 2 * xc + p; const unsigned char* tvs = TV + (size_t)s * (16384 * 128);
                u32x4 evA[4], evB[4], vvA[16], vvB[16], aqA, aqB, aqC; int acc[16];
#pragma unroll
                for (int i = 0; i < 16; ++i) acc[i] = 0;
                F3_LOADIDX(0, evA, aqA); F3_LOADIDX(1, evB, aqB); F3_GATHER(evA, vvA);
#pragma unroll 1
                for (int it = 0; it < nit; it += 2) {
                    F3_GATHER(evB, vvB); F3_LOADIDX(it + 2, evA, aqC); F3_COMPUTE(it, vvA, aqA); aqA = aqC;
                    F3_GATHER(evA, vvA); F3_LOADIDX(it + 3, evB, aqC); F3_COMPUTE(it + 1, vvB, aqB); aqB = aqC;
                }
            }
#undef F3_LOADIDX
#undef F3_GATHER
#undef F3_T4
#undef F3_Q
#undef F3_COMPUTE
        }
    }
    xcd_barrier(bar);
    if (PH(7)) { KArgsP kc = kargs(); unsigned char* ws = kc->ws; PHASE_IDS();
        const bf16_t* H2B = (const bf16_t*)WSP(WS_H2B); unsigned char* H2Q = WSP(WS_H2Q); float* RQ3 = (float*)WSP(WS_RQ3);
        for (int r = gw * 8; r < M; r += NGW * 8) { quant_act_rows<4, true>(H2B, H2Q, RQ3, nullptr, r, lane); quant_act_rows<4, true>(H2B, H2Q, RQ3, nullptr, r + 4, lane); } }
    xcd_barrier(bar); STAMP();
    if (DBG_STOP == 7) return;

    if (PH(8)) {
        KArgsP ka = kargs(); unsigned char* ws = ka->ws; float* OUT = ka->out;
        bf16_t* PB = (bf16_t*)WSP(WS_PB); bf16_t* WP = (bf16_t*)WSP(WS_WP); bf16_t* PROJ = (bf16_t*)WSP(WS_R1); bf16_t* H2B = (bf16_t*)WSP(WS_H2B); bf16_t* WG = (bf16_t*)WSP(WS_WG); float* SSQ2 = (float*)WSP(WS_SSQ2);
        pg8::StaticOrder S; S.init(M, 2048, G, bx);
        pg8::Gemm gp{PB, WP, 256, 256, 256};
        EpiStoreQ Ep{(unsigned char*)PROJ, (float*)WSP(WS_PSC)};
        pg8::gemm_phase<EpiStoreQ, pg8::StaticOrder, true>(lds, eps, gp, S, Ep, wave0);
        pg8::Gemm gg{(bf16_t*)WSP(WS_H2Q), WG, 2048, 2048, 2048};
        EpiGate Eg{OUT, (const unsigned char*)PROJ, (const float*)WSP(WS_PSC), (const float*)WSP(WS_RQ3), (const float*)WSP(WS_SBG), H2B};
        pg8::gemm_phase<EpiGate, pg8::StaticOrder, true, true, true>(lds, eps, gg, S, Eg, wave0);
    }
#ifdef TIMING
    xcd_barrier(bar); STAMP();
    if (blockIdx.x == 0 && threadIdx.x == 0) { KArgsP ka = kargs(); float* OUT = ka->out; OUT[0] += ts_val; }
#endif
}

extern "C" void kernel_launch(void* const* d_in, const int* in_sizes, int n_in, void* d_out, int out_size, void* d_ws, size_t ws_size, hipStream_t stream) {
    static int ready = 0;
    if (ready == 0) {
        if (n_in != 23 || out_size != M * DM || ws_size < WS_END) { fprintf(stderr, "kernel_launch: unexpected shapes (n_in %d, out %d, ws %zu)\n", n_in, out_size, ws_size); ready = -1; return; }
        if (hipFuncSetAttribute((const void*)fwd_kernel, hipFuncAttributeMaxDynamicSharedMemorySize, LDS_BYTES) != hipSuccess) { fprintf(stderr, "kernel_launch: hipFuncSetAttribute failed\n"); ready = -1; return; }
        ready = 1;
    }
    if (ready < 0) return;
    (void)hipMemsetAsync((char*)d_ws + WS_CTL, 0, CTL_ZERO_BYTES, stream);
    Args a{};
    for (int i = 0; i < 23; ++i) a.in[i] = (const float*)d_in[i];
    a.out = (float*)d_out; a.ws = (unsigned char*)d_ws;
    hipLaunchKernelGGL(fwd_kernel, dim3(256), dim3(NWAVES * 64), LDS_BYTES, stream, a);
}
```
